# Optimizing an MI355X kernel written in HIP

```python
import math
import jax
import jax.numpy as jnp
from jax import lax
import numpy as np

D_MODEL = 1024
BATCH = 4
SEQ = 4096
DEPTH = 4

GRID_W = 64
CTX_LEN = 256
N_EVEN = (DEPTH + 1) // 2
N_ODD = DEPTH // 2
MIX_WIDTH = D_MODEL
HGRN_WIDTH = MIX_WIDTH // 2
HGRN_HEAD_DIM = 128
HGRN_HEADS = HGRN_WIDTH // HGRN_HEAD_DIM
CHUNK = 64
DIFF_WIDTH = MIX_WIDTH - HGRN_WIDTH
DIFF_HEAD_DIM = 64
DIFF_HEADS = DIFF_WIDTH // (2 * DIFF_HEAD_DIM)
Q_BLOCK = 128
ROPE_THETA = 10000.0
EVEN_IN = 5 * HGRN_WIDTH + 3 * DIFF_WIDTH
CONV_WIDTH = 3
N_EXPERTS = 16
EXPERT_FF = 1024
EC_CAPACITY = 2
MOD_CHUNKS = 6
EPS = 1e-6

kernel_name = "hybrid_hgrn2_diffattn_shortconv_ecmoe_dit"


def rmsnorm(x, g):
    xf = x.astype(jnp.float32)
    y = xf * lax.rsqrt(jnp.mean(xf * xf, axis=-1, keepdims=True) + EPS)
    return y.astype(x.dtype) * g


def modulate(h, shift, scale):
    return h * (1 + scale) + shift


def lambda_init(layer):
    return 0.8 - 0.6 * math.exp(-0.3 * layer)


def _heads(a, n_heads):
    B, T, W = a.shape
    return a.reshape(B, T, n_heads, W // n_heads).transpose(0, 2, 1, 3)


def _rope_axis(x, pos):
    n = x.shape[-1]
    inv = 1.0 / (ROPE_THETA ** (jnp.arange(0, n, 2, dtype=jnp.float32) / n))
    ang = pos.astype(jnp.float32)[:, None] * inv[None, :]
    cos, sin = jnp.cos(ang).astype(x.dtype), jnp.sin(ang).astype(x.dtype)
    x1, x2 = x[..., : n // 2], x[..., n // 2:]
    return jnp.concatenate([x1 * cos - x2 * sin, x2 * cos + x1 * sin], axis=-1)


def rope_2d(x):
    T = x.shape[-2]
    n_rows = T // GRID_W
    rows = jnp.repeat(jnp.arange(n_rows), GRID_W)
    cols = jnp.tile(jnp.arange(GRID_W), n_rows)
    half = x.shape[-1] // 2
    return jnp.concatenate([_rope_axis(x[..., :half], rows), _rope_axis(x[..., half:], cols)], axis=-1)


def gla_chunk_scan(q, k, v, log_f, s0, with_output=True):
    B, H, T, dk = q.shape
    dv = v.shape[-1]
    n_chunks = T // CHUNK

    def to_chunks(a):
        return jnp.moveaxis(a.reshape(B, H, n_chunks, CHUNK, a.shape[-1]), 2, 0)

    lower = jnp.tril(jnp.ones((CHUNK, CHUNK), dtype=bool))[:, :, None]

    def step(s, inp):
        qi, ki, vi, gi = inp
        b = jnp.cumsum(gi, axis=2)
        b_last = b[:, :, -1:, :]
        s_new = (jnp.exp(b_last)[:, :, 0, :, None] * s
                 + jnp.einsum('bhsd,bhse->bhde', ki * jnp.exp(b_last - b), vi))
        if not with_output:
            return s_new, None
        rel = b[:, :, :, None, :] - b[:, :, None, :, :]
        decay = jnp.where(lower, jnp.exp(jnp.where(lower, rel, 0.0)), 0.0)
        scores = jnp.einsum('bhtd,bhtsd,bhsd->bhts', qi, decay, ki)
        o = (jnp.einsum('bhld,bhde->bhle', qi * jnp.exp(b), s)
             + jnp.einsum('bhts,bhse->bhte', scores, vi))
        return s_new, o

    s_final, oc = lax.scan(step, s0, tuple(to_chunks(a) for a in (q, k, v, log_f)))
    if not with_output:
        return None, s_final
    return jnp.moveaxis(oc, 0, 2).reshape(B, H, T, dv), s_final


def hgrn2_direction(q, z, v, lb, qc, zc, vc, reverse, ctx_out):
    def prep(qq, zz, vv):
        zf = zz.astype(jnp.float32)
        log_f = jnp.log(lb + (1 - lb) * jax.nn.sigmoid(zf))
        key = (1 - lb) * jax.nn.sigmoid(-zf)
        arrs = [_heads(a, HGRN_HEADS) for a in (qq.astype(jnp.float32), key, vv.astype(jnp.float32), log_f)]
        return [jnp.flip(a, axis=2) for a in arrs] if reverse else arrs

    B = q.shape[0]
    s0 = jnp.zeros((B, HGRN_HEADS, HGRN_HEAD_DIM, HGRN_HEAD_DIM), jnp.float32)
    oc, s_ctx = gla_chunk_scan(*prep(qc, zc, vc), s0, with_output=ctx_out)
    o, _ = gla_chunk_scan(*prep(q, z, v), s_ctx)
    if reverse:
        o = jnp.flip(o, axis=2)
        oc = jnp.flip(oc, axis=2) if ctx_out else None
    return o, oc


def hgrn2_readout(o, gate, g):
    B, H, T, dv = o.shape
    o = rmsnorm(o, g[:, None, :]).transpose(0, 2, 1, 3).reshape(B, T, H * dv)
    return o.astype(gate.dtype) * jax.nn.silu(gate)


def qk_heads(a, g, rotary):
    B, T, _ = a.shape
    a = rmsnorm(a.reshape(B, T, DIFF_HEADS, 2, DIFF_HEAD_DIM).transpose(0, 2, 3, 1, 4), g)
    return rope_2d(a) if rotary else a


def diff_attend(q, k, v, lam):
    s = jnp.einsum('bhmqd,bhmkd->bhmqk', q, k).astype(jnp.float32)
    p = jax.nn.softmax(s, axis=-1)
    w = p[:, :, 0] - lam * p[:, :, 1]
    return jnp.einsum('bhqk,bhke->bhqe', w.astype(v.dtype), v)


def blocked_diff_attention(q, k_all, v_all, lam):
    B, H, _, T, dh = q.shape
    nb = T // Q_BLOCK
    qb = jnp.moveaxis(q.reshape(B, H, 2, nb, Q_BLOCK, dh), 3, 0)
    ob = lax.map(lambda qi: diff_attend(qi, k_all, v_all, lam), qb)
    return jnp.moveaxis(ob, 0, 2).reshape(B, H, T, 2 * DIFF_HEAD_DIM)


def diff_readout(o, g, lam_init):
    B, H, T, e = o.shape
    o = rmsnorm(o, g) * (1 - lam_init)
    return o.transpose(0, 2, 1, 3).reshape(B, T, H * e)


def even_mixer(h, hc, w_in, w_out, lb, hgrn_g, qn_g, kn_g, lam_vec, subln_g, lam_init, ctx_out):
    cuts = [HGRN_WIDTH * i for i in range(1, 6)] + [5 * HGRN_WIDTH + DIFF_WIDTH * i for i in range(1, 3)]
    hq, hzf, hzb, hv, hgate, dq, dk, dv = jnp.split(h @ w_in, cuts, axis=-1)
    cq, czf, czb, cv, cgate, cdq, cdk, cdv = jnp.split(hc @ w_in, cuts, axis=-1)
    o_f, oc_f = hgrn2_direction(hq, hzf, hv, lb[0], cq, czf, cv, False, ctx_out)
    o_b, oc_b = hgrn2_direction(hq, hzb, hv, lb[1], cq, czb, cv, True, ctx_out)
    y_h = hgrn2_readout(o_f + o_b, hgate, hgrn_g)
    lv = lam_vec.astype(jnp.float32)
    lam = jnp.exp(jnp.sum(lv[0] * lv[1])) - jnp.exp(jnp.sum(lv[2] * lv[3])) + lam_init
    scale = DIFF_HEAD_DIM ** -0.5
    q = qk_heads(dq, qn_g, True) * scale
    k = qk_heads(dk, kn_g, True)
    kc = qk_heads(cdk, kn_g, False)
    v, vc = _heads(dv, DIFF_HEADS), _heads(cdv, DIFF_HEADS)
    k_all = jnp.concatenate([k, kc], axis=3)
    v_all = jnp.concatenate([v, vc], axis=2)
    y_d = diff_readout(blocked_diff_attention(q, k_all, v_all, lam), subln_g, lam_init)
    y = jnp.concatenate([y_h, y_d], axis=-1) @ w_out
    if not ctx_out:
        return y, None
    yc_h = hgrn2_readout(oc_f + oc_b, cgate, hgrn_g)
    qc = qk_heads(cdq, qn_g, False) * scale
    yc_d = diff_readout(diff_attend(qc, kc, vc, lam), subln_g, lam_init)
    yc = jnp.concatenate([yc_h, yc_d], axis=-1) @ w_out
    return y, yc


def short_conv_mixer(h, w_in, conv_w, w_out):
    b_gate, c_gate, v = jnp.split(h @ w_in, 3, axis=-1)
    u = c_gate * v
    y = lax.conv_general_dilated(u, conv_w[:, None, :].astype(u.dtype), window_strides=(1,),
                                 padding=((CONV_WIDTH // 2, CONV_WIDTH // 2),),
                                 dimension_numbers=('NWC', 'WIO', 'NWC'),
                                 feature_group_count=u.shape[-1])
    return (b_gate * y) @ w_out


def expert_choice_ffn(h, router_w, w_gate, w_up, w_down):
    B, N, D = h.shape
    cap = EC_CAPACITY * N // N_EXPERTS
    affinity = jax.nn.softmax((h @ router_w).astype(jnp.float32), axis=-1)
    gate, idx = lax.top_k(jnp.swapaxes(affinity, 1, 2), cap)
    idx_flat = idx.reshape(B, N_EXPERTS * cap)
    xe = jax.vmap(lambda hb, ib: hb[ib])(h, idx_flat).reshape(B, N_EXPERTS, cap, D)
    a = jnp.einsum('becd,edf->becf', xe, w_gate)
    u = jnp.einsum('becd,edf->becf', xe, w_up)
    ye = jnp.einsum('becf,efd->becd', jax.nn.silu(a) * u, w_down) * gate[..., None].astype(h.dtype)
    return jax.vmap(lambda yb, ib: jnp.zeros((N, D), h.dtype).at[ib].add(yb))(
        ye.reshape(B, N_EXPERTS * cap, D), idx_flat)


def setup_inputs(seed: int = 0) -> dict:
    key = jax.random.key(seed)
    ks = jax.random.split(key, 24)
    D = D_MODEL

    def nrm(k, shape, scale):
        return jax.random.normal(k, shape, jnp.float32) * scale

    return {
        "x": nrm(ks[0], (BATCH, SEQ, D), 1.0),
        "c": nrm(ks[1], (BATCH, D), 1.0),
        "ctx": nrm(ks[2], (BATCH, CTX_LEN, D), 1.0),
        "c_ctx": nrm(ks[3], (D,), 1.0),
        "mod_w": nrm(ks[4], (DEPTH, D, MOD_CHUNKS * D), 0.3 * D ** -0.5),
        "mod_b": nrm(ks[5], (DEPTH, MOD_CHUNKS * D), 0.02),
        "norm1_g": 1.0 + nrm(ks[6], (DEPTH, D), 0.02),
        "norm2_g": 1.0 + nrm(ks[7], (DEPTH, D), 0.02),
        "even_w_in": nrm(ks[8], (N_EVEN, D, EVEN_IN), D ** -0.5),
        "even_w_out": nrm(ks[9], (N_EVEN, MIX_WIDTH, D), MIX_WIDTH ** -0.5),
        "hgrn_lb_logits": nrm(ks[10], (N_EVEN, 2, HGRN_WIDTH), 1.0),
        "hgrn_norm_g": 1.0 + nrm(ks[11], (N_EVEN, HGRN_HEADS, HGRN_HEAD_DIM), 0.02),
        "diff_qnorm_g": 1.0 + nrm(ks[12], (N_EVEN, DIFF_HEAD_DIM), 0.02),
        "diff_knorm_g": 1.0 + nrm(ks[13], (N_EVEN, DIFF_HEAD_DIM), 0.02),
        "diff_lambda": nrm(ks[14], (N_EVEN, 4, DIFF_HEAD_DIM), 0.1),
        "diff_subln_g": 1.0 + nrm(ks[15], (N_EVEN, 2 * DIFF_HEAD_DIM), 0.02),
        "conv_w_in": nrm(ks[16], (N_ODD, D, 3 * D), D ** -0.5),
        "conv_w": nrm(ks[17], (N_ODD, CONV_WIDTH, D), CONV_WIDTH ** -0.5),
        "conv_w_out": nrm(ks[18], (N_ODD, D, D), D ** -0.5),
        "router_w": nrm(ks[19], (DEPTH, D, N_EXPERTS), D ** -0.5),
        "exp_w_gate": nrm(ks[20], (DEPTH, N_EXPERTS, D, EXPERT_FF), D ** -0.5),
        "exp_w_up": nrm(ks[21], (DEPTH, N_EXPERTS, D, EXPERT_FF), D ** -0.5),
        "exp_w_down": nrm(ks[22], (DEPTH, N_EXPERTS, EXPERT_FF, D), EXPERT_FF ** -0.5),
    }


def reference(x, c, ctx, c_ctx, mod_w, mod_b, norm1_g, norm2_g, even_w_in, even_w_out,
              hgrn_lb_logits, hgrn_norm_g, diff_qnorm_g, diff_knorm_g, diff_lambda, diff_subln_g,
              conv_w_in, conv_w, conv_w_out, router_w, exp_w_gate, exp_w_up, exp_w_down):
    lb_soft = jax.nn.softmax(hgrn_lb_logits.astype(jnp.float32), axis=0)
    lower_bounds = jnp.cumsum(lb_soft, axis=0) - lb_soft[:1]
    last_ctx_layer = 2 * ((DEPTH - 1) // 2)
    silu_c = jax.nn.silu(c)
    silu_cc = jax.nn.silu(c_ctx)
    xc = ctx
    for l in range(DEPTH):
        read_ctx = l <= last_ctx_layer
        ctx_out = l < last_ctx_layer
        sh1, sc1, g1, sh2, sc2, g2 = jnp.split((silu_c @ mod_w[l] + mod_b[l])[:, None, :], MOD_CHUNKS, axis=-1)
        h = modulate(rmsnorm(x, norm1_g[l]), sh1, sc1)
        if read_ctx:
            csh1, csc1, cg1, csh2, csc2, cg2 = jnp.split(silu_cc @ mod_w[l] + mod_b[l], MOD_CHUNKS, axis=-1)
            hc = modulate(rmsnorm(xc, norm1_g[l]), csh1, csc1)
        if l % 2 == 0:
            e = l // 2
            y, yc = even_mixer(h, hc, even_w_in[e], even_w_out[e], lower_bounds[e], hgrn_norm_g[e],
                               diff_qnorm_g[e], diff_knorm_g[e], diff_lambda[e], diff_subln_g[e],
                               lambda_init(l), ctx_out)
        else:
            j = l // 2
            y = short_conv_mixer(h, conv_w_in[j], conv_w[j], conv_w_out[j])
            yc = short_conv_mixer(hc, conv_w_in[j], conv_w[j], conv_w_out[j]) if ctx_out else None
        x = x + g1 * y
        x = x + g2 * expert_choice_ffn(modulate(rmsnorm(x, norm2_g[l]), sh2, sc2),
                                       router_w[l], exp_w_gate[l], exp_w_up[l], exp_w_down[l])
        if ctx_out:
            xc = xc + cg1 * yc
            xc = xc + cg2 * expert_choice_ffn(modulate(rmsnorm(xc, norm2_g[l]), csh2, csc2),
                                              router_w[l], exp_w_gate[l], exp_w_up[l], exp_w_down[l])
    return x
```

```cpp
#include <hip/hip_runtime.h>
#include <type_traits>
#ifndef DUP_PHASE
#define DUP_PHASE 0
#endif
#include <cstdint>
#include <cstdio>

#define GAS __attribute__((address_space(1)))
#define LAS __attribute__((address_space(3)))
typedef unsigned short bf16;
typedef float f32x4 __attribute__((ext_vector_type(4)));
typedef unsigned u32x4 __attribute__((ext_vector_type(4)));
typedef unsigned u32x2 __attribute__((ext_vector_type(2)));

constexpr int D = 1024, NB = 4, T = 4096, TC = 256, DEPTH = 4;
constexpr int ML = NB * T, MC = NB * TC, MT = ML + MC;
constexpr int NE = 16, FF = 1024, CAP = 512, CAPC = 32;
constexpr int XR = 2304;
constexpr int NTHREADS = 512;
constexpr float EPS = 1e-6f;

constexpr size_t MiB = 1u << 20;
constexpr size_t WS_CTL = 0;
constexpr size_t WS_MODV = 1 * MiB;
constexpr size_t WS_ROPE = WS_MODV + 512 * 1024;
constexpr size_t WS_X = 2 * MiB;
constexpr size_t WS_H = WS_X + (size_t)MT * D * 4;
constexpr size_t WS_H2 = WS_H + (size_t)MT * D * 2;
constexpr size_t WS_PROJ = WS_H2 + (size_t)MT * D * 2;
constexpr size_t WS_MIX = WS_PROJ + (size_t)MT * 4096 * 2;
constexpr size_t WS_OF = WS_MIX + (size_t)MT * D * 2;
constexpr size_t WS_AFF = WS_OF + (size_t)2 * MT * 512 * 4;
constexpr size_t WS_GATE = WS_AFF + 2 * MiB;
constexpr size_t WS_SEL = WS_GATE + 1 * MiB;
constexpr size_t WS_TOKSLOT = WS_SEL + 1 * MiB;
constexpr size_t WS_XE = WS_TOKSLOT + 2 * MiB;
constexpr size_t WS_ACT = WS_XE + (size_t)NE * XR * D * 2;
constexpr size_t WS_YE = WS_ACT + (size_t)NE * XR * D * 2;
constexpr size_t WS_WIN = WS_YE + (size_t)NE * XR * D * 2;
constexpr size_t WS_WOUT = WS_WIN + (size_t)4096 * D * 2;
constexpr size_t WS_WUP = WS_WOUT + (size_t)D * D * 2;
constexpr size_t WS_WDN = WS_WUP + (size_t)NE * 2048 * D * 2;
constexpr int HG_NCH = 68, HG_ITEMS = NB * 4 * 2 * HG_NCH;
constexpr size_t WS_HDS = WS_WDN + (size_t)NE * D * FF * 2;
constexpr size_t WS_HST = WS_HDS + (size_t)HG_ITEMS * 128 * 128 * 2;
constexpr size_t WS_HG = WS_HST + (size_t)HG_ITEMS * 128 * 128 * 2;
constexpr size_t WS_END = WS_HG + (size_t)HG_ITEMS * 128 * 4;

constexpr int LDS_BYTES = 155648;

struct Prm {
    const float *x, *c, *ctx, *c_ctx, *mod_w, *mod_b, *norm1_g, *norm2_g, *even_w_in, *even_w_out, *hgrn_lb, *hgrn_g, *qn_g, *kn_g, *dlam, *subln_g,
        *conv_w_in, *conv_w, *conv_w_out, *router_w, *w_gate, *w_up, *w_down;
    float* out; unsigned char* ws;
};

__device__ __forceinline__ float bf2f(bf16 v) { return __uint_as_float((unsigned)v << 16); }
__device__ __forceinline__ bf16 f2bf(float f) { unsigned u = __float_as_uint(f); return (bf16)((u + 0x7fffu + ((u >> 16) & 1u)) >> 16); }
__device__ __forceinline__ unsigned pk2(float lo, float hi) { return (unsigned)f2bf(lo) | ((unsigned)f2bf(hi) << 16); }
__device__ __forceinline__ float wave_sum(float v) {
#pragma unroll
    for (int o = 1; o < 64; o <<= 1) v += __shfl_xor(v, o);
    return v;
}
__device__ __forceinline__ int otid() { int t = threadIdx.x; asm volatile("" : "+v"(t)); return t; }
__device__ __forceinline__ int obid() { int b = blockIdx.x; asm volatile("" : "+s"(b)); return b; }
__device__ __forceinline__ int vcu_id() { const int G = gridDim.x, bx = obid(); return (G % 8 == 0) ? (bx % 8) * (G / 8) + bx / 8 : bx; }
__device__ __forceinline__ float sigmoidf_(float x) { return 1.f / (1.f + __expf(-x)); }
__device__ __forceinline__ float siluf_(float x) { return x / (1.f + __expf(-x)); }

#define XB_TMO      128
#define XB_XCNT(j)  (256  + 64 * (j))
#define XB_XSUB(j)  (1280 + 64 * (j))
#define XB_XGEN(j)  (2304 + 64 * (j))
#define XB_TOP      3328
#define XB_TOPGEN   3392
#define XCD_BAR_WORDS 3456
#define XB_SPIN_CAP (1u << 28)
__device__ __forceinline__ unsigned xb_ld(unsigned* p)              { return __hip_atomic_load(p, __ATOMIC_RELAXED, __HIP_MEMORY_SCOPE_AGENT); }
__device__ __forceinline__ unsigned xb_add(unsigned* p, unsigned v) { return __hip_atomic_fetch_add(p, v, __ATOMIC_RELAXED, __HIP_MEMORY_SCOPE_AGENT); }
__device__ __forceinline__ unsigned xb_xcc_id() { return (unsigned)__builtin_amdgcn_s_getreg((3 << 11) | 20) & 0xFu; }
#define XB_SPIN(cond, bar) do { unsigned _sp = 0; while (cond) { __builtin_amdgcn_s_sleep(1); \
    if ((++_sp & 255u) == 0u) { if (xb_ld(&(bar)[XB_TMO])) break; if (_sp > XB_SPIN_CAP) { atomicAdd(&(bar)[XB_TMO], 1u); break; } } } } while (0)
struct XcdBarrier { unsigned* bar; unsigned x; volatile LAS unsigned* st; };
__device__ __forceinline__ XcdBarrier xcd_barrier_post(unsigned* bar, volatile LAS unsigned* st) {
    XcdBarrier b; b.bar = bar; b.x = xb_xcc_id(); b.st = st;
    if (threadIdx.x == 0) (void)xb_add(&bar[XB_XCNT(b.x)], 1u);
    return b;
}
__device__ __forceinline__ void xcd_barrier_complete(unsigned* bar, unsigned x, unsigned& nloc, unsigned& nx) {
    const unsigned G = gridDim.x * gridDim.y * gridDim.z;
    unsigned sum, cnt, mine, sp = 0u;
    for (;;) {
        sum = 0u; cnt = 0u; mine = 0u;
#pragma unroll
        for (unsigned j = 0; j < 16; ++j) { const unsigned c = xb_ld(&bar[XB_XCNT(j)]); sum += c; cnt += (c > 0u) ? 1u : 0u; mine = (j == x) ? c : mine; }
        if (sum == G) break;
        __builtin_amdgcn_s_sleep(1);
        if ((++sp & 255u) == 0u) { if (xb_ld(&bar[XB_TMO])) break; if (sp > XB_SPIN_CAP) { atomicAdd(&bar[XB_TMO], 1u); break; } }
    }
    nloc = mine > 0u ? mine : 1u; nx = cnt > 0u ? cnt : 1u;
}
__device__ __forceinline__ void xcd_barrier(const XcdBarrier& b) {
    asm volatile("s_waitcnt vmcnt(0)" ::: "memory");
    __syncthreads();
    if (threadIdx.x == 0) {
        unsigned* bar = b.bar;
        __builtin_amdgcn_s_waitcnt(0);
        unsigned nloc = b.st[0], nx = b.st[1];
        if (nloc == 0u) { xcd_barrier_complete(bar, b.x, nloc, nx); b.st[0] = nloc; b.st[1] = nx; }
        const unsigned old = xb_add(&bar[XB_XSUB(b.x)], 1u);
        const unsigned gen = old / nloc;
        if (old + 1u == (gen + 1u) * nloc) {
            __builtin_amdgcn_fence(__ATOMIC_RELEASE, "agent");
            asm volatile("s_waitcnt vmcnt(0)" ::: "memory");
            const unsigned og = xb_add(&bar[XB_TOP], 1u);
            const unsigned tg = og / nx;
            if (og + 1u == (tg + 1u) * nx) xb_add(&bar[XB_TOPGEN], 1u);
            else XB_SPIN(xb_ld(&bar[XB_TOPGEN]) == tg, bar);
            __builtin_amdgcn_fence(__ATOMIC_ACQUIRE, "agent");
            xb_add(&bar[XB_XGEN(b.x)], 1u);
            asm volatile("s_waitcnt vmcnt(0)" ::: "memory");
        } else {
            XB_SPIN(xb_ld(&bar[XB_XGEN(b.x)]) == gen, bar);
            __builtin_amdgcn_fence(__ATOMIC_ACQUIRE, "agent");
            asm volatile("s_waitcnt vmcnt(0)" ::: "memory");
        }
    }
    __syncthreads();
}

namespace pg8 {
#define PG8_LAS __attribute__((address_space(3)))
typedef unsigned short bf16_t;
typedef short bf16x8 __attribute__((ext_vector_type(8)));
typedef float f32x4 __attribute__((ext_vector_type(4)));
typedef unsigned u32x4 __attribute__((ext_vector_type(4)));
constexpr int BM = 256, BK = 64, HALF = 128, HTB = HALF * BK * 2  , STAGE_BYTES = 8 * HTB, NXCD = 8, WGM = 8;

__host__ __device__ __forceinline__ int lds_byte(int r, int c) { const int st = (r >> 4) * 2 + (c >> 5), rr = r & 15, cc = c & 31, ob = rr * 64 + cc * 2; return st * 1024 + (ob ^ (((ob >> 9) & 1) << 5)); }
__host__ __device__ __forceinline__ void stage_rc(int b, int& R, int& C) { const int st = b / 1024, sb = b % 1024, swz = sb ^ (((sb >> 9) & 1) << 5); R = (st >> 1) * 16 + swz / 64; C = (st & 1) * 32 + (swz % 64) / 2; }
__host__ __device__ __forceinline__ int perm32(int rho) { const int n = rho >> 4, i = rho & 15; return 8 * (i >> 2) + 4 * n + (i & 3); }

struct Unit { int pm, pn, ab; };
struct Gemm { const bf16_t* A; const bf16_t* Bt; int M, N, K; };

template <int SPLIT = 0>
struct StaticOrderT {
    static constexpr bool HAS_SPLIT = SPLIT != 0;
    int nM, nN, nwg, G, c, nsplit;
    __host__ __device__ void init(int M, int N, int G_, int c_, int Mfull = -1) { if (Mfull < 0) Mfull = M; nM = Mfull / BM; nN = N / BM; nwg = nM * nN; G = G_; c = c_; nsplit = SPLIT ? ((M - Mfull) / BM) * nN * SPLIT : 0; }
    __host__ __device__ bool next(int i, Unit& u) const {
        const long L = (long)i * G + c;
        if (L >= (long)nwg + nsplit) return false;
        int pm, pn, ab;
        if (SPLIT != 0 && L >= nwg) { int q = (int)(L - nwg);
            q = (q % NXCD) * (nsplit / NXCD) + q / NXCD;
            const int t = q / (SPLIT ? SPLIT : 1), s = q % (SPLIT ? SPLIT : 1); pn = t / 4; pm = nM + t % 4; ab = (1 << (s & 1)) | ((SPLIT == 4 ? (1 << (s >> 1)) : 3) << 2);
        } else {
            int wgid = (int)L; { const int q = nwg / NXCD, r = nwg % NXCD, xcd = wgid % NXCD, off = wgid / NXCD; wgid = (xcd < r ? xcd * (q + 1) : r * (q + 1) + (xcd - r) * q) + off; }
            const int nig = WGM * nN, gid = wgid / nig, fm = gid * WGM, gsz = (nM - fm) < WGM ? (nM - fm) : WGM;
            pm = fm + ((wgid % nig) % gsz); pn = (wgid % nig) / gsz; ab = 15; }
        u.pm = pm; u.pn = pn; u.ab = ab; return true;
    }
    __device__ __forceinline__ void a_ready(const Unit&) const {}
    __device__ __forceinline__ void done(const Unit&) const {}
};
typedef StaticOrderT<0> StaticOrder;

__device__ __forceinline__ unsigned cvt_pk_bf16(float lo, float hi) { unsigned r; asm volatile("v_cvt_pk_bf16_f32 %0, %1, %2" : "=v"(r) : "v"(lo), "v"(hi)); return r; }

struct EpiBf16 {
    static constexpr bool PERM = true, AFTER_DRAIN = false;
    bf16_t* O; int ldc;
    __device__ __forceinline__ void operator()(const f32x4 (&acc)[2][2][4][2], const Unit& u, int wr, int wc, int fr, int fq) const {
        const int row0 = u.pm * BM + wr * 64 + fr; const int col0 = u.pn * BM + wc * 32 + 8 * fq;
#pragma unroll
        for (int ai = 0; ai < 2; ++ai)
#pragma unroll
            for (int m = 0; m < 4; ++m) { if (!((u.ab >> ai) & 1)) continue; bf16_t* rowp = O + (size_t)(row0 + ai * HALF + m * 16) * ldc + col0;
#pragma unroll
                for (int bj = 0; bj < 2; ++bj) { if (!((u.ab >> (2 + bj)) & 1)) continue; const f32x4 v0 = acc[ai][bj][m][0], v1 = acc[ai][bj][m][1];
                    u32x4 w; w.x = cvt_pk_bf16(v0[0], v0[1]); w.y = cvt_pk_bf16(v0[2], v0[3]); w.z = cvt_pk_bf16(v1[0], v1[1]); w.w = cvt_pk_bf16(v1[2], v1[3]);
                    *(u32x4*)(rowp + bj * HALF) = w; } }
    }
};
struct EpiGY {
    static constexpr bool PERM = true, AFTER_DRAIN = false;
    bf16_t* Y; const float* g1; int ml;
    __device__ __forceinline__ void operator()(const f32x4 (&acc)[2][2][4][2], const Unit& u, int wr, int wc, int fr, int fq) const {
        const int rbase = u.pm * BM; const int mr = rbase >= ml ? 4 : (rbase >> 12); const float* g = g1 + (size_t)mr * 6144;
        const int row0 = rbase + wr * 64 + fr, col0 = u.pn * BM + wc * 32 + 8 * fq;
        f32x4 gv[2][2];
#pragma unroll
        for (int bj = 0; bj < 2; ++bj)
#pragma unroll
            for (int n = 0; n < 2; ++n) gv[bj][n] = *(const f32x4*)(g + col0 + bj * HALF + n * 4);
#pragma unroll
        for (int ai = 0; ai < 2; ++ai)
#pragma unroll
            for (int m = 0; m < 4; ++m) { bf16_t* rowp = Y + (size_t)(row0 + ai * HALF + m * 16) * 1024 + col0;
#pragma unroll
                for (int bj = 0; bj < 2; ++bj) { const f32x4 v0 = acc[ai][bj][m][0] * gv[bj][0], v1 = acc[ai][bj][m][1] * gv[bj][1];
                    u32x4 w; w.x = cvt_pk_bf16(v0[0], v0[1]); w.y = cvt_pk_bf16(v0[2], v0[3]); w.z = cvt_pk_bf16(v1[0], v1[1]); w.w = cvt_pk_bf16(v1[2], v1[3]);
                    *(u32x4*)(rowp + bj * HALF) = w; } }
    }
};
struct EpiResid {
    static constexpr bool PERM = false, AFTER_DRAIN = false;
    const float* xl; const float* xc; float* X; const float* g1; int ml;
    __device__ __forceinline__ void operator()(const f32x4 (&acc)[2][2][4][2], const Unit& u, int wr, int wc, int fr, int fq) const {
        const int rbase = u.pm * BM; const bool isc = rbase >= ml; const int mr = isc ? 4 : (rbase >> 12);
        const float* xin = isc ? xc - (size_t)ml * 1024 : xl; const float* g = g1 + (size_t)mr * 6144;
        const int col0 = u.pn * BM + wc * 32 + 4 * fq;
        f32x4 gv[2][2];
#pragma unroll
        for (int bj = 0; bj < 2; ++bj)
#pragma unroll
            for (int n = 0; n < 2; ++n) gv[bj][n] = *(const f32x4*)(g + col0 + bj * HALF + n * 16);
#pragma unroll
        for (int ai = 0; ai < 2; ++ai)
#pragma unroll
            for (int m = 0; m < 4; ++m) { const size_t off = (size_t)(rbase + ai * HALF + wr * 64 + m * 16 + fr) * 1024 + col0;
#pragma unroll
                for (int bj = 0; bj < 2; ++bj)
#pragma unroll
                    for (int n = 0; n < 2; ++n) { const f32x4 xi = *(const f32x4*)(xin + off + bj * HALF + n * 16); *(f32x4*)(X + off + bj * HALF + n * 16) = xi + gv[bj][n] * acc[ai][bj][m][n]; } }
    }
};
__device__ __forceinline__ float silu_f(float x) { return x * __builtin_amdgcn_rcpf(1.f + __expf(-x)); }
struct EpiSwiglu {
    static constexpr bool PERM = true, AFTER_DRAIN = false;
    bf16_t* O; int ntn;
    __device__ __forceinline__ void operator()(const f32x4 (&acc)[2][2][4][2], const Unit& u, int wr, int wc, int fr, int fq) const {
        const int row0 = u.pm * BM + wr * 64 + fr; const int col0 = (u.pn % ntn) * HALF + wc * 32 + 8 * fq;
#pragma unroll
        for (int ai = 0; ai < 2; ++ai)
#pragma unroll
            for (int m = 0; m < 4; ++m) { if (!((u.ab >> ai) & 1)) continue; bf16_t* rowp = O + (size_t)(row0 + ai * HALF + m * 16) * 1024 + col0;
                const f32x4 g0 = acc[ai][0][m][0], g1 = acc[ai][0][m][1], u0 = acc[ai][1][m][0], u1 = acc[ai][1][m][1];
                u32x4 w; w.x = cvt_pk_bf16(silu_f(g0[0]) * u0[0], silu_f(g0[1]) * u0[1]); w.y = cvt_pk_bf16(silu_f(g0[2]) * u0[2], silu_f(g0[3]) * u0[3]);
                w.z = cvt_pk_bf16(silu_f(g1[0]) * u1[0], silu_f(g1[1]) * u1[1]); w.w = cvt_pk_bf16(silu_f(g1[2]) * u1[2], silu_f(g1[3]) * u1[3]);
                *(u32x4*)rowp = w; }
    }
};
struct EpiConvIn {
    static constexpr bool PERM = true, AFTER_DRAIN = false;
    bf16_t* O;
    __device__ __forceinline__ void operator()(const f32x4 (&acc)[2][2][4][2], const Unit& u, int wr, int wc, int fr, int fq) const {
        const int row0 = u.pm * BM + wr * 64 + fr;
        if (u.pn < 4) { const int col0 = u.pn * BM + wc * 32 + 8 * fq;
#pragma unroll
            for (int ai = 0; ai < 2; ++ai)
#pragma unroll
                for (int m = 0; m < 4; ++m) { if (!((u.ab >> ai) & 1)) continue; bf16_t* rowp = O + (size_t)(row0 + ai * HALF + m * 16) * 2048 + col0;
#pragma unroll
                    for (int bj = 0; bj < 2; ++bj) { const f32x4 v0 = acc[ai][bj][m][0], v1 = acc[ai][bj][m][1];
                        u32x4 w; w.x = cvt_pk_bf16(v0[0], v0[1]); w.y = cvt_pk_bf16(v0[2], v0[3]); w.z = cvt_pk_bf16(v1[0], v1[1]); w.w = cvt_pk_bf16(v1[2], v1[3]);
                        *(u32x4*)(rowp + bj * HALF) = w; } }
        } else { const int col0 = 1024 + (u.pn - 4) * HALF + wc * 32 + 8 * fq;
#pragma unroll
            for (int ai = 0; ai < 2; ++ai)
#pragma unroll
                for (int m = 0; m < 4; ++m) { if (!((u.ab >> ai) & 1)) continue; bf16_t* rowp = O + (size_t)(row0 + ai * HALF + m * 16) * 2048 + col0;
                    const f32x4 c0 = acc[ai][0][m][0], c1 = acc[ai][0][m][1], v0 = acc[ai][1][m][0], v1 = acc[ai][1][m][1];
                    u32x4 w; w.x = cvt_pk_bf16(c0[0] * v0[0], c0[1] * v0[1]); w.y = cvt_pk_bf16(c0[2] * v0[2], c0[3] * v0[3]); w.z = cvt_pk_bf16(c1[0] * v1[0], c1[1] * v1[1]); w.w = cvt_pk_bf16(c1[2] * v1[2], c1[3] * v1[3]);
                    *(u32x4*)rowp = w; }
        }
    }
};
struct EpiDown {
    static constexpr bool PERM = true, AFTER_DRAIN = false;
    bf16_t* O; const float* gate; int ntn;
    __device__ __forceinline__ void operator()(const f32x4 (&acc)[2][2][4][2], const Unit& u, int wr, int wc, int fr, int fq) const {
        const int row0 = u.pm * BM + wr * 64 + fr; const int col0 = (u.pn % ntn) * BM + wc * 32 + 8 * fq;
#pragma unroll
        for (int ai = 0; ai < 2; ++ai)
#pragma unroll
            for (int m = 0; m < 4; ++m) { if (!((u.ab >> ai) & 1)) continue; const int r = row0 + ai * HALF + m * 16; const float gt = gate[r]; bf16_t* rowp = O + (size_t)r * 1024 + col0;
#pragma unroll
                for (int bj = 0; bj < 2; ++bj) { if (!((u.ab >> (2 + bj)) & 1)) continue; const f32x4 v0 = acc[ai][bj][m][0] * gt, v1 = acc[ai][bj][m][1] * gt;
                    u32x4 w; w.x = cvt_pk_bf16(v0[0], v0[1]); w.y = cvt_pk_bf16(v0[2], v0[3]); w.z = cvt_pk_bf16(v1[0], v1[1]); w.w = cvt_pk_bf16(v1[2], v1[3]);
                    *(u32x4*)(rowp + bj * HALF) = w; } }
    }
};
struct OneUnit { static constexpr bool HAS_SPLIT = false; int pm, pn;
    __device__ bool next(int i, Unit& u) const { if (i > 0) return false; u.pm = pm; u.pn = pn; u.ab = 15; return true; }
    __device__ __forceinline__ void a_ready(const Unit&) const {}
    __device__ __forceinline__ void done(const Unit&) const {}
};
template <int NTN, int QUARTER>
struct GroupOrderT {
    static constexpr bool HAS_SPLIT = true;
    int nfull, nsplit, G, c;
    __device__ void init(int mt_, int ne, int G_, int c_) { nfull = ne * 8 * NTN; nsplit = mt_ > 8 ? ne * NTN * (QUARTER ? 2 : 1) : 0; G = G_; c = c_; }
    __device__ bool next(int i, Unit& u) const { const int L = i * G + c; if (L >= nfull + nsplit) return false;
        int pm, pn, ab;
        if (L < nfull) { const int e = L / (8 * NTN), r = L % (8 * NTN); pm = e * 9 + (r % 8); pn = e * NTN + (r / 8); ab = 15; }
        else { const int q = L - nfull; const int sp = QUARTER ? 2 : 1, t = q / sp, s = q % sp; pm = (t / NTN) * 9 + 8; pn = t; ab = 1 | ((QUARTER ? (1 << s) : 3) << 2); }
        u.pm = pm; u.pn = pn; u.ab = ab; return true; }
    __device__ __forceinline__ void a_ready(const Unit&) const {}
    __device__ __forceinline__ void done(const Unit&) const {}
};

struct DenseA { static constexpr bool GATHER = false;
    __device__ __forceinline__ unsigned off(const Unit&, int h, int R, int C, int K) const { return (unsigned)((h * HALF + R) * K + C) * 2u; }
    __device__ __forceinline__ size_t base(const Unit& u, size_t tstep) const { return (size_t)u.pm * tstep; } };
struct GatherA { static constexpr bool GATHER = true; const int* sel; int sel_ld, tiles_per_e, nvalid;
    __device__ __forceinline__ unsigned off(const Unit& u, int h, int R, int C, int K) const { const int e = u.pm / tiles_per_e, xr = (u.pm % tiles_per_e) * BM + h * HALF + R; const int row = sel[e * sel_ld + (xr < nvalid ? xr : 0)]; return (unsigned)(row * K + C) * 2u; }
    __device__ __forceinline__ size_t base(const Unit&, size_t) const { return 0; } };
template <class Epi, class Sched, bool ALIGN_EPI = false, bool SP2 = false, class AOff = DenseA>
__device__ __forceinline__ void gemm_phase(PG8_LAS unsigned char* lds, const Gemm g, const Sched& S, const Epi& E, const AOff AO = AOff()) {
    const int tid = otid(), wid = __builtin_amdgcn_readfirstlane(tid >> 6), lane = tid & 63, wr = wid >> 2, wc = wid & 3, fr = lane & 15, fq = lane >> 4;
    const int K = g.K, nt = K / BK;
    unsigned voffB[2];
#pragma unroll
    for (int i = 0; i < 2; ++i) { int R, C; stage_rc(tid * 16 + i * 8192, R, C); const int Rb = Epi::PERM ? ((R & ~31) + perm32(R & 31)) : R;
        voffB[i] = (unsigned)(Rb * K + C) * 2u; }
    const size_t kstep = (size_t)(BK * 2);
    const size_t hstep = (size_t)HALF * K * 2;
    const size_t tstep = 2 * hstep;
    const unsigned ldsw = (unsigned)wid * 1024u;
    const int aoff = lds_byte(wr * 64 + fr, fq * 8), boff = lds_byte(wc * 32 + fr, fq * 8);
#define PG8_SA(b, h) (((b) * 2 + (h)) * HTB)
#define PG8_SB(b, h) ((4 + (b) * 2 + (h)) * HTB)
#define PG8_STAGE(bufoff, gbase, voff) do { _Pragma("unroll") for (int _i = 0; _i < 2; ++_i) \
        __builtin_amdgcn_global_load_lds((const unsigned*)((const char*)(gbase) + (voff)[_i]), (PG8_LAS unsigned*)(lds + (bufoff) + ldsw + _i * 8192), 16, 0, 0); } while (0)
#define PG8_STAGE_AC(b, h, base) PG8_STAGE(PG8_SA(b, h), base, roC[h])
#define PG8_STAGE_A2(b, h, base) PG8_STAGE(PG8_SA(b, h), base, r2[h])
#define PG8_LDA(dst, b, h) do { _Pragma("unroll") for (int m = 0; m < 4; ++m) _Pragma("unroll") for (int k = 0; k < 2; ++k) dst[m][k] = *(const PG8_LAS bf16x8*)(lds + PG8_SA(b, h) + aoff + m * 2048 + k * 1024); } while (0)
#define PG8_LDB(dst, b, h) do { _Pragma("unroll") for (int n = 0; n < 2; ++n) _Pragma("unroll") for (int k = 0; k < 2; ++k) dst[n][k] = *(const PG8_LAS bf16x8*)(lds + PG8_SB(b, h) + boff + n * 2048 + k * 1024); } while (0)
#define PG8_MMA(ai, bj, At, Bt) do { if (GATED && !(((cur.ab >> (ai)) & 1) && ((cur.ab >> (2 + (bj))) & 1))) break; __builtin_amdgcn_s_setprio(1); _Pragma("unroll") for (int m = 0; m < 4; ++m) _Pragma("unroll") for (int n = 0; n < 2; ++n) _Pragma("unroll") for (int k = 0; k < 2; ++k) \
        acc[ai][bj][m][n] = __builtin_amdgcn_mfma_f32_16x16x32_bf16(Bt[n][k], At[m][k], acc[ai][bj][m][n], 0, 0, 0); __builtin_amdgcn_s_setprio(0); } while (0)
#define PG8_WAIT_V(n) asm volatile("s_waitcnt vmcnt(" #n ")" ::: "memory")
#define PG8_WAIT_L(n) asm volatile("s_waitcnt lgkmcnt(" #n ")" ::: "memory")
#define PG8_BAR __builtin_amdgcn_s_barrier()
#define PG8_SCHED __builtin_amdgcn_sched_barrier(0)
    Unit cur, nxt; int ui = 0;
    if (!S.next(0, cur)) return;
    f32x4 acc[2][2][4][2];
#pragma unroll
    for (int a = 0; a < 2; ++a)
#pragma unroll
        for (int b = 0; b < 2; ++b)
#pragma unroll
            for (int m = 0; m < 4; ++m)
#pragma unroll
                for (int n = 0; n < 2; ++n) acc[a][b][m][n] = (f32x4){0.f, 0.f, 0.f, 0.f};
    bf16x8 At[4][2], B0[2][2], B1[2][2];
    unsigned roC[2][2], roN[2][2];
#pragma unroll
    for (int h = 0; h < 2; ++h)
#pragma unroll
        for (int i = 0; i < 2; ++i) { int R, C; stage_rc(tid * 16 + i * 8192, R, C); roC[h][i] = AO.off(cur, h, R, C, K); }
    const char* cA = (const char*)g.A + AO.base(cur, tstep); const char* cB = (const char*)g.Bt + (size_t)cur.pn * tstep;
    S.a_ready(cur);
    if constexpr (SP2) {
        PG8_STAGE(PG8_SB(0, 0), cB, voffB); PG8_STAGE(PG8_SB(0, 1), cB + hstep, voffB); PG8_STAGE_AC(0, 0, cA); PG8_STAGE_AC(0, 1, cA);
        if (wr == 1) PG8_BAR;
        PG8_WAIT_V(2); PG8_BAR;
        PG8_STAGE(PG8_SB(1, 0), cB + kstep, voffB); PG8_STAGE_AC(1, 0, cA + kstep); PG8_STAGE(PG8_SB(1, 1), cB + hstep + kstep, voffB);
        PG8_WAIT_V(6); PG8_BAR;
    } else {
        PG8_STAGE(PG8_SB(0, 0), cB, voffB); PG8_STAGE_AC(0, 0, cA); PG8_STAGE(PG8_SB(0, 1), cB + hstep, voffB); PG8_STAGE_AC(0, 1, cA);
        if (wr == 1) PG8_BAR;
        PG8_WAIT_V(4); PG8_BAR;
        PG8_STAGE(PG8_SB(1, 0), cB + kstep, voffB); PG8_STAGE_AC(1, 0, cA + kstep); PG8_STAGE(PG8_SB(1, 1), cB + hstep + kstep, voffB);
        PG8_WAIT_V(6); PG8_BAR;
    }
    for (;;) {
        const bool has_next = S.next(ui + 1, nxt);
        const char* nA = has_next ? (const char*)g.A + AO.base(nxt, tstep) : cA; const char* nB = has_next ? (const char*)g.Bt + (size_t)nxt.pn * tstep : cB;
#pragma unroll
        for (int h = 0; h < 2; ++h)
#pragma unroll
            for (int i = 0; i < 2; ++i) { if (AOff::GATHER && has_next) { int R, C; stage_rc(tid * 16 + i * 8192, R, C); roN[h][i] = AO.off(nxt, h, R, C, K); } else roN[h][i] = roC[h][i]; }
        auto kloop = [&](auto gated_tag) { constexpr bool GATED = decltype(gated_tag)::value;
        for (int t = 0; t < nt; t += 2) {
            const bool last = (t == nt - 2);
            const char* a1 = cA + (size_t)(t + 1) * kstep;
            const char* a2 = last ? nA : cA + (size_t)(t + 2) * kstep; const char* b2 = last ? nB : cB + (size_t)(t + 2) * kstep;
            unsigned r2[2][2];
#pragma unroll
            for (int h = 0; h < 2; ++h)
#pragma unroll
                for (int i = 0; i < 2; ++i) r2[h][i] = (AOff::GATHER && last) ? roN[h][i] : roC[h][i];
            const char* a3 = a2 + kstep; const char* b3 = b2 + kstep;
            if (last && has_next) S.a_ready(nxt);
            if constexpr (SP2) {
            PG8_LDB(B0, 0, 0); PG8_LDB(B1, 0, 1); PG8_SCHED; PG8_LDA(At, 0, 0); PG8_STAGE_AC(1, 1, a1);
            PG8_WAIT_V(8); PG8_WAIT_L(0); PG8_BAR; PG8_MMA(0, 0, At, B0); PG8_MMA(0, 1, At, B1); PG8_BAR; PG8_SCHED;
            PG8_LDA(At, 0, 1); PG8_STAGE(PG8_SB(0, 0), b2, voffB); PG8_STAGE(PG8_SB(0, 1), b2 + hstep, voffB); PG8_STAGE_A2(0, 0, a2);
            PG8_WAIT_V(8); PG8_WAIT_L(0); PG8_BAR; PG8_MMA(1, 0, At, B0); PG8_MMA(1, 1, At, B1); PG8_BAR; PG8_SCHED;
            PG8_LDB(B0, 1, 0); PG8_LDB(B1, 1, 1); PG8_SCHED; PG8_LDA(At, 1, 0); PG8_STAGE_A2(0, 1, a2);
            PG8_WAIT_V(8); PG8_WAIT_L(0); PG8_BAR; PG8_MMA(0, 0, At, B0); PG8_MMA(0, 1, At, B1); PG8_BAR; PG8_SCHED;
            PG8_LDA(At, 1, 1); PG8_STAGE(PG8_SB(1, 0), b3, voffB); PG8_STAGE(PG8_SB(1, 1), b3 + hstep, voffB); PG8_STAGE_A2(1, 0, a3);
            PG8_WAIT_V(8); PG8_WAIT_L(0); PG8_BAR; PG8_MMA(1, 0, At, B0); PG8_MMA(1, 1, At, B1); PG8_BAR; PG8_SCHED;
            } else {
            PG8_LDB(B0, 0, 0); PG8_SCHED; PG8_LDA(At, 0, 0); PG8_STAGE_AC(1, 1, a1);
            PG8_WAIT_L(8); PG8_BAR; PG8_WAIT_L(0); PG8_MMA(0, 0, At, B0); PG8_BAR; PG8_SCHED;
            PG8_LDB(B1, 0, 1); PG8_STAGE(PG8_SB(0, 0), b2, voffB);
            PG8_BAR; PG8_WAIT_L(0); PG8_MMA(0, 1, At, B1); PG8_BAR;
            PG8_LDA(At, 0, 1); PG8_STAGE_A2(0, 0, a2);
            PG8_BAR; PG8_WAIT_L(0); PG8_MMA(1, 0, At, B0); PG8_BAR; PG8_SCHED;
            PG8_STAGE(PG8_SB(0, 1), b2 + hstep, voffB);
            PG8_WAIT_V(6); PG8_BAR; PG8_MMA(1, 1, At, B1); PG8_BAR;
            PG8_LDB(B0, 1, 0); PG8_SCHED; PG8_LDA(At, 1, 0); PG8_STAGE_A2(0, 1, a2);
            PG8_WAIT_L(8); PG8_BAR; PG8_WAIT_L(0); PG8_MMA(0, 0, At, B0); PG8_BAR; PG8_SCHED;
            PG8_LDB(B1, 1, 1); PG8_STAGE(PG8_SB(1, 0), b3, voffB);
            PG8_BAR; PG8_WAIT_L(0); PG8_MMA(0, 1, At, B1); PG8_BAR;
            PG8_LDA(At, 1, 1); PG8_STAGE_A2(1, 0, a3);
            PG8_BAR; PG8_WAIT_L(0); PG8_MMA(1, 0, At, B0); PG8_BAR; PG8_SCHED;
            PG8_STAGE(PG8_SB(1, 1), b3 + hstep, voffB);
            PG8_WAIT_V(6); PG8_BAR; PG8_MMA(1, 1, At, B1); PG8_BAR;
            }
        }
        };
        if constexpr (Sched::HAS_SPLIT) { if (cur.ab == 15) kloop(std::false_type{}); else kloop(std::true_type{}); } else kloop(std::false_type{});
        if constexpr (ALIGN_EPI) { if (wr == 0) PG8_BAR; }
        if constexpr (!Epi::AFTER_DRAIN) { E(acc, cur, wr, wc, fr, fq); S.done(cur); }
        if (!has_next) break;
#pragma unroll
        for (int a = 0; a < 2; ++a)
#pragma unroll
            for (int b = 0; b < 2; ++b)
#pragma unroll
                for (int m = 0; m < 4; ++m)
#pragma unroll
                    for (int n = 0; n < 2; ++n) acc[a][b][m][n] = (f32x4){0.f, 0.f, 0.f, 0.f};
        cur = nxt; cA = nA; cB = nB; ++ui;
#pragma unroll
        for (int h = 0; h < 2; ++h)
#pragma unroll
            for (int i = 0; i < 2; ++i) roC[h][i] = roN[h][i];
        if constexpr (ALIGN_EPI) { if (wr == 1) PG8_BAR; }
    }
    PG8_WAIT_V(0);
    if constexpr (!ALIGN_EPI) { if (wr == 0) PG8_BAR; }
    PG8_BAR;
    if constexpr (Epi::AFTER_DRAIN) { E.fused(acc, cur, wr, wc, fr, fq, lds, wid, lane); S.done(cur); }
#undef PG8_SA
#undef PG8_STAGE_AC
#undef PG8_STAGE_A2
#undef PG8_SB
#undef PG8_STAGE
#undef PG8_LDA
#undef PG8_LDB
#undef PG8_MMA
#undef PG8_WAIT_V
#undef PG8_WAIT_L
#undef PG8_BAR
#undef PG8_SCHED
}
}

__device__ __forceinline__ void mini_barrier(unsigned* ctr, unsigned n) {
    asm volatile("s_waitcnt vmcnt(0)" ::: "memory");
    __syncthreads();
    if (threadIdx.x == 0) {
        __builtin_amdgcn_fence(__ATOMIC_RELEASE, "agent");
        asm volatile("s_waitcnt vmcnt(0)" ::: "memory");
        (void)xb_add(ctr, 1u);
        unsigned sp = 0u; while (xb_ld(ctr) < n) { __builtin_amdgcn_s_sleep(1); if (++sp > XB_SPIN_CAP) break; }
        __builtin_amdgcn_fence(__ATOMIC_ACQUIRE, "agent");
        asm volatile("s_waitcnt vmcnt(0)" ::: "memory");
    }
    __syncthreads();
}
constexpr int CW_MINI = 16384;
__device__ __forceinline__ void ph_setup(const Prm& p, LAS float* lds) {
    float* modv = (float*)(p.ws + WS_MODV);
    float* rope = (float*)(p.ws + WS_ROPE);
    const int tid = otid();
    LAS float* sc = lds;
    LAS float* red = lds + 5 * 1024;
    for (int i = tid; i < 5 * 1024; i += NTHREADS) { const int r = i >> 10, k = i & 1023; const float v = r < 4 ? p.c[r * 1024 + k] : p.c_ctx[k]; sc[i] = siluf_(v); }
    __syncthreads();
    const int nitems = DEPTH * 6144 / 128;
    for (int it = obid(); it < nitems; it += gridDim.x) {
        const int l = it / 48, n0 = (it % 48) * 128;
        const int kp = tid >> 7, nn = tid & 127;
        const float* w = p.mod_w + ((size_t)l * 1024 + kp * 256) * 6144 + n0 + nn;
        float a0 = 0.f, a1 = 0.f, a2 = 0.f, a3 = 0.f, a4 = 0.f;
        for (int k = 0; k < 256; ++k) {
            const float wv = w[(size_t)k * 6144]; const int kk = kp * 256 + k;
            a0 += sc[kk] * wv; a1 += sc[1024 + kk] * wv; a2 += sc[2048 + kk] * wv; a3 += sc[3072 + kk] * wv; a4 += sc[4096 + kk] * wv;
        }
        LAS float* r5 = red + (kp * 128 + nn) * 5;
        r5[0] = a0; r5[1] = a1; r5[2] = a2; r5[3] = a3; r5[4] = a4;
        __syncthreads();
        if (tid < 128) {
            const float bias = p.mod_b[l * 6144 + n0 + tid];
#pragma unroll
            for (int r = 0; r < 5; ++r) { float s = bias; for (int q = 0; q < 4; ++q) s += red[(q * 128 + tid) * 5 + r]; modv[((size_t)l * 5 + r) * 6144 + n0 + tid] = s; }
        }
        __syncthreads();
    }
    if (obid() == gridDim.x - 1) {
        for (int i = tid; i < 64 * 16; i += NTHREADS) { const int pos = i >> 4, f = i & 15; const float inv = exp2f(-(float)f * (13.287712379549449f / 16.f)); const float ang = (float)pos * inv;
            rope[i * 2] = __cosf(ang); rope[i * 2 + 1] = __sinf(ang); }
    }
}

#define CJ(jj) (8 * lane + 512 * ((jj) >> 1) + 4 * ((jj) & 1))
__device__ __forceinline__ void acc_bf16x8(f32x4& lo, f32x4& hi, const u32x4 w, float f) {
    lo.x += f * __uint_as_float(w.x << 16); lo.y += f * __uint_as_float(w.x & 0xffff0000u); lo.z += f * __uint_as_float(w.y << 16); lo.w += f * __uint_as_float(w.y & 0xffff0000u);
    hi.x += f * __uint_as_float(w.z << 16); hi.y += f * __uint_as_float(w.z & 0xffff0000u); hi.z += f * __uint_as_float(w.w << 16); hi.w += f * __uint_as_float(w.w & 0xffff0000u);
}
__device__ __forceinline__ u32x4 pack_bf16x8(const f32x4 lo, const f32x4 hi) { u32x4 o; o.x = pk2(lo.x, lo.y); o.y = pk2(lo.z, lo.w); o.z = pk2(hi.x, hi.y); o.w = pk2(hi.z, hi.w); return o; }
__device__ __forceinline__ void load_xrow(const bf16* xrow, int lane, f32x4 (&v)[4]) {
#pragma unroll
    for (int j2 = 0; j2 < 2; ++j2) { const u32x4 w = __builtin_nontemporal_load((const u32x4*)(xrow + 8 * lane + 512 * j2)); v[2 * j2] = (f32x4){0.f, 0.f, 0.f, 0.f}; v[2 * j2 + 1] = (f32x4){0.f, 0.f, 0.f, 0.f}; acc_bf16x8(v[2 * j2], v[2 * j2 + 1], w, 1.f); }
}
__device__ __forceinline__ void store_xrow(bf16* xrow, int lane, const f32x4 (&v)[4]) {
#pragma unroll
    for (int j2 = 0; j2 < 2; ++j2) *(u32x4*)(xrow + 8 * lane + 512 * j2) = pack_bf16x8(v[2 * j2], v[2 * j2 + 1]);
}
struct Sel4 { const bf16* y[4]; float f[4]; unsigned long long rest; };
__device__ __forceinline__ Sel4 moe_sel4(const bf16* YE, int sl, int lane) {
    Sel4 q; unsigned long long m = __ballot(sl >= 0); int e0 = 0, s0 = 0;
#pragma unroll
    for (int k = 0; k < 4; ++k) { const bool has = m != 0; const int e = has ? __builtin_ctzll(m) : e0; if (has) m &= m - 1; const int s = __builtin_amdgcn_readlane(sl, e);
        if (k == 0) { e0 = e; s0 = has ? s : 0; }
        q.y[k] = YE + ((size_t)(has ? e : e0) * XR + (has ? s : s0)) * D + 8 * lane; q.f[k] = has ? 1.f : 0.f; }
    q.rest = m; return q;
}
__device__ __forceinline__ void moe_load4(const Sel4& q, u32x4 (&w)[4][2]) {
#pragma unroll
    for (int k = 0; k < 4; ++k)
#pragma unroll
        for (int j = 0; j < 2; ++j) w[k][j] = __builtin_nontemporal_load((const u32x4*)(q.y[k] + 512 * j));
}
__device__ __forceinline__ void moe_acc4(const Sel4& q, const u32x4 (&w)[4][2], f32x4 (&a)[4]) {
#pragma unroll
    for (int jj = 0; jj < 4; ++jj) a[jj] = (f32x4){0.f, 0.f, 0.f, 0.f};
#pragma unroll
    for (int k = 0; k < 4; ++k)
#pragma unroll
        for (int j = 0; j < 2; ++j) acc_bf16x8(a[2 * j], a[2 * j + 1], w[k][j], q.f[k]);
}
__device__ __forceinline__ void moe_gather_rest(const bf16* YE, int sl, unsigned long long m, int lane, f32x4 (&a)[4]) {
    while (m) { const int e = __builtin_ctzll(m); m &= m - 1; const int s = __builtin_amdgcn_readlane(sl, e); const bf16* y = YE + ((size_t)e * XR + s) * D + 8 * lane;
#pragma unroll
        for (int j = 0; j < 2; ++j) { const u32x4 w = *(const u32x4*)(y + 512 * j); acc_bf16x8(a[2 * j], a[2 * j + 1], w, 1.f); } }
}
__device__ __forceinline__ void norm1_pair(const Prm& p, int l, int r, int lane, bool comb_ctx, bool wb) {
    const float* modv = (const float*)(p.ws + WS_MODV) + (size_t)l * 5 * 6144;
    const float* modp = (const float*)(p.ws + WS_MODV) + (size_t)(l > 0 ? l - 1 : 0) * 5 * 6144;
    bf16* X = (bf16*)(p.ws + WS_X); bf16* H = (bf16*)(p.ws + WS_H); const int* tokslot = (const int*)(p.ws + WS_TOKSLOT); const bf16* YE = (const bf16*)(p.ws + WS_YE);
    const bool isc = r >= ML; const int mr = isc ? 4 : (r >> 12);
    f32x4 v[2][4];
    if (l == 0) { const float* src = isc ? p.ctx + (size_t)(r - ML) * D : p.x + (size_t)r * D;
#pragma unroll
        for (int u = 0; u < 2; ++u)
#pragma unroll
            for (int j = 0; j < 4; ++j) v[u][j] = __builtin_nontemporal_load((const f32x4*)(src + (size_t)u * D + CJ(j)));
    } else {
        const bool comb = !isc || comb_ctx;
        int sl0 = -1, sl1 = -1; if (comb && lane < NE) { sl0 = tokslot[(size_t)r * NE + lane]; sl1 = tokslot[(size_t)(r + 1) * NE + lane]; }
        load_xrow(X + (size_t)r * D, lane, v[0]); load_xrow(X + (size_t)(r + 1) * D, lane, v[1]);
        if (comb) { const Sel4 q0 = moe_sel4(YE, sl0, lane), q1 = moe_sel4(YE, sl1, lane); u32x4 w0[4][2], w1[4][2]; moe_load4(q0, w0); moe_load4(q1, w1);
            f32x4 a0[4], a1[4]; moe_acc4(q0, w0, a0); moe_acc4(q1, w1, a1);
            if (q0.rest) moe_gather_rest(YE, sl0, q0.rest, lane, a0); if (q1.rest) moe_gather_rest(YE, sl1, q1.rest, lane, a1);
#pragma unroll
            for (int j = 0; j < 4; ++j) { const f32x4 g2 = *(const f32x4*)(modp + (size_t)mr * 6144 + 5 * 1024 + CJ(j)); v[0][j] += g2 * a0[j]; v[1][j] += g2 * a1[j]; }
            if (wb) { store_xrow(X + (size_t)r * D, lane, v[0]); store_xrow(X + (size_t)(r + 1) * D, lane, v[1]); } }
    }
#pragma unroll
    for (int u = 0; u < 2; ++u) { float s = 0.f;
#pragma unroll
        for (int j = 0; j < 4; ++j) s += v[u][j].x * v[u][j].x + v[u][j].y * v[u][j].y + v[u][j].z * v[u][j].z + v[u][j].w * v[u][j].w;
        const float rstd = rsqrtf(wave_sum(s) * (1.f / D) + EPS);
        f32x4 hh[4];
#pragma unroll
        for (int j = 0; j < 4; ++j) { const int c = CJ(j);
            const f32x4 g = *(const f32x4*)(p.norm1_g + l * D + c), sh = *(const f32x4*)(modv + (size_t)mr * 6144 + c), scl = *(const f32x4*)(modv + (size_t)mr * 6144 + 1024 + c);
            hh[j] = (v[u][j] * rstd * g) * (scl + 1.f) + sh; }
#pragma unroll
        for (int j2 = 0; j2 < 2; ++j2) *(u32x4*)(H + (size_t)(r + u) * D + 8 * lane + 512 * j2) = pack_bf16x8(hh[2 * j2], hh[2 * j2 + 1]); }
}
__device__ __forceinline__ void ph_norm1(const Prm& p, int l, bool wb = true) {
    const int lane = otid() & 63, ngw = gridDim.x * 8, gw = ngw - 1 - (obid() * 8 + (otid() >> 6));
    const int nrows = (l <= 2) ? MT : ML;
    const bool comb_ctx = (l >= 1 && l <= 2);
    for (int r = gw * 2; r < nrows; r += ngw * 2) norm1_pair(p, l, r, lane, comb_ctx, wb);
}
__device__ __forceinline__ void ph_final(const Prm& p) {
    const int lane = otid() & 63, gw = obid() * 8 + (otid() >> 6), ngw = gridDim.x * 8;
    const float* modp = (const float*)(p.ws + WS_MODV) + (size_t)3 * 5 * 6144;
    const bf16* X = (const bf16*)(p.ws + WS_X); const int* tokslot = (const int*)(p.ws + WS_TOKSLOT); const bf16* YE = (const bf16*)(p.ws + WS_YE);
    for (int r = gw * 2; r < ML; r += ngw * 2) {
        const int mr = r >> 12; f32x4 v[2][4];
        int sl0 = -1, sl1 = -1; if (lane < NE) { sl0 = tokslot[(size_t)r * NE + lane]; sl1 = tokslot[(size_t)(r + 1) * NE + lane]; }
        load_xrow(X + (size_t)r * D, lane, v[0]); load_xrow(X + (size_t)(r + 1) * D, lane, v[1]);
        const Sel4 q0 = moe_sel4(YE, sl0, lane), q1 = moe_sel4(YE, sl1, lane); u32x4 w0[4][2], w1[4][2]; moe_load4(q0, w0); moe_load4(q1, w1);
        f32x4 a0[4], a1[4]; moe_acc4(q0, w0, a0); moe_acc4(q1, w1, a1);
        if (q0.rest) moe_gather_rest(YE, sl0, q0.rest, lane, a0); if (q1.rest) moe_gather_rest(YE, sl1, q1.rest, lane, a1);
#pragma unroll
        for (int j = 0; j < 4; ++j) { const f32x4 g2 = *(const f32x4*)(modp + (size_t)mr * 6144 + 5 * 1024 + CJ(j));
            *(f32x4*)(p.out + (size_t)r * D + CJ(j)) = v[0][j] + g2 * a0[j]; *(f32x4*)(p.out + (size_t)(r + 1) * D + CJ(j)) = v[1][j] + g2 * a1[j]; }
    }
}

__device__ __forceinline__ unsigned cvtpk_(float lo, float hi) { unsigned r; asm volatile("v_cvt_pk_bf16_f32 %0, %1, %2" : "=v"(r) : "v"(lo), "v"(hi)); return r; }
__device__ __forceinline__ void cvt_item(const float* W, int N, bf16* WT, int gu, LAS unsigned char* img, int item, int tid) {
    const int nblk = N / 512, kb = item / nblk, nb = item % nblk, k0 = 64 * kb, n0 = 512 * nb;
    const int lane = tid & 63, w = tid >> 6;
    const float* src = W + (size_t)(k0 + 8 * w) * N + n0 + 4 * lane;
    f32x4 a[4][2], b[4][2];
#pragma unroll
    for (int j = 0; j < 4; ++j)
#pragma unroll
        for (int hh = 0; hh < 2; ++hh) { a[j][hh] = __builtin_nontemporal_load((const f32x4*)(src + (size_t)(2 * j) * N + 256 * hh)); b[j][hh] = __builtin_nontemporal_load((const f32x4*)(src + (size_t)(2 * j + 1) * N + 256 * hh)); }
    __syncthreads();
    const int sw = (lane >> 1) & 7;
#pragma unroll
    for (int hh = 0; hh < 2; ++hh)
#pragma unroll
        for (int j = 0; j < 4; ++j) { const int wofs = ((w ^ sw) * 4 + j) * 4;
            LAS unsigned char* rowp = img + (size_t)(4 * lane + 256 * hh) * 144 + wofs;
            *(LAS unsigned*)(rowp) = cvtpk_(a[j][hh].x, b[j][hh].x); *(LAS unsigned*)(rowp + 144) = cvtpk_(a[j][hh].y, b[j][hh].y);
            *(LAS unsigned*)(rowp + 288) = cvtpk_(a[j][hh].z, b[j][hh].z); *(LAS unsigned*)(rowp + 432) = cvtpk_(a[j][hh].w, b[j][hh].w); }
    __syncthreads();
    const int jq = tid & 7, nr = tid >> 3;
#pragma unroll
    for (int i = 0; i < 8; ++i) { const int n = nr + 64 * i; const u32x4 v = *(const LAS u32x4*)(img + n * 144 + ((jq ^ ((n >> 3) & 7)) * 16));
        const int ncol = n0 + n; int drow;
        if (gu < 0) drow = ncol; else if (gu < 2) drow = (ncol >> 7) * 256 + (ncol & 127) + gu * 128;
        else { const int ch = (ncol - 1024) & 1023; drow = ncol < 1024 ? ncol : 1024 + (ch >> 7) * 256 + (ncol >= 2048 ? 128 : 0) + (ch & 127); }
        *(u32x4*)(WT + (size_t)drow * 1024 + k0 + 8 * jq) = v; }
}
__device__ __forceinline__ void ph_convert(const Prm& p, int l, LAS unsigned char* lds) {
    const int tid = otid();
    const bool even = (l & 1) == 0; const int Nin = even ? 4096 : 3072;
    const float* Win = even ? p.even_w_in + (size_t)(l / 2) * D * 4096 : p.conv_w_in + (size_t)(l / 2) * D * 3072;
    const float* Wout = even ? p.even_w_out + (size_t)(l / 2) * D * D : p.conv_w_out + (size_t)(l / 2) * D * D;
    const int I_IN = 16 * (Nin / 512), I_OUT = 32, I_E = 32;
    const int total = I_IN + I_OUT + NE * 3 * I_E;
    for (int it = obid(); it < total; it += gridDim.x) {
        int r = it;
        if (r < I_IN) { cvt_item(Win, Nin, (bf16*)(p.ws + WS_WIN), even ? -1 : 2, lds, r, tid); continue; } r -= I_IN;
        if (r < I_OUT) { cvt_item(Wout, D, (bf16*)(p.ws + WS_WOUT), -1, lds, r, tid); continue; } r -= I_OUT;
        const int e = r / (3 * I_E), w = (r / I_E) % 3, item = r % I_E;
        if (w < 2) cvt_item((w == 0 ? p.w_gate : p.w_up) + ((size_t)l * NE + e) * D * FF, FF, (bf16*)(p.ws + WS_WUP) + (size_t)e * 2048 * D, w, lds, item, tid);
        else cvt_item(p.w_down + ((size_t)l * NE + e) * FF * D, D, (bf16*)(p.ws + WS_WDN) + (size_t)e * D * FF, -1, lds, item, tid);
    }
    __syncthreads();
}

template <int MODE> __device__ __forceinline__ void ph_probe_read(const Prm& p, int l) {
    const f32x4* s0 = (const f32x4*)(p.w_gate + (size_t)l * NE * D * FF);
    const f32x4* s1 = (const f32x4*)(p.w_up + (size_t)l * NE * D * FF); const f32x4* s2 = (const f32x4*)(p.w_down + (size_t)l * NE * D * FF);
    const size_t n4 = (size_t)NE * D * FF / 4; f32x4 acc = (f32x4){0.f, 0.f, 0.f, 0.f};
    if (MODE == 0 || MODE == 1) {
        const size_t st = (size_t)gridDim.x * NTHREADS;
        for (size_t i = (size_t)obid() * NTHREADS + otid(); i < n4; i += st * 4) {
#pragma unroll
            for (int t = 0; t < 3; ++t) { const f32x4* s = t == 0 ? s0 : (t == 1 ? s1 : s2);
#pragma unroll
                for (int k = 0; k < 4; ++k) { const size_t j = i + k * st; if (j < n4) acc += (MODE == 1) ? __builtin_nontemporal_load(s + j) : s[j]; } } }
    } else {
        constexpr int NL = MODE == 2 ? 16 : 32; const int lane = otid() & 63; const size_t gw = (size_t)obid() * 8 + (otid() >> 6), ngw = (size_t)gridDim.x * 8;
        const size_t nch = 3 * n4 / (64 * NL);
        for (size_t c = gw; c < nch; c += ngw) { const size_t base = c * 64 * NL; const f32x4* s = base < n4 ? s0 + base : (base < 2 * n4 ? s1 + (base - n4) : s2 + (base - 2 * n4));
            f32x4 v[NL];
#pragma unroll
            for (int k = 0; k < NL; ++k) v[k] = __builtin_nontemporal_load(s + k * 64 + lane);
#pragma unroll
            for (int k = 0; k < NL; ++k) acc += v[k]; }
    }
    if (acc.x + acc.y + acc.z + acc.w == 1.2345e33f) ((float*)(p.ws + WS_OF))[otid()] = acc.x;
}
template <int MODE> __device__ __forceinline__ void ph_probe_cvt(const Prm& p, int l) {
    const int lane = otid() & 63, gw = obid() * 8 + (otid() >> 6), ngw = gridDim.x * 8; f32x4 acc = (f32x4){0.f, 0.f, 0.f, 0.f};
    for (int it = gw; it < NE * 3 * 256; it += ngw) { const int e = it / 768, w = (it / 256) % 3, item = it % 256, kb = item / 16, nb = item % 16;
        if (MODE == 4) { const float* W = (w == 0 ? p.w_gate : (w == 1 ? p.w_up : p.w_down)) + ((size_t)l * NE + e) * D * FF; const float* src = W + (size_t)(64 * kb + 2 * (lane >> 4)) * 1024 + 64 * nb + 4 * (lane & 15);
#pragma unroll
            for (int j = 0; j < 8; ++j) { acc += __builtin_nontemporal_load((const f32x4*)(src + (size_t)(8 * j) * 1024)); acc += __builtin_nontemporal_load((const f32x4*)(src + (size_t)(8 * j + 1) * 1024)); } }
        else { bf16* WT = (bf16*)(p.ws + WS_OF) + (size_t)((e * 3 + w) % 16) * 1024 * 1024; const u32x4 v = {(unsigned)it, 1u, 2u, 3u};
#pragma unroll
            for (int i = 0; i < 8; ++i) { const int n = (lane >> 3) + 8 * i; *(u32x4*)(WT + (size_t)(64 * nb + n) * 1024 + 64 * kb + 8 * (lane & 7)) = v; } } }
    if (acc.x + acc.y + acc.z + acc.w == 1.2345e33f) ((float*)(p.ws + WS_OF))[otid()] = acc.x;
}
__device__ __forceinline__ void ph_gemm_in(const Prm& p, int l, LAS unsigned char* ldsb) {
    const bool even = (l & 1) == 0; const int N = even ? 4096 : 3072; const int M = (l <= 2) ? MT : ML;
    pg8::Gemm g{(const bf16*)(p.ws + WS_H), (const bf16*)(p.ws + WS_WIN), M, N, D};
    if (even) { pg8::StaticOrderT<4> S; S.init(M, N, (int)gridDim.x, obid(), ML); pg8::EpiBf16 E{(bf16*)(p.ws + WS_PROJ), N}; pg8::gemm_phase<pg8::EpiBf16, pg8::StaticOrderT<4>, true, true>(ldsb, g, S, E); }
    else { pg8::StaticOrderT<2> S; S.init(M, N, (int)gridDim.x, obid(), ML); pg8::EpiConvIn E{(bf16*)(p.ws + WS_PROJ)}; pg8::gemm_phase<pg8::EpiConvIn, pg8::StaticOrderT<2>, true, true>(ldsb, g, S, E); }
}
__device__ __forceinline__ void ph_gemm_out(const Prm& p, int l, LAS unsigned char* ldsb) {
    const int M = ML;
    pg8::Gemm g{(const bf16*)(p.ws + WS_MIX), (const bf16*)(p.ws + WS_WOUT), M, D, D}; pg8::StaticOrder S; S.init(M, D, (int)gridDim.x, obid());
    pg8::EpiGY E{(bf16*)(p.ws + WS_H), (const float*)(p.ws + WS_MODV) + (size_t)l * 5 * 6144 + 2 * 1024, ML};
    pg8::gemm_phase<pg8::EpiGY, pg8::StaticOrder, true, true>(ldsb, g, S, E);
}
__device__ __forceinline__ void ph_expert_up(const Prm& p, int l, LAS unsigned char* ldsb) {
    pg8::Gemm g{(const bf16*)(p.ws + WS_H2), (const bf16*)(p.ws + WS_WUP), NE * XR, NE * 2048, D};
    pg8::GroupOrderT<8, 0> S; S.init((l < 2) ? 9 : 8, NE, (int)gridDim.x, vcu_id());
    pg8::EpiSwiglu E{(bf16*)(p.ws + WS_ACT), 8};
    pg8::GatherA AO{(const int*)(p.ws + WS_SEL), XR, 9, (l < 2) ? 2176 : 2048};
    pg8::gemm_phase<pg8::EpiSwiglu, pg8::GroupOrderT<8, 0>, true, true, pg8::GatherA>(ldsb, g, S, E, AO);
}
__device__ __forceinline__ void ph_expert_down(const Prm& p, int l, LAS unsigned char* ldsb) {
    pg8::Gemm g{(const bf16*)(p.ws + WS_ACT), (const bf16*)(p.ws + WS_WDN), NE * XR, NE * 1024, FF};
    pg8::GroupOrderT<4, 1> S; S.init((l < 2) ? 9 : 8, NE, (int)gridDim.x, vcu_id());
    pg8::EpiDown E{(bf16*)(p.ws + WS_YE), (const float*)(p.ws + WS_GATE), 4};
    pg8::gemm_phase<pg8::EpiDown, pg8::GroupOrderT<4, 1>, true, true>(ldsb, g, S, E);
}

__device__ __forceinline__ void ph_qkprep(const Prm& p, int l) {
    const int e = l / 2; bf16* PROJ = (bf16*)(p.ws + WS_PROJ); const float* rope = (const float*)(p.ws + WS_ROPE);
    const int NQK0 = gridDim.x == 256 ? 64 : 0;
    if (obid() < NQK0) return;
    const int j = otid() & 7, ngrp = ((int)gridDim.x - NQK0) * (NTHREADS / 8);
    const float* kg = p.kn_g + e * 64;
    const f32x4 g0 = *(const f32x4*)(kg + 8 * j), g1 = *(const f32x4*)(kg + 8 * j + 4);
    const float gg[8] = {g0.x, g0.y, g0.z, g0.w, g1.x, g1.y, g1.z, g1.w};
    const int total = MT * 8;
    for (int g = ((obid() - NQK0) * NTHREADS + otid()) >> 3; g < total; g += ngrp) {
        const int r = g >> 3, hm = g & 7;
        bf16* ptr = PROJ + (size_t)r * 4096 + 2560 + 512 + hm * 64 + 8 * j;
        const u32x4 w = *(const u32x4*)ptr; const unsigned ww[4] = {w.x, w.y, w.z, w.w};
        float v[8];
#pragma unroll
        for (int m = 0; m < 4; ++m) { v[2 * m] = __uint_as_float(ww[m] << 16); v[2 * m + 1] = __uint_as_float(ww[m] & 0xffff0000u); }
        float s = 0.f;
#pragma unroll
        for (int m = 0; m < 8; ++m) s += v[m] * v[m];
        s += __shfl_xor(s, 1); s += __shfl_xor(s, 2); s += __shfl_xor(s, 4);
        const float rstd = rsqrtf(s * (1.f / 64.f) + EPS);
#pragma unroll
        for (int m = 0; m < 8; ++m) v[m] *= rstd * gg[m];
        if (r < ML) { const int t = r & 4095, pos = (j & 4) ? (t & 63) : (t >> 6);
            const float* rp = rope + (pos * 16 + 8 * (j & 1)) * 2; const f32x4 c0 = *(const f32x4*)rp, c1 = *(const f32x4*)(rp + 4), c2 = *(const f32x4*)(rp + 8), c3 = *(const f32x4*)(rp + 12);
            const float cs[16] = {c0.x, c0.y, c0.z, c0.w, c1.x, c1.y, c1.z, c1.w, c2.x, c2.y, c2.z, c2.w, c3.x, c3.y, c3.z, c3.w};
            const float sg = (j & 2) ? 1.f : -1.f;
#pragma unroll
            for (int m = 0; m < 8; ++m) { const float pv = __shfl_xor(v[m], 2); v[m] = v[m] * cs[2 * m] + sg * pv * cs[2 * m + 1]; } }
        *(u32x4*)ptr = (u32x4){cvtpk_(v[0], v[1]), cvtpk_(v[2], v[3]), cvtpk_(v[4], v[5]), cvtpk_(v[6], v[7])};
    }
}

__device__ __forceinline__ void ph_hgrn_naive(const Prm& p, int l, LAS float* lds) {
    const int ev = l / 2; const bf16* PROJ = (const bf16*)(p.ws + WS_PROJ); float* OF = (float*)(p.ws + WS_OF);
    const int tid = otid(), el = tid >> 4, dg = tid & 15;
    LAS float* sq = lds;
    LAS float* sk = lds + 64 * 128;
    LAS float* sf = lds + 2 * 64 * 128;
    LAS float* sv = lds + 3 * 64 * 128;
    for (int it = obid(); it < 128; it += gridDim.x) {
        const int b = it >> 5, h = (it >> 3) & 3, dir = (it >> 2) & 1, eq = it & 3;
        float S[8];
#pragma unroll
        for (int j = 0; j < 8; ++j) S[j] = 0.f;
        for (int c0 = 0; c0 < (TC + T) / 64; ++c0) {
            const bool isc = c0 < 4; const int step0 = isc ? c0 * 64 : (c0 - 4) * 64; const int len = isc ? TC : T; const int rbase = isc ? ML + b * TC : b * T;
            __syncthreads();
            for (int i = tid; i < 64 * 128; i += NTHREADS) { const int s = i >> 7, d = i & 127; const int tt = dir ? (len - 1 - (step0 + s)) : (step0 + s);
                const bf16* row = PROJ + (size_t)(rbase + tt) * 4096; const int col = h * 128 + d;
                float lb = 0.f;
                if (ev == 1) { const float l0 = p.hgrn_lb[(0 * 2 + dir) * 512 + col], l1 = p.hgrn_lb[(1 * 2 + dir) * 512 + col]; lb = 1.f / (1.f + __expf(l0 - l1)); }
                const float z = bf2f(row[512 + dir * 512 + col]); const float sg = sigmoidf_(z);
                const float f = lb + (1.f - lb) * sg;
                sq[i] = bf2f(row[col]); sf[i] = f; sk[i] = 1.f - f; }
            for (int i = tid; i < 64 * 32; i += NTHREADS) { const int s = i >> 5, e2 = i & 31; const int tt = dir ? (len - 1 - (step0 + s)) : (step0 + s);
                sv[i] = bf2f(PROJ[(size_t)(rbase + tt) * 4096 + 1536 + h * 128 + eq * 32 + e2]); }
            __syncthreads();
#pragma unroll 1
            for (int s = 0; s < 64; ++s) {
                const f32x4 q0 = *(const LAS f32x4*)(sq + s * 128 + dg * 8), q1 = *(const LAS f32x4*)(sq + s * 128 + dg * 8 + 4);
                const f32x4 k0 = *(const LAS f32x4*)(sk + s * 128 + dg * 8), k1 = *(const LAS f32x4*)(sk + s * 128 + dg * 8 + 4);
                const f32x4 f0 = *(const LAS f32x4*)(sf + s * 128 + dg * 8), f1 = *(const LAS f32x4*)(sf + s * 128 + dg * 8 + 4);
                const float v = sv[s * 32 + el];
                S[0] = f0.x * S[0] + k0.x * v; S[1] = f0.y * S[1] + k0.y * v; S[2] = f0.z * S[2] + k0.z * v; S[3] = f0.w * S[3] + k0.w * v;
                S[4] = f1.x * S[4] + k1.x * v; S[5] = f1.y * S[5] + k1.y * v; S[6] = f1.z * S[6] + k1.z * v; S[7] = f1.w * S[7] + k1.w * v;
                float o = q0.x * S[0] + q0.y * S[1] + q0.z * S[2] + q0.w * S[3] + q1.x * S[4] + q1.y * S[5] + q1.z * S[6] + q1.w * S[7];
                o += __shfl_xor(o, 1); o += __shfl_xor(o, 2); o += __shfl_xor(o, 4); o += __shfl_xor(o, 8);
                if (dg == 0) { const int tt = dir ? (len - 1 - (step0 + s)) : (step0 + s); OF[((size_t)dir * MT + rbase + tt) * 512 + h * 128 + eq * 32 + el] = o; }
            }
        }
        __syncthreads();
    }
}
__device__ __forceinline__ void ph_hgrn_readout(const Prm& p, int l) {
    const int ev = l / 2; const bf16* PROJ = (const bf16*)(p.ws + WS_PROJ); const float* OF = (const float*)(p.ws + WS_OF); bf16* MIX = (bf16*)(p.ws + WS_MIX);
    const int lane = otid() & 63, gw = obid() * 8 + (otid() >> 6), ngw = gridDim.x * 8;
    const int nrows = (l < 2) ? MT : ML;
    for (int g = gw; g < nrows * 4; g += ngw) { const int r = g >> 2, h = g & 3;
        const float o0 = OF[(size_t)r * 512 + h * 128 + lane] + OF[((size_t)MT + r) * 512 + h * 128 + lane];
        const float o1 = OF[(size_t)r * 512 + h * 128 + 64 + lane] + OF[((size_t)MT + r) * 512 + h * 128 + 64 + lane];
        const float rstd = rsqrtf(wave_sum(o0 * o0 + o1 * o1) * (1.f / 128.f) + EPS);
        const float g0 = p.hgrn_g[(ev * 4 + h) * 128 + lane], g1 = p.hgrn_g[(ev * 4 + h) * 128 + 64 + lane];
        const float ga0 = bf2f(PROJ[(size_t)r * 4096 + 2048 + h * 128 + lane]), ga1 = bf2f(PROJ[(size_t)r * 4096 + 2048 + h * 128 + 64 + lane]);
        MIX[(size_t)r * D + h * 128 + lane] = f2bf(o0 * rstd * g0 * siluf_(ga0)); MIX[(size_t)r * D + h * 128 + 64 + lane] = f2bf(o1 * rstd * g1 * siluf_(ga1)); }
}

namespace dat {
using bf16x8 = __attribute__((ext_vector_type(8))) short;
using s16x4  = __attribute__((ext_vector_type(4))) short;
using f32x16 = __attribute__((ext_vector_type(16))) float;
constexpr int SHM_V = 64 * 128 * 2, SHM_K = 64 * 128 * 2;
#define DKSWZ(row, colB) ((row) * 256 + ((colB) ^ (((row) & 7) << 4)))
__device__ __forceinline__ int crow(int r, int hi) { return (r & 3) + 8 * (r >> 2) + 4 * hi; }
__device__ __forceinline__ unsigned cvtpk(float lo, float hi) { unsigned r; asm volatile("v_cvt_pk_bf16_f32 %0, %1, %2" : "=v"(r) : "v"(lo), "v"(hi)); return r; }
__device__ __forceinline__ int v_st(int k, int c) { const int kk = (k & ~0xC) | ((k & 4) << 1) | ((k & 8) >> 1); return ((kk >> 3) * 4 + (c >> 5)) * 512 + ((kk & 7) * 32 + (c & 31)) * 2; }
__device__ __forceinline__ int v_rd_base(int lane) { return ((lane & 3) << 3) | (((lane >> 2) & 3) << 6) | (((lane >> 4) & 1) << 5) | (((lane >> 5) & 1) << 8); }
constexpr int v_rd_off(int d0, int ks, int half) { return d0 * 512 + ks * 4096 + half * 2048; }
template <int OFF> __device__ __forceinline__ s16x4 tr_read(int vb) { s16x4 r; asm volatile("ds_read_b64_tr_b16 %0, %1 offset:%2" : "=&v"(r) : "v"(vb), "i"(OFF) : "memory"); return r; }
template <int VAR> __device__ __forceinline__ void softmax_pack(f32x16& p0, f32x16& p1, float negb, float& l, bf16x8& pa0, bf16x8& pa1, bf16x8& pa2, bf16x8& pa3) {
    if (VAR == 5) {
#pragma unroll
    for (int r = 0; r < 16; ++r) { p0[r] = __builtin_amdgcn_exp2f(p0[r]); p1[r] = __builtin_amdgcn_exp2f(p1[r]); } }
    else if (VAR != 1) {
#pragma unroll
    for (int r = 0; r < 16; ++r) { p0[r] = __builtin_amdgcn_exp2f(p0[r] + negb); p1[r] = __builtin_amdgcn_exp2f(p1[r] + negb); } }
    float ps = 0.f;
#pragma unroll
    for (int r = 0; r < 16; ++r) ps += p0[r] + p1[r];
    { auto rr = __builtin_amdgcn_permlane32_swap(__float_as_uint(ps), __float_as_uint(ps), false, false); ps = __uint_as_float(rr[0]) + __uint_as_float(rr[1]); }
    l += ps;
#define DPK4(P, BASE, OUT) do { unsigned a0 = cvtpk(P[BASE + 0], P[BASE + 1]), a1 = cvtpk(P[BASE + 2], P[BASE + 3]);   \
    unsigned b0 = cvtpk(P[BASE + 4], P[BASE + 5]), b1 = cvtpk(P[BASE + 6], P[BASE + 7]);                              \
    auto r0 = __builtin_amdgcn_permlane32_swap(a0, b0, false, false); auto r1 = __builtin_amdgcn_permlane32_swap(a1, b1, false, false); \
    u32x4 w = {r0[0], r1[0], r0[1], r1[1]}; OUT = *reinterpret_cast<bf16x8*>(&w); } while (0)
    DPK4(p0, 0, pa0); DPK4(p0, 8, pa1); DPK4(p1, 0, pa2); DPK4(p1, 8, pa3);
#undef DPK4
}
template <int D0> __device__ __forceinline__ void pv_one(f32x16& oa, int vb, const bf16x8 (&pa)[4]) {
    const s16x4 l0 = tr_read<v_rd_off(D0, 0, 0)>(vb), h0 = tr_read<v_rd_off(D0, 0, 1)>(vb), l1 = tr_read<v_rd_off(D0, 1, 0)>(vb), h1 = tr_read<v_rd_off(D0, 1, 1)>(vb);
    const s16x4 l2 = tr_read<v_rd_off(D0, 2, 0)>(vb), h2 = tr_read<v_rd_off(D0, 2, 1)>(vb), l3 = tr_read<v_rd_off(D0, 3, 0)>(vb), h3 = tr_read<v_rd_off(D0, 3, 1)>(vb);
    asm volatile("s_waitcnt lgkmcnt(0)" ::: "memory"); __builtin_amdgcn_sched_barrier(0);
#define DPK1(L, H) (bf16x8){L[0], L[1], L[2], L[3], H[0], H[1], H[2], H[3]}
    oa = __builtin_amdgcn_mfma_f32_32x32x16_bf16(pa[0], DPK1(l0, h0), oa, 0, 0, 0);
    oa = __builtin_amdgcn_mfma_f32_32x32x16_bf16(pa[1], DPK1(l1, h1), oa, 0, 0, 0);
    oa = __builtin_amdgcn_mfma_f32_32x32x16_bf16(pa[2], DPK1(l2, h2), oa, 0, 0, 0);
    oa = __builtin_amdgcn_mfma_f32_32x32x16_bf16(pa[3], DPK1(l3, h3), oa, 0, 0, 0);
#undef DPK1
}
#define DPK(L, H) (bf16x8){L[0], L[1], L[2], L[3], H[0], H[1], H[2], H[3]}
#define DVRD(KS, l0, h0, l1, h1, l2, h2, l3, h3) do { l0 = tr_read<v_rd_off(0, KS, 0)>(vb); h0 = tr_read<v_rd_off(0, KS, 1)>(vb); l1 = tr_read<v_rd_off(1, KS, 0)>(vb); h1 = tr_read<v_rd_off(1, KS, 1)>(vb); \
        l2 = tr_read<v_rd_off(2, KS, 0)>(vb); h2 = tr_read<v_rd_off(2, KS, 1)>(vb); l3 = tr_read<v_rd_off(3, KS, 0)>(vb); h3 = tr_read<v_rd_off(3, KS, 1)>(vb); } while (0)
#define DVMM(KS, l0, h0, l1, h1, l2, h2, l3, h3) do { o[0] = __builtin_amdgcn_mfma_f32_32x32x16_bf16(pa[KS], DPK(l0, h0), o[0], 0, 0, 0); o[1] = __builtin_amdgcn_mfma_f32_32x32x16_bf16(pa[KS], DPK(l1, h1), o[1], 0, 0, 0); \
        o[2] = __builtin_amdgcn_mfma_f32_32x32x16_bf16(pa[KS], DPK(l2, h2), o[2], 0, 0, 0); o[3] = __builtin_amdgcn_mfma_f32_32x32x16_bf16(pa[KS], DPK(l3, h3), o[3], 0, 0, 0); } while (0)
__device__ __forceinline__ void pv_all(f32x16 (&o)[4], int vb, const bf16x8 (&pa)[4]) {
    s16x4 a0, a1, a2, a3, a4, a5, a6, a7, b0, b1, b2, b3, b4, b5, b6, b7;
    DVRD(0, a0, a1, a2, a3, a4, a5, a6, a7);
    DVRD(1, b0, b1, b2, b3, b4, b5, b6, b7);
    asm volatile("s_waitcnt lgkmcnt(8)" ::: "memory"); __builtin_amdgcn_sched_barrier(0);
    DVMM(0, a0, a1, a2, a3, a4, a5, a6, a7);
    __builtin_amdgcn_sched_barrier(0);
    DVRD(2, a0, a1, a2, a3, a4, a5, a6, a7);
    asm volatile("s_waitcnt lgkmcnt(8)" ::: "memory"); __builtin_amdgcn_sched_barrier(0);
    DVMM(1, b0, b1, b2, b3, b4, b5, b6, b7);
    __builtin_amdgcn_sched_barrier(0);
    DVRD(3, b0, b1, b2, b3, b4, b5, b6, b7);
    asm volatile("s_waitcnt lgkmcnt(8)" ::: "memory"); __builtin_amdgcn_sched_barrier(0);
    DVMM(2, a0, a1, a2, a3, a4, a5, a6, a7);
    asm volatile("s_waitcnt lgkmcnt(0)" ::: "memory"); __builtin_amdgcn_sched_barrier(0);
    DVMM(3, b0, b1, b2, b3, b4, b5, b6, b7);
}
#undef DVRD
#undef DVMM
#undef DPK
template <int VAR> __device__ __forceinline__ void unit(const bf16* __restrict__ PROJ, bf16* __restrict__ MIX, int qrow0, int b, int h, bool ctxq, LAS unsigned char* lds,
                                     float negb, float lam, float onem, const float* __restrict__ sg, const float* __restrict__ qg, const float* __restrict__ ropet) {
    const int tid = otid(), wid = __builtin_amdgcn_readfirstlane(tid >> 6), lane = tid & 63, r32 = lane & 31, hi = lane >> 5, rb = wid >> 1, mp = wid & 1;
    LAS unsigned char* V_lds = lds; LAS unsigned char* K_lds = lds + 4 * SHM_V;
    LAS float* wsf = (LAS float*)(lds + 4 * SHM_V + 3 * SHM_K) + wid * 32;
    f32x16 o[4];
#pragma unroll
    for (int d = 0; d < 4; ++d)
#pragma unroll
        for (int r = 0; r < 16; ++r) o[d][r] = 0.f;
    float l = 0.f; bf16x8 qr[4];
    { const bf16* Qw = PROJ + (size_t)(qrow0 + rb * 32 + r32) * 4096 + 2560 + h * 128 + mp * 64 + hi * 8;
      float q[4][8]; float ss = 0.f;
#pragma unroll
      for (int d = 0; d < 4; ++d) { const u32x4 w = *(const u32x4*)(Qw + d * 16); const unsigned ww[4] = {w.x, w.y, w.z, w.w};
#pragma unroll
          for (int k = 0; k < 4; ++k) { q[d][2 * k] = __uint_as_float(ww[k] << 16); q[d][2 * k + 1] = __uint_as_float(ww[k] & 0xffff0000u); ss += q[d][2 * k] * q[d][2 * k] + q[d][2 * k + 1] * q[d][2 * k + 1]; } }
      { auto rr = __builtin_amdgcn_permlane32_swap(__float_as_uint(ss), __float_as_uint(ss), false, false); ss = __uint_as_float(rr[0]) + __uint_as_float(rr[1]); }
      const float rstd = rsqrtf(ss * (1.f / 64.f) + EPS);
#pragma unroll
      for (int d = 0; d < 4; ++d)
#pragma unroll
          for (int j = 0; j < 8; ++j) q[d][j] *= rstd * qg[d * 16 + hi * 8 + j];
      if (!ctxq) { const int t = (qrow0 + rb * 32 + r32) & (T - 1), pr = t >> 6, pc = t & 63;
#pragma unroll
          for (int j = 0; j < 8; ++j) { const int i = hi * 8 + j; const float c0 = ropet[(pr * 16 + i) * 2], s0 = ropet[(pr * 16 + i) * 2 + 1], c1 = ropet[(pc * 16 + i) * 2], s1 = ropet[(pc * 16 + i) * 2 + 1];
              const float a0 = q[0][j] * c0 - q[1][j] * s0, a1 = q[1][j] * c0 + q[0][j] * s0, a2 = q[2][j] * c1 - q[3][j] * s1, a3 = q[3][j] * c1 + q[2][j] * s1; q[0][j] = a0; q[1][j] = a1; q[2][j] = a2; q[3][j] = a3; } }
      const float qs = 0.125f * 1.4426950408889634f;
#pragma unroll
      for (int d = 0; d < 4; ++d) { u32x4 w; w.x = cvtpk(q[d][0] * qs, q[d][1] * qs); w.y = cvtpk(q[d][2] * qs, q[d][3] * qs); w.z = cvtpk(q[d][4] * qs, q[d][5] * qs); w.w = cvtpk(q[d][6] * qs, q[d][7] * qs); qr[d] = *reinterpret_cast<bf16x8*>(&w); } }
    const int vb0 = (int)(uintptr_t)V_lds + v_rd_base(lane);
    const int NT = ctxq ? (TC / 64) : ((T + TC) / 64);
    const int rb_lat = b * T, rb_ctx = ML + b * TC;
    const int kb0 = (mp * 64 + hi * 8) * 2;
    unsigned ksrc[2], vsrc[2];
#pragma unroll
    for (int i = 0; i < 2; ++i) { const int G = wid * 128 + i * 64 + lane;
        { const int row = G >> 4, ch = (G & 15) ^ (row & 7); ksrc[i] = (unsigned)(row * 8192 + (3072 + h * 128) * 2 + ch * 16); }
        { const int sub = G >> 5, within = G & 31, kk = (sub >> 2) * 8 + (within >> 2), cg = (sub & 3) * 4 + (within & 3); const int k = (kk & ~0xC) | ((kk & 4) << 1) | ((kk & 8) >> 1);
          vsrc[i] = (unsigned)(k * 8192 + (3584 + h * 128) * 2 + cg * 16); } }
#define DROWB(t) ((t) * 64 < T || ctxq ? (ctxq ? rb_ctx + (t) * 64 : rb_lat + (t) * 64) : rb_ctx + ((t) * 64 - T))
#define DDMA(SRC, t, LBUF) do { const char* tb_ = (const char*)PROJ + (size_t)DROWB(t) * 8192; _Pragma("unroll") for (int i_ = 0; i_ < 2; ++i_) \
        __builtin_amdgcn_global_load_lds((const unsigned*)(tb_ + SRC[i_]), (LAS unsigned*)((LBUF) + wid * 2048 + i_ * 1024), 16, 0, 0); } while (0)
#define DQKT(P0, P1, Kt) do { _Pragma("unroll") for (int r = 0; r < 16; ++r) { P0[r] = 0.f; P1[r] = 0.f; } \
        _Pragma("unroll") for (int d = 0; d < 4; ++d) { const int cb = kb0 + d * 32; \
            const bf16x8 b0 = *(const LAS bf16x8*)((Kt) + DKSWZ(r32, cb)); const bf16x8 b1 = *(const LAS bf16x8*)((Kt) + DKSWZ(32 + r32, cb)); \
            P0 = __builtin_amdgcn_mfma_f32_32x32x16_bf16(b0, qr[d], P0, 0, 0, 0); P1 = __builtin_amdgcn_mfma_f32_32x32x16_bf16(b1, qr[d], P1, 0, 0, 0); } } while (0)
#define DBAR() do { asm volatile("s_waitcnt lgkmcnt(0)" ::: "memory"); __builtin_amdgcn_s_barrier(); asm volatile("" ::: "memory"); } while (0)
    const bool late = wid >= 4;
    __syncthreads();
    DDMA(ksrc, 0, K_lds); DDMA(vsrc, 0, V_lds); DDMA(ksrc, 1, K_lds + SHM_K); DDMA(vsrc, 1, V_lds + SHM_V); DDMA(ksrc, 2, K_lds + 2 * SHM_K);
    asm volatile("s_waitcnt vmcnt(0)" ::: "memory"); DBAR();
    f32x16 pA0, pA1, pB0, pB1; bf16x8 pa[4];
    DQKT(pA0, pA1, K_lds);
    DBAR();
#define DSTEP(PC0, PC1, PN0, PN1, t) do { \
        if ((t) + 3 < NT) DDMA(ksrc, (t) + 3, K_lds + ((t) % 3) * SHM_K); if ((t) + 2 < NT) DDMA(vsrc, (t) + 2, V_lds + (((t) + 2) & 3) * SHM_V); \
        if (late && (t) > 0) { const int vbp = vb0 + (((t) - 1) & 3) * SHM_V; pv_one<0>(o[0], vbp, pa); pv_one<1>(o[1], vbp, pa); pv_one<2>(o[2], vbp, pa); pv_one<3>(o[3], vbp, pa); } \
        if ((t) + 1 < NT) DQKT(PN0, PN1, K_lds + (((t) + 1) % 3) * SHM_K); \
        softmax_pack<VAR>(PC0, PC1, negb, l, pa[0], pa[1], pa[2], pa[3]); \
        if (!late) { const int vb = vb0 + ((t) & 3) * SHM_V; pv_one<0>(o[0], vb, pa); pv_one<1>(o[1], vb, pa); pv_one<2>(o[2], vb, pa); pv_one<3>(o[3], vb, pa); } \
        if ((t) + 3 < NT) asm volatile("s_waitcnt vmcnt(4)" ::: "memory"); else asm volatile("s_waitcnt vmcnt(0)" ::: "memory"); \
        DBAR(); } while (0)
    for (int t = 0; t < NT; t += 2) {
        DSTEP(pA0, pA1, pB0, pB1, t);
        DSTEP(pB0, pB1, pA0, pA1, t + 1);
    }
    if (late) { const int vbp = vb0 + ((NT - 1) & 3) * SHM_V; pv_one<0>(o[0], vbp, pa); pv_one<1>(o[1], vbp, pa); pv_one<2>(o[2], vbp, pa); pv_one<3>(o[3], vbp, pa); }
    __syncthreads();
#undef DSTEP
#undef DQKT
#undef DDMA
#undef DBAR
#undef DROWB
    if (hi == 0) wsf[r32] = l;
    asm volatile("s_waitcnt lgkmcnt(0)" ::: "memory");
    LAS float* xch = (LAS float*)lds + rb * (16 * 4 * 64);
    if (mp == 1) {
#pragma unroll
        for (int r = 0; r < 16; ++r) { const float i1 = lam * __builtin_amdgcn_rcpf(wsf[crow(r, hi)]);
#pragma unroll
            for (int d = 0; d < 4; ++d) xch[(r * 4 + d) * 64 + lane] = o[d][r] * i1; }
    }
    __syncthreads();
    if (mp == 0) {
        float g4[4];
#pragma unroll
        for (int d = 0; d < 4; ++d) g4[d] = sg[32 * d + r32] * onem;
        LAS unsigned char* ot = lds + 65536 + (size_t)(rb * 32) * 272;
#pragma unroll
        for (int r = 0; r < 16; ++r) { const int row = crow(r, hi); const float i0 = __builtin_amdgcn_rcpf(wsf[row]);
            float w[4], ss = 0.f;
#pragma unroll
            for (int d = 0; d < 4; ++d) { w[d] = o[d][r] * i0 - xch[(r * 4 + d) * 64 + lane]; ss += w[d] * w[d]; }
            ss += __shfl_xor(ss, 1); ss += __shfl_xor(ss, 2); ss += __shfl_xor(ss, 4); ss += __shfl_xor(ss, 8); ss += __shfl_xor(ss, 16);
            const float rstd = rsqrtf(ss * (1.f / 128.f) + EPS);
#pragma unroll
            for (int d = 0; d < 4; ++d) *(LAS bf16*)(ot + row * 272 + (32 * d + r32) * 2) = f2bf(w[d] * rstd * g4[d]); }
    }
    __syncthreads();
    {
        const int row = tid >> 2, cq = (tid & 3) * 64; const LAS unsigned char* sp = lds + 65536 + row * 272 + cq; bf16* dst = MIX + (size_t)(qrow0 + row) * D + 512 + h * 128 + cq / 2;
#pragma unroll
        for (int k = 0; k < 4; ++k) *(u32x4*)(dst + 8 * k) = *(const LAS u32x4*)(sp + 16 * k); }
}
}
template <int VAR> __device__ __forceinline__ void ph_attn(const Prm& p, int l, LAS unsigned char* ldsb) {
    const int ev = l / 2; const bf16* PROJ = (const bf16*)(p.ws + WS_PROJ); bf16* MIX = (bf16*)(p.ws + ((VAR == 0 || VAR == 5) ? WS_MIX : WS_OF));
    const float lam_init = 0.8f - 0.6f * __expf(-0.3f * (float)l);
    float d0 = 0.f, d1 = 0.f;
    for (int i = 0; i < 64; ++i) { d0 += p.dlam[(ev * 4 + 0) * 64 + i] * p.dlam[(ev * 4 + 1) * 64 + i]; d1 += p.dlam[(ev * 4 + 2) * 64 + i] * p.dlam[(ev * 4 + 3) * 64 + i]; }
    const float lam = __expf(d0) - __expf(d1) + lam_init;
    float gq = 0.f, gk = 0.f;
    for (int i = 0; i < 64; ++i) { gq = fmaxf(gq, fabsf(p.qn_g[ev * 64 + i])); gk = fmaxf(gk, fabsf(p.kn_g[ev * 64 + i])); }
    const float negb = -8.f * gq * gk * 1.4426950408889634f;
    const int vc = vcu_id();
    for (int u = vc; u < 512; u += gridDim.x) { const int v2 = (u < 256) ? u * 2 : (u - 256) * 2 + 1;
        const int b = v2 >> 7, h = (v2 >> 5) & 3, qb = v2 & 31;
        if (VAR == 5 && negb < -48.f) dat::unit<0>(PROJ, MIX, b * T + qb * 128, b, h, false, ldsb, negb, lam, 1.f - lam_init, p.subln_g + ev * 128, p.qn_g + ev * 64, (const float*)(p.ws + WS_ROPE));
        else dat::unit<VAR>(PROJ, MIX, b * T + qb * 128, b, h, false, ldsb, negb, lam, 1.f - lam_init, p.subln_g + ev * 128, p.qn_g + ev * 64, (const float*)(p.ws + WS_ROPE)); }
    if (l == 0) for (int u = vc; u < 32; u += gridDim.x) { const int b = u >> 3, h = (u >> 1) & 3, qb = u & 1;
        if (VAR == 5 && negb < -48.f) dat::unit<0>(PROJ, MIX, ML + b * TC + qb * 128, b, h, true, ldsb, negb, lam, 1.f - lam_init, p.subln_g + ev * 128, p.qn_g + ev * 64, (const float*)(p.ws + WS_ROPE));
        else dat::unit<VAR>(PROJ, MIX, ML + b * TC + qb * 128, b, h, true, ldsb, negb, lam, 1.f - lam_init, p.subln_g + ev * 128, p.qn_g + ev * 64, (const float*)(p.ws + WS_ROPE)); }
    __syncthreads();
}

namespace hg {
using bf16x8 = __attribute__((ext_vector_type(8))) short;
__device__ __forceinline__ int swz256(int row, int colB) { return row * 256 + (colB ^ ((row & 15) << 4)); }
__device__ __forceinline__ int swz128(int row, int colB) { return row * 128 + (colB ^ (((row >> 1) & 7) << 4)); }
constexpr int BFS = 132;
constexpr int L_BF = 0, L_TOT = 33792, L_LB = 35840, L_P = 0, L_RED = 8192, L_QP = 36864, L_KP = 53248, L_QT = 69632, L_VT = 86016, L_ST = 102400;
__device__ __forceinline__ float lbound(const float* lbl, int ev, int dir, int col) {
    if (ev == 0) return 0.f; const float l0 = lbl[(0 * 2 + dir) * 512 + col], l1 = lbl[(1 * 2 + dir) * 512 + col]; return 1.f / (1.f + __expf(l0 - l1)); }
__device__ __forceinline__ void pass1(const bf16* PROJ, const float* lbl, int ev, int dir, int h, int row0, LAS unsigned char* lds, int tid) {
    const int qt = tid >> 7, d = tid & 127; const float lb = lbound(lbl, ev, dir, h * 128 + d);
    LAS float* Bf = (LAS float*)(lds + L_BF); float run = 0.f;
    const bf16* zp = PROJ + (size_t)row0 * 4096 + 512 + dir * 512 + h * 128 + d;
    float zv[16];
#pragma unroll
    for (int i = 0; i < 16; ++i) { const int s = qt * 16 + i, tau = dir ? 63 - s : s; zv[i] = bf2f(zp[(size_t)tau * 4096]); }
#pragma unroll
    for (int i = 0; i < 16; ++i) { const float f = lb + (1.f - lb) * sigmoidf_(zv[i]); run += __logf(fmaxf(f, 1e-30f)); Bf[(qt * 16 + i) * BFS + d] = run; }
    ((LAS float*)(lds + L_TOT))[qt * 128 + d] = run; if (qt == 0) ((LAS float*)(lds + L_LB))[d] = lb;
}
__device__ __forceinline__ void decay4(const LAS unsigned char* lds, int s, int d0, f32x4& b, f32x4& bmid, f32x4& blast, f32x4& lb) {
    const LAS float* Bf = (const LAS float*)(lds + L_BF); const LAS float* tot = (const LAS float*)(lds + L_TOT);
    const f32x4 t0 = *(const LAS f32x4*)(tot + d0), t1 = *(const LAS f32x4*)(tot + 128 + d0), t2 = *(const LAS f32x4*)(tot + 256 + d0), t3 = *(const LAS f32x4*)(tot + 384 + d0);
    const int qt = s >> 4; f32x4 pre = (f32x4){0.f, 0.f, 0.f, 0.f}; if (qt >= 1) pre += t0; if (qt >= 2) pre += t1; if (qt >= 3) pre += t2;
    b = *(const LAS f32x4*)(Bf + s * BFS + d0) + pre; bmid = t0 + t1; blast = (t0 + t1) + (t2 + t3); lb = *(const LAS f32x4*)((const LAS float*)(lds + L_LB) + d0);
}
__device__ __forceinline__ void pass1_pre(const float (&zv)[16], float lb, LAS unsigned char* lds, int tb, int tid) {
    const int qt = tid >> 7, d = tid & 127; LAS float* Bf = (LAS float*)(lds + tb + L_BF); float run = 0.f;
#pragma unroll
    for (int i = 0; i < 16; ++i) { const float f = lb + (1.f - lb) * sigmoidf_(zv[i]); run += __logf(fmaxf(f, 1e-30f)); Bf[(qt * 16 + i) * BFS + d] = run; }
    ((LAS float*)(lds + tb + L_TOT))[qt * 128 + d] = run; if (qt == 0) ((LAS float*)(lds + tb + L_LB))[d] = lb;
}
__device__ __forceinline__ void decay4b(const LAS unsigned char* lds, int tb, int s, int d0, f32x4& b, f32x4& bmid, f32x4& lb) {
    const LAS float* Bf = (const LAS float*)(lds + tb + L_BF); const LAS float* tot = (const LAS float*)(lds + tb + L_TOT);
    const f32x4 t0 = *(const LAS f32x4*)(tot + d0), t1 = *(const LAS f32x4*)(tot + 128 + d0), t2 = *(const LAS f32x4*)(tot + 256 + d0);
    const int qt = s >> 4; f32x4 pre = (f32x4){0.f, 0.f, 0.f, 0.f}; if (qt >= 1) pre += t0; if (qt >= 2) pre += t1; if (qt >= 3) pre += t2;
    b = *(const LAS f32x4*)(Bf + s * BFS + d0) + pre; bmid = t0 + t1; lb = *(const LAS f32x4*)((const LAS float*)(lds + tb + L_LB) + d0);
}
__device__ __forceinline__ void stage_vt(const bf16* PROJ, int h, int row0, LAS unsigned char* lds, int tid) {
    const int tau = tid >> 3, e0 = (tid & 7) * 16; const bf16* vp = PROJ + (size_t)(row0 + tau) * 4096 + 1536 + h * 128 + e0;
    const u32x4 w0 = *(const u32x4*)vp, w1 = *(const u32x4*)(vp + 8); const unsigned ww[8] = {w0.x, w0.y, w0.z, w0.w, w1.x, w1.y, w1.z, w1.w};
#pragma unroll
    for (int i = 0; i < 8; ++i) { *(LAS bf16*)(lds + L_VT + swz128(e0 + 2 * i, tau * 2)) = (bf16)(ww[i] & 0xffffu); *(LAS bf16*)(lds + L_VT + swz128(e0 + 2 * i + 1, tau * 2)) = (bf16)(ww[i] >> 16); }
}
}
template <int LV> __device__ __forceinline__ void ph_hgrn_local(const Prm& p, int l, LAS unsigned char* lds) {
    constexpr int RS = 288, L_VR = hg::L_VT, L_KR = hg::L_QP;
    const int ev = l / 2; const bf16* PROJ = (const bf16*)(p.ws + WS_PROJ); bf16* DS = (bf16*)(p.ws + (LV == 0 ? WS_HDS : WS_XE)); float* G = (float*)(p.ws + (LV == 0 ? WS_HG : WS_OF));
    const int tid = otid(), lane = tid & 63, wv = tid >> 6;
    for (int it = obid(); it < HG_ITEMS; it += gridDim.x) {
        const int c = it % HG_NCH, chain = it / HG_NCH, dir = chain & 1, h = (chain >> 1) & 3, b = chain >> 3;
        const bool isc = c < 4; const int j = isc ? c : c - 4, nt = isc ? 4 : 64, tj = dir ? nt - 1 - j : j; const int row0 = isc ? ML + b * TC + tj * 64 : b * T + tj * 64;
        u32x4 zpre0, zpre1;
        { const int s_ = tid >> 3, tau_ = dir ? 63 - s_ : s_; const bf16* zp_ = PROJ + (size_t)(row0 + tau_) * 4096 + 512 + dir * 512 + h * 128 + (tid & 7) * 16; zpre0 = *(const u32x4*)zp_; zpre1 = *(const u32x4*)(zp_ + 8); }
        float zv[16]; u32x4 vw0, vw1;
        { const int qt = tid >> 7, d = tid & 127; const bf16* zc = PROJ + (size_t)(row0 + (dir ? 63 - qt * 16 : qt * 16)) * 4096 + 512 + dir * 512 + h * 128 + d;
#pragma unroll
          for (int i = 0; i < 16; ++i) zv[i] = bf2f(dir ? *(zc - (size_t)i * 4096) : zc[(size_t)i * 4096]);
          const bf16* vp = PROJ + (size_t)(row0 + (tid >> 3)) * 4096 + 1536 + h * 128 + (tid & 7) * 16; vw0 = *(const u32x4*)vp; vw1 = *(const u32x4*)(vp + 8); }
        const float lbt = hg::lbound(p.hgrn_lb, ev, dir, h * 128 + (tid & 127));
        __syncthreads();
        hg::pass1_pre(zv, lbt, lds, 0, tid);
        { LAS unsigned char* vr = lds + L_VR + (tid >> 3) * RS + (tid & 7) * 32; *(LAS u32x4*)vr = vw0; *(LAS u32x4*)(vr + 16) = vw1; }
        __syncthreads();
        {
            const int s = tid >> 3, dg = (tid & 7) * 16, tau = dir ? 63 - s : s;
            const unsigned zz[8] = {zpre0.x, zpre0.y, zpre0.z, zpre0.w, zpre1.x, zpre1.y, zpre1.z, zpre1.w}; float kh[16];
#pragma unroll
            for (int g4 = 0; g4 < 4; ++g4) { f32x4 bb, bm, bl, lb; hg::decay4(lds, s, dg + g4 * 4, bb, bm, bl, lb);
#pragma unroll
                for (int i = 0; i < 4; ++i) { const int k = g4 * 4 + i, d = dg + k; const float z = (k & 1) ? __uint_as_float(zz[k >> 1] & 0xffff0000u) : __uint_as_float(zz[k >> 1] << 16);
                    const float f = lb[i] + (1.f - lb[i]) * sigmoidf_(z);
                    kh[k] = (1.f - f) * __expf(bl[i] - bb[i]);
                    if (s == 0) G[(size_t)it * 128 + d] = __expf(bl[i]); } }
            LAS unsigned char* kr = lds + L_KR + tau * RS + dg * 2;
            *(LAS u32x4*)kr = (u32x4){dat::cvtpk(kh[0], kh[1]), dat::cvtpk(kh[2], kh[3]), dat::cvtpk(kh[4], kh[5]), dat::cvtpk(kh[6], kh[7])};
            *(LAS u32x4*)(kr + 16) = (u32x4){dat::cvtpk(kh[8], kh[9]), dat::cvtpk(kh[10], kh[11]), dat::cvtpk(kh[12], kh[13]), dat::cvtpk(kh[14], kh[15])};
        }
        __syncthreads();
        {
            f32x4 acc[8];
#pragma unroll
            for (int db = 0; db < 8; ++db) acc[db] = (f32x4){0.f, 0.f, 0.f, 0.f};
            const int r16 = lane & 15, q4 = lane >> 4;
            const int trb = (q4 * 8 + (r16 >> 2)) * RS + (r16 & 3) * 8;
#pragma unroll
            for (int ks = 0; ks < 2; ++ks) { const int kb = trb + ks * 32 * RS;
                dat::s16x4 al, ah, bl_[8], bh_[8];
                { const int ad = (int)(uintptr_t)(lds + L_VR) + kb + wv * 32; asm volatile("ds_read_b64_tr_b16 %0, %1" : "=&v"(al) : "v"(ad) : "memory"); asm volatile("ds_read_b64_tr_b16 %0, %1 offset:1152" : "=&v"(ah) : "v"(ad) : "memory"); }
#pragma unroll
                for (int db = 0; db < 8; ++db) { const int ad = (int)(uintptr_t)(lds + L_KR) + kb + db * 32; asm volatile("ds_read_b64_tr_b16 %0, %1" : "=&v"(bl_[db]) : "v"(ad) : "memory"); asm volatile("ds_read_b64_tr_b16 %0, %1 offset:1152" : "=&v"(bh_[db]) : "v"(ad) : "memory"); }
                asm volatile("s_waitcnt lgkmcnt(0)" ::: "memory"); __builtin_amdgcn_sched_barrier(0);
                const hg::bf16x8 a = (hg::bf16x8){al[0], al[1], al[2], al[3], ah[0], ah[1], ah[2], ah[3]};
#pragma unroll
                for (int db = 0; db < 8; ++db) { const hg::bf16x8 bb = (hg::bf16x8){bl_[db][0], bl_[db][1], bl_[db][2], bl_[db][3], bh_[db][0], bh_[db][1], bh_[db][2], bh_[db][3]};
                    acc[db] = __builtin_amdgcn_mfma_f32_16x16x32_bf16(a, bb, acc[db], 0, 0, 0); } }
            bf16* dst = DS + (size_t)it * 16384;
#pragma unroll
            for (int db = 0; db < 8; ++db)
#pragma unroll
                for (int jj = 0; jj < 4; ++jj) dst[(wv * 16 + q4 * 4 + jj) * 128 + db * 16 + r16] = f2bf(acc[db][jj]);
        }
    }
    __syncthreads();
}
__device__ __forceinline__ void ph_hgrn_scan(const Prm& p) {
    const bf16* __restrict__ DS = (const bf16*)(p.ws + WS_HDS); bf16* __restrict__ ST = (bf16*)(p.ws + WS_HST); const float* __restrict__ G = (const float*)(p.ws + WS_HG);
    for (int gt = obid() * NTHREADS + otid(); gt < 32 * 128 * 32; gt += gridDim.x * NTHREADS) {
        const int chain = gt >> 12, rem = gt & 4095; const size_t eo = (size_t)(rem >> 5) * 128 + (rem & 31) * 4; const int dq = (rem & 31) * 4;
        float s0 = 0.f, s1 = 0.f, s2 = 0.f, s3 = 0.f;
#pragma unroll 4
        for (int c = 0; c < HG_NCH; ++c) { const size_t it = (size_t)chain * HG_NCH + c;
            const u32x2 dv = *(const u32x2*)(DS + it * 16384 + eo); const f32x4 g = *(const f32x4*)(G + it * 128 + dq);
            u32x2 o; o.x = pk2(s0, s1); o.y = pk2(s2, s3); *(u32x2*)(ST + it * 16384 + eo) = o;
            s0 = g.x * s0 + __uint_as_float(dv.x << 16); s1 = g.y * s1 + __uint_as_float(dv.x & 0xffff0000u); s2 = g.z * s2 + __uint_as_float(dv.y << 16); s3 = g.w * s3 + __uint_as_float(dv.y & 0xffff0000u); }
    }
}
template <int HV> __device__ __forceinline__ void ph_hgrn_out(const Prm& p, int l, LAS unsigned char* lds) {
    constexpr int L_P2 = hg::L_ST + 36864;
    constexpr int L_RED2 = L_P2;
    static_assert(L_P2 + 8192 <= LDS_BYTES - 256, "hgrn_out LDS map");
    const int ev = l / 2; const bf16* PROJ = (const bf16*)(p.ws + WS_PROJ); const bf16* ST = (const bf16*)(p.ws + WS_HST); bf16* MIX = (bf16*)(p.ws + (HV == 0 ? WS_MIX : WS_OF));
    const int tid = otid(), lane = tid & 63, wv = tid >> 6, r16 = lane & 15, q4 = lane >> 4;
    const int tt0 = (l < 2) ? 0 : 4;
    const int nitems = 16 * (HG_NCH - tt0);
    const bool bal = gridDim.x == 256 && nitems == 1088;
    for (int k = 0;; ++k) { int it = obid() + k * (int)gridDim.x;
        if (bal && k == 4) { const int m8 = obid() & 7; if (m8 != 1 && m8 != 2) break; it = 1024 + (obid() >> 3) + 32 * (m8 - 1); }
        if (it >= nitems) break;
        const int tt = tt0 + it % (HG_NCH - tt0), bh = it / (HG_NCH - tt0), h = bh & 3, b = bh >> 2;
        const bool isc = tt < 4; const int tj = isc ? tt : tt - 4, nt = isc ? 4 : 64; const int row0 = isc ? ML + b * TC + tj * 64 : b * T + tj * 64;
        const int s2 = tid >> 3, dg = (tid & 7) * 16;
        u32x4 zq[2][2], qq[2][2]; float zv[2][16]; hg::bf16x8 sfr[2][4]; float lbv[2];
        const u32x4 vw0 = *(const u32x4*)(PROJ + (size_t)(row0 + s2) * 4096 + 1536 + h * 128 + dg), vw1 = *(const u32x4*)(PROJ + (size_t)(row0 + s2) * 4096 + 1536 + h * 128 + dg + 8);
#pragma unroll
        for (int dir = 0; dir < 2; ++dir) { const int tau = dir ? 63 - s2 : s2; const bf16* rp = PROJ + (size_t)(row0 + tau) * 4096 + h * 128 + dg;
            zq[dir][0] = *(const u32x4*)(rp + 512 + dir * 512); zq[dir][1] = *(const u32x4*)(rp + 512 + dir * 512 + 8); qq[dir][0] = *(const u32x4*)rp; qq[dir][1] = *(const u32x4*)(rp + 8);
            lbv[dir] = hg::lbound(p.hgrn_lb, ev, dir, h * 128 + (tid & 127));
            const int c = (isc ? 0 : 4) + (dir ? nt - 1 - tj : tj); const bf16* sp = ST + (size_t)(((b * 4 + h) * 2 + dir) * HG_NCH + c) * 16384 + (wv * 16 + r16) * 128 + q4 * 8;
#pragma unroll
            for (int ks = 0; ks < 4; ++ks) sfr[dir][ks] = *(const hg::bf16x8*)(sp + ks * 32); }
        f32x4 o[4];
#pragma unroll
        for (int i = 0; i < 4; ++i) o[i] = (f32x4){0.f, 0.f, 0.f, 0.f};
        { const int qt = tid >> 7, d = tid & 127; const bf16* zp = PROJ + (size_t)(row0 + qt * 16) * 4096 + 512 + h * 128 + d;
#pragma unroll
          for (int i = 0; i < 16; ++i) zv[0][i] = bf2f(zp[(size_t)i * 4096]); }
        __syncthreads();
        { const unsigned ww[8] = {vw0.x, vw0.y, vw0.z, vw0.w, vw1.x, vw1.y, vw1.z, vw1.w};
#pragma unroll
          for (int i = 0; i < 8; ++i) { *(LAS bf16*)(lds + hg::L_VT + hg::swz128(dg + 2 * i, s2 * 2)) = (bf16)(ww[i] & 0xffffu); *(LAS bf16*)(lds + hg::L_VT + hg::swz128(dg + 2 * i + 1, s2 * 2)) = (bf16)(ww[i] >> 16); } }
#pragma unroll
        for (int dir = 0; dir < 2; ++dir) {
            const int qt = tid >> 7, d = tid & 127; const bf16* zp = PROJ + (size_t)(row0 + (dir ? 63 - qt * 16 : qt * 16)) * 4096 + 512 + dir * 512 + h * 128 + d;
            if (dir) {
#pragma unroll
                for (int i = 0; i < 16; ++i) zv[1][i] = bf2f(*(zp - (size_t)i * 4096)); }
            hg::pass1_pre(zv[dir], lbv[dir], lds, dir ? hg::L_ST : 0, tid);
            __builtin_amdgcn_sched_barrier(0); }
        __syncthreads();
        const u32x4 gw0 = *(const u32x4*)(PROJ + (size_t)(row0 + s2) * 4096 + 2048 + h * 128 + dg), gw1 = *(const u32x4*)(PROJ + (size_t)(row0 + s2) * 4096 + 2048 + h * 128 + dg + 8);
#pragma unroll
        for (int dir = 0; dir < 2; ++dir) { const int tb = dir ? hg::L_ST : 0;
            if (HV != 2) {
                const int tau = dir ? 63 - s2 : s2;
                const unsigned zz[8] = {zq[dir][0].x, zq[dir][0].y, zq[dir][0].z, zq[dir][0].w, zq[dir][1].x, zq[dir][1].y, zq[dir][1].z, zq[dir][1].w};
                const unsigned qv[8] = {qq[dir][0].x, qq[dir][0].y, qq[dir][0].z, qq[dir][0].w, qq[dir][1].x, qq[dir][1].y, qq[dir][1].z, qq[dir][1].w};
#pragma unroll
                for (int jj = 0; jj < 2; ++jj) { const int d0 = dg + jj * 8; float qp[8], kp[8], qt[8];
#pragma unroll
                    for (int g4 = 0; g4 < 2; ++g4) { f32x4 bb, bm, lb; hg::decay4b(lds, tb, s2, d0 + g4 * 4, bb, bm, lb);
#pragma unroll
                        for (int i = 0; i < 4; ++i) { const int k = jj * 8 + g4 * 4 + i; const float z = (k & 1) ? __uint_as_float(zz[k >> 1] & 0xffff0000u) : __uint_as_float(zz[k >> 1] << 16);
                            const float qf = (k & 1) ? __uint_as_float(qv[k >> 1] & 0xffff0000u) : __uint_as_float(qv[k >> 1] << 16);
                            const float f = lb[i] + (1.f - lb[i]) * sigmoidf_(z); const float rel = bb[i] - bm[i];
                            qp[g4 * 4 + i] = qf * __expf(fminf(rel, 80.f)); kp[g4 * 4 + i] = (1.f - f) * __expf(fminf(-rel, 80.f)); qt[g4 * 4 + i] = qf * __expf(bb[i]); } }
                    u32x4 w; w.x = dat::cvtpk(qp[0], qp[1]); w.y = dat::cvtpk(qp[2], qp[3]); w.z = dat::cvtpk(qp[4], qp[5]); w.w = dat::cvtpk(qp[6], qp[7]); *(LAS u32x4*)(lds + hg::L_QP + hg::swz256(tau, d0 * 2)) = w;
                    w.x = dat::cvtpk(kp[0], kp[1]); w.y = dat::cvtpk(kp[2], kp[3]); w.z = dat::cvtpk(kp[4], kp[5]); w.w = dat::cvtpk(kp[6], kp[7]); *(LAS u32x4*)(lds + hg::L_KP + hg::swz256(tau, d0 * 2)) = w;
                    w.x = dat::cvtpk(qt[0], qt[1]); w.y = dat::cvtpk(qt[2], qt[3]); w.z = dat::cvtpk(qt[4], qt[5]); w.w = dat::cvtpk(qt[6], qt[7]); *(LAS u32x4*)(lds + hg::L_QT + hg::swz256(tau, d0 * 2)) = w; }
            }
            __syncthreads();
            if (HV != 3) {
#pragma unroll
                for (int k2 = 0; k2 < 2; ++k2) { const int bi = wv * 2 + k2, rbk = bi >> 2, cbk = bi & 3; f32x4 acc = (f32x4){0.f, 0.f, 0.f, 0.f};
#pragma unroll
                    for (int ks = 0; ks < 4; ++ks) { const int cb = (ks * 32 + q4 * 8) * 2;
                        const hg::bf16x8 a = *(const LAS hg::bf16x8*)(lds + hg::L_QP + hg::swz256(rbk * 16 + r16, cb)); const hg::bf16x8 bb = *(const LAS hg::bf16x8*)(lds + hg::L_KP + hg::swz256(cbk * 16 + r16, cb));
                        acc = __builtin_amdgcn_mfma_f32_16x16x32_bf16(a, bb, acc, 0, 0, 0); }
                    const int tcol = cbk * 16 + r16;
#pragma unroll
                    for (int jj = 0; jj < 4; ++jj) { const int trow = rbk * 16 + q4 * 4 + jj; const bool keep = dir ? (tcol >= trow) : (tcol <= trow);
                        *(LAS bf16*)(lds + L_P2 + hg::swz128(trow, tcol * 2)) = keep ? f2bf(acc[jj]) : (bf16)0; } }
            }
            __syncthreads();
            if (HV != 3) {
#pragma unroll
                for (int ks = 0; ks < 2; ++ks) { const int cb = (ks * 32 + q4 * 8) * 2; const hg::bf16x8 bb = *(const LAS hg::bf16x8*)(lds + hg::L_VT + hg::swz128(wv * 16 + r16, cb));
#pragma unroll
                    for (int rbk = 0; rbk < 4; ++rbk) { const hg::bf16x8 a = *(const LAS hg::bf16x8*)(lds + L_P2 + hg::swz128(rbk * 16 + r16, cb)); o[rbk] = __builtin_amdgcn_mfma_f32_16x16x32_bf16(a, bb, o[rbk], 0, 0, 0); } }
#pragma unroll
                for (int ks = 0; ks < 4; ++ks) { const int cb = (ks * 32 + q4 * 8) * 2;
#pragma unroll
                    for (int rbk = 0; rbk < 4; ++rbk) { const hg::bf16x8 a = *(const LAS hg::bf16x8*)(lds + hg::L_QT + hg::swz256(rbk * 16 + r16, cb)); o[rbk] = __builtin_amdgcn_mfma_f32_16x16x32_bf16(a, dir ? sfr[1][ks] : sfr[0][ks], o[rbk], 0, 0, 0); } }
            }
            __syncthreads();
        }
        LAS float* ot = (LAS float*)(lds + hg::L_QP);
#pragma unroll
        for (int rbk = 0; rbk < 4; ++rbk)
#pragma unroll
            for (int jj = 0; jj < 4; ++jj) ot[(rbk * 16 + q4 * 4 + jj) * 132 + wv * 16 + r16] = o[rbk][jj];
        __syncthreads();
        { f32x4 ov[4]; float ss = 0.f;
#pragma unroll
          for (int k = 0; k < 4; ++k) { ov[k] = *(const LAS f32x4*)(ot + s2 * 132 + dg + 4 * k); ss += ov[k].x * ov[k].x + ov[k].y * ov[k].y + ov[k].z * ov[k].z + ov[k].w * ov[k].w; }
          ss += __shfl_xor(ss, 1); ss += __shfl_xor(ss, 2); ss += __shfl_xor(ss, 4);
          const float rstd = rsqrtf(ss * (1.f / 128.f) + EPS);
          const unsigned gwv[8] = {gw0.x, gw0.y, gw0.z, gw0.w, gw1.x, gw1.y, gw1.z, gw1.w}; const float* gp = p.hgrn_g + (ev * 4 + h) * 128 + dg; unsigned ow[8];
#pragma unroll
          for (int k = 0; k < 4; ++k) { const f32x4 g4 = *(const f32x4*)(gp + 4 * k);
              const float a0 = __uint_as_float(gwv[2 * k] << 16), a1 = __uint_as_float(gwv[2 * k] & 0xffff0000u), a2 = __uint_as_float(gwv[2 * k + 1] << 16), a3 = __uint_as_float(gwv[2 * k + 1] & 0xffff0000u);
              ow[2 * k] = pk2(ov[k].x * rstd * g4.x * siluf_(a0), ov[k].y * rstd * g4.y * siluf_(a1)); ow[2 * k + 1] = pk2(ov[k].z * rstd * g4.z * siluf_(a2), ov[k].w * rstd * g4.w * siluf_(a3)); }
          bf16* mp = MIX + (size_t)(row0 + s2) * D + h * 128 + dg;
          *(u32x4*)mp = (u32x4){ow[0], ow[1], ow[2], ow[3]}; *(u32x4*)(mp + 8) = (u32x4){ow[4], ow[5], ow[6], ow[7]}; }
    }
    __syncthreads();
}

__device__ __forceinline__ void ph_conv(const Prm& p, int l) {
    const int j = l / 2; const bf16* __restrict__ PROJ = (const bf16*)(p.ws + WS_PROJ); bf16* __restrict__ MIX = (bf16*)(p.ws + WS_MIX); const float* cw = p.conv_w + (size_t)j * 3 * D;
    const int nrows = (l < 2) ? MT : ML; const int total = (nrows / 8) * 128;
    for (int i = obid() * NTHREADS + otid(); i < total; i += gridDim.x * NTHREADS) {
        const int rb = i >> 7, c = (i & 127) * 8, r0 = rb * 8;
        const bool isc = r0 >= ML; const int t0 = isc ? ((r0 - ML) & (TC - 1)) : (r0 & (T - 1)); const int len = isc ? TC : T;
        u32x4 ur[10], bg[8];
#pragma unroll
        for (int k = 0; k < 10; ++k) { const bool ok = (k == 0) ? (t0 > 0) : (k == 9 ? (t0 + 8 < len) : true);
            ur[k] = ok ? *(const u32x4*)(PROJ + (size_t)(r0 - 1 + k) * 2048 + 1024 + c) : (u32x4){0u, 0u, 0u, 0u}; }
#pragma unroll
        for (int k = 0; k < 8; ++k) bg[k] = *(const u32x4*)(PROJ + (size_t)(r0 + k) * 2048 + c);
        float w0[8], w1[8], w2[8];
        { const f32x4 a0 = *(const f32x4*)(cw + c), a1 = *(const f32x4*)(cw + c + 4), b0 = *(const f32x4*)(cw + D + c), b1 = *(const f32x4*)(cw + D + c + 4), c0 = *(const f32x4*)(cw + 2 * D + c), c1 = *(const f32x4*)(cw + 2 * D + c + 4);
          w0[0] = a0.x; w0[1] = a0.y; w0[2] = a0.z; w0[3] = a0.w; w0[4] = a1.x; w0[5] = a1.y; w0[6] = a1.z; w0[7] = a1.w;
          w1[0] = b0.x; w1[1] = b0.y; w1[2] = b0.z; w1[3] = b0.w; w1[4] = b1.x; w1[5] = b1.y; w1[6] = b1.z; w1[7] = b1.w;
          w2[0] = c0.x; w2[1] = c0.y; w2[2] = c0.z; w2[3] = c0.w; w2[4] = c1.x; w2[5] = c1.y; w2[6] = c1.z; w2[7] = c1.w; }
#pragma unroll
        for (int k = 0; k < 8; ++k) { const int r = r0 + k;
            const unsigned pw[4] = {ur[k].x, ur[k].y, ur[k].z, ur[k].w}, cw_[4] = {ur[k + 1].x, ur[k + 1].y, ur[k + 1].z, ur[k + 1].w}, nw[4] = {ur[k + 2].x, ur[k + 2].y, ur[k + 2].z, ur[k + 2].w};
            const unsigned bw[4] = {bg[k].x, bg[k].y, bg[k].z, bg[k].w}; unsigned ow[4];
#pragma unroll
            for (int q = 0; q < 4; ++q) {
                const float y0 = __uint_as_float(pw[q] << 16) * w0[2 * q] + __uint_as_float(cw_[q] << 16) * w1[2 * q] + __uint_as_float(nw[q] << 16) * w2[2 * q];
                const float y1 = __uint_as_float(pw[q] & 0xffff0000u) * w0[2 * q + 1] + __uint_as_float(cw_[q] & 0xffff0000u) * w1[2 * q + 1] + __uint_as_float(nw[q] & 0xffff0000u) * w2[2 * q + 1];
                ow[q] = pk2(__uint_as_float(bw[q] << 16) * y0, __uint_as_float(bw[q] & 0xffff0000u) * y1); }
            *(u32x4*)(MIX + (size_t)r * D + c) = (u32x4){ow[0], ow[1], ow[2], ow[3]}; }
    }
}

__device__ __forceinline__ void ph_router(const Prm& p, int l, LAS float* lds) {
    const int tid = otid(), lane = tid & 63, gw = obid() * 8 + (tid >> 6), ngw = gridDim.x * 8;
    const float* modv = (const float*)(p.ws + WS_MODV) + (size_t)l * 5 * 6144;
    bf16* X = (bf16*)(p.ws + WS_X); const bf16* Yb = (const bf16*)(p.ws + WS_H); bf16* H2 = (bf16*)(p.ws + WS_H2); float* AFF = (float*)(p.ws + WS_AFF);
    const float* rw = p.router_w + (size_t)l * D * NE;
    const bool split = (l < 2) && gridDim.x > 32, ctxw = split && obid() < 16;
    if (ctxw) { pg8::Gemm g{(const bf16*)(p.ws + WS_MIX), (const bf16*)(p.ws + WS_WOUT), MT, D, D}; pg8::OneUnit S{ML / 256 + obid() / 4, obid() % 4};
        pg8::EpiGY E{(bf16*)(p.ws + WS_H), (const float*)(p.ws + WS_MODV) + (size_t)l * 5 * 6144 + 2 * 1024, ML};
        pg8::gemm_phase<pg8::EpiGY, pg8::OneUnit, true, true>((LAS unsigned char*)lds, g, S, E);
        mini_barrier((unsigned*)(p.ws + WS_CTL) + CW_MINI + 64 * l, 16u); }
    __syncthreads();
    for (int i = tid; i < D * NE / 4; i += NTHREADS) { const f32x4 w = *(const f32x4*)(rw + (size_t)i * 4); const int c = i >> 2, e0 = (i & 3) * 4;
        const int pos = ((((c >> 9) << 1) | ((c >> 2) & 1)) * 256) + (((c & 511) >> 3) * 4) + (c & 3);
        lds[(e0 + 0) * D + pos] = w.x; lds[(e0 + 1) * D + pos] = w.y; lds[(e0 + 2) * D + pos] = w.z; lds[(e0 + 3) * D + pos] = w.w; }
    __syncthreads();
    int ebeg, eend, estep;
    if (!split) { ebeg = gw; eend = ((l < 2) ? MT : ML) / 2; estep = ngw; }
    else if (ctxw) { ebeg = ML / 2 + gw; eend = ebeg + 1; estep = 1; }
    else { ebeg = gw - 16 * 8; eend = ML / 2 + 384; estep = ngw - 16 * 8; }
    bool seen = false;
    for (int en = ebeg; en < eend; en += estep) {
        const int r0 = (split && !ctxw && en >= ML / 2) ? (en + 128) * 2 : en * 2;
        if (split && !ctxw && en >= ML / 2 && !seen) { unsigned* ctr = (unsigned*)(p.ws + WS_CTL) + CW_MINI + 64 * l; unsigned sp = 0u;
            while (xb_ld(ctr) < 16u) { __builtin_amdgcn_s_sleep(1); if (++sp > XB_SPIN_CAP) break; }
            __builtin_amdgcn_fence(__ATOMIC_ACQUIRE, "agent"); seen = true; }
        f32x4 hv[2][4]; float my0 = 0.f, my1 = 0.f;
#pragma unroll
        for (int u = 0; u < 2; ++u) { const int r = r0 + u; const bool isc = r >= ML; const int mr = isc ? 4 : (r >> 12);
            f32x4 v[4]; float s = 0.f;
            u32x4 yw[2];
#pragma unroll
            for (int j2 = 0; j2 < 2; ++j2) yw[j2] = __builtin_nontemporal_load((const u32x4*)(Yb + (size_t)r * D + 8 * lane + 512 * j2));
            if (l == 0) { const float* xin = isc ? p.ctx + (size_t)(r - ML) * D : p.x + (size_t)r * D;
#pragma unroll
                for (int j = 0; j < 4; ++j) v[j] = __builtin_nontemporal_load((const f32x4*)(xin + CJ(j))); }
            else load_xrow(X + (size_t)r * D, lane, v);
#pragma unroll
            for (int j2 = 0; j2 < 2; ++j2) acc_bf16x8(v[2 * j2], v[2 * j2 + 1], yw[j2], 1.f);
            store_xrow(X + (size_t)r * D, lane, v);
#pragma unroll
            for (int j = 0; j < 4; ++j) s += v[j].x * v[j].x + v[j].y * v[j].y + v[j].z * v[j].z + v[j].w * v[j].w;
            const float rstd = rsqrtf(wave_sum(s) * (1.f / D) + EPS);
#pragma unroll
            for (int j = 0; j < 4; ++j) { const int c = CJ(j);
                const f32x4 g = *(const f32x4*)(p.norm2_g + l * D + c), sh = *(const f32x4*)(modv + (size_t)mr * 6144 + 3 * 1024 + c), scl = *(const f32x4*)(modv + (size_t)mr * 6144 + 4 * 1024 + c);
                hv[u][j] = (v[j] * rstd * g) * (scl + 1.f) + sh; }
#pragma unroll
            for (int j2 = 0; j2 < 2; ++j2) *(u32x4*)(H2 + (size_t)r * D + 8 * lane + 512 * j2) = pack_bf16x8(hv[u][2 * j2], hv[u][2 * j2 + 1]); }
#pragma unroll 2
        for (int e = 0; e < 16; ++e) { float a0 = 0.f, a1 = 0.f;
#pragma unroll
            for (int j = 0; j < 4; ++j) { const f32x4 w = *(const LAS f32x4*)(lds + e * D + j * 256 + 4 * lane);
                a0 += hv[0][j].x * w.x + hv[0][j].y * w.y + hv[0][j].z * w.z + hv[0][j].w * w.w; a1 += hv[1][j].x * w.x + hv[1][j].y * w.y + hv[1][j].z * w.z + hv[1][j].w * w.w; }
            a0 = wave_sum(a0); a1 = wave_sum(a1); if (lane == e) { my0 = a0; my1 = a1; } }
#pragma unroll
        for (int u = 0; u < 2; ++u) { const int r = r0 + u; const bool isc = r >= ML; const float lgt = u ? my1 : my0;
            float mx = lgt; mx = fmaxf(mx, __shfl_xor(mx, 1)); mx = fmaxf(mx, __shfl_xor(mx, 2)); mx = fmaxf(mx, __shfl_xor(mx, 4)); mx = fmaxf(mx, __shfl_xor(mx, 8));
            const float ex = __expf(lgt - mx); float den = ex; den += __shfl_xor(den, 1); den += __shfl_xor(den, 2); den += __shfl_xor(den, 4); den += __shfl_xor(den, 8);
            if (lane < 16) { const float a = ex / den;
                if (!isc) AFF[((size_t)(r >> 12) * NE + lane) * T + (r & (T - 1))] = a;
                else { const int rc = r - ML; AFF[(size_t)NB * NE * T + ((size_t)(rc >> 8) * NE + lane) * TC + (rc & (TC - 1))] = a; } } }
    }
    __syncthreads();
}

__device__ __forceinline__ void ph_topk(const Prm& p, int l, LAS float* lds) {
    const float* AFF = (const float*)(p.ws + WS_AFF); float* GATE = (float*)(p.ws + WS_GATE); int* SEL = (int*)(p.ws + WS_SEL); int* TOKSLOT = (int*)(p.ws + WS_TOKSLOT);
    const int tid = otid(), lane = tid & 63, wv = tid >> 6; const int nitems = (l < 2) ? 128 : 64;
    LAS unsigned* hist = (LAS unsigned*)lds;
    LAS unsigned* ctl = hist + 256;
    LAS unsigned* wtot = hist + 272;
    for (int it = obid(); it < nitems; it += gridDim.x) {
        const bool isc = it >= 64; const int be = it & 63, b = be >> 4, e = be & 15; const int n = isc ? TC : T, cap = isc ? CAPC : CAP;
        const float* a = AFF + (isc ? (size_t)NB * NE * T + (size_t)be * TC : (size_t)be * T);
        const bool valid = tid * 8 < n;
        unsigned bits[8];
        if (valid) { const u32x4 w0 = *(const u32x4*)(a + tid * 8), w1 = *(const u32x4*)(a + tid * 8 + 4); bits[0] = w0.x; bits[1] = w0.y; bits[2] = w0.z; bits[3] = w0.w; bits[4] = w1.x; bits[5] = w1.y; bits[6] = w1.z; bits[7] = w1.w; }
        else {
#pragma unroll
            for (int j = 0; j < 8; ++j) bits[j] = 0u; }
        unsigned prefix = 0u, remaining = (unsigned)cap;
#pragma unroll 1
        for (int pass = 0; pass < 4; ++pass) { const int shift = 24 - 8 * pass;
            __syncthreads();
            if (tid < 256) hist[tid] = 0u;
            __syncthreads();
            if (valid) {
#pragma unroll
                for (int j = 0; j < 8; ++j) { const bool m = (pass == 0) || ((bits[j] >> (shift + 8)) == prefix); if (m) __hip_atomic_fetch_add(&hist[(bits[j] >> shift) & 255u], 1u, __ATOMIC_RELAXED, __HIP_MEMORY_SCOPE_WORKGROUP); } }
            __syncthreads();
            if (wv == 0) { const unsigned c0 = hist[4 * lane], c1 = hist[4 * lane + 1], c2 = hist[4 * lane + 2], c3 = hist[4 * lane + 3]; const unsigned s = c0 + c1 + c2 + c3;
                unsigned incl = s;
#pragma unroll
                for (int o = 1; o < 64; o <<= 1) { const unsigned t = __shfl_down(incl, o); if (lane + o < 64) incl += t; }
                unsigned above = incl - s;
                if (above < remaining && remaining <= above + s) { unsigned B;
                    if (above + c3 >= remaining) B = 4 * lane + 3; else { above += c3; if (above + c2 >= remaining) B = 4 * lane + 2; else { above += c2; if (above + c1 >= remaining) B = 4 * lane + 1; else { above += c1; B = 4 * lane; } } }
                    ctl[0] = (prefix << 8) | B; ctl[1] = remaining - above; } }
            __syncthreads();
            prefix = ctl[0]; remaining = ctl[1];
        }
        const unsigned thr = prefix;
        unsigned cg = 0u, ce = 0u;
#pragma unroll
        for (int j = 0; j < 8; ++j) { cg += (valid && bits[j] > thr) ? 1u : 0u; ce += (valid && bits[j] == thr) ? 1u : 0u; }
        unsigned pk = cg | (ce << 16), incl = pk;
#pragma unroll
        for (int o = 1; o < 64; o <<= 1) { const unsigned t = __shfl_up(incl, o); if (lane >= o) incl += t; }
        __syncthreads();
        if (lane == 63) wtot[wv] = incl;
        __syncthreads();
        unsigned base = 0u, total = 0u;
#pragma unroll
        for (int w = 0; w < 8; ++w) { const unsigned t = wtot[w]; if (w < wv) base += t; total += t; }
        const unsigned excl = base + incl - pk; unsigned gpos = excl & 0xffffu, epos = excl >> 16; const unsigned ngt = total & 0xffffu;
        if (valid) {
#pragma unroll
            for (int j = 0; j < 8; ++j) { const int t0 = tid * 8 + j; const int row = isc ? ML + b * TC + t0 : b * T + t0; int slot = -1;
                if (bits[j] > thr) { slot = (int)gpos; ++gpos; } else if (bits[j] == thr) { if (epos < remaining) slot = (int)(ngt + epos); ++epos; }
                if (slot >= 0) { const int xr = isc ? 2048 + b * CAPC + slot : b * CAP + slot; SEL[e * XR + xr] = row; GATE[e * XR + xr] = __uint_as_float(bits[j]); TOKSLOT[(size_t)row * NE + e] = xr; }
                else TOKSLOT[(size_t)row * NE + e] = -1; } }
    }
    __syncthreads();
}
__device__ __forceinline__ void ph_dispatch(const Prm& p, int l) {
    const int lane = otid() & 63, gw = obid() * 8 + (otid() >> 6), ngw = gridDim.x * 8;
    const int* SEL = (const int*)(p.ws + WS_SEL); const bf16* H2 = (const bf16*)(p.ws + WS_H2); bf16* XE = (bf16*)(p.ws + WS_XE);
    const int rows_e = (l < 2) ? 2176 : 2048;
    for (int g = gw; g < NE * rows_e; g += ngw) { const int e = g / rows_e, xr = g % rows_e; const int src = SEL[e * XR + xr];
        const u32x4* s4 = (const u32x4*)(H2 + (size_t)src * D); u32x4* d4 = (u32x4*)(XE + ((size_t)e * XR + xr) * D);
        d4[lane] = s4[lane]; d4[lane + 64] = s4[lane + 64]; }
}

__global__ void __launch_bounds__(NTHREADS, 2) mega(Prm p) {
    extern __shared__ __attribute__((aligned(16))) unsigned char lds_raw[];
    LAS unsigned char* ldsb = (LAS unsigned char*)lds_raw;
    LAS float* lds = (LAS float*)ldsb;
    volatile LAS unsigned* misc = (volatile LAS unsigned*)(ldsb + LDS_BYTES - 256);
    if (threadIdx.x < 32) misc[threadIdx.x] = 0u;
    __syncthreads();
    XcdBarrier bar = xcd_barrier_post((unsigned*)(p.ws + WS_CTL) + 1024, misc + 8);
#define GRID_BAR() do { XcdBarrier b_; { unsigned long long w_ = (unsigned long long)p.ws; asm volatile("" : "+s"(w_)); b_.bar = (unsigned*)((unsigned char*)w_ + WS_CTL) + 1024; } b_.x = xb_xcc_id(); b_.st = misc + 8; xcd_barrier(b_); } while (0)
    (void)bar;
    ph_setup(p, lds);
    ph_convert(p, 0, ldsb);
    GRID_BAR();
    if (DUP_PHASE == 13) { ph_setup(p, lds); GRID_BAR(); ph_setup(p, lds); GRID_BAR(); ph_setup(p, lds); GRID_BAR(); }
    for (int l = 0; l < DEPTH; ++l) {
        if (l > 0) ph_convert(p, l, ldsb);
        ph_norm1(p, l);
        GRID_BAR();
        ph_gemm_in(p, l, ldsb);
        GRID_BAR();
        if (DUP_PHASE == 1) { ph_gemm_in(p, l, ldsb); GRID_BAR(); }
        if (DUP_PHASE == 2) { ph_convert(p, l, ldsb); GRID_BAR(); }
        if (DUP_PHASE == 14) { ph_probe_read<0>(p, l); GRID_BAR(); }
        if (DUP_PHASE == 41) { ph_probe_read<1>(p, l); GRID_BAR(); }
        if (DUP_PHASE == 42) { ph_probe_read<2>(p, l); GRID_BAR(); }
        if (DUP_PHASE == 43) { ph_probe_read<3>(p, l); GRID_BAR(); }
        if (DUP_PHASE == 44) { ph_probe_cvt<4>(p, l); GRID_BAR(); }
        if (DUP_PHASE == 45) { ph_probe_cvt<5>(p, l); GRID_BAR(); }
        if (DUP_PHASE == 18 && l >= 1) { ph_norm1(p, l, false); GRID_BAR(); }
        if ((l & 1) == 0) {
            if (DUP_PHASE == 5 || DUP_PHASE == 7) { ph_hgrn_local<9>(p, l, ldsb); GRID_BAR(); }
            if (DUP_PHASE == 7) { ph_hgrn_local<9>(p, l, ldsb); GRID_BAR(); }
            ph_qkprep(p, l);
            ph_hgrn_local<0>(p, l, ldsb);
            GRID_BAR();
            ph_hgrn_scan(p);
            GRID_BAR();
            if (DUP_PHASE == 3) { ph_hgrn_local<9>(p, l, ldsb); GRID_BAR(); }
            if (DUP_PHASE == 4) { ph_hgrn_scan(p); GRID_BAR(); }
            ph_attn<5>(p, l, ldsb);
            ph_hgrn_out<0>(p, l, ldsb);
            GRID_BAR();
            if (DUP_PHASE == 5) { ph_attn<0>(p, l, ldsb); GRID_BAR(); }
            if (DUP_PHASE == 21) { ph_attn<1>(p, l, ldsb); GRID_BAR(); }
            if (DUP_PHASE == 22) { ph_attn<2>(p, l, ldsb); GRID_BAR(); }
            if (DUP_PHASE == 23) { ph_attn<3>(p, l, ldsb); GRID_BAR(); }
            if (DUP_PHASE == 24) { ph_attn<4>(p, l, ldsb); GRID_BAR(); }
            if (DUP_PHASE == 6) { ph_hgrn_out<5>(p, l, ldsb); GRID_BAR(); }
            if (DUP_PHASE == 31) { ph_hgrn_out<1>(p, l, ldsb); GRID_BAR(); }
            if (DUP_PHASE == 32) { ph_hgrn_out<2>(p, l, ldsb); GRID_BAR(); }
            if (DUP_PHASE == 33) { ph_hgrn_out<3>(p, l, ldsb); GRID_BAR(); }
        } else {
            ph_conv(p, l);
            GRID_BAR();
            if (DUP_PHASE == 17) { ph_conv(p, l); GRID_BAR(); }
        }
        ph_gemm_out(p, l, ldsb);
        GRID_BAR();
        ph_router(p, l, lds);
        GRID_BAR();
        ph_topk(p, l, lds);
        GRID_BAR();
        if (DUP_PHASE == 7) { ph_topk(p, l, lds); GRID_BAR(); }
        ph_expert_up(p, l, ldsb);
        GRID_BAR();
        if (DUP_PHASE == 10) { ph_expert_up(p, l, ldsb); GRID_BAR(); }
        ph_expert_down(p, l, ldsb);
        GRID_BAR();
        if (DUP_PHASE == 11) { ph_expert_down(p, l, ldsb); GRID_BAR(); }
        if (DUP_PHASE == 12) { GRID_BAR(); GRID_BAR(); GRID_BAR(); GRID_BAR(); GRID_BAR(); GRID_BAR(); GRID_BAR(); GRID_BAR(); GRID_BAR(); GRID_BAR(); }
    }
    ph_final(p);
    if (DUP_PHASE == 19) { GRID_BAR(); ph_final(p); GRID_BAR(); ph_final(p); }
}

extern "C" void kernel_launch(void* const* d_in, const int* in_sizes, int n_in, void* d_out, int out_size, void* d_ws, size_t ws_size, hipStream_t stream) {
    static int grid = 0;
    if (grid == 0) {
        if (n_in != 23 || out_size != ML * D || ws_size < WS_END) { fprintf(stderr, "kernel_launch: unexpected shapes: n_in %d out %d ws %zu (need %zu)\n", n_in, out_size, ws_size, (size_t)WS_END); grid = -1; return; }
        int dev = 0, cus = 0, per_cu = 0;
        if (hipGetDevice(&dev) != hipSuccess || hipDeviceGetAttribute(&cus, hipDeviceAttributeMultiprocessorCount, dev) != hipSuccess) { grid = -1; return; }
        if (hipFuncSetAttribute((const void*)mega, hipFuncAttributeMaxDynamicSharedMemorySize, LDS_BYTES) != hipSuccess) { fprintf(stderr, "kernel_launch: hipFuncSetAttribute failed\n"); grid = -1; return; }
        if (hipOccupancyMaxActiveBlocksPerMultiprocessor(&per_cu, (const void*)mega, NTHREADS, LDS_BYTES) != hipSuccess || per_cu < 1) fprintf(stderr, "kernel_launch: occupancy query says %d\n", per_cu);
        (void)hipGetLastError();
        grid = cus;
    }
    if (grid < 0) return;
    (void)hipMemsetAsync((char*)d_ws + WS_CTL, 0, 1 * MiB, stream);
    Prm p{};
    const float** pp = (const float**)&p;
    for (int i = 0; i < 23; ++i) pp[i] = (const float*)d_in[i];
    p.out = (float*)d_out; p.ws = (unsigned char*)d_ws;
    hipLaunchKernelGGL(mega, dim3(grid), dim3(NTHREADS), LDS_BYTES, stream, p);
}
```

```cpp
#include <hip/hip_runtime.h>
#include <type_traits>
#ifndef DUP_PHASE
#define DUP_PHASE 0
#endif
#include <cstdint>
#include <cstdio>

#define GAS __attribute__((address_space(1)))
#define LAS __attribute__((address_space(3)))
typedef unsigned short bf16;
typedef float f32x4 __attribute__((ext_vector_type(4)));
typedef unsigned u32x4 __attribute__((ext_vector_type(4)));
typedef unsigned u32x2 __attribute__((ext_vector_type(2)));

constexpr int D = 1024, NB = 4, T = 4096, TC = 256, DEPTH = 4;
constexpr int ML = NB * T, MC = NB * TC, MT = ML + MC;
constexpr int NE = 16, FF = 1024, CAP = 512, CAPC = 32;
constexpr int XR = 2304;
constexpr int NTHREADS = 512;
constexpr float EPS = 1e-6f;

constexpr size_t MiB = 1u << 20;
constexpr size_t WS_CTL = 0;
constexpr size_t WS_MODV = 1 * MiB;
constexpr size_t WS_ROPE = WS_MODV + 512 * 1024;
constexpr size_t WS_X = 2 * MiB;
constexpr size_t WS_H = WS_X + (size_t)MT * D * 4;
constexpr size_t WS_H2 = WS_H + (size_t)MT * D * 2;
constexpr size_t WS_PROJ = WS_H2 + (size_t)MT * D * 2;
constexpr size_t WS_MIX = WS_PROJ + (size_t)MT * 4096 * 2;
constexpr size_t WS_OF = WS_MIX + (size_t)MT * D * 2;
constexpr size_t WS_AFF = WS_OF + (size_t)2 * MT * 512 * 4;
constexpr size_t WS_GATE = WS_AFF + 2 * MiB;
constexpr size_t WS_SEL = WS_GATE + 1 * MiB;
constexpr size_t WS_TOKSLOT = WS_SEL + 1 * MiB;
constexpr size_t WS_XE = WS_TOKSLOT + 2 * MiB;
constexpr size_t WS_ACT = WS_XE + (size_t)NE * XR * D * 2;
constexpr size_t WS_YE = WS_ACT + (size_t)NE * XR * D * 2;
constexpr size_t WS_WIN = WS_YE + (size_t)NE * XR * D * 2;
constexpr size_t WS_WOUT = WS_WIN + (size_t)4096 * D * 2;
constexpr size_t WS_WUP = WS_WOUT + (size_t)D * D * 2;
constexpr size_t WS_WDN = WS_WUP + (size_t)NE * 2048 * D * 2;
constexpr int HG_NCH = 68, HG_ITEMS = NB * 4 * 2 * HG_NCH;
constexpr size_t WS_HDS = WS_WDN + (size_t)NE * D * FF * 2;
constexpr size_t WS_HST = WS_HDS + (size_t)HG_ITEMS * 128 * 128 * 2;
constexpr size_t WS_HG = WS_HST + (size_t)HG_ITEMS * 128 * 128 * 2;
constexpr size_t WS_END = WS_HG + (size_t)HG_ITEMS * 128 * 4;

constexpr int LDS_BYTES = 155648;

struct Prm {
    const float *x, *c, *ctx, *c_ctx, *mod_w, *mod_b, *norm1_g, *norm2_g, *even_w_in, *even_w_out, *hgrn_lb, *hgrn_g, *qn_g, *kn_g, *dlam, *subln_g,
        *conv_w_in, *conv_w, *conv_w_out, *router_w, *w_gate, *w_up, *w_down;
    float* out; unsigned char* ws;
};

__device__ __forceinline__ float bf2f(bf16 v) { return __uint_as_float((unsigned)v << 16); }
__device__ __forceinline__ bf16 f2bf(float f) { unsigned u = __float_as_uint(f); return (bf16)((u + 0x7fffu + ((u >> 16) & 1u)) >> 16); }
__device__ __forceinline__ unsigned pk2(float lo, float hi) { return (unsigned)f2bf(lo) | ((unsigned)f2bf(hi) << 16); }
__device__ __forceinline__ float wave_sum(float v) {
#pragma unroll
    for (int o = 1; o < 64; o <<= 1) v += __shfl_xor(v, o);
    return v;
}
__device__ __forceinline__ int otid() { int t = threadIdx.x; asm volatile("" : "+v"(t)); return t; }
__device__ __forceinline__ int obid() { int b = blockIdx.x; asm volatile("" : "+s"(b)); return b; }
__device__ __forceinline__ int vcu_id() { const int G = gridDim.x, bx = obid(); return (G % 8 == 0) ? (bx % 8) * (G / 8) + bx / 8 : bx; }
__device__ __forceinline__ float sigmoidf_(float x) { return 1.f / (1.f + __expf(-x)); }
__device__ __forceinline__ float siluf_(float x) { return x / (1.f + __expf(-x)); }

#define XB_TMO      128
#define XB_XCNT(j)  (256  + 64 * (j))
#define XB_XSUB(j)  (1280 + 64 * (j))
#define XB_XGEN(j)  (2304 + 64 * (j))
#define XB_TOP      3328
#define XB_TOPGEN   3392
#define XCD_BAR_WORDS 3456
#define XB_SPIN_CAP (1u << 28)
__device__ __forceinline__ unsigned xb_ld(unsigned* p)              { return __hip_atomic_load(p, __ATOMIC_RELAXED, __HIP_MEMORY_SCOPE_AGENT); }
__device__ __forceinline__ unsigned xb_add(unsigned* p, unsigned v) { return __hip_atomic_fetch_add(p, v, __ATOMIC_RELAXED, __HIP_MEMORY_SCOPE_AGENT); }
__device__ __forceinline__ unsigned xb_xcc_id() { return (unsigned)__builtin_amdgcn_s_getreg((3 << 11) | 20) & 0xFu; }
#define XB_SPIN(cond, bar) do { unsigned _sp = 0; while (cond) { __builtin_amdgcn_s_sleep(1); \
    if ((++_sp & 255u) == 0u) { if (xb_ld(&(bar)[XB_TMO])) break; if (_sp > XB_SPIN_CAP) { atomicAdd(&(bar)[XB_TMO], 1u); break; } } } } while (0)
struct XcdBarrier { unsigned* bar; unsigned x; volatile LAS unsigned* st; };
__device__ __forceinline__ XcdBarrier xcd_barrier_post(unsigned* bar, volatile LAS unsigned* st) {
    XcdBarrier b; b.bar = bar; b.x = xb_xcc_id(); b.st = st;
    if (threadIdx.x == 0) (void)xb_add(&bar[XB_XCNT(b.x)], 1u);
    return b;
}
__device__ __forceinline__ void xcd_barrier_complete(unsigned* bar, unsigned x, unsigned& nloc, unsigned& nx) {
    const unsigned G = gridDim.x * gridDim.y * gridDim.z;
    unsigned sum, cnt, mine, sp = 0u;
    for (;;) {
        sum = 0u; cnt = 0u; mine = 0u;
#pragma unroll
        for (unsigned j = 0; j < 16; ++j) { const unsigned c = xb_ld(&bar[XB_XCNT(j)]); sum += c; cnt += (c > 0u) ? 1u : 0u; mine = (j == x) ? c : mine; }
        if (sum == G) break;
        __builtin_amdgcn_s_sleep(1);
        if ((++sp & 255u) == 0u) { if (xb_ld(&bar[XB_TMO])) break; if (sp > XB_SPIN_CAP) { atomicAdd(&bar[XB_TMO], 1u); break; } }
    }
    nloc = mine > 0u ? mine : 1u; nx = cnt > 0u ? cnt : 1u;
}
__device__ __forceinline__ void xcd_barrier(const XcdBarrier& b) {
    asm volatile("s_waitcnt vmcnt(0)" ::: "memory");
    __syncthreads();
    if (threadIdx.x == 0) {
        unsigned* bar = b.bar;
        __builtin_amdgcn_s_waitcnt(0);
        unsigned nloc = b.st[0], nx = b.st[1];
        if (nloc == 0u) { xcd_barrier_complete(bar, b.x, nloc, nx); b.st[0] = nloc; b.st[1] = nx; }
        const unsigned old = xb_add(&bar[XB_XSUB(b.x)], 1u);
        const unsigned gen = old / nloc;
        if (old + 1u == (gen + 1u) * nloc) {
            __builtin_amdgcn_fence(__ATOMIC_RELEASE, "agent");
            asm volatile("s_waitcnt vmcnt(0)" ::: "memory");
            const unsigned og = xb_add(&bar[XB_TOP], 1u);
            const unsigned tg = og / nx;
            if (og + 1u == (tg + 1u) * nx) xb_add(&bar[XB_TOPGEN], 1u);
            else XB_SPIN(xb_ld(&bar[XB_TOPGEN]) == tg, bar);
            __builtin_amdgcn_fence(__ATOMIC_ACQUIRE, "agent");
            xb_add(&bar[XB_XGEN(b.x)], 1u);
            asm volatile("s_waitcnt vmcnt(0)" ::: "memory");
        } else {
            XB_SPIN(xb_ld(&bar[XB_XGEN(b.x)]) == gen, bar);
            __builtin_amdgcn_fence(__ATOMIC_ACQUIRE, "agent");
            asm volatile("s_waitcnt vmcnt(0)" ::: "memory");
        }
    }
    __syncthreads();
}

namespace pg8 {
#define PG8_LAS __attribute__((address_space(3)))
typedef unsigned short bf16_t;
typedef short bf16x8 __attribute__((ext_vector_type(8)));
typedef float f32x4 __attribute__((ext_vector_type(4)));
typedef unsigned u32x4 __attribute__((ext_vector_type(4)));
constexpr int BM = 256, BK = 64, HALF = 128, HTB = HALF * BK * 2  , STAGE_BYTES = 8 * HTB, NXCD = 8, WGM = 8;

__host__ __device__ __forceinline__ int lds_byte(int r, int c) { const int st = (r >> 4) * 2 + (c >> 5), rr = r & 15, cc = c & 31, ob = rr * 64 + cc * 2; return st * 1024 + (ob ^ (((ob >> 9) & 1) << 5)); }
__host__ __device__ __forceinline__ void stage_rc(int b, int& R, int& C) { const int st = b / 1024, sb = b % 1024, swz = sb ^ (((sb >> 9) & 1) << 5); R = (st >> 1) * 16 + swz / 64; C = (st & 1) * 32 + (swz % 64) / 2; }
__host__ __device__ __forceinline__ int perm32(int rho) { const int n = rho >> 4, i = rho & 15; return 8 * (i >> 2) + 4 * n + (i & 3); }

struct Unit { int pm, pn, ab; };
struct Gemm { const bf16_t* A; const bf16_t* Bt; int M, N, K; };

template <int SPLIT = 0>
struct StaticOrderT {
    static constexpr bool HAS_SPLIT = SPLIT != 0;
    int nM, nN, nwg, G, c, nsplit;
    __host__ __device__ void init(int M, int N, int G_, int c_, int Mfull = -1) { if (Mfull < 0) Mfull = M; nM = Mfull / BM; nN = N / BM; nwg = nM * nN; G = G_; c = c_; nsplit = SPLIT ? ((M - Mfull) / BM) * nN * SPLIT : 0; }
    __host__ __device__ bool next(int i, Unit& u) const {
        const long L = (long)i * G + c;
        if (L >= (long)nwg + nsplit) return false;
        int pm, pn, ab;
        if (SPLIT != 0 && L >= nwg) { int q = (int)(L - nwg);
            q = (q % NXCD) * (nsplit / NXCD) + q / NXCD;
            const int t = q / (SPLIT ? SPLIT : 1), s = q % (SPLIT ? SPLIT : 1); pn = t / 4; pm = nM + t % 4; ab = (1 << (s & 1)) | ((SPLIT == 4 ? (1 << (s >> 1)) : 3) << 2);
        } else {
            int wgid = (int)L; { const int q = nwg / NXCD, r = nwg % NXCD, xcd = wgid % NXCD, off = wgid / NXCD; wgid = (xcd < r ? xcd * (q + 1) : r * (q + 1) + (xcd - r) * q) + off; }
            const int nig = WGM * nN, gid = wgid / nig, fm = gid * WGM, gsz = (nM - fm) < WGM ? (nM - fm) : WGM;
            pm = fm + ((wgid % nig) % gsz); pn = (wgid % nig) / gsz; ab = 15; }
        u.pm = pm; u.pn = pn; u.ab = ab; return true;
    }
    __device__ __forceinline__ void a_ready(const Unit&) const {}
    __device__ __forceinline__ void done(const Unit&) const {}
};
typedef StaticOrderT<0> StaticOrder;

__device__ __forceinline__ unsigned cvt_pk_bf16(float lo, float hi) { unsigned r; asm volatile("v_cvt_pk_bf16_f32 %0, %1, %2" : "=v"(r) : "v"(lo), "v"(hi)); return r; }

struct EpiBf16 {
    static constexpr bool PERM = true, AFTER_DRAIN = false;
    bf16_t* O; int ldc;
    __device__ __forceinline__ void operator()(const f32x4 (&acc)[2][2][4][2], const Unit& u, int wr, int wc, int fr, int fq) const {
        const int row0 = u.pm * BM + wr * 64 + fr; const int col0 = u.pn * BM + wc * 32 + 8 * fq;
#pragma unroll
        for (int ai = 0; ai < 2; ++ai)
#pragma unroll
            for (int m = 0; m < 4; ++m) { if (!((u.ab >> ai) & 1)) continue; bf16_t* rowp = O + (size_t)(row0 + ai * HALF + m * 16) * ldc + col0;
#pragma unroll
                for (int bj = 0; bj < 2; ++bj) { if (!((u.ab >> (2 + bj)) & 1)) continue; const f32x4 v0 = acc[ai][bj][m][0], v1 = acc[ai][bj][m][1];
                    u32x4 w; w.x = cvt_pk_bf16(v0[0], v0[1]); w.y = cvt_pk_bf16(v0[2], v0[3]); w.z = cvt_pk_bf16(v1[0], v1[1]); w.w = cvt_pk_bf16(v1[2], v1[3]);
                    *(u32x4*)(rowp + bj * HALF) = w; } }
    }
};
struct EpiGY {
    static constexpr bool PERM = true, AFTER_DRAIN = false;
    bf16_t* Y; const float* g1; int ml;
    __device__ __forceinline__ void operator()(const f32x4 (&acc)[2][2][4][2], const Unit& u, int wr, int wc, int fr, int fq) const {
        const int rbase = u.pm * BM; const int mr = rbase >= ml ? 4 : (rbase >> 12); const float* g = g1 + (size_t)mr * 6144;
        const int row0 = rbase + wr * 64 + fr, col0 = u.pn * BM + wc * 32 + 8 * fq;
        f32x4 gv[2][2];
#pragma unroll
        for (int bj = 0; bj < 2; ++bj)
#pragma unroll
            for (int n = 0; n < 2; ++n) gv[bj][n] = *(const f32x4*)(g + col0 + bj * HALF + n * 4);
#pragma unroll
        for (int ai = 0; ai < 2; ++ai)
#pragma unroll
            for (int m = 0; m < 4; ++m) { bf16_t* rowp = Y + (size_t)(row0 + ai * HALF + m * 16) * 1024 + col0;
#pragma unroll
                for (int bj = 0; bj < 2; ++bj) { const f32x4 v0 = acc[ai][bj][m][0] * gv[bj][0], v1 = acc[ai][bj][m][1] * gv[bj][1];
                    u32x4 w; w.x = cvt_pk_bf16(v0[0], v0[1]); w.y = cvt_pk_bf16(v0[2], v0[3]); w.z = cvt_pk_bf16(v1[0], v1[1]); w.w = cvt_pk_bf16(v1[2], v1[3]);
                    *(u32x4*)(rowp + bj * HALF) = w; } }
    }
};
struct EpiResid {
    static constexpr bool PERM = false, AFTER_DRAIN = false;
    const float* xl; const float* xc; float* X; const float* g1; int ml;
    __device__ __forceinline__ void operator()(const f32x4 (&acc)[2][2][4][2], const Unit& u, int wr, int wc, int fr, int fq) const {
        const int rbase = u.pm * BM; const bool isc = rbase >= ml; const int mr = isc ? 4 : (rbase >> 12);
        const float* xin = isc ? xc - (size_t)ml * 1024 : xl; const float* g = g1 + (size_t)mr * 6144;
        const int col0 = u.pn * BM + wc * 32 + 4 * fq;
        f32x4 gv[2][2];
#pragma unroll
        for (int bj = 0; bj < 2; ++bj)
#pragma unroll
            for (int n = 0; n < 2; ++n) gv[bj][n] = *(const f32x4*)(g + col0 + bj * HALF + n * 16);
#pragma unroll
        for (int ai = 0; ai < 2; ++ai)
#pragma unroll
            for (int m = 0; m < 4; ++m) { const size_t off = (size_t)(rbase + ai * HALF + wr * 64 + m * 16 + fr) * 1024 + col0;
#pragma unroll
                for (int bj = 0; bj < 2; ++bj)
#pragma unroll
                    for (int n = 0; n < 2; ++n) { const f32x4 xi = *(const f32x4*)(xin + off + bj * HALF + n * 16); *(f32x4*)(X + off + bj * HALF + n * 16) = xi + gv[bj][n] * acc[ai][bj][m][n]; } }
    }
};
__device__ __forceinline__ float silu_f(float x) { return x * __builtin_amdgcn_rcpf(1.f + __expf(-x)); }
struct EpiSwiglu {
    static constexpr bool PERM = true, AFTER_DRAIN = false;
    bf16_t* O; int ntn;
    __device__ __forceinline__ void operator()(const f32x4 (&acc)[2][2][4][2], const Unit& u, int wr, int wc, int fr, int fq) const {
        const int row0 = u.pm * BM + wr * 64 + fr; const int col0 = (u.pn % ntn) * HALF + wc * 32 + 8 * fq;
#pragma unroll
        for (int ai = 0; ai < 2; ++ai)
#pragma unroll
            for (int m = 0; m < 4; ++m) { if (!((u.ab >> ai) & 1)) continue; bf16_t* rowp = O + (size_t)(row0 + ai * HALF + m * 16) * 1024 + col0;
                const f32x4 g0 = acc[ai][0][m][0], g1 = acc[ai][0][m][1], u0 = acc[ai][1][m][0], u1 = acc[ai][1][m][1];
                u32x4 w; w.x = cvt_pk_bf16(silu_f(g0[0]) * u0[0], silu_f(g0[1]) * u0[1]); w.y = cvt_pk_bf16(silu_f(g0[2]) * u0[2], silu_f(g0[3]) * u0[3]);
                w.z = cvt_pk_bf16(silu_f(g1[0]) * u1[0], silu_f(g1[1]) * u1[1]); w.w = cvt_pk_bf16(silu_f(g1[2]) * u1[2], silu_f(g1[3]) * u1[3]);
                *(u32x4*)rowp = w; }
    }
};
struct EpiConvIn {
    static constexpr bool PERM = true, AFTER_DRAIN = false;
    bf16_t* O;
    __device__ __forceinline__ void operator()(const f32x4 (&acc)[2][2][4][2], const Unit& u, int wr, int wc, int fr, int fq) const {
        const int row0 = u.pm * BM + wr * 64 + fr;
        if (u.pn < 4) { const int col0 = u.pn * BM + wc * 32 + 8 * fq;
#pragma unroll
            for (int ai = 0; ai < 2; ++ai)
#pragma unroll
                for (int m = 0; m < 4; ++m) { if (!((u.ab >> ai) & 1)) continue; bf16_t* rowp = O + (size_t)(row0 + ai * HALF + m * 16) * 2048 + col0;
#pragma unroll
                    for (int bj = 0; bj < 2; ++bj) { const f32x4 v0 = acc[ai][bj][m][0], v1 = acc[ai][bj][m][1];
                        u32x4 w; w.x = cvt_pk_bf16(v0[0], v0[1]); w.y = cvt_pk_bf16(v0[2], v0[3]); w.z = cvt_pk_bf16(v1[0], v1[1]); w.w = cvt_pk_bf16(v1[2], v1[3]);
                        *(u32x4*)(rowp + bj * HALF) = w; } }
        } else { const int col0 = 1024 + (u.pn - 4) * HALF + wc * 32 + 8 * fq;
#pragma unroll
            for (int ai = 0; ai < 2; ++ai)
#pragma unroll
                for (int m = 0; m < 4; ++m) { if (!((u.ab >> ai) & 1)) continue; bf16_t* rowp = O + (size_t)(row0 + ai * HALF + m * 16) * 2048 + col0;
                    const f32x4 c0 = acc[ai][0][m][0], c1 = acc[ai][0][m][1], v0 = acc[ai][1][m][0], v1 = acc[ai][1][m][1];
                    u32x4 w; w.x = cvt_pk_bf16(c0[0] * v0[0], c0[1] * v0[1]); w.y = cvt_pk_bf16(c0[2] * v0[2], c0[3] * v0[3]); w.z = cvt_pk_bf16(c1[0] * v1[0], c1[1] * v1[1]); w.w = cvt_pk_bf16(c1[2] * v1[2], c1[3] * v1[3]);
                    *(u32x4*)rowp = w; }
        }
    }
};
struct EpiDown {
    static constexpr bool PERM = true, AFTER_DRAIN = false;
    bf16_t* O; const float* gate; int ntn;
    __device__ __forceinline__ void operator()(const f32x4 (&acc)[2][2][4][2], const Unit& u, int wr, int wc, int fr, int fq) const {
        const int row0 = u.pm * BM + wr * 64 + fr; const int col0 = (u.pn % ntn) * BM + wc * 32 + 8 * fq;
#pragma unroll
        for (int ai = 0; ai < 2; ++ai)
#pragma unroll
            for (int m = 0; m < 4; ++m) { if (!((u.ab >> ai) & 1)) continue; const int r = row0 + ai * HALF + m * 16; const float gt = gate[r]; bf16_t* rowp = O + (size_t)r * 1024 + col0;
#pragma unroll
                for (int bj = 0; bj < 2; ++bj) { if (!((u.ab >> (2 + bj)) & 1)) continue; const f32x4 v0 = acc[ai][bj][m][0] * gt, v1 = acc[ai][bj][m][1] * gt;
                    u32x4 w; w.x = cvt_pk_bf16(v0[0], v0[1]); w.y = cvt_pk_bf16(v0[2], v0[3]); w.z = cvt_pk_bf16(v1[0], v1[1]); w.w = cvt_pk_bf16(v1[2], v1[3]);
                    *(u32x4*)(rowp + bj * HALF) = w; } }
    }
};
struct OneUnit { static constexpr bool HAS_SPLIT = false; int pm, pn;
    __device__ bool next(int i, Unit& u) const { if (i > 0) return false; u.pm = pm; u.pn = pn; u.ab = 15; return true; }
    __device__ __forceinline__ void a_ready(const Unit&) const {}
    __device__ __forceinline__ void done(const Unit&) const {}
};
template <int NTN, int QUARTER>
struct GroupOrderT {
    static constexpr bool HAS_SPLIT = true;
    int nfull, nsplit, G, c;
    __device__ void init(int mt_, int ne, int G_, int c_) { nfull = ne * 8 * NTN; nsplit = mt_ > 8 ? ne * NTN * (QUARTER ? 2 : 1) : 0; G = G_; c = c_; }
    __device__ bool next(int i, Unit& u) const { const int L = i * G + c; if (L >= nfull + nsplit) return false;
        int pm, pn, ab;
        if (L < nfull) { const int e = L / (8 * NTN), r = L % (8 * NTN); pm = e * 9 + (r % 8); pn = e * NTN + (r / 8); ab = 15; }
        else { const int q = L - nfull; const int sp = QUARTER ? 2 : 1, t = q / sp, s = q % sp; pm = (t / NTN) * 9 + 8; pn = t; ab = 1 | ((QUARTER ? (1 << s) : 3) << 2); }
        u.pm = pm; u.pn = pn; u.ab = ab; return true; }
    __device__ __forceinline__ void a_ready(const Unit&) const {}
    __device__ __forceinline__ void done(const Unit&) const {}
};

struct DenseA { static constexpr bool GATHER = false;
    __device__ __forceinline__ unsigned off(const Unit&, int h, int R, int C, int K) const { return (unsigned)((h * HALF + R) * K + C) * 2u; }
    __device__ __forceinline__ size_t base(const Unit& u, size_t tstep) const { return (size_t)u.pm * tstep; } };
struct GatherA { static constexpr bool GATHER = true; const int* sel; int sel_ld, tiles_per_e, nvalid;
    __device__ __forceinline__ unsigned off(const Unit& u, int h, int R, int C, int K) const { const int e = u.pm / tiles_per_e, xr = (u.pm % tiles_per_e) * BM + h * HALF + R; const int row = sel[e * sel_ld + (xr < nvalid ? xr : 0)]; return (unsigned)(row * K + C) * 2u; }
    __device__ __forceinline__ size_t base(const Unit&, size_t) const { return 0; } };
template <class Epi, class Sched, bool ALIGN_EPI = false, bool SP2 = false, class AOff = DenseA>
__device__ __forceinline__ void gemm_phase(PG8_LAS unsigned char* lds, const Gemm g, const Sched& S, const Epi& E, const AOff AO = AOff()) {
    const int tid = otid(), wid = __builtin_amdgcn_readfirstlane(tid >> 6), lane = tid & 63, wr = wid >> 2, wc = wid & 3, fr = lane & 15, fq = lane >> 4;
    const int K = g.K, nt = K / BK;
    unsigned voffB[2];
#pragma unroll
    for (int i = 0; i < 2; ++i) { int R, C; stage_rc(tid * 16 + i * 8192, R, C); const int Rb = Epi::PERM ? ((R & ~31) + perm32(R & 31)) : R;
        voffB[i] = (unsigned)(Rb * K + C) * 2u; }
    const size_t kstep = (size_t)(BK * 2);
    const size_t hstep = (size_t)HALF * K * 2;
    const size_t tstep = 2 * hstep;
    const unsigned ldsw = (unsigned)wid * 1024u;
    const int aoff = lds_byte(wr * 64 + fr, fq * 8), boff = lds_byte(wc * 32 + fr, fq * 8);
#define PG8_SA(b, h) (((b) * 2 + (h)) * HTB)
#define PG8_SB(b, h) ((4 + (b) * 2 + (h)) * HTB)
#define PG8_STAGE(bufoff, gbase, voff) do { _Pragma("unroll") for (int _i = 0; _i < 2; ++_i) \
        __builtin_amdgcn_global_load_lds((const unsigned*)((const char*)(gbase) + (voff)[_i]), (PG8_LAS unsigned*)(lds + (bufoff) + ldsw + _i * 8192), 16, 0, 0); } while (0)
#define PG8_STAGE_AC(b, h, base) PG8_STAGE(PG8_SA(b, h), base, roC[h])
#define PG8_STAGE_A2(b, h, base) PG8_STAGE(PG8_SA(b, h), base, r2[h])
#define PG8_LDA(dst, b, h) do { _Pragma("unroll") for (int m = 0; m < 4; ++m) _Pragma("unroll") for (int k = 0; k < 2; ++k) dst[m][k] = *(const PG8_LAS bf16x8*)(lds + PG8_SA(b, h) + aoff + m * 2048 + k * 1024); } while (0)
#define PG8_LDB(dst, b, h) do { _Pragma("unroll") for (int n = 0; n < 2; ++n) _Pragma("unroll") for (int k = 0; k < 2; ++k) dst[n][k] = *(const PG8_LAS bf16x8*)(lds + PG8_SB(b, h) + boff + n * 2048 + k * 1024); } while (0)
#define PG8_MMA(ai, bj, At, Bt) do { if (GATED && !(((cur.ab >> (ai)) & 1) && ((cur.ab >> (2 + (bj))) & 1))) break; __builtin_amdgcn_s_setprio(1); _Pragma("unroll") for (int m = 0; m < 4; ++m) _Pragma("unroll") for (int n = 0; n < 2; ++n) _Pragma("unroll") for (int k = 0; k < 2; ++k) \
        acc[ai][bj][m][n] = __builtin_amdgcn_mfma_f32_16x16x32_bf16(Bt[n][k], At[m][k], acc[ai][bj][m][n], 0, 0, 0); __builtin_amdgcn_s_setprio(0); } while (0)
#define PG8_WAIT_V(n) asm volatile("s_waitcnt vmcnt(" #n ")" ::: "memory")
#define PG8_WAIT_L(n) asm volatile("s_waitcnt lgkmcnt(" #n ")" ::: "memory")
#define PG8_BAR __builtin_amdgcn_s_barrier()
#define PG8_SCHED __builtin_amdgcn_sched_barrier(0)
    Unit cur, nxt; int ui = 0;
    if (!S.next(0, cur)) return;
    f32x4 acc[2][2][4][2];
#pragma unroll
    for (int a = 0; a < 2; ++a)
#pragma unroll
        for (int b = 0; b < 2; ++b)
#pragma unroll
            for (int m = 0; m < 4; ++m)
#pragma unroll
                for (int n = 0; n < 2; ++n) acc[a][b][m][n] = (f32x4){0.f, 0.f, 0.f, 0.f};
    bf16x8 At[4][2], B0[2][2], B1[2][2];
    unsigned roC[2][2], roN[2][2];
#pragma unroll
    for (int h = 0; h < 2; ++h)
#pragma unroll
        for (int i = 0; i < 2; ++i) { int R, C; stage_rc(tid * 16 + i * 8192, R, C); roC[h][i] = AO.off(cur, h, R, C, K); }
    const char* cA = (const char*)g.A + AO.base(cur, tstep); const char* cB = (const char*)g.Bt + (size_t)cur.pn * tstep;
    S.a_ready(cur);
    if constexpr (SP2) {
        PG8_STAGE(PG8_SB(0, 0), cB, voffB); PG8_STAGE(PG8_SB(0, 1), cB + hstep, voffB); PG8_STAGE_AC(0, 0, cA); PG8_STAGE_AC(0, 1, cA);
        if (wr == 1) PG8_BAR;
        PG8_WAIT_V(2); PG8_BAR;
        PG8_STAGE(PG8_SB(1, 0), cB + kstep, voffB); PG8_STAGE_AC(1, 0, cA + kstep); PG8_STAGE(PG8_SB(1, 1), cB + hstep + kstep, voffB);
        PG8_WAIT_V(6); PG8_BAR;
    } else {
        PG8_STAGE(PG8_SB(0, 0), cB, voffB); PG8_STAGE_AC(0, 0, cA); PG8_STAGE(PG8_SB(0, 1), cB + hstep, voffB); PG8_STAGE_AC(0, 1, cA);
        if (wr == 1) PG8_BAR;
        PG8_WAIT_V(4); PG8_BAR;
        PG8_STAGE(PG8_SB(1, 0), cB + kstep, voffB); PG8_STAGE_AC(1, 0, cA + kstep); PG8_STAGE(PG8_SB(1, 1), cB + hstep + kstep, voffB);
        PG8_WAIT_V(6); PG8_BAR;
    }
    for (;;) {
        const bool has_next = S.next(ui + 1, nxt);
        const char* nA = has_next ? (const char*)g.A + AO.base(nxt, tstep) : cA; const char* nB = has_next ? (const char*)g.Bt + (size_t)nxt.pn * tstep : cB;
#pragma unroll
        for (int h = 0; h < 2; ++h)
#pragma unroll
            for (int i = 0; i < 2; ++i) { if (AOff::GATHER && has_next) { int R, C; stage_rc(tid * 16 + i * 8192, R, C); roN[h][i] = AO.off(nxt, h, R, C, K); } else roN[h][i] = roC[h][i]; }
        auto kloop = [&](auto gated_tag) { constexpr bool GATED = decltype(gated_tag)::value;
        for (int t = 0; t < nt; t += 2) {
            const bool last = (t == nt - 2);
            const char* a1 = cA + (size_t)(t + 1) * kstep;
            const char* a2 = last ? nA : cA + (size_t)(t + 2) * kstep; const char* b2 = last ? nB : cB + (size_t)(t + 2) * kstep;
            unsigned r2[2][2];
#pragma unroll
            for (int h = 0; h < 2; ++h)
#pragma unroll
                for (int i = 0; i < 2; ++i) r2[h][i] = (AOff::GATHER && last) ? roN[h][i] : roC[h][i];
            const char* a3 = a2 + kstep; const char* b3 = b2 + kstep;
            if (last && has_next) S.a_ready(nxt);
            if constexpr (SP2) {
            PG8_LDB(B0, 0, 0); PG8_LDB(B1, 0, 1); PG8_SCHED; PG8_LDA(At, 0, 0); PG8_STAGE_AC(1, 1, a1);
            PG8_WAIT_V(8); PG8_WAIT_L(0); PG8_BAR; PG8_MMA(0, 0, At, B0); PG8_MMA(0, 1, At, B1); PG8_BAR; PG8_SCHED;
            PG8_LDA(At, 0, 1); PG8_STAGE(PG8_SB(0, 0), b2, voffB); PG8_STAGE(PG8_SB(0, 1), b2 + hstep, voffB); PG8_STAGE_A2(0, 0, a2);
            PG8_WAIT_V(8); PG8_WAIT_L(0); PG8_BAR; PG8_MMA(1, 0, At, B0); PG8_MMA(1, 1, At, B1); PG8_BAR; PG8_SCHED;
            PG8_LDB(B0, 1, 0); PG8_LDB(B1, 1, 1); PG8_SCHED; PG8_LDA(At, 1, 0); PG8_STAGE_A2(0, 1, a2);
            PG8_WAIT_V(8); PG8_WAIT_L(0); PG8_BAR; PG8_MMA(0, 0, At, B0); PG8_MMA(0, 1, At, B1); PG8_BAR; PG8_SCHED;
            PG8_LDA(At, 1, 1); PG8_STAGE(PG8_SB(1, 0), b3, voffB); PG8_STAGE(PG8_SB(1, 1), b3 + hstep, voffB); PG8_STAGE_A2(1, 0, a3);
            PG8_WAIT_V(8); PG8_WAIT_L(0); PG8_BAR; PG8_MMA(1, 0, At, B0); PG8_MMA(1, 1, At, B1); PG8_BAR; PG8_SCHED;
            } else {
            PG8_LDB(B0, 0, 0); PG8_SCHED; PG8_LDA(At, 0, 0); PG8_STAGE_AC(1, 1, a1);
            PG8_WAIT_L(8); PG8_BAR; PG8_WAIT_L(0); PG8_MMA(0, 0, At, B0); PG8_BAR; PG8_SCHED;
            PG8_LDB(B1, 0, 1); PG8_STAGE(PG8_SB(0, 0), b2, voffB);
            PG8_BAR; PG8_WAIT_L(0); PG8_MMA(0, 1, At, B1); PG8_BAR;
            PG8_LDA(At, 0, 1); PG8_STAGE_A2(0, 0, a2);
            PG8_BAR; PG8_WAIT_L(0); PG8_MMA(1, 0, At, B0); PG8_BAR; PG8_SCHED;
            PG8_STAGE(PG8_SB(0, 1), b2 + hstep, voffB);
            PG8_WAIT_V(6); PG8_BAR; PG8_MMA(1, 1, At, B1); PG8_BAR;
            PG8_LDB(B0, 1, 0); PG8_SCHED; PG8_LDA(At, 1, 0); PG8_STAGE_A2(0, 1, a2);
            PG8_WAIT_L(8); PG8_BAR; PG8_WAIT_L(0); PG8_MMA(0, 0, At, B0); PG8_BAR; PG8_SCHED;
            PG8_LDB(B1, 1, 1); PG8_STAGE(PG8_SB(1, 0), b3, voffB);
            PG8_BAR; PG8_WAIT_L(0); PG8_MMA(0, 1, At, B1); PG8_BAR;
            PG8_LDA(At, 1, 1); PG8_STAGE_A2(1, 0, a3);
            PG8_BAR; PG8_WAIT_L(0); PG8_MMA(1, 0, At, B0); PG8_BAR; PG8_SCHED;
            PG8_STAGE(PG8_SB(1, 1), b3 + hstep, voffB);
            PG8_WAIT_V(6); PG8_BAR; PG8_MMA(1, 1, At, B1); PG8_BAR;
            }
        }
        };
        if constexpr (Sched::HAS_SPLIT) { if (cur.ab == 15) kloop(std::false_type{}); else kloop(std::true_type{}); } else kloop(std::false_type{});
        if constexpr (ALIGN_EPI) { if (wr == 0) PG8_BAR; }
        if constexpr (!Epi::AFTER_DRAIN) { E(acc, cur, wr, wc, fr, fq); S.done(cur); }
        if (!has_next) break;
#pragma unroll
        for (int a = 0; a < 2; ++a)
#pragma unroll
            for (int b = 0; b < 2; ++b)
#pragma unroll
                for (int m = 0; m < 4; ++m)
#pragma unroll
                    for (int n = 0; n < 2; ++n) acc[a][b][m][n] = (f32x4){0.f, 0.f, 0.f, 0.f};
        cur = nxt; cA = nA; cB = nB; ++ui;
#pragma unroll
        for (int h = 0; h < 2; ++h)
#pragma unroll
            for (int i = 0; i < 2; ++i) roC[h][i] = roN[h][i];
        if constexpr (ALIGN_EPI) { if (wr == 1) PG8_BAR; }
    }
    PG8_WAIT_V(0);
    if constexpr (!ALIGN_EPI) { if (wr == 0) PG8_BAR; }
    PG8_BAR;
    if constexpr (Epi::AFTER_DRAIN) { E.fused(acc, cur, wr, wc, fr, fq, lds, wid, lane); S.done(cur); }
#undef PG8_SA
#undef PG8_STAGE_AC
#undef PG8_STAGE_A2
#undef PG8_SB
#undef PG8_STAGE
#undef PG8_LDA
#undef PG8_LDB
#undef PG8_MMA
#undef PG8_WAIT_V
#undef PG8_WAIT_L
#undef PG8_BAR
#undef PG8_SCHED
}
}

__device__ __forceinline__ void mini_barrier(unsigned* ctr, unsigned n) {
    asm volatile("s_waitcnt vmcnt(0)" ::: "memory");
    __syncthreads();
    if (threadIdx.x == 0) {
        __builtin_amdgcn_fence(__ATOMIC_RELEASE, "agent");
        asm volatile("s_waitcnt vmcnt(0)" ::: "memory");
        (void)xb_add(ctr, 1u);
        unsigned sp = 0u; while (xb_ld(ctr) < n) { __builtin_amdgcn_s_sleep(1); if (++sp > XB_SPIN_CAP) break; }
        __builtin_amdgcn_fence(__ATOMIC_ACQUIRE, "agent");
        asm volatile("s_waitcnt vmcnt(0)" ::: "memory");
    }
    __syncthreads();
}
constexpr int CW_MINI = 16384;
__device__ __forceinline__ void ph_setup(const Prm& p, LAS float* lds) {
    float* modv = (float*)(p.ws + WS_MODV);
    float* rope = (float*)(p.ws + WS_ROPE);
    const int tid = otid();
    LAS float* sc = lds;
    LAS float* red = lds + 5 * 1024;
    for (int i = tid; i < 5 * 1024; i += NTHREADS) { const int r = i >> 10, k = i & 1023; const float v = r < 4 ? p.c[r * 1024 + k] : p.c_ctx[k]; sc[i] = siluf_(v); }
    __syncthreads();
    const int nitems = DEPTH * 6144 / 128;
    for (int it = obid(); it < nitems; it += gridDim.x) {
        const int l = it / 48, n0 = (it % 48) * 128;
        const int kp = tid >> 5, q = tid & 31;
        const float* w = p.mod_w + ((size_t)l * 1024 + kp * 64) * 6144 + n0 + 4 * q;
        f32x4 a[5];
#pragma unroll
        for (int r = 0; r < 5; ++r) a[r] = (f32x4){0.f, 0.f, 0.f, 0.f};
#pragma unroll 1
        for (int k0 = 0; k0 < 64; k0 += 8) { f32x4 wv[8];
#pragma unroll
            for (int k = 0; k < 8; ++k) wv[k] = __builtin_nontemporal_load((const f32x4*)(w + (size_t)(k0 + k) * 6144));
#pragma unroll
            for (int k = 0; k < 8; ++k) { const int kk = kp * 64 + k0 + k;
#pragma unroll
                for (int r = 0; r < 5; ++r) a[r] += wv[k] * sc[r * 1024 + kk]; } }
#pragma unroll
        for (int r = 0; r < 5; ++r) *(LAS f32x4*)(red + ((kp * 5 + r) * 128 + 4 * q)) = a[r];
        __syncthreads();
        for (int i = tid; i < 5 * 128; i += NTHREADS) { const int r = i >> 7, n = i & 127; float s = p.mod_b[l * 6144 + n0 + n];
#pragma unroll
            for (int q2 = 0; q2 < 16; ++q2) s += red[(q2 * 5 + r) * 128 + n];
            modv[((size_t)l * 5 + r) * 6144 + n0 + n] = s; }
        __syncthreads();
    }
    if (obid() == gridDim.x - 1) {
        for (int i = tid; i < 64 * 16; i += NTHREADS) { const int pos = i >> 4, f = i & 15; const float inv = exp2f(-(float)f * (13.287712379549449f / 16.f)); const float ang = (float)pos * inv;
            rope[i * 2] = __cosf(ang); rope[i * 2 + 1] = __sinf(ang); }
    }
}

#define CJ(jj) (8 * lane + 512 * ((jj) >> 1) + 4 * ((jj) & 1))
__device__ __forceinline__ void acc_bf16x8(f32x4& lo, f32x4& hi, const u32x4 w, float f) {
    lo.x += f * __uint_as_float(w.x << 16); lo.y += f * __uint_as_float(w.x & 0xffff0000u); lo.z += f * __uint_as_float(w.y << 16); lo.w += f * __uint_as_float(w.y & 0xffff0000u);
    hi.x += f * __uint_as_float(w.z << 16); hi.y += f * __uint_as_float(w.z & 0xffff0000u); hi.z += f * __uint_as_float(w.w << 16); hi.w += f * __uint_as_float(w.w & 0xffff0000u);
}
__device__ __forceinline__ u32x4 pack_bf16x8(const f32x4 lo, const f32x4 hi) { u32x4 o; o.x = pk2(lo.x, lo.y); o.y = pk2(lo.z, lo.w); o.z = pk2(hi.x, hi.y); o.w = pk2(hi.z, hi.w); return o; }
__device__ __forceinline__ void load_xrow(const bf16* xrow, int lane, f32x4 (&v)[4]) {
#pragma unroll
    for (int j2 = 0; j2 < 2; ++j2) { const u32x4 w = __builtin_nontemporal_load((const u32x4*)(xrow + 8 * lane + 512 * j2)); v[2 * j2] = (f32x4){0.f, 0.f, 0.f, 0.f}; v[2 * j2 + 1] = (f32x4){0.f, 0.f, 0.f, 0.f}; acc_bf16x8(v[2 * j2], v[2 * j2 + 1], w, 1.f); }
}
__device__ __forceinline__ void store_xrow(bf16* xrow, int lane, const f32x4 (&v)[4]) {
#pragma unroll
    for (int j2 = 0; j2 < 2; ++j2) *(u32x4*)(xrow + 8 * lane + 512 * j2) = pack_bf16x8(v[2 * j2], v[2 * j2 + 1]);
}
struct Sel4 { const bf16* y[4]; float f[4]; unsigned long long rest; };
__device__ __forceinline__ Sel4 moe_sel4(const bf16* YE, int sl, int lane) {
    Sel4 q; unsigned long long m = __ballot(sl >= 0); int e0 = 0, s0 = 0;
#pragma unroll
    for (int k = 0; k < 4; ++k) { const bool has = m != 0; const int e = has ? __builtin_ctzll(m) : e0; if (has) m &= m - 1; const int s = __builtin_amdgcn_readlane(sl, e);
        if (k == 0) { e0 = e; s0 = has ? s : 0; }
        q.y[k] = YE + ((size_t)(has ? e : e0) * XR + (has ? s : s0)) * D + 8 * lane; q.f[k] = has ? 1.f : 0.f; }
    q.rest = m; return q;
}
__device__ __forceinline__ void moe_load4(const Sel4& q, u32x4 (&w)[4][2]) {
#pragma unroll
    for (int k = 0; k < 4; ++k)
#pragma unroll
        for (int j = 0; j < 2; ++j) w[k][j] = __builtin_nontemporal_load((const u32x4*)(q.y[k] + 512 * j));
}
__device__ __forceinline__ void moe_acc4(const Sel4& q, const u32x4 (&w)[4][2], f32x4 (&a)[4]) {
#pragma unroll
    for (int jj = 0; jj < 4; ++jj) a[jj] = (f32x4){0.f, 0.f, 0.f, 0.f};
#pragma unroll
    for (int k = 0; k < 4; ++k)
#pragma unroll
        for (int j = 0; j < 2; ++j) acc_bf16x8(a[2 * j], a[2 * j + 1], w[k][j], q.f[k]);
}
__device__ __forceinline__ void moe_gather_rest(const bf16* YE, int sl, unsigned long long m, int lane, f32x4 (&a)[4]) {
    while (m) { const int e = __builtin_ctzll(m); m &= m - 1; const int s = __builtin_amdgcn_readlane(sl, e); const bf16* y = YE + ((size_t)e * XR + s) * D + 8 * lane;
#pragma unroll
        for (int j = 0; j < 2; ++j) { const u32x4 w = *(const u32x4*)(y + 512 * j); acc_bf16x8(a[2 * j], a[2 * j + 1], w, 1.f); } }
}
__device__ __forceinline__ void norm1_pair(const Prm& p, int l, int r, int lane, bool comb_ctx, bool wb) {
    const float* modv = (const float*)(p.ws + WS_MODV) + (size_t)l * 5 * 6144;
    const float* modp = (const float*)(p.ws + WS_MODV) + (size_t)(l > 0 ? l - 1 : 0) * 5 * 6144;
    bf16* X = (bf16*)(p.ws + WS_X); bf16* H = (bf16*)(p.ws + WS_H); const int* tokslot = (const int*)(p.ws + WS_TOKSLOT); const bf16* YE = (const bf16*)(p.ws + WS_YE);
    const bool isc = r >= ML; const int mr = isc ? 4 : (r >> 12);
    f32x4 v[2][4];
    if (l == 0) { const float* src = isc ? p.ctx + (size_t)(r - ML) * D : p.x + (size_t)r * D;
#pragma unroll
        for (int u = 0; u < 2; ++u)
#pragma unroll
            for (int j = 0; j < 4; ++j) v[u][j] = __builtin_nontemporal_load((const f32x4*)(src + (size_t)u * D + CJ(j)));
    } else {
        const bool comb = !isc || comb_ctx;
        int sl0 = -1, sl1 = -1; if (comb && lane < NE) { sl0 = tokslot[(size_t)r * NE + lane]; sl1 = tokslot[(size_t)(r + 1) * NE + lane]; }
        load_xrow(X + (size_t)r * D, lane, v[0]); load_xrow(X + (size_t)(r + 1) * D, lane, v[1]);
        if (comb) { const Sel4 q0 = moe_sel4(YE, sl0, lane), q1 = moe_sel4(YE, sl1, lane); u32x4 w0[4][2], w1[4][2]; moe_load4(q0, w0); moe_load4(q1, w1);
            f32x4 a0[4], a1[4]; moe_acc4(q0, w0, a0); moe_acc4(q1, w1, a1);
            if (q0.rest) moe_gather_rest(YE, sl0, q0.rest, lane, a0); if (q1.rest) moe_gather_rest(YE, sl1, q1.rest, lane, a1);
#pragma unroll
            for (int j = 0; j < 4; ++j) { const f32x4 g2 = *(const f32x4*)(modp + (size_t)mr * 6144 + 5 * 1024 + CJ(j)); v[0][j] += g2 * a0[j]; v[1][j] += g2 * a1[j]; }
            if (wb) { store_xrow(X + (size_t)r * D, lane, v[0]); store_xrow(X + (size_t)(r + 1) * D, lane, v[1]); } }
    }
#pragma unroll
    for (int u = 0; u < 2; ++u) { float s = 0.f;
#pragma unroll
        for (int j = 0; j < 4; ++j) s += v[u][j].x * v[u][j].x + v[u][j].y * v[u][j].y + v[u][j].z * v[u][j].z + v[u][j].w * v[u][j].w;
        const float rstd = rsqrtf(wave_sum(s) * (1.f / D) + EPS);
        f32x4 hh[4];
#pragma unroll
        for (int j = 0; j < 4; ++j) { const int c = CJ(j);
            const f32x4 g = *(const f32x4*)(p.norm1_g + l * D + c), sh = *(const f32x4*)(modv + (size_t)mr * 6144 + c), scl = *(const f32x4*)(modv + (size_t)mr * 6144 + 1024 + c);
            hh[j] = (v[u][j] * rstd * g) * (scl + 1.f) + sh; }
#pragma unroll
        for (int j2 = 0; j2 < 2; ++j2) *(u32x4*)(H + (size_t)(r + u) * D + 8 * lane + 512 * j2) = pack_bf16x8(hh[2 * j2], hh[2 * j2 + 1]); }
}
__device__ __forceinline__ void ph_norm1(const Prm& p, int l, bool wb = true) {
    const int lane = otid() & 63, ngw = gridDim.x * 8, gw = ngw - 1 - (obid() * 8 + (otid() >> 6));
    const int nrows = (l <= 2) ? MT : ML;
    const bool comb_ctx = (l >= 1 && l <= 2);
    for (int r = gw * 2; r < nrows; r += ngw * 2) norm1_pair(p, l, r, lane, comb_ctx, wb);
}
__device__ __forceinline__ void ph_final(const Prm& p) {
    const int lane = otid() & 63, gw = obid() * 8 + (otid() >> 6), ngw = gridDim.x * 8;
    const float* modp = (const float*)(p.ws + WS_MODV) + (size_t)3 * 5 * 6144;
    const bf16* X = (const bf16*)(p.ws + WS_X); const int* tokslot = (const int*)(p.ws + WS_TOKSLOT); const bf16* YE = (const bf16*)(p.ws + WS_YE);
    for (int r = gw * 2; r < ML; r += ngw * 2) {
        const int mr = r >> 12; f32x4 v[2][4];
        int sl0 = -1, sl1 = -1; if (lane < NE) { sl0 = tokslot[(size_t)r * NE + lane]; sl1 = tokslot[(size_t)(r + 1) * NE + lane]; }
        load_xrow(X + (size_t)r * D, lane, v[0]); load_xrow(X + (size_t)(r + 1) * D, lane, v[1]);
        const Sel4 q0 = moe_sel4(YE, sl0, lane), q1 = moe_sel4(YE, sl1, lane); u32x4 w0[4][2], w1[4][2]; moe_load4(q0, w0); moe_load4(q1, w1);
        f32x4 a0[4], a1[4]; moe_acc4(q0, w0, a0); moe_acc4(q1, w1, a1);
        if (q0.rest) moe_gather_rest(YE, sl0, q0.rest, lane, a0); if (q1.rest) moe_gather_rest(YE, sl1, q1.rest, lane, a1);
#pragma unroll
        for (int j = 0; j < 4; ++j) { const f32x4 g2 = *(const f32x4*)(modp + (size_t)mr * 6144 + 5 * 1024 + CJ(j));
            *(f32x4*)(p.out + (size_t)r * D + CJ(j)) = v[0][j] + g2 * a0[j]; *(f32x4*)(p.out + (size_t)(r + 1) * D + CJ(j)) = v[1][j] + g2 * a1[j]; }
    }
}

__device__ __forceinline__ unsigned cvtpk_(float lo, float hi) { unsigned r; asm volatile("v_cvt_pk_bf16_f32 %0, %1, %2" : "=v"(r) : "v"(lo), "v"(hi)); return r; }
__device__ __forceinline__ void cvt_item(const float* W, int N, bf16* WT, int gu, LAS unsigned char* img, int item, int tid) {
    const int nblk = N / 512, kb = item / nblk, nb = item % nblk, k0 = 64 * kb, n0 = 512 * nb;
    const int lane = tid & 63, w = tid >> 6;
    const float* src = W + (size_t)(k0 + 8 * w) * N + n0 + 4 * lane;
    f32x4 a[4][2], b[4][2];
#pragma unroll
    for (int j = 0; j < 4; ++j)
#pragma unroll
        for (int hh = 0; hh < 2; ++hh) { a[j][hh] = __builtin_nontemporal_load((const f32x4*)(src + (size_t)(2 * j) * N + 256 * hh)); b[j][hh] = __builtin_nontemporal_load((const f32x4*)(src + (size_t)(2 * j + 1) * N + 256 * hh)); }
    __syncthreads();
    const int sw = (lane >> 1) & 7;
#pragma unroll
    for (int hh = 0; hh < 2; ++hh)
#pragma unroll
        for (int j = 0; j < 4; ++j) { const int wofs = ((w ^ sw) * 4 + j) * 4;
            LAS unsigned char* rowp = img + (size_t)(4 * lane + 256 * hh) * 144 + wofs;
            *(LAS unsigned*)(rowp) = cvtpk_(a[j][hh].x, b[j][hh].x); *(LAS unsigned*)(rowp + 144) = cvtpk_(a[j][hh].y, b[j][hh].y);
            *(LAS unsigned*)(rowp + 288) = cvtpk_(a[j][hh].z, b[j][hh].z); *(LAS unsigned*)(rowp + 432) = cvtpk_(a[j][hh].w, b[j][hh].w); }
    __syncthreads();
    const int jq = tid & 7, nr = tid >> 3;
#pragma unroll
    for (int i = 0; i < 8; ++i) { const int n = nr + 64 * i; const u32x4 v = *(const LAS u32x4*)(img + n * 144 + ((jq ^ ((n >> 3) & 7)) * 16));
        const int ncol = n0 + n; int drow;
        if (gu < 0) drow = ncol; else if (gu < 2) drow = (ncol >> 7) * 256 + (ncol & 127) + gu * 128;
        else { const int ch = (ncol - 1024) & 1023; drow = ncol < 1024 ? ncol : 1024 + (ch >> 7) * 256 + (ncol >= 2048 ? 128 : 0) + (ch & 127); }
        *(u32x4*)(WT + (size_t)drow * 1024 + k0 + 8 * jq) = v; }
}
__device__ __forceinline__ void ph_convert(const Prm& p, int l, LAS unsigned char* lds) {
    const int tid = otid();
    const bool even = (l & 1) == 0; const int Nin = even ? 4096 : 3072;
    const float* Win = even ? p.even_w_in + (size_t)(l / 2) * D * 4096 : p.conv_w_in + (size_t)(l / 2) * D * 3072;
    const float* Wout = even ? p.even_w_out + (size_t)(l / 2) * D * D : p.conv_w_out + (size_t)(l / 2) * D * D;
    const int I_IN = 16 * (Nin / 512), I_OUT = 32, I_E = 32;
    const int total = I_IN + I_OUT + NE * 3 * I_E;
    for (int it = obid(); it < total; it += gridDim.x) {
        int r = it;
        if (r < I_IN) { cvt_item(Win, Nin, (bf16*)(p.ws + WS_WIN), even ? -1 : 2, lds, r, tid); continue; } r -= I_IN;
        if (r < I_OUT) { cvt_item(Wout, D, (bf16*)(p.ws + WS_WOUT), -1, lds, r, tid); continue; } r -= I_OUT;
        const int e = r / (3 * I_E), w = (r / I_E) % 3, item = r % I_E;
        if (w < 2) cvt_item((w == 0 ? p.w_gate : p.w_up) + ((size_t)l * NE + e) * D * FF, FF, (bf16*)(p.ws + WS_WUP) + (size_t)e * 2048 * D, w, lds, item, tid);
        else cvt_item(p.w_down + ((size_t)l * NE + e) * FF * D, D, (bf16*)(p.ws + WS_WDN) + (size_t)e * D * FF, -1, lds, item, tid);
    }
    __syncthreads();
}

template <int MODE> __device__ __forceinline__ void ph_probe_read(const Prm& p, int l) {
    const f32x4* s0 = (const f32x4*)(p.w_gate + (size_t)l * NE * D * FF);
    const f32x4* s1 = (const f32x4*)(p.w_up + (size_t)l * NE * D * FF); const f32x4* s2 = (const f32x4*)(p.w_down + (size_t)l * NE * D * FF);
    const size_t n4 = (size_t)NE * D * FF / 4; f32x4 acc = (f32x4){0.f, 0.f, 0.f, 0.f};
    if (MODE == 0 || MODE == 1) {
        const size_t st = (size_t)gridDim.x * NTHREADS;
        for (size_t i = (size_t)obid() * NTHREADS + otid(); i < n4; i += st * 4) {
#pragma unroll
            for (int t = 0; t < 3; ++t) { const f32x4* s = t == 0 ? s0 : (t == 1 ? s1 : s2);
#pragma unroll
                for (int k = 0; k < 4; ++k) { const size_t j = i + k * st; if (j < n4) acc += (MODE == 1) ? __builtin_nontemporal_load(s + j) : s[j]; } } }
    } else {
        constexpr int NL = MODE == 2 ? 16 : 32; const int lane = otid() & 63; const size_t gw = (size_t)obid() * 8 + (otid() >> 6), ngw = (size_t)gridDim.x * 8;
        const size_t nch = 3 * n4 / (64 * NL);
        for (size_t c = gw; c < nch; c += ngw) { const size_t base = c * 64 * NL; const f32x4* s = base < n4 ? s0 + base : (base < 2 * n4 ? s1 + (base - n4) : s2 + (base - 2 * n4));
            f32x4 v[NL];
#pragma unroll
            for (int k = 0; k < NL; ++k) v[k] = __builtin_nontemporal_load(s + k * 64 + lane);
#pragma unroll
            for (int k = 0; k < NL; ++k) acc += v[k]; }
    }
    if (acc.x + acc.y + acc.z + acc.w == 1.2345e33f) ((float*)(p.ws + WS_OF))[otid()] = acc.x;
}
template <int MODE> __device__ __forceinline__ void ph_probe_cvt(const Prm& p, int l) {
    const int lane = otid() & 63, gw = obid() * 8 + (otid() >> 6), ngw = gridDim.x * 8; f32x4 acc = (f32x4){0.f, 0.f, 0.f, 0.f};
    for (int it = gw; it < NE * 3 * 256; it += ngw) { const int e = it / 768, w = (it / 256) % 3, item = it % 256, kb = item / 16, nb = item % 16;
        if (MODE == 4) { const float* W = (w == 0 ? p.w_gate : (w == 1 ? p.w_up : p.w_down)) + ((size_t)l * NE + e) * D * FF; const float* src = W + (size_t)(64 * kb + 2 * (lane >> 4)) * 1024 + 64 * nb + 4 * (lane & 15);
#pragma unroll
            for (int j = 0; j < 8; ++j) { acc += __builtin_nontemporal_load((const f32x4*)(src + (size_t)(8 * j) * 1024)); acc += __builtin_nontemporal_load((const f32x4*)(src + (size_t)(8 * j + 1) * 1024)); } }
        else { bf16* WT = (bf16*)(p.ws + WS_OF) + (size_t)((e * 3 + w) % 16) * 1024 * 1024; const u32x4 v = {(unsigned)it, 1u, 2u, 3u};
#pragma unroll
            for (int i = 0; i < 8; ++i) { const int n = (lane >> 3) + 8 * i; *(u32x4*)(WT + (size_t)(64 * nb + n) * 1024 + 64 * kb + 8 * (lane & 7)) = v; } } }
    if (acc.x + acc.y + acc.z + acc.w == 1.2345e33f) ((float*)(p.ws + WS_OF))[otid()] = acc.x;
}
__device__ __forceinline__ void ph_gemm_in(const Prm& p, int l, LAS unsigned char* ldsb) {
    const bool even = (l & 1) == 0; const int N = even ? 4096 : 3072; const int M = (l <= 2) ? MT : ML;
    pg8::Gemm g{(const bf16*)(p.ws + WS_H), (const bf16*)(p.ws + WS_WIN), M, N, D};
    if (even) { pg8::StaticOrderT<4> S; S.init(M, N, (int)gridDim.x, obid(), ML); pg8::EpiBf16 E{(bf16*)(p.ws + WS_PROJ), N}; pg8::gemm_phase<pg8::EpiBf16, pg8::StaticOrderT<4>, true, true>(ldsb, g, S, E); }
    else { pg8::StaticOrderT<2> S; S.init(M, N, (int)gridDim.x, obid(), ML); pg8::EpiConvIn E{(bf16*)(p.ws + WS_PROJ)}; pg8::gemm_phase<pg8::EpiConvIn, pg8::StaticOrderT<2>, true, true>(ldsb, g, S, E); }
}
__device__ __forceinline__ void ph_gemm_out(const Prm& p, int l, LAS unsigned char* ldsb) {
    const int M = ML;
    pg8::Gemm g{(const bf16*)(p.ws + WS_MIX), (const bf16*)(p.ws + WS_WOUT), M, D, D}; pg8::StaticOrder S; S.init(M, D, (int)gridDim.x, obid());
    pg8::EpiGY E{(bf16*)(p.ws + WS_H), (const float*)(p.ws + WS_MODV) + (size_t)l * 5 * 6144 + 2 * 1024, ML};
    pg8::gemm_phase<pg8::EpiGY, pg8::StaticOrder, true, true>(ldsb, g, S, E);
}
__device__ __forceinline__ void ph_expert_up(const Prm& p, int l, LAS unsigned char* ldsb) {
    pg8::Gemm g{(const bf16*)(p.ws + WS_H2), (const bf16*)(p.ws + WS_WUP), NE * XR, NE * 2048, D};
    pg8::GroupOrderT<8, 0> S; S.init((l < 2) ? 9 : 8, NE, (int)gridDim.x, vcu_id());
    pg8::EpiSwiglu E{(bf16*)(p.ws + WS_ACT), 8};
    pg8::GatherA AO{(const int*)(p.ws + WS_SEL), XR, 9, (l < 2) ? 2176 : 2048};
    pg8::gemm_phase<pg8::EpiSwiglu, pg8::GroupOrderT<8, 0>, true, true, pg8::GatherA>(ldsb, g, S, E, AO);
}
__device__ __forceinline__ void ph_expert_down(const Prm& p, int l, LAS unsigned char* ldsb) {
    pg8::Gemm g{(const bf16*)(p.ws + WS_ACT), (const bf16*)(p.ws + WS_WDN), NE * XR, NE * 1024, FF};
    pg8::GroupOrderT<4, 1> S; S.init((l < 2) ? 9 : 8, NE, (int)gridDim.x, vcu_id());
    pg8::EpiDown E{(bf16*)(p.ws + WS_YE), (const float*)(p.ws + WS_GATE), 4};
    pg8::gemm_phase<pg8::EpiDown, pg8::GroupOrderT<4, 1>, true, true>(ldsb, g, S, E);
}

__device__ __forceinline__ void ph_qkprep(const Prm& p, int l) {
    const int e = l / 2; bf16* PROJ = (bf16*)(p.ws + WS_PROJ); const float* rope = (const float*)(p.ws + WS_ROPE);
    const int NQK0 = gridDim.x == 256 ? 64 : 0;
    if (obid() < NQK0) return;
    const int j = otid() & 7, ngrp = ((int)gridDim.x - NQK0) * (NTHREADS / 8);
    const float* kg = p.kn_g + e * 64;
    const f32x4 g0 = *(const f32x4*)(kg + 8 * j), g1 = *(const f32x4*)(kg + 8 * j + 4);
    const float gg[8] = {g0.x, g0.y, g0.z, g0.w, g1.x, g1.y, g1.z, g1.w};
    const int total = MT * 8;
    for (int g = ((obid() - NQK0) * NTHREADS + otid()) >> 3; g < total; g += ngrp) {
        const int r = g >> 3, hm = g & 7;
        bf16* ptr = PROJ + (size_t)r * 4096 + 2560 + 512 + hm * 64 + 8 * j;
        const u32x4 w = *(const u32x4*)ptr; const unsigned ww[4] = {w.x, w.y, w.z, w.w};
        float v[8];
#pragma unroll
        for (int m = 0; m < 4; ++m) { v[2 * m] = __uint_as_float(ww[m] << 16); v[2 * m + 1] = __uint_as_float(ww[m] & 0xffff0000u); }
        float s = 0.f;
#pragma unroll
        for (int m = 0; m < 8; ++m) s += v[m] * v[m];
        s += __shfl_xor(s, 1); s += __shfl_xor(s, 2); s += __shfl_xor(s, 4);
        const float rstd = rsqrtf(s * (1.f / 64.f) + EPS);
#pragma unroll
        for (int m = 0; m < 8; ++m) v[m] *= rstd * gg[m];
        if (r < ML) { const int t = r & 4095, pos = (j & 4) ? (t & 63) : (t >> 6);
            const float* rp = rope + (pos * 16 + 8 * (j & 1)) * 2; const f32x4 c0 = *(const f32x4*)rp, c1 = *(const f32x4*)(rp + 4), c2 = *(const f32x4*)(rp + 8), c3 = *(const f32x4*)(rp + 12);
            const float cs[16] = {c0.x, c0.y, c0.z, c0.w, c1.x, c1.y, c1.z, c1.w, c2.x, c2.y, c2.z, c2.w, c3.x, c3.y, c3.z, c3.w};
            const float sg = (j & 2) ? 1.f : -1.f;
#pragma unroll
            for (int m = 0; m < 8; ++m) { const float pv = __shfl_xor(v[m], 2); v[m] = v[m] * cs[2 * m] + sg * pv * cs[2 * m + 1]; } }
        *(u32x4*)ptr = (u32x4){cvtpk_(v[0], v[1]), cvtpk_(v[2], v[3]), cvtpk_(v[4], v[5]), cvtpk_(v[6], v[7])};
    }
}

__device__ __forceinline__ void ph_hgrn_naive(const Prm& p, int l, LAS float* lds) {
    const int ev = l / 2; const bf16* PROJ = (const bf16*)(p.ws + WS_PROJ); float* OF = (float*)(p.ws + WS_OF);
    const int tid = otid(), el = tid >> 4, dg = tid & 15;
    LAS float* sq = lds;
    LAS float* sk = lds + 64 * 128;
    LAS float* sf = lds + 2 * 64 * 128;
    LAS float* sv = lds + 3 * 64 * 128;
    for (int it = obid(); it < 128; it += gridDim.x) {
        const int b = it >> 5, h = (it >> 3) & 3, dir = (it >> 2) & 1, eq = it & 3;
        float S[8];
#pragma unroll
        for (int j = 0; j < 8; ++j) S[j] = 0.f;
        for (int c0 = 0; c0 < (TC + T) / 64; ++c0) {
            const bool isc = c0 < 4; const int step0 = isc ? c0 * 64 : (c0 - 4) * 64; const int len = isc ? TC : T; const int rbase = isc ? ML + b * TC : b * T;
            __syncthreads();
            for (int i = tid; i < 64 * 128; i += NTHREADS) { const int s = i >> 7, d = i & 127; const int tt = dir ? (len - 1 - (step0 + s)) : (step0 + s);
                const bf16* row = PROJ + (size_t)(rbase + tt) * 4096; const int col = h * 128 + d;
                float lb = 0.f;
                if (ev == 1) { const float l0 = p.hgrn_lb[(0 * 2 + dir) * 512 + col], l1 = p.hgrn_lb[(1 * 2 + dir) * 512 + col]; lb = 1.f / (1.f + __expf(l0 - l1)); }
                const float z = bf2f(row[512 + dir * 512 + col]); const float sg = sigmoidf_(z);
                const float f = lb + (1.f - lb) * sg;
                sq[i] = bf2f(row[col]); sf[i] = f; sk[i] = 1.f - f; }
            for (int i = tid; i < 64 * 32; i += NTHREADS) { const int s = i >> 5, e2 = i & 31; const int tt = dir ? (len - 1 - (step0 + s)) : (step0 + s);
                sv[i] = bf2f(PROJ[(size_t)(rbase + tt) * 4096 + 1536 + h * 128 + eq * 32 + e2]); }
            __syncthreads();
#pragma unroll 1
            for (int s = 0; s < 64; ++s) {
                const f32x4 q0 = *(const LAS f32x4*)(sq + s * 128 + dg * 8), q1 = *(const LAS f32x4*)(sq + s * 128 + dg * 8 + 4);
                const f32x4 k0 = *(const LAS f32x4*)(sk + s * 128 + dg * 8), k1 = *(const LAS f32x4*)(sk + s * 128 + dg * 8 + 4);
                const f32x4 f0 = *(const LAS f32x4*)(sf + s * 128 + dg * 8), f1 = *(const LAS f32x4*)(sf + s * 128 + dg * 8 + 4);
                const float v = sv[s * 32 + el];
                S[0] = f0.x * S[0] + k0.x * v; S[1] = f0.y * S[1] + k0.y * v; S[2] = f0.z * S[2] + k0.z * v; S[3] = f0.w * S[3] + k0.w * v;
                S[4] = f1.x * S[4] + k1.x * v; S[5] = f1.y * S[5] + k1.y * v; S[6] = f1.z * S[6] + k1.z * v; S[7] = f1.w * S[7] + k1.w * v;
                float o = q0.x * S[0] + q0.y * S[1] + q0.z * S[2] + q0.w * S[3] + q1.x * S[4] + q1.y * S[5] + q1.z * S[6] + q1.w * S[7];
                o += __shfl_xor(o, 1); o += __shfl_xor(o, 2); o += __shfl_xor(o, 4); o += __shfl_xor(o, 8);
                if (dg == 0) { const int tt = dir ? (len - 1 - (step0 + s)) : (step0 + s); OF[((size_t)dir * MT + rbase + tt) * 512 + h * 128 + eq * 32 + el] = o; }
            }
        }
        __syncthreads();
    }
}
__device__ __forceinline__ void ph_hgrn_readout(const Prm& p, int l) {
    const int ev = l / 2; const bf16* PROJ = (const bf16*)(p.ws + WS_PROJ); const float* OF = (const float*)(p.ws + WS_OF); bf16* MIX = (bf16*)(p.ws + WS_MIX);
    const int lane = otid() & 63, gw = obid() * 8 + (otid() >> 6), ngw = gridDim.x * 8;
    const int nrows = (l < 2) ? MT : ML;
    for (int g = gw; g < nrows * 4; g += ngw) { const int r = g >> 2, h = g & 3;
        const float o0 = OF[(size_t)r * 512 + h * 128 + lane] + OF[((size_t)MT + r) * 512 + h * 128 + lane];
        const float o1 = OF[(size_t)r * 512 + h * 128 + 64 + lane] + OF[((size_t)MT + r) * 512 + h * 128 + 64 + lane];
        const float rstd = rsqrtf(wave_sum(o0 * o0 + o1 * o1) * (1.f / 128.f) + EPS);
        const float g0 = p.hgrn_g[(ev * 4 + h) * 128 + lane], g1 = p.hgrn_g[(ev * 4 + h) * 128 + 64 + lane];
        const float ga0 = bf2f(PROJ[(size_t)r * 4096 + 2048 + h * 128 + lane]), ga1 = bf2f(PROJ[(size_t)r * 4096 + 2048 + h * 128 + 64 + lane]);
        MIX[(size_t)r * D + h * 128 + lane] = f2bf(o0 * rstd * g0 * siluf_(ga0)); MIX[(size_t)r * D + h * 128 + 64 + lane] = f2bf(o1 * rstd * g1 * siluf_(ga1)); }
}

namespace dat {
using bf16x8 = __attribute__((ext_vector_type(8))) short;
using s16x4  = __attribute__((ext_vector_type(4))) short;
using f32x16 = __attribute__((ext_vector_type(16))) float;
constexpr int SHM_V = 64 * 128 * 2, SHM_K = 64 * 128 * 2;
#define DKSWZ(row, colB) ((row) * 256 + ((colB) ^ (((row) & 7) << 4)))
__device__ __forceinline__ int crow(int r, int hi) { return (r & 3) + 8 * (r >> 2) + 4 * hi; }
__device__ __forceinline__ unsigned cvtpk(float lo, float hi) { unsigned r; asm volatile("v_cvt_pk_bf16_f32 %0, %1, %2" : "=v"(r) : "v"(lo), "v"(hi)); return r; }
__device__ __forceinline__ int v_st(int k, int c) { const int kk = (k & ~0xC) | ((k & 4) << 1) | ((k & 8) >> 1); return ((kk >> 3) * 4 + (c >> 5)) * 512 + ((kk & 7) * 32 + (c & 31)) * 2; }
__device__ __forceinline__ int v_rd_base(int lane) { return ((lane & 3) << 3) | (((lane >> 2) & 3) << 6) | (((lane >> 4) & 1) << 5) | (((lane >> 5) & 1) << 8); }
constexpr int v_rd_off(int d0, int ks, int half) { return d0 * 512 + ks * 4096 + half * 2048; }
template <int OFF> __device__ __forceinline__ s16x4 tr_read(int vb) { s16x4 r; asm volatile("ds_read_b64_tr_b16 %0, %1 offset:%2" : "=&v"(r) : "v"(vb), "i"(OFF) : "memory"); return r; }
template <int VAR> __device__ __forceinline__ void softmax_pack(f32x16& p0, f32x16& p1, float negb, float& l, bf16x8& pa0, bf16x8& pa1, bf16x8& pa2, bf16x8& pa3) {
    if (VAR == 5) {
#pragma unroll
    for (int r = 0; r < 16; ++r) { p0[r] = __builtin_amdgcn_exp2f(p0[r]); p1[r] = __builtin_amdgcn_exp2f(p1[r]); } }
    else if (VAR != 1) {
#pragma unroll
    for (int r = 0; r < 16; ++r) { p0[r] = __builtin_amdgcn_exp2f(p0[r] + negb); p1[r] = __builtin_amdgcn_exp2f(p1[r] + negb); } }
    float ps = 0.f;
#pragma unroll
    for (int r = 0; r < 16; ++r) ps += p0[r] + p1[r];
    { auto rr = __builtin_amdgcn_permlane32_swap(__float_as_uint(ps), __float_as_uint(ps), false, false); ps = __uint_as_float(rr[0]) + __uint_as_float(rr[1]); }
    l += ps;
#define DPK4(P, BASE, OUT) do { unsigned a0 = cvtpk(P[BASE + 0], P[BASE + 1]), a1 = cvtpk(P[BASE + 2], P[BASE + 3]);   \
    unsigned b0 = cvtpk(P[BASE + 4], P[BASE + 5]), b1 = cvtpk(P[BASE + 6], P[BASE + 7]);                              \
    auto r0 = __builtin_amdgcn_permlane32_swap(a0, b0, false, false); auto r1 = __builtin_amdgcn_permlane32_swap(a1, b1, false, false); \
    u32x4 w = {r0[0], r1[0], r0[1], r1[1]}; OUT = *reinterpret_cast<bf16x8*>(&w); } while (0)
    DPK4(p0, 0, pa0); DPK4(p0, 8, pa1); DPK4(p1, 0, pa2); DPK4(p1, 8, pa3);
#undef DPK4
}
template <int D0> __device__ __forceinline__ void pv_one(f32x16& oa, int vb, const bf16x8 (&pa)[4]) {
    const s16x4 l0 = tr_read<v_rd_off(D0, 0, 0)>(vb), h0 = tr_read<v_rd_off(D0, 0, 1)>(vb), l1 = tr_read<v_rd_off(D0, 1, 0)>(vb), h1 = tr_read<v_rd_off(D0, 1, 1)>(vb);
    const s16x4 l2 = tr_read<v_rd_off(D0, 2, 0)>(vb), h2 = tr_read<v_rd_off(D0, 2, 1)>(vb), l3 = tr_read<v_rd_off(D0, 3, 0)>(vb), h3 = tr_read<v_rd_off(D0, 3, 1)>(vb);
    asm volatile("s_waitcnt lgkmcnt(0)" ::: "memory"); __builtin_amdgcn_sched_barrier(0);
#define DPK1(L, H) (bf16x8){L[0], L[1], L[2], L[3], H[0], H[1], H[2], H[3]}
    oa = __builtin_amdgcn_mfma_f32_32x32x16_bf16(pa[0], DPK1(l0, h0), oa, 0, 0, 0);
    oa = __builtin_amdgcn_mfma_f32_32x32x16_bf16(pa[1], DPK1(l1, h1), oa, 0, 0, 0);
    oa = __builtin_amdgcn_mfma_f32_32x32x16_bf16(pa[2], DPK1(l2, h2), oa, 0, 0, 0);
    oa = __builtin_amdgcn_mfma_f32_32x32x16_bf16(pa[3], DPK1(l3, h3), oa, 0, 0, 0);
#undef DPK1
}
#define DPK(L, H) (bf16x8){L[0], L[1], L[2], L[3], H[0], H[1], H[2], H[3]}
#define DVRD(KS, l0, h0, l1, h1, l2, h2, l3, h3) do { l0 = tr_read<v_rd_off(0, KS, 0)>(vb); h0 = tr_read<v_rd_off(0, KS, 1)>(vb); l1 = tr_read<v_rd_off(1, KS, 0)>(vb); h1 = tr_read<v_rd_off(1, KS, 1)>(vb); \
        l2 = tr_read<v_rd_off(2, KS, 0)>(vb); h2 = tr_read<v_rd_off(2, KS, 1)>(vb); l3 = tr_read<v_rd_off(3, KS, 0)>(vb); h3 = tr_read<v_rd_off(3, KS, 1)>(vb); } while (0)
#define DVMM(KS, l0, h0, l1, h1, l2, h2, l3, h3) do { o[0] = __builtin_amdgcn_mfma_f32_32x32x16_bf16(pa[KS], DPK(l0, h0), o[0], 0, 0, 0); o[1] = __builtin_amdgcn_mfma_f32_32x32x16_bf16(pa[KS], DPK(l1, h1), o[1], 0, 0, 0); \
        o[2] = __builtin_amdgcn_mfma_f32_32x32x16_bf16(pa[KS], DPK(l2, h2), o[2], 0, 0, 0); o[3] = __builtin_amdgcn_mfma_f32_32x32x16_bf16(pa[KS], DPK(l3, h3), o[3], 0, 0, 0); } while (0)
__device__ __forceinline__ void pv_all(f32x16 (&o)[4], int vb, const bf16x8 (&pa)[4]) {
    s16x4 a0, a1, a2, a3, a4, a5, a6, a7, b0, b1, b2, b3, b4, b5, b6, b7;
    DVRD(0, a0, a1, a2, a3, a4, a5, a6, a7);
    DVRD(1, b0, b1, b2, b3, b4, b5, b6, b7);
    asm volatile("s_waitcnt lgkmcnt(8)" ::: "memory"); __builtin_amdgcn_sched_barrier(0);
    DVMM(0, a0, a1, a2, a3, a4, a5, a6, a7);
    __builtin_amdgcn_sched_barrier(0);
    DVRD(2, a0, a1, a2, a3, a4, a5, a6, a7);
    asm volatile("s_waitcnt lgkmcnt(8)" ::: "memory"); __builtin_amdgcn_sched_barrier(0);
    DVMM(1, b0, b1, b2, b3, b4, b5, b6, b7);
    __builtin_amdgcn_sched_barrier(0);
    DVRD(3, b0, b1, b2, b3, b4, b5, b6, b7);
    asm volatile("s_waitcnt lgkmcnt(8)" ::: "memory"); __builtin_amdgcn_sched_barrier(0);
    DVMM(2, a0, a1, a2, a3, a4, a5, a6, a7);
    asm volatile("s_waitcnt lgkmcnt(0)" ::: "memory"); __builtin_amdgcn_sched_barrier(0);
    DVMM(3, b0, b1, b2, b3, b4, b5, b6, b7);
}
#undef DVRD
#undef DVMM
#undef DPK
template <int VAR> __device__ __forceinline__ void unit(const bf16* __restrict__ PROJ, bf16* __restrict__ MIX, int qrow0, int b, int h, bool ctxq, LAS unsigned char* lds,
                                     float negb, float lam, float onem, const float* __restrict__ sg, const float* __restrict__ qg, const float* __restrict__ ropet) {
    const int tid = otid(), wid = __builtin_amdgcn_readfirstlane(tid >> 6), lane = tid & 63, r32 = lane & 31, hi = lane >> 5, rb = wid >> 1, mp = wid & 1;
    LAS unsigned char* V_lds = lds; LAS unsigned char* K_lds = lds + 4 * SHM_V;
    LAS float* wsf = (LAS float*)(lds + 4 * SHM_V + 3 * SHM_K) + wid * 32;
    f32x16 o[4];
#pragma unroll
    for (int d = 0; d < 4; ++d)
#pragma unroll
        for (int r = 0; r < 16; ++r) o[d][r] = 0.f;
    float l = 0.f; bf16x8 qr[4];
    { const bf16* Qw = PROJ + (size_t)(qrow0 + rb * 32 + r32) * 4096 + 2560 + h * 128 + mp * 64 + hi * 8;
      float q[4][8]; float ss = 0.f;
#pragma unroll
      for (int d = 0; d < 4; ++d) { const u32x4 w = *(const u32x4*)(Qw + d * 16); const unsigned ww[4] = {w.x, w.y, w.z, w.w};
#pragma unroll
          for (int k = 0; k < 4; ++k) { q[d][2 * k] = __uint_as_float(ww[k] << 16); q[d][2 * k + 1] = __uint_as_float(ww[k] & 0xffff0000u); ss += q[d][2 * k] * q[d][2 * k] + q[d][2 * k + 1] * q[d][2 * k + 1]; } }
      { auto rr = __builtin_amdgcn_permlane32_swap(__float_as_uint(ss), __float_as_uint(ss), false, false); ss = __uint_as_float(rr[0]) + __uint_as_float(rr[1]); }
      const float rstd = rsqrtf(ss * (1.f / 64.f) + EPS);
#pragma unroll
      for (int d = 0; d < 4; ++d)
#pragma unroll
          for (int j = 0; j < 8; ++j) q[d][j] *= rstd * qg[d * 16 + hi * 8 + j];
      if (!ctxq) { const int t = (qrow0 + rb * 32 + r32) & (T - 1), pr = t >> 6, pc = t & 63;
#pragma unroll
          for (int j = 0; j < 8; ++j) { const int i = hi * 8 + j; const float c0 = ropet[(pr * 16 + i) * 2], s0 = ropet[(pr * 16 + i) * 2 + 1], c1 = ropet[(pc * 16 + i) * 2], s1 = ropet[(pc * 16 + i) * 2 + 1];
              const float a0 = q[0][j] * c0 - q[1][j] * s0, a1 = q[1][j] * c0 + q[0][j] * s0, a2 = q[2][j] * c1 - q[3][j] * s1, a3 = q[3][j] * c1 + q[2][j] * s1; q[0][j] = a0; q[1][j] = a1; q[2][j] = a2; q[3][j] = a3; } }
      const float qs = 0.125f * 1.4426950408889634f;
#pragma unroll
      for (int d = 0; d < 4; ++d) { u32x4 w; w.x = cvtpk(q[d][0] * qs, q[d][1] * qs); w.y = cvtpk(q[d][2] * qs, q[d][3] * qs); w.z = cvtpk(q[d][4] * qs, q[d][5] * qs); w.w = cvtpk(q[d][6] * qs, q[d][7] * qs); qr[d] = *reinterpret_cast<bf16x8*>(&w); } }
    const int vb0 = (int)(uintptr_t)V_lds + v_rd_base(lane);
    const int NT = ctxq ? (TC / 64) : ((T + TC) / 64);
    const int rb_lat = b * T, rb_ctx = ML + b * TC;
    const int kb0 = (mp * 64 + hi * 8) * 2;
    unsigned ksrc[2], vsrc[2];
#pragma unroll
    for (int i = 0; i < 2; ++i) { const int G = wid * 128 + i * 64 + lane;
        { const int row = G >> 4, ch = (G & 15) ^ (row & 7); ksrc[i] = (unsigned)(row * 8192 + (3072 + h * 128) * 2 + ch * 16); }
        { const int sub = G >> 5, within = G & 31, kk = (sub >> 2) * 8 + (within >> 2), cg = (sub & 3) * 4 + (within & 3); const int k = (kk & ~0xC) | ((kk & 4) << 1) | ((kk & 8) >> 1);
          vsrc[i] = (unsigned)(k * 8192 + (3584 + h * 128) * 2 + cg * 16); } }
#define DROWB(t) ((t) * 64 < T || ctxq ? (ctxq ? rb_ctx + (t) * 64 : rb_lat + (t) * 64) : rb_ctx + ((t) * 64 - T))
#define DDMA(SRC, t, LBUF) do { const char* tb_ = (const char*)PROJ + (size_t)DROWB(t) * 8192; _Pragma("unroll") for (int i_ = 0; i_ < 2; ++i_) \
        __builtin_amdgcn_global_load_lds((const unsigned*)(tb_ + SRC[i_]), (LAS unsigned*)((LBUF) + wid * 2048 + i_ * 1024), 16, 0, 0); } while (0)
#define DQKT(P0, P1, Kt) do { _Pragma("unroll") for (int r = 0; r < 16; ++r) { P0[r] = 0.f; P1[r] = 0.f; } \
        _Pragma("unroll") for (int d = 0; d < 4; ++d) { const int cb = kb0 + d * 32; \
            const bf16x8 b0 = *(const LAS bf16x8*)((Kt) + DKSWZ(r32, cb)); const bf16x8 b1 = *(const LAS bf16x8*)((Kt) + DKSWZ(32 + r32, cb)); \
            P0 = __builtin_amdgcn_mfma_f32_32x32x16_bf16(b0, qr[d], P0, 0, 0, 0); P1 = __builtin_amdgcn_mfma_f32_32x32x16_bf16(b1, qr[d], P1, 0, 0, 0); } } while (0)
#define DBAR() do { asm volatile("s_waitcnt lgkmcnt(0)" ::: "memory"); __builtin_amdgcn_s_barrier(); asm volatile("" ::: "memory"); } while (0)
    const bool late = wid >= 4;
    __syncthreads();
    DDMA(ksrc, 0, K_lds); DDMA(vsrc, 0, V_lds); DDMA(ksrc, 1, K_lds + SHM_K); DDMA(vsrc, 1, V_lds + SHM_V); DDMA(ksrc, 2, K_lds + 2 * SHM_K);
    asm volatile("s_waitcnt vmcnt(0)" ::: "memory"); DBAR();
    f32x16 pA0, pA1, pB0, pB1; bf16x8 pa[4];
    DQKT(pA0, pA1, K_lds);
    DBAR();
#define DSTEP(PC0, PC1, PN0, PN1, t) do { \
        if ((t) + 3 < NT) DDMA(ksrc, (t) + 3, K_lds + ((t) % 3) * SHM_K); if ((t) + 2 < NT) DDMA(vsrc, (t) + 2, V_lds + (((t) + 2) & 3) * SHM_V); \
        if (late && (t) > 0) { const int vbp = vb0 + (((t) - 1) & 3) * SHM_V; pv_one<0>(o[0], vbp, pa); pv_one<1>(o[1], vbp, pa); pv_one<2>(o[2], vbp, pa); pv_one<3>(o[3], vbp, pa); } \
        if ((t) + 1 < NT) DQKT(PN0, PN1, K_lds + (((t) + 1) % 3) * SHM_K); \
        softmax_pack<VAR>(PC0, PC1, negb, l, pa[0], pa[1], pa[2], pa[3]); \
        if (!late) { const int vb = vb0 + ((t) & 3) * SHM_V; pv_one<0>(o[0], vb, pa); pv_one<1>(o[1], vb, pa); pv_one<2>(o[2], vb, pa); pv_one<3>(o[3], vb, pa); } \
        if ((t) + 3 < NT) asm volatile("s_waitcnt vmcnt(4)" ::: "memory"); else asm volatile("s_waitcnt vmcnt(0)" ::: "memory"); \
        DBAR(); } while (0)
    for (int t = 0; t < NT; t += 2) {
        DSTEP(pA0, pA1, pB0, pB1, t);
        DSTEP(pB0, pB1, pA0, pA1, t + 1);
    }
    if (late) { const int vbp = vb0 + ((NT - 1) & 3) * SHM_V; pv_one<0>(o[0], vbp, pa); pv_one<1>(o[1], vbp, pa); pv_one<2>(o[2], vbp, pa); pv_one<3>(o[3], vbp, pa); }
    __syncthreads();
#undef DSTEP
#undef DQKT
#undef DDMA
#undef DBAR
#undef DROWB
    if (hi == 0) wsf[r32] = l;
    asm volatile("s_waitcnt lgkmcnt(0)" ::: "memory");
    LAS float* xch = (LAS float*)lds + rb * (16 * 4 * 64);
    if (mp == 1) {
#pragma unroll
        for (int r = 0; r < 16; ++r) { const float i1 = lam * __builtin_amdgcn_rcpf(wsf[crow(r, hi)]);
#pragma unroll
            for (int d = 0; d < 4; ++d) xch[(r * 4 + d) * 64 + lane] = o[d][r] * i1; }
    }
    __syncthreads();
    if (mp == 0) {
        float g4[4];
#pragma unroll
        for (int d = 0; d < 4; ++d) g4[d] = sg[32 * d + r32] * onem;
        LAS unsigned char* ot = lds + 65536 + (size_t)(rb * 32) * 272;
#pragma unroll
        for (int r = 0; r < 16; ++r) { const int row = crow(r, hi); const float i0 = __builtin_amdgcn_rcpf(wsf[row]);
            float w[4], ss = 0.f;
#pragma unroll
            for (int d = 0; d < 4; ++d) { w[d] = o[d][r] * i0 - xch[(r * 4 + d) * 64 + lane]; ss += w[d] * w[d]; }
            ss += __shfl_xor(ss, 1); ss += __shfl_xor(ss, 2); ss += __shfl_xor(ss, 4); ss += __shfl_xor(ss, 8); ss += __shfl_xor(ss, 16);
            const float rstd = rsqrtf(ss * (1.f / 128.f) + EPS);
#pragma unroll
            for (int d = 0; d < 4; ++d) *(LAS bf16*)(ot + row * 272 + (32 * d + r32) * 2) = f2bf(w[d] * rstd * g4[d]); }
    }
    __syncthreads();
    {
        const int row = tid >> 2, cq = (tid & 3) * 64; const LAS unsigned char* sp = lds + 65536 + row * 272 + cq; bf16* dst = MIX + (size_t)(qrow0 + row) * D + 512 + h * 128 + cq / 2;
#pragma unroll
        for (int k = 0; k < 4; ++k) *(u32x4*)(dst + 8 * k) = *(const LAS u32x4*)(sp + 16 * k); }
}
}
template <int VAR> __device__ __forceinline__ void ph_attn(const Prm& p, int l, LAS unsigned char* ldsb) {
    const int ev = l / 2; const bf16* PROJ = (const bf16*)(p.ws + WS_PROJ); bf16* MIX = (bf16*)(p.ws + ((VAR == 0 || VAR == 5) ? WS_MIX : WS_OF));
    const float lam_init = 0.8f - 0.6f * __expf(-0.3f * (float)l);
    float d0 = 0.f, d1 = 0.f;
    for (int i = 0; i < 64; ++i) { d0 += p.dlam[(ev * 4 + 0) * 64 + i] * p.dlam[(ev * 4 + 1) * 64 + i]; d1 += p.dlam[(ev * 4 + 2) * 64 + i] * p.dlam[(ev * 4 + 3) * 64 + i]; }
    const float lam = __expf(d0) - __expf(d1) + lam_init;
    float gq = 0.f, gk = 0.f;
    for (int i = 0; i < 64; ++i) { gq = fmaxf(gq, fabsf(p.qn_g[ev * 64 + i])); gk = fmaxf(gk, fabsf(p.kn_g[ev * 64 + i])); }
    const float negb = -8.f * gq * gk * 1.4426950408889634f;
    const int vc = vcu_id();
    for (int u = vc; u < 512; u += gridDim.x) { const int v2 = (u < 256) ? u * 2 : (u - 256) * 2 + 1;
        const int b = v2 >> 7, h = (v2 >> 5) & 3, qb = v2 & 31;
        if (VAR == 5 && negb < -48.f) dat::unit<0>(PROJ, MIX, b * T + qb * 128, b, h, false, ldsb, negb, lam, 1.f - lam_init, p.subln_g + ev * 128, p.qn_g + ev * 64, (const float*)(p.ws + WS_ROPE));
        else dat::unit<VAR>(PROJ, MIX, b * T + qb * 128, b, h, false, ldsb, negb, lam, 1.f - lam_init, p.subln_g + ev * 128, p.qn_g + ev * 64, (const float*)(p.ws + WS_ROPE)); }
    if (l == 0) for (int u = vc; u < 32; u += gridDim.x) { const int b = u >> 3, h = (u >> 1) & 3, qb = u & 1;
        if (VAR == 5 && negb < -48.f) dat::unit<0>(PROJ, MIX, ML + b * TC + qb * 128, b, h, true, ldsb, negb, lam, 1.f - lam_init, p.subln_g + ev * 128, p.qn_g + ev * 64, (const float*)(p.ws + WS_ROPE));
        else dat::unit<VAR>(PROJ, MIX, ML + b * TC + qb * 128, b, h, true, ldsb, negb, lam, 1.f - lam_init, p.subln_g + ev * 128, p.qn_g + ev * 64, (const float*)(p.ws + WS_ROPE)); }
    __syncthreads();
}

namespace hg {
using bf16x8 = __attribute__((ext_vector_type(8))) short;
__device__ __forceinline__ int swz256(int row, int colB) { return row * 256 + (colB ^ ((row & 15) << 4)); }
__device__ __forceinline__ int swz128(int row, int colB) { return row * 128 + (colB ^ (((row >> 1) & 7) << 4)); }
constexpr int BFS = 132;
constexpr int L_BF = 0, L_TOT = 33792, L_LB = 35840, L_P = 0, L_RED = 8192, L_QP = 36864, L_KP = 53248, L_QT = 69632, L_VT = 86016, L_ST = 102400;
__device__ __forceinline__ float lbound(const float* lbl, int ev, int dir, int col) {
    if (ev == 0) return 0.f; const float l0 = lbl[(0 * 2 + dir) * 512 + col], l1 = lbl[(1 * 2 + dir) * 512 + col]; return 1.f / (1.f + __expf(l0 - l1)); }
__device__ __forceinline__ void pass1(const bf16* PROJ, const float* lbl, int ev, int dir, int h, int row0, LAS unsigned char* lds, int tid) {
    const int qt = tid >> 7, d = tid & 127; const float lb = lbound(lbl, ev, dir, h * 128 + d);
    LAS float* Bf = (LAS float*)(lds + L_BF); float run = 0.f;
    const bf16* zp = PROJ + (size_t)row0 * 4096 + 512 + dir * 512 + h * 128 + d;
    float zv[16];
#pragma unroll
    for (int i = 0; i < 16; ++i) { const int s = qt * 16 + i, tau = dir ? 63 - s : s; zv[i] = bf2f(zp[(size_t)tau * 4096]); }
#pragma unroll
    for (int i = 0; i < 16; ++i) { const float f = lb + (1.f - lb) * sigmoidf_(zv[i]); run += __logf(fmaxf(f, 1e-30f)); Bf[(qt * 16 + i) * BFS + d] = run; }
    ((LAS float*)(lds + L_TOT))[qt * 128 + d] = run; if (qt == 0) ((LAS float*)(lds + L_LB))[d] = lb;
}
__device__ __forceinline__ void decay4(const LAS unsigned char* lds, int s, int d0, f32x4& b, f32x4& bmid, f32x4& blast, f32x4& lb) {
    const LAS float* Bf = (const LAS float*)(lds + L_BF); const LAS float* tot = (const LAS float*)(lds + L_TOT);
    const f32x4 t0 = *(const LAS f32x4*)(tot + d0), t1 = *(const LAS f32x4*)(tot + 128 + d0), t2 = *(const LAS f32x4*)(tot + 256 + d0), t3 = *(const LAS f32x4*)(tot + 384 + d0);
    const int qt = s >> 4; f32x4 pre = (f32x4){0.f, 0.f, 0.f, 0.f}; if (qt >= 1) pre += t0; if (qt >= 2) pre += t1; if (qt >= 3) pre += t2;
    b = *(const LAS f32x4*)(Bf + s * BFS + d0) + pre; bmid = t0 + t1; blast = (t0 + t1) + (t2 + t3); lb = *(const LAS f32x4*)((const LAS float*)(lds + L_LB) + d0);
}
__device__ __forceinline__ void pass1_pre(const float (&zv)[16], float lb, LAS unsigned char* lds, int tb, int tid) {
    const int qt = tid >> 7, d = tid & 127; LAS float* Bf = (LAS float*)(lds + tb + L_BF); float run = 0.f;
#pragma unroll
    for (int i = 0; i < 16; ++i) { const float f = lb + (1.f - lb) * sigmoidf_(zv[i]); run += __logf(fmaxf(f, 1e-30f)); Bf[(qt * 16 + i) * BFS + d] = run; }
    ((LAS float*)(lds + tb + L_TOT))[qt * 128 + d] = run; if (qt == 0) ((LAS float*)(lds + tb + L_LB))[d] = lb;
}
__device__ __forceinline__ void decay4b(const LAS unsigned char* lds, int tb, int s, int d0, f32x4& b, f32x4& bmid, f32x4& lb) {
    const LAS float* Bf = (const LAS float*)(lds + tb + L_BF); const LAS float* tot = (const LAS float*)(lds + tb + L_TOT);
    const f32x4 t0 = *(const LAS f32x4*)(tot + d0), t1 = *(const LAS f32x4*)(tot + 128 + d0), t2 = *(const LAS f32x4*)(tot + 256 + d0);
    const int qt = s >> 4; f32x4 pre = (f32x4){0.f, 0.f, 0.f, 0.f}; if (qt >= 1) pre += t0; if (qt >= 2) pre += t1; if (qt >= 3) pre += t2;
    b = *(const LAS f32x4*)(Bf + s * BFS + d0) + pre; bmid = t0 + t1; lb = *(const LAS f32x4*)((const LAS float*)(lds + tb + L_LB) + d0);
}
__device__ __forceinline__ void stage_vt(const bf16* PROJ, int h, int row0, LAS unsigned char* lds, int tid) {
    const int tau = tid >> 3, e0 = (tid & 7) * 16; const bf16* vp = PROJ + (size_t)(row0 + tau) * 4096 + 1536 + h * 128 + e0;
    const u32x4 w0 = *(const u32x4*)vp, w1 = *(const u32x4*)(vp + 8); const unsigned ww[8] = {w0.x, w0.y, w0.z, w0.w, w1.x, w1.y, w1.z, w1.w};
#pragma unroll
    for (int i = 0; i < 8; ++i) { *(LAS bf16*)(lds + L_VT + swz128(e0 + 2 * i, tau * 2)) = (bf16)(ww[i] & 0xffffu); *(LAS bf16*)(lds + L_VT + swz128(e0 + 2 * i + 1, tau * 2)) = (bf16)(ww[i] >> 16); }
}
}
template <int LV> __device__ __forceinline__ void ph_hgrn_local(const Prm& p, int l, LAS unsigned char* lds) {
    constexpr int RS = 288, L_VR = hg::L_VT, L_KR = hg::L_QP;
    const int ev = l / 2; const bf16* PROJ = (const bf16*)(p.ws + WS_PROJ); bf16* DS = (bf16*)(p.ws + (LV == 0 ? WS_HDS : WS_XE)); float* G = (float*)(p.ws + (LV == 0 ? WS_HG : WS_OF));
    const int tid = otid(), lane = tid & 63, wv = tid >> 6;
    for (int it = obid(); it < HG_ITEMS; it += gridDim.x) {
        const int c = it % HG_NCH, chain = it / HG_NCH, dir = chain & 1, h = (chain >> 1) & 3, b = chain >> 3;
        const bool isc = c < 4; const int j = isc ? c : c - 4, nt = isc ? 4 : 64, tj = dir ? nt - 1 - j : j; const int row0 = isc ? ML + b * TC + tj * 64 : b * T + tj * 64;
        u32x4 zpre0, zpre1;
        { const int s_ = tid >> 3, tau_ = dir ? 63 - s_ : s_; const bf16* zp_ = PROJ + (size_t)(row0 + tau_) * 4096 + 512 + dir * 512 + h * 128 + (tid & 7) * 16; zpre0 = *(const u32x4*)zp_; zpre1 = *(const u32x4*)(zp_ + 8); }
        float zv[16]; u32x4 vw0, vw1;
        { const int qt = tid >> 7, d = tid & 127; const bf16* zc = PROJ + (size_t)(row0 + (dir ? 63 - qt * 16 : qt * 16)) * 4096 + 512 + dir * 512 + h * 128 + d;
#pragma unroll
          for (int i = 0; i < 16; ++i) zv[i] = bf2f(dir ? *(zc - (size_t)i * 4096) : zc[(size_t)i * 4096]);
          const bf16* vp = PROJ + (size_t)(row0 + (tid >> 3)) * 4096 + 1536 + h * 128 + (tid & 7) * 16; vw0 = *(const u32x4*)vp; vw1 = *(const u32x4*)(vp + 8); }
        const float lbt = hg::lbound(p.hgrn_lb, ev, dir, h * 128 + (tid & 127));
        __syncthreads();
        hg::pass1_pre(zv, lbt, lds, 0, tid);
        { LAS unsigned char* vr = lds + L_VR + (tid >> 3) * RS + (tid & 7) * 32; *(LAS u32x4*)vr = vw0; *(LAS u32x4*)(vr + 16) = vw1; }
        __syncthreads();
        {
            const int s = tid >> 3, dg = (tid & 7) * 16, tau = dir ? 63 - s : s;
            const unsigned zz[8] = {zpre0.x, zpre0.y, zpre0.z, zpre0.w, zpre1.x, zpre1.y, zpre1.z, zpre1.w}; float kh[16];
#pragma unroll
            for (int g4 = 0; g4 < 4; ++g4) { f32x4 bb, bm, bl, lb; hg::decay4(lds, s, dg + g4 * 4, bb, bm, bl, lb);
#pragma unroll
                for (int i = 0; i < 4; ++i) { const int k = g4 * 4 + i, d = dg + k; const float z = (k & 1) ? __uint_as_float(zz[k >> 1] & 0xffff0000u) : __uint_as_float(zz[k >> 1] << 16);
                    const float f = lb[i] + (1.f - lb[i]) * sigmoidf_(z);
                    kh[k] = (1.f - f) * __expf(bl[i] - bb[i]);
                    if (s == 0) G[(size_t)it * 128 + d] = __expf(bl[i]); } }
            LAS unsigned char* kr = lds + L_KR + tau * RS + dg * 2;
            *(LAS u32x4*)kr = (u32x4){dat::cvtpk(kh[0], kh[1]), dat::cvtpk(kh[2], kh[3]), dat::cvtpk(kh[4], kh[5]), dat::cvtpk(kh[6], kh[7])};
            *(LAS u32x4*)(kr + 16) = (u32x4){dat::cvtpk(kh[8], kh[9]), dat::cvtpk(kh[10], kh[11]), dat::cvtpk(kh[12], kh[13]), dat::cvtpk(kh[14], kh[15])};
        }
        __syncthreads();
        {
            f32x4 acc[8];
#pragma unroll
            for (int db = 0; db < 8; ++db) acc[db] = (f32x4){0.f, 0.f, 0.f, 0.f};
            const int r16 = lane & 15, q4 = lane >> 4;
            const int trb = (q4 * 8 + (r16 >> 2)) * RS + (r16 & 3) * 8;
#pragma unroll
            for (int ks = 0; ks < 2; ++ks) { const int kb = trb + ks * 32 * RS;
                dat::s16x4 al, ah, bl_[8], bh_[8];
                { const int ad = (int)(uintptr_t)(lds + L_VR) + kb + wv * 32; asm volatile("ds_read_b64_tr_b16 %0, %1" : "=&v"(al) : "v"(ad) : "memory"); asm volatile("ds_read_b64_tr_b16 %0, %1 offset:1152" : "=&v"(ah) : "v"(ad) : "memory"); }
#pragma unroll
                for (int db = 0; db < 8; ++db) { const int ad = (int)(uintptr_t)(lds + L_KR) + kb + db * 32; asm volatile("ds_read_b64_tr_b16 %0, %1" : "=&v"(bl_[db]) : "v"(ad) : "memory"); asm volatile("ds_read_b64_tr_b16 %0, %1 offset:1152" : "=&v"(bh_[db]) : "v"(ad) : "memory"); }
                asm volatile("s_waitcnt lgkmcnt(0)" ::: "memory"); __builtin_amdgcn_sched_barrier(0);
                const hg::bf16x8 a = (hg::bf16x8){al[0], al[1], al[2], al[3], ah[0], ah[1], ah[2], ah[3]};
#pragma unroll
                for (int db = 0; db < 8; ++db) { const hg::bf16x8 bb = (hg::bf16x8){bl_[db][0], bl_[db][1], bl_[db][2], bl_[db][3], bh_[db][0], bh_[db][1], bh_[db][2], bh_[db][3]};
                    acc[db] = __builtin_amdgcn_mfma_f32_16x16x32_bf16(a, bb, acc[db], 0, 0, 0); } }
            bf16* dst = DS + (size_t)it * 16384;
#pragma unroll
            for (int db = 0; db < 8; ++db)
#pragma unroll
                for (int jj = 0; jj < 4; ++jj) dst[(wv * 16 + q4 * 4 + jj) * 128 + db * 16 + r16] = f2bf(acc[db][jj]);
        }
    }
    __syncthreads();
}
__device__ __forceinline__ void ph_hgrn_scan(const Prm& p) {
    const bf16* DS = (const bf16*)(p.ws + WS_HDS); bf16* ST = (bf16*)(p.ws + WS_HST); const float* G = (const float*)(p.ws + WS_HG);
    for (int gt = obid() * NTHREADS + otid(); gt < 32 * 128 * 32; gt += gridDim.x * NTHREADS) {
        const int chain = gt >> 12, rem = gt & 4095; const size_t eo = (size_t)(rem >> 5) * 128 + (rem & 31) * 4; const int dq = (rem & 31) * 4;
        float s0 = 0.f, s1 = 0.f, s2 = 0.f, s3 = 0.f;
#pragma unroll 4
        for (int c = 0; c < HG_NCH; ++c) { const size_t it = (size_t)chain * HG_NCH + c;
            const u32x2 dv = *(const u32x2*)(DS + it * 16384 + eo); const f32x4 g = *(const f32x4*)(G + it * 128 + dq);
            u32x2 o; o.x = pk2(s0, s1); o.y = pk2(s2, s3); *(u32x2*)(ST + it * 16384 + eo) = o;
            s0 = g.x * s0 + __uint_as_float(dv.x << 16); s1 = g.y * s1 + __uint_as_float(dv.x & 0xffff0000u); s2 = g.z * s2 + __uint_as_float(dv.y << 16); s3 = g.w * s3 + __uint_as_float(dv.y & 0xffff0000u); }
    }
}
template <int HV> __device__ __forceinline__ void ph_hgrn_out(const Prm& p, int l, LAS unsigned char* lds) {
    constexpr int L_P2 = hg::L_ST + 36864;
    constexpr int L_RED2 = L_P2;
    static_assert(L_P2 + 8192 <= LDS_BYTES - 256, "hgrn_out LDS map");
    const int ev = l / 2; const bf16* PROJ = (const bf16*)(p.ws + WS_PROJ); const bf16* ST = (const bf16*)(p.ws + WS_HST); bf16* MIX = (bf16*)(p.ws + (HV == 0 ? WS_MIX : WS_OF));
    const int tid = otid(), lane = tid & 63, wv = tid >> 6, r16 = lane & 15, q4 = lane >> 4;
    const int tt0 = (l < 2) ? 0 : 4;
    const int nitems = 16 * (HG_NCH - tt0);
    const bool bal = gridDim.x == 256 && nitems == 1088;
    for (int k = 0;; ++k) { int it = obid() + k * (int)gridDim.x;
        if (bal && k == 4) { const int m8 = obid() & 7; if (m8 != 1 && m8 != 2) break; it = 1024 + (obid() >> 3) + 32 * (m8 - 1); }
        if (it >= nitems) break;
        const int tt = tt0 + it % (HG_NCH - tt0), bh = it / (HG_NCH - tt0), h = bh & 3, b = bh >> 2;
        const bool isc = tt < 4; const int tj = isc ? tt : tt - 4, nt = isc ? 4 : 64; const int row0 = isc ? ML + b * TC + tj * 64 : b * T + tj * 64;
        const int s2 = tid >> 3, dg = (tid & 7) * 16;
        u32x4 zq[2][2], qq[2][2]; float zv[2][16]; hg::bf16x8 sfr[2][4]; float lbv[2];
        const u32x4 vw0 = *(const u32x4*)(PROJ + (size_t)(row0 + s2) * 4096 + 1536 + h * 128 + dg), vw1 = *(const u32x4*)(PROJ + (size_t)(row0 + s2) * 4096 + 1536 + h * 128 + dg + 8);
#pragma unroll
        for (int dir = 0; dir < 2; ++dir) { const int tau = dir ? 63 - s2 : s2; const bf16* rp = PROJ + (size_t)(row0 + tau) * 4096 + h * 128 + dg;
            zq[dir][0] = *(const u32x4*)(rp + 512 + dir * 512); zq[dir][1] = *(const u32x4*)(rp + 512 + dir * 512 + 8); qq[dir][0] = *(const u32x4*)rp; qq[dir][1] = *(const u32x4*)(rp + 8);
            lbv[dir] = hg::lbound(p.hgrn_lb, ev, dir, h * 128 + (tid & 127));
            const int c = (isc ? 0 : 4) + (dir ? nt - 1 - tj : tj); const bf16* sp = ST + (size_t)(((b * 4 + h) * 2 + dir) * HG_NCH + c) * 16384 + (wv * 16 + r16) * 128 + q4 * 8;
#pragma unroll
            for (int ks = 0; ks < 4; ++ks) sfr[dir][ks] = *(const hg::bf16x8*)(sp + ks * 32); }
        f32x4 o[4];
#pragma unroll
        for (int i = 0; i < 4; ++i) o[i] = (f32x4){0.f, 0.f, 0.f, 0.f};
        { const int qt = tid >> 7, d = tid & 127; const bf16* zp = PROJ + (size_t)(row0 + qt * 16) * 4096 + 512 + h * 128 + d;
#pragma unroll
          for (int i = 0; i < 16; ++i) zv[0][i] = bf2f(zp[(size_t)i * 4096]); }
        __syncthreads();
        { const unsigned ww[8] = {vw0.x, vw0.y, vw0.z, vw0.w, vw1.x, vw1.y, vw1.z, vw1.w};
#pragma unroll
          for (int i = 0; i < 8; ++i) { *(LAS bf16*)(lds + hg::L_VT + hg::swz128(dg + 2 * i, s2 * 2)) = (bf16)(ww[i] & 0xffffu); *(LAS bf16*)(lds + hg::L_VT + hg::swz128(dg + 2 * i + 1, s2 * 2)) = (bf16)(ww[i] >> 16); } }
#pragma unroll
        for (int dir = 0; dir < 2; ++dir) {
            const int qt = tid >> 7, d = tid & 127; const bf16* zp = PROJ + (size_t)(row0 + (dir ? 63 - qt * 16 : qt * 16)) * 4096 + 512 + dir * 512 + h * 128 + d;
            if (dir) {
#pragma unroll
                for (int i = 0; i < 16; ++i) zv[1][i] = bf2f(*(zp - (size_t)i * 4096)); }
            hg::pass1_pre(zv[dir], lbv[dir], lds, dir ? hg::L_ST : 0, tid);
            __builtin_amdgcn_sched_barrier(0); }
        __syncthreads();
        const u32x4 gw0 = *(const u32x4*)(PROJ + (size_t)(row0 + s2) * 4096 + 2048 + h * 128 + dg), gw1 = *(const u32x4*)(PROJ + (size_t)(row0 + s2) * 4096 + 2048 + h * 128 + dg + 8);
#pragma unroll
        for (int dir = 0; dir < 2; ++dir) { const int tb = dir ? hg::L_ST : 0;
            if (HV != 2) {
                const int tau = dir ? 63 - s2 : s2;
                const unsigned zz[8] = {zq[dir][0].x, zq[dir][0].y, zq[dir][0].z, zq[dir][0].w, zq[dir][1].x, zq[dir][1].y, zq[dir][1].z, zq[dir][1].w};
                const unsigned qv[8] = {qq[dir][0].x, qq[dir][0].y, qq[dir][0].z, qq[dir][0].w, qq[dir][1].x, qq[dir][1].y, qq[dir][1].z, qq[dir][1].w};
#pragma unroll
                for (int jj = 0; jj < 2; ++jj) { const int d0 = dg + jj * 8; float qp[8], kp[8], qt[8];
#pragma unroll
                    for (int g4 = 0; g4 < 2; ++g4) { f32x4 bb, bm, lb; hg::decay4b(lds, tb, s2, d0 + g4 * 4, bb, bm, lb);
#pragma unroll
                        for (int i = 0; i < 4; ++i) { const int k = jj * 8 + g4 * 4 + i; const float z = (k & 1) ? __uint_as_float(zz[k >> 1] & 0xffff0000u) : __uint_as_float(zz[k >> 1] << 16);
                            const float qf = (k & 1) ? __uint_as_float(qv[k >> 1] & 0xffff0000u) : __uint_as_float(qv[k >> 1] << 16);
                            const float f = lb[i] + (1.f - lb[i]) * sigmoidf_(z); const float rel = bb[i] - bm[i];
                            qp[g4 * 4 + i] = qf * __expf(fminf(rel, 80.f)); kp[g4 * 4 + i] = (1.f - f) * __expf(fminf(-rel, 80.f)); qt[g4 * 4 + i] = qf * __expf(bb[i]); } }
                    u32x4 w; w.x = dat::cvtpk(qp[0], qp[1]); w.y = dat::cvtpk(qp[2], qp[3]); w.z = dat::cvtpk(qp[4], qp[5]); w.w = dat::cvtpk(qp[6], qp[7]); *(LAS u32x4*)(lds + hg::L_QP + hg::swz256(tau, d0 * 2)) = w;
                    w.x = dat::cvtpk(kp[0], kp[1]); w.y = dat::cvtpk(kp[2], kp[3]); w.z = dat::cvtpk(kp[4], kp[5]); w.w = dat::cvtpk(kp[6], kp[7]); *(LAS u32x4*)(lds + hg::L_KP + hg::swz256(tau, d0 * 2)) = w;
                    w.x = dat::cvtpk(qt[0], qt[1]); w.y = dat::cvtpk(qt[2], qt[3]); w.z = dat::cvtpk(qt[4], qt[5]); w.w = dat::cvtpk(qt[6], qt[7]); *(LAS u32x4*)(lds + hg::L_QT + hg::swz256(tau, d0 * 2)) = w; }
            }
            __syncthreads();
            if (HV != 3) {
#pragma unroll
                for (int k2 = 0; k2 < 2; ++k2) { const int bi = wv * 2 + k2, rbk = bi >> 2, cbk = bi & 3; f32x4 acc = (f32x4){0.f, 0.f, 0.f, 0.f};
#pragma unroll
                    for (int ks = 0; ks < 4; ++ks) { const int cb = (ks * 32 + q4 * 8) * 2;
                        const hg::bf16x8 a = *(const LAS hg::bf16x8*)(lds + hg::L_QP + hg::swz256(rbk * 16 + r16, cb)); const hg::bf16x8 bb = *(const LAS hg::bf16x8*)(lds + hg::L_KP + hg::swz256(cbk * 16 + r16, cb));
                        acc = __builtin_amdgcn_mfma_f32_16x16x32_bf16(a, bb, acc, 0, 0, 0); }
                    const int tcol = cbk * 16 + r16;
#pragma unroll
                    for (int jj = 0; jj < 4; ++jj) { const int trow = rbk * 16 + q4 * 4 + jj; const bool keep = dir ? (tcol >= trow) : (tcol <= trow);
                        *(LAS bf16*)(lds + L_P2 + hg::swz128(trow, tcol * 2)) = keep ? f2bf(acc[jj]) : (bf16)0; } }
            }
            __syncthreads();
            if (HV != 3) {
#pragma unroll
                for (int ks = 0; ks < 2; ++ks) { const int cb = (ks * 32 + q4 * 8) * 2; const hg::bf16x8 bb = *(const LAS hg::bf16x8*)(lds + hg::L_VT + hg::swz128(wv * 16 + r16, cb));
#pragma unroll
                    for (int rbk = 0; rbk < 4; ++rbk) { const hg::bf16x8 a = *(const LAS hg::bf16x8*)(lds + L_P2 + hg::swz128(rbk * 16 + r16, cb)); o[rbk] = __builtin_amdgcn_mfma_f32_16x16x32_bf16(a, bb, o[rbk], 0, 0, 0); } }
#pragma unroll
                for (int ks = 0; ks < 4; ++ks) { const int cb = (ks * 32 + q4 * 8) * 2;
#pragma unroll
                    for (int rbk = 0; rbk < 4; ++rbk) { const hg::bf16x8 a = *(const LAS hg::bf16x8*)(lds + hg::L_QT + hg::swz256(rbk * 16 + r16, cb)); o[rbk] = __builtin_amdgcn_mfma_f32_16x16x32_bf16(a, dir ? sfr[1][ks] : sfr[0][ks], o[rbk], 0, 0, 0); } }
            }
            __syncthreads();
        }
        LAS float* ot = (LAS float*)(lds + hg::L_QP);
#pragma unroll
        for (int rbk = 0; rbk < 4; ++rbk)
#pragma unroll
            for (int jj = 0; jj < 4; ++jj) ot[(rbk * 16 + q4 * 4 + jj) * 132 + wv * 16 + r16] = o[rbk][jj];
        __syncthreads();
        { f32x4 ov[4]; float ss = 0.f;
#pragma unroll
          for (int k = 0; k < 4; ++k) { ov[k] = *(const LAS f32x4*)(ot + s2 * 132 + dg + 4 * k); ss += ov[k].x * ov[k].x + ov[k].y * ov[k].y + ov[k].z * ov[k].z + ov[k].w * ov[k].w; }
          ss += __shfl_xor(ss, 1); ss += __shfl_xor(ss, 2); ss += __shfl_xor(ss, 4);
          const float rstd = rsqrtf(ss * (1.f / 128.f) + EPS);
          const unsigned gwv[8] = {gw0.x, gw0.y, gw0.z, gw0.w, gw1.x, gw1.y, gw1.z, gw1.w}; const float* gp = p.hgrn_g + (ev * 4 + h) * 128 + dg; unsigned ow[8];
#pragma unroll
          for (int k = 0; k < 4; ++k) { const f32x4 g4 = *(const f32x4*)(gp + 4 * k);
              const float a0 = __uint_as_float(gwv[2 * k] << 16), a1 = __uint_as_float(gwv[2 * k] & 0xffff0000u), a2 = __uint_as_float(gwv[2 * k + 1] << 16), a3 = __uint_as_float(gwv[2 * k + 1] & 0xffff0000u);
              ow[2 * k] = pk2(ov[k].x * rstd * g4.x * siluf_(a0), ov[k].y * rstd * g4.y * siluf_(a1)); ow[2 * k + 1] = pk2(ov[k].z * rstd * g4.z * siluf_(a2), ov[k].w * rstd * g4.w * siluf_(a3)); }
          bf16* mp = MIX + (size_t)(row0 + s2) * D + h * 128 + dg;
          *(u32x4*)mp = (u32x4){ow[0], ow[1], ow[2], ow[3]}; *(u32x4*)(mp + 8) = (u32x4){ow[4], ow[5], ow[6], ow[7]}; }
    }
    __syncthreads();
}

__device__ __forceinline__ void ph_conv(const Prm& p, int l) {
    const int j = l / 2; const bf16* PROJ = (const bf16*)(p.ws + WS_PROJ); bf16* MIX = (bf16*)(p.ws + WS_MIX); const float* cw = p.conv_w + (size_t)j * 3 * D;
    const int nrows = (l < 2) ? MT : ML; const int total = (nrows / 8) * 128;
    for (int i = obid() * NTHREADS + otid(); i < total; i += gridDim.x * NTHREADS) {
        const int rb = i >> 7, c = (i & 127) * 8, r0 = rb * 8;
        const bool isc = r0 >= ML; const int t0 = isc ? ((r0 - ML) & (TC - 1)) : (r0 & (T - 1)); const int len = isc ? TC : T;
        float w0[8], w1[8], w2[8];
        { const f32x4 a0 = *(const f32x4*)(cw + c), a1 = *(const f32x4*)(cw + c + 4), b0 = *(const f32x4*)(cw + D + c), b1 = *(const f32x4*)(cw + D + c + 4), c0 = *(const f32x4*)(cw + 2 * D + c), c1 = *(const f32x4*)(cw + 2 * D + c + 4);
          w0[0] = a0.x; w0[1] = a0.y; w0[2] = a0.z; w0[3] = a0.w; w0[4] = a1.x; w0[5] = a1.y; w0[6] = a1.z; w0[7] = a1.w;
          w1[0] = b0.x; w1[1] = b0.y; w1[2] = b0.z; w1[3] = b0.w; w1[4] = b1.x; w1[5] = b1.y; w1[6] = b1.z; w1[7] = b1.w;
          w2[0] = c0.x; w2[1] = c0.y; w2[2] = c0.z; w2[3] = c0.w; w2[4] = c1.x; w2[5] = c1.y; w2[6] = c1.z; w2[7] = c1.w; }
        float up[8], uc[8], un[8];
#define CONV_U(dst, rr, ok) do { if (ok) { const u32x4 uu_ = *(const u32x4*)(PROJ + (size_t)(rr) * 2048 + 1024 + c); const unsigned uw_[4] = {uu_.x, uu_.y, uu_.z, uu_.w}; \
            _Pragma("unroll") for (int q = 0; q < 4; ++q) { dst[2 * q] = __uint_as_float(uw_[q] << 16); dst[2 * q + 1] = __uint_as_float(uw_[q] & 0xffff0000u); } } \
          else { _Pragma("unroll") for (int q = 0; q < 8; ++q) dst[q] = 0.f; } } while (0)
        CONV_U(up, r0 - 1, t0 > 0); CONV_U(uc, r0, true);
#pragma unroll
        for (int k = 0; k < 8; ++k) { const int r = r0 + k; CONV_U(un, r + 1, t0 + k + 1 < len);
            const u32x4 bg = *(const u32x4*)(PROJ + (size_t)r * 2048 + c); const unsigned bw[4] = {bg.x, bg.y, bg.z, bg.w}; u32x4 o; unsigned ow[4];
#pragma unroll
            for (int q = 0; q < 4; ++q) { const float y0 = up[2 * q] * w0[2 * q] + uc[2 * q] * w1[2 * q] + un[2 * q] * w2[2 * q], y1 = up[2 * q + 1] * w0[2 * q + 1] + uc[2 * q + 1] * w1[2 * q + 1] + un[2 * q + 1] * w2[2 * q + 1];
                ow[q] = pk2(__uint_as_float(bw[q] << 16) * y0, __uint_as_float(bw[q] & 0xffff0000u) * y1); }
            o.x = ow[0]; o.y = ow[1]; o.z = ow[2]; o.w = ow[3]; *(u32x4*)(MIX + (size_t)r * D + c) = o;
#pragma unroll
            for (int q = 0; q < 8; ++q) { up[q] = uc[q]; uc[q] = un[q]; } }
#undef CONV_U
    }
}

__device__ __forceinline__ void ph_router(const Prm& p, int l, LAS float* lds) {
    const int tid = otid(), lane = tid & 63, gw = obid() * 8 + (tid >> 6), ngw = gridDim.x * 8;
    const float* modv = (const float*)(p.ws + WS_MODV) + (size_t)l * 5 * 6144;
    bf16* X = (bf16*)(p.ws + WS_X); const bf16* Yb = (const bf16*)(p.ws + WS_H); bf16* H2 = (bf16*)(p.ws + WS_H2); float* AFF = (float*)(p.ws + WS_AFF);
    const float* rw = p.router_w + (size_t)l * D * NE;
    const bool split = (l < 2) && gridDim.x > 32, ctxw = split && obid() < 16;
    if (ctxw) { pg8::Gemm g{(const bf16*)(p.ws + WS_MIX), (const bf16*)(p.ws + WS_WOUT), MT, D, D}; pg8::OneUnit S{ML / 256 + obid() / 4, obid() % 4};
        pg8::EpiGY E{(bf16*)(p.ws + WS_H), (const float*)(p.ws + WS_MODV) + (size_t)l * 5 * 6144 + 2 * 1024, ML};
        pg8::gemm_phase<pg8::EpiGY, pg8::OneUnit, true, true>((LAS unsigned char*)lds, g, S, E);
        mini_barrier((unsigned*)(p.ws + WS_CTL) + CW_MINI + 64 * l, 16u); }
    __syncthreads();
    for (int i = tid; i < D * NE / 4; i += NTHREADS) { const f32x4 w = *(const f32x4*)(rw + (size_t)i * 4); const int c = i >> 2, e0 = (i & 3) * 4;
        const int pos = ((((c >> 9) << 1) | ((c >> 2) & 1)) * 256) + (((c & 511) >> 3) * 4) + (c & 3);
        lds[(e0 + 0) * D + pos] = w.x; lds[(e0 + 1) * D + pos] = w.y; lds[(e0 + 2) * D + pos] = w.z; lds[(e0 + 3) * D + pos] = w.w; }
    __syncthreads();
    int ebeg, eend, estep;
    if (!split) { ebeg = gw; eend = ((l < 2) ? MT : ML) / 2; estep = ngw; }
    else if (ctxw) { ebeg = ML / 2 + gw; eend = ebeg + 1; estep = 1; }
    else { ebeg = gw - 16 * 8; eend = ML / 2 + 384; estep = ngw - 16 * 8; }
    bool seen = false;
    for (int en = ebeg; en < eend; en += estep) {
        const int r0 = (split && !ctxw && en >= ML / 2) ? (en + 128) * 2 : en * 2;
        if (split && !ctxw && en >= ML / 2 && !seen) { unsigned* ctr = (unsigned*)(p.ws + WS_CTL) + CW_MINI + 64 * l; unsigned sp = 0u;
            while (xb_ld(ctr) < 16u) { __builtin_amdgcn_s_sleep(1); if (++sp > XB_SPIN_CAP) break; }
            __builtin_amdgcn_fence(__ATOMIC_ACQUIRE, "agent"); seen = true; }
        f32x4 hv[2][4]; float my0 = 0.f, my1 = 0.f;
#pragma unroll
        for (int u = 0; u < 2; ++u) { const int r = r0 + u; const bool isc = r >= ML; const int mr = isc ? 4 : (r >> 12);
            f32x4 v[4]; float s = 0.f;
            u32x4 yw[2];
#pragma unroll
            for (int j2 = 0; j2 < 2; ++j2) yw[j2] = __builtin_nontemporal_load((const u32x4*)(Yb + (size_t)r * D + 8 * lane + 512 * j2));
            if (l == 0) { const float* xin = isc ? p.ctx + (size_t)(r - ML) * D : p.x + (size_t)r * D;
#pragma unroll
                for (int j = 0; j < 4; ++j) v[j] = __builtin_nontemporal_load((const f32x4*)(xin + CJ(j))); }
            else load_xrow(X + (size_t)r * D, lane, v);
#pragma unroll
            for (int j2 = 0; j2 < 2; ++j2) acc_bf16x8(v[2 * j2], v[2 * j2 + 1], yw[j2], 1.f);
            store_xrow(X + (size_t)r * D, lane, v);
#pragma unroll
            for (int j = 0; j < 4; ++j) s += v[j].x * v[j].x + v[j].y * v[j].y + v[j].z * v[j].z + v[j].w * v[j].w;
            const float rstd = rsqrtf(wave_sum(s) * (1.f / D) + EPS);
#pragma unroll
            for (int j = 0; j < 4; ++j) { const int c = CJ(j);
                const f32x4 g = *(const f32x4*)(p.norm2_g + l * D + c), sh = *(const f32x4*)(modv + (size_t)mr * 6144 + 3 * 1024 + c), scl = *(const f32x4*)(modv + (size_t)mr * 6144 + 4 * 1024 + c);
                hv[u][j] = (v[j] * rstd * g) * (scl + 1.f) + sh; }
#pragma unroll
            for (int j2 = 0; j2 < 2; ++j2) *(u32x4*)(H2 + (size_t)r * D + 8 * lane + 512 * j2) = pack_bf16x8(hv[u][2 * j2], hv[u][2 * j2 + 1]); }
#pragma unroll 2
        for (int e = 0; e < 16; ++e) { float a0 = 0.f, a1 = 0.f;
#pragma unroll
            for (int j = 0; j < 4; ++j) { const f32x4 w = *(const LAS f32x4*)(lds + e * D + j * 256 + 4 * lane);
                a0 += hv[0][j].x * w.x + hv[0][j].y * w.y + hv[0][j].z * w.z + hv[0][j].w * w.w; a1 += hv[1][j].x * w.x + hv[1][j].y * w.y + hv[1][j].z * w.z + hv[1][j].w * w.w; }
            a0 = wave_sum(a0); a1 = wave_sum(a1); if (lane == e) { my0 = a0; my1 = a1; } }
#pragma unroll
        for (int u = 0; u < 2; ++u) { const int r = r0 + u; const bool isc = r >= ML; const float lgt = u ? my1 : my0;
            float mx = lgt; mx = fmaxf(mx, __shfl_xor(mx, 1)); mx = fmaxf(mx, __shfl_xor(mx, 2)); mx = fmaxf(mx, __shfl_xor(mx, 4)); mx = fmaxf(mx, __shfl_xor(mx, 8));
            const float ex = __expf(lgt - mx); float den = ex; den += __shfl_xor(den, 1); den += __shfl_xor(den, 2); den += __shfl_xor(den, 4); den += __shfl_xor(den, 8);
            if (lane < 16) { const float a = ex / den;
                if (!isc) AFF[((size_t)(r >> 12) * NE + lane) * T + (r & (T - 1))] = a;
                else { const int rc = r - ML; AFF[(size_t)NB * NE * T + ((size_t)(rc >> 8) * NE + lane) * TC + (rc & (TC - 1))] = a; } } }
    }
    __syncthreads();
}

__device__ __forceinline__ void ph_topk(const Prm& p, int l, LAS float* lds) {
    const float* AFF = (const float*)(p.ws + WS_AFF); float* GATE = (float*)(p.ws + WS_GATE); int* SEL = (int*)(p.ws + WS_SEL); int* TOKSLOT = (int*)(p.ws + WS_TOKSLOT);
    const int tid = otid(), lane = tid & 63, wv = tid >> 6; const int nitems = (l < 2) ? 128 : 64;
    LAS unsigned* hist = (LAS unsigned*)lds;
    LAS unsigned* ctl = hist + 256;
    LAS unsigned* wtot = hist + 272;
    for (int it = obid(); it < nitems; it += gridDim.x) {
        const bool isc = it >= 64; const int be = it & 63, b = be >> 4, e = be & 15; const int n = isc ? TC : T, cap = isc ? CAPC : CAP;
        const float* a = AFF + (isc ? (size_t)NB * NE * T + (size_t)be * TC : (size_t)be * T);
        const bool valid = tid * 8 < n;
        unsigned bits[8];
        if (valid) { const u32x4 w0 = *(const u32x4*)(a + tid * 8), w1 = *(const u32x4*)(a + tid * 8 + 4); bits[0] = w0.x; bits[1] = w0.y; bits[2] = w0.z; bits[3] = w0.w; bits[4] = w1.x; bits[5] = w1.y; bits[6] = w1.z; bits[7] = w1.w; }
        else {
#pragma unroll
            for (int j = 0; j < 8; ++j) bits[j] = 0u; }
        unsigned prefix = 0u, remaining = (unsigned)cap;
#pragma unroll 1
        for (int pass = 0; pass < 4; ++pass) { const int shift = 24 - 8 * pass;
            __syncthreads();
            if (tid < 256) hist[tid] = 0u;
            __syncthreads();
            if (valid) {
#pragma unroll
                for (int j = 0; j < 8; ++j) { const bool m = (pass == 0) || ((bits[j] >> (shift + 8)) == prefix); if (m) __hip_atomic_fetch_add(&hist[(bits[j] >> shift) & 255u], 1u, __ATOMIC_RELAXED, __HIP_MEMORY_SCOPE_WORKGROUP); } }
            __syncthreads();
            if (wv == 0) { const unsigned c0 = hist[4 * lane], c1 = hist[4 * lane + 1], c2 = hist[4 * lane + 2], c3 = hist[4 * lane + 3]; const unsigned s = c0 + c1 + c2 + c3;
                unsigned incl = s;
#pragma unroll
                for (int o = 1; o < 64; o <<= 1) { const unsigned t = __shfl_down(incl, o); if (lane + o < 64) incl += t; }
                unsigned above = incl - s;
                if (above < remaining && remaining <= above + s) { unsigned B;
                    if (above + c3 >= remaining) B = 4 * lane + 3; else { above += c3; if (above + c2 >= remaining) B = 4 * lane + 2; else { above += c2; if (above + c1 >= remaining) B = 4 * lane + 1; else { above += c1; B = 4 * lane; } } }
                    ctl[0] = (prefix << 8) | B; ctl[1] = remaining - above; } }
            __syncthreads();
            prefix = ctl[0]; remaining = ctl[1];
        }
        const unsigned thr = prefix;
        unsigned cg = 0u, ce = 0u;
#pragma unroll
        for (int j = 0; j < 8; ++j) { cg += (valid && bits[j] > thr) ? 1u : 0u; ce += (valid && bits[j] == thr) ? 1u : 0u; }
        unsigned pk = cg | (ce << 16), incl = pk;
#pragma unroll
        for (int o = 1; o < 64; o <<= 1) { const unsigned t = __shfl_up(incl, o); if (lane >= o) incl += t; }
        __syncthreads();
        if (lane == 63) wtot[wv] = incl;
        __syncthreads();
        unsigned base = 0u, total = 0u;
#pragma unroll
        for (int w = 0; w < 8; ++w) { const unsigned t = wtot[w]; if (w < wv) base += t; total += t; }
        const unsigned excl = base + incl - pk; unsigned gpos = excl & 0xffffu, epos = excl >> 16; const unsigned ngt = total & 0xffffu;
        if (valid) {
#pragma unroll
            for (int j = 0; j < 8; ++j) { const int t0 = tid * 8 + j; const int row = isc ? ML + b * TC + t0 : b * T + t0; int slot = -1;
                if (bits[j] > thr) { slot = (int)gpos; ++gpos; } else if (bits[j] == thr) { if (epos < remaining) slot = (int)(ngt + epos); ++epos; }
                if (slot >= 0) { const int xr = isc ? 2048 + b * CAPC + slot : b * CAP + slot; SEL[e * XR + xr] = row; GATE[e * XR + xr] = __uint_as_float(bits[j]); TOKSLOT[(size_t)row * NE + e] = xr; }
                else TOKSLOT[(size_t)row * NE + e] = -1; } }
    }
    __syncthreads();
}
__device__ __forceinline__ void ph_dispatch(const Prm& p, int l) {
    const int lane = otid() & 63, gw = obid() * 8 + (otid() >> 6), ngw = gridDim.x * 8;
    const int* SEL = (const int*)(p.ws + WS_SEL); const bf16* H2 = (const bf16*)(p.ws + WS_H2); bf16* XE = (bf16*)(p.ws + WS_XE);
    const int rows_e = (l < 2) ? 2176 : 2048;
    for (int g = gw; g < NE * rows_e; g += ngw) { const int e = g / rows_e, xr = g % rows_e; const int src = SEL[e * XR + xr];
        const u32x4* s4 = (const u32x4*)(H2 + (size_t)src * D); u32x4* d4 = (u32x4*)(XE + ((size_t)e * XR + xr) * D);
        d4[lane] = s4[lane]; d4[lane + 64] = s4[lane + 64]; }
}

__global__ void __launch_bounds__(NTHREADS, 2) mega(Prm p) {
    extern __shared__ __attribute__((aligned(16))) unsigned char lds_raw[];
    LAS unsigned char* ldsb = (LAS unsigned char*)lds_raw;
    LAS float* lds = (LAS float*)ldsb;
    volatile LAS unsigned* misc = (volatile LAS unsigned*)(ldsb + LDS_BYTES - 256);
    if (threadIdx.x < 32) misc[threadIdx.x] = 0u;
    __syncthreads();
    XcdBarrier bar = xcd_barrier_post((unsigned*)(p.ws + WS_CTL) + 1024, misc + 8);
#define GRID_BAR() do { XcdBarrier b_; { unsigned long long w_ = (unsigned long long)p.ws; asm volatile("" : "+s"(w_)); b_.bar = (unsigned*)((unsigned char*)w_ + WS_CTL) + 1024; } b_.x = xb_xcc_id(); b_.st = misc + 8; xcd_barrier(b_); } while (0)
    (void)bar;
    ph_setup(p, lds);
    ph_convert(p, 0, ldsb);
    GRID_BAR();
    if (DUP_PHASE == 13) { ph_setup(p, lds); GRID_BAR(); ph_setup(p, lds); GRID_BAR(); ph_setup(p, lds); GRID_BAR(); }
    for (int l = 0; l < DEPTH; ++l) {
        if (l > 0) ph_convert(p, l, ldsb);
        ph_norm1(p, l);
        GRID_BAR();
        ph_gemm_in(p, l, ldsb);
        GRID_BAR();
        if (DUP_PHASE == 1) { ph_gemm_in(p, l, ldsb); GRID_BAR(); }
        if (DUP_PHASE == 2) { ph_convert(p, l, ldsb); GRID_BAR(); }
        if (DUP_PHASE == 14) { ph_probe_read<0>(p, l); GRID_BAR(); }
        if (DUP_PHASE == 41) { ph_probe_read<1>(p, l); GRID_BAR(); }
        if (DUP_PHASE == 42) { ph_probe_read<2>(p, l); GRID_BAR(); }
        if (DUP_PHASE == 43) { ph_probe_read<3>(p, l); GRID_BAR(); }
        if (DUP_PHASE == 44) { ph_probe_cvt<4>(p, l); GRID_BAR(); }
        if (DUP_PHASE == 45) { ph_probe_cvt<5>(p, l); GRID_BAR(); }
        if (DUP_PHASE == 18 && l >= 1) { ph_norm1(p, l, false); GRID_BAR(); }
        if ((l & 1) == 0) {
            if (DUP_PHASE == 5 || DUP_PHASE == 7) { ph_hgrn_local<9>(p, l, ldsb); GRID_BAR(); }
            if (DUP_PHASE == 7) { ph_hgrn_local<9>(p, l, ldsb); GRID_BAR(); }
            ph_qkprep(p, l);
            ph_hgrn_local<0>(p, l, ldsb);
            GRID_BAR();
            ph_hgrn_scan(p);
            GRID_BAR();
            if (DUP_PHASE == 3) { ph_hgrn_local<9>(p, l, ldsb); GRID_BAR(); }
            if (DUP_PHASE == 4) { ph_hgrn_scan(p); GRID_BAR(); }
            ph_attn<5>(p, l, ldsb);
            ph_hgrn_out<0>(p, l, ldsb);
            GRID_BAR();
            if (DUP_PHASE == 5) { ph_attn<0>(p, l, ldsb); GRID_BAR(); }
            if (DUP_PHASE == 21) { ph_attn<1>(p, l, ldsb); GRID_BAR(); }
            if (DUP_PHASE == 22) { ph_attn<2>(p, l, ldsb); GRID_BAR(); }
            if (DUP_PHASE == 23) { ph_attn<3>(p, l, ldsb); GRID_BAR(); }
            if (DUP_PHASE == 24) { ph_attn<4>(p, l, ldsb); GRID_BAR(); }
            if (DUP_PHASE == 6) { ph_hgrn_out<5>(p, l, ldsb); GRID_BAR(); }
            if (DUP_PHASE == 31) { ph_hgrn_out<1>(p, l, ldsb); GRID_BAR(); }
            if (DUP_PHASE == 32) { ph_hgrn_out<2>(p, l, ldsb); GRID_BAR(); }
            if (DUP_PHASE == 33) { ph_hgrn_out<3>(p, l, ldsb); GRID_BAR(); }
        } else {
            ph_conv(p, l);
            GRID_BAR();
            if (DUP_PHASE == 17) { ph_conv(p, l); GRID_BAR(); }
        }
        ph_gemm_out(p, l, ldsb);
        GRID_BAR();
        ph_router(p, l, lds);
        GRID_BAR();
        ph_topk(p, l, lds);
        GRID_BAR();
        if (DUP_PHASE == 7) { ph_topk(p, l, lds); GRID_BAR(); }
        ph_expert_up(p, l, ldsb);
        GRID_BAR();
        if (DUP_PHASE == 10) { ph_expert_up(p, l, ldsb); GRID_BAR(); }
        ph_expert_down(p, l, ldsb);
        GRID_BAR();
        if (DUP_PHASE == 11) { ph_expert_down(p, l, ldsb); GRID_BAR(); }
        if (DUP_PHASE == 12) { GRID_BAR(); GRID_BAR(); GRID_BAR(); GRID_BAR(); GRID_BAR(); GRID_BAR(); GRID_BAR(); GRID_BAR(); GRID_BAR(); GRID_BAR(); }
    }
    ph_final(p);
    if (DUP_PHASE == 19) { GRID_BAR(); ph_final(p); GRID_BAR(); ph_final(p); }
}

extern "C" void kernel_launch(void* const* d_in, const int* in_sizes, int n_in, void* d_out, int out_size, void* d_ws, size_t ws_size, hipStream_t stream) {
    static int grid = 0;
    if (grid == 0) {
        if (n_in != 23 || out_size != ML * D || ws_size < WS_END) { fprintf(stderr, "kernel_launch: unexpected shapes: n_in %d out %d ws %zu (need %zu)\n", n_in, out_size, ws_size, (size_t)WS_END); grid = -1; return; }
        int dev = 0, cus = 0, per_cu = 0;
        if (hipGetDevice(&dev) != hipSuccess || hipDeviceGetAttribute(&cus, hipDeviceAttributeMultiprocessorCount, dev) != hipSuccess) { grid = -1; return; }
        if (hipFuncSetAttribute((const void*)mega, hipFuncAttributeMaxDynamicSharedMemorySize, LDS_BYTES) != hipSuccess) { fprintf(stderr, "kernel_launch: hipFuncSetAttribute failed\n"); grid = -1; return; }
        if (hipOccupancyMaxActiveBlocksPerMultiprocessor(&per_cu, (const void*)mega, NTHREADS, LDS_BYTES) != hipSuccess || per_cu < 1) fprintf(stderr, "kernel_launch: occupancy query says %d\n", per_cu);
        (void)hipGetLastError();
        grid = cus;
    }
    if (grid < 0) return;
    (void)hipMemsetAsync((char*)d_ws + WS_CTL, 0, 1 * MiB, stream);
    Prm p{};
    const float** pp = (const float**)&p;
    for (int i = 0; i < 23; ++i) pp[i] = (const float*)d_in[i];
    p.out = (float*)d_out; p.ws = (unsigned char*)d_ws;
    hipLaunchKernelGGL(mega, dim3(grid), dim3(NTHREADS), LDS_BYTES, stream, p);
}
```

```cpp
#include <hip/hip_runtime.h>
#include <type_traits>
#ifndef DUP_PHASE
#define DUP_PHASE 0
#endif
#include <cstdint>
#include <cstdio>

#define GAS __attribute__((address_space(1)))
#define LAS __attribute__((address_space(3)))
typedef unsigned short bf16;
typedef float f32x4 __attribute__((ext_vector_type(4)));
typedef unsigned u32x4 __attribute__((ext_vector_type(4)));
typedef unsigned u32x2 __attribute__((ext_vector_type(2)));

constexpr int D = 1024, NB = 4, T = 4096, TC = 256, DEPTH = 4;
constexpr int ML = NB * T, MC = NB * TC, MT = ML + MC;
constexpr int NE = 16, FF = 1024, CAP = 512, CAPC = 32;
constexpr int XR = 2304;
constexpr int NTHREADS = 512;
constexpr float EPS = 1e-6f;

constexpr size_t MiB = 1u << 20;
constexpr size_t WS_CTL = 0;
constexpr size_t WS_MODV = 1 * MiB;
constexpr size_t WS_ROPE = WS_MODV + 512 * 1024;
constexpr size_t WS_X = 2 * MiB;
constexpr size_t WS_H = WS_X + (size_t)MT * D * 4;
constexpr size_t WS_H2 = WS_H + (size_t)MT * D * 2;
constexpr size_t WS_PROJ = WS_H2 + (size_t)MT * D * 2;
constexpr size_t WS_MIX = WS_PROJ + (size_t)MT * 4096 * 2;
constexpr size_t WS_OF = WS_MIX + (size_t)MT * D * 2;
constexpr size_t WS_AFF = WS_OF + (size_t)2 * MT * 512 * 4;
constexpr size_t WS_GATE = WS_AFF + 2 * MiB;
constexpr size_t WS_SEL = WS_GATE + 1 * MiB;
constexpr size_t WS_TOKSLOT = WS_SEL + 1 * MiB;
constexpr size_t WS_XE = WS_TOKSLOT + 2 * MiB;
constexpr size_t WS_ACT = WS_XE + (size_t)NE * XR * D * 2;
constexpr size_t WS_YE = WS_ACT + (size_t)NE * XR * D * 2;
constexpr size_t WS_WIN = WS_YE + (size_t)NE * XR * D * 2;
constexpr size_t WS_WOUT = WS_WIN + (size_t)4096 * D * 2;
constexpr size_t WS_WUP = WS_WOUT + (size_t)D * D * 2;
constexpr size_t WS_WDN = WS_WUP + (size_t)NE * 2048 * D * 2;
constexpr int HG_NCH = 68, HG_ITEMS = NB * 4 * 2 * HG_NCH;
constexpr size_t WS_HDS = WS_WDN + (size_t)NE * D * FF * 2;
constexpr size_t WS_HST = WS_HDS + (size_t)HG_ITEMS * 128 * 128 * 2;
constexpr size_t WS_HG = WS_HST + (size_t)HG_ITEMS * 128 * 128 * 2;
constexpr size_t WS_END = WS_HG + (size_t)HG_ITEMS * 128 * 4;

constexpr int LDS_BYTES = 155648;

struct Prm {
    const float *x, *c, *ctx, *c_ctx, *mod_w, *mod_b, *norm1_g, *norm2_g, *even_w_in, *even_w_out, *hgrn_lb, *hgrn_g, *qn_g, *kn_g, *dlam, *subln_g,
        *conv_w_in, *conv_w, *conv_w_out, *router_w, *w_gate, *w_up, *w_down;
    float* out; unsigned char* ws;
};

__device__ __forceinline__ float bf2f(bf16 v) { return __uint_as_float((unsigned)v << 16); }
__device__ __forceinline__ bf16 f2bf(float f) { unsigned u = __float_as_uint(f); return (bf16)((u + 0x7fffu + ((u >> 16) & 1u)) >> 16); }
__device__ __forceinline__ unsigned pk2_sw(float lo, float hi) { return (unsigned)f2bf(lo) | ((unsigned)f2bf(hi) << 16); }
__device__ __forceinline__ unsigned pk2(float lo, float hi) { unsigned r; asm volatile("v_cvt_pk_bf16_f32 %0, %1, %2" : "=v"(r) : "v"(lo), "v"(hi)); return r; }
__device__ __forceinline__ float wave_sum(float v) {
#pragma unroll
    for (int o = 1; o < 64; o <<= 1) v += __shfl_xor(v, o);
    return v;
}
__device__ __forceinline__ int otid() { int t = threadIdx.x; asm volatile("" : "+v"(t)); return t; }
__device__ __forceinline__ int obid() { int b = blockIdx.x; asm volatile("" : "+s"(b)); return b; }
__device__ __forceinline__ int vcu_id() { const int G = gridDim.x, bx = obid(); return (G % 8 == 0) ? (bx % 8) * (G / 8) + bx / 8 : bx; }
__device__ __forceinline__ float sigmoidf_(float x) { return __builtin_amdgcn_rcpf(1.f + __expf(-x)); }
__device__ __forceinline__ float siluf_(float x) { return x * __builtin_amdgcn_rcpf(1.f + __expf(-x)); }

#define XB_TMO      128
#define XB_XCNT(j)  (256  + 64 * (j))
#define XB_XSUB(j)  (1280 + 64 * (j))
#define XB_XGEN(j)  (2304 + 64 * (j))
#define XB_TOP      3328
#define XB_TOPGEN   3392
#define XCD_BAR_WORDS 3456
#define XB_SPIN_CAP (1u << 28)
__device__ __forceinline__ unsigned xb_ld(unsigned* p)              { return __hip_atomic_load(p, __ATOMIC_RELAXED, __HIP_MEMORY_SCOPE_AGENT); }
__device__ __forceinline__ unsigned xb_add(unsigned* p, unsigned v) { return __hip_atomic_fetch_add(p, v, __ATOMIC_RELAXED, __HIP_MEMORY_SCOPE_AGENT); }
__device__ __forceinline__ unsigned xb_xcc_id() { return (unsigned)__builtin_amdgcn_s_getreg((3 << 11) | 20) & 0xFu; }
#define XB_SPIN(cond, bar) do { unsigned _sp = 0; while (cond) { __builtin_amdgcn_s_sleep(1); \
    if ((++_sp & 255u) == 0u) { if (xb_ld(&(bar)[XB_TMO])) break; if (_sp > XB_SPIN_CAP) { atomicAdd(&(bar)[XB_TMO], 1u); break; } } } } while (0)
struct XcdBarrier { unsigned* bar; unsigned x; volatile LAS unsigned* st; };
__device__ __forceinline__ XcdBarrier xcd_barrier_post(unsigned* bar, volatile LAS unsigned* st) {
    XcdBarrier b; b.bar = bar; b.x = xb_xcc_id(); b.st = st;
    if (threadIdx.x == 0) (void)xb_add(&bar[XB_XCNT(b.x)], 1u);
    return b;
}
__device__ __forceinline__ void xcd_barrier_complete(unsigned* bar, unsigned x, unsigned& nloc, unsigned& nx) {
    const unsigned G = gridDim.x * gridDim.y * gridDim.z;
    unsigned sum, cnt, mine, sp = 0u;
    for (;;) {
        sum = 0u; cnt = 0u; mine = 0u;
#pragma unroll
        for (unsigned j = 0; j < 16; ++j) { const unsigned c = xb_ld(&bar[XB_XCNT(j)]); sum += c; cnt += (c > 0u) ? 1u : 0u; mine = (j == x) ? c : mine; }
        if (sum == G) break;
        __builtin_amdgcn_s_sleep(1);
        if ((++sp & 255u) == 0u) { if (xb_ld(&bar[XB_TMO])) break; if (sp > XB_SPIN_CAP) { atomicAdd(&bar[XB_TMO], 1u); break; } }
    }
    nloc = mine > 0u ? mine : 1u; nx = cnt > 0u ? cnt : 1u;
}
__device__ __forceinline__ void xcd_barrier(const XcdBarrier& b) {
    asm volatile("s_waitcnt vmcnt(0)" ::: "memory");
    __syncthreads();
    if (threadIdx.x == 0) {
        unsigned* bar = b.bar;
        __builtin_amdgcn_s_waitcnt(0);
        unsigned nloc = b.st[0], nx = b.st[1];
        if (nloc == 0u) { xcd_barrier_complete(bar, b.x, nloc, nx); b.st[0] = nloc; b.st[1] = nx; }
        const unsigned old = xb_add(&bar[XB_XSUB(b.x)], 1u);
        const unsigned gen = old / nloc;
        if (old + 1u == (gen + 1u) * nloc) {
            __builtin_amdgcn_fence(__ATOMIC_RELEASE, "agent");
            asm volatile("s_waitcnt vmcnt(0)" ::: "memory");
            const unsigned og = xb_add(&bar[XB_TOP], 1u);
            const unsigned tg = og / nx;
            if (og + 1u == (tg + 1u) * nx) xb_add(&bar[XB_TOPGEN], 1u);
            else XB_SPIN(xb_ld(&bar[XB_TOPGEN]) == tg, bar);
            __builtin_amdgcn_fence(__ATOMIC_ACQUIRE, "agent");
            xb_add(&bar[XB_XGEN(b.x)], 1u);
            asm volatile("s_waitcnt vmcnt(0)" ::: "memory");
        } else {
            XB_SPIN(xb_ld(&bar[XB_XGEN(b.x)]) == gen, bar);
            __builtin_amdgcn_fence(__ATOMIC_ACQUIRE, "agent");
            asm volatile("s_waitcnt vmcnt(0)" ::: "memory");
        }
    }
    __syncthreads();
}

namespace pg8 {
#define PG8_LAS __attribute__((address_space(3)))
typedef unsigned short bf16_t;
typedef short bf16x8 __attribute__((ext_vector_type(8)));
typedef float f32x4 __attribute__((ext_vector_type(4)));
typedef unsigned u32x4 __attribute__((ext_vector_type(4)));
constexpr int BM = 256, BK = 64, HALF = 128, HTB = HALF * BK * 2  , STAGE_BYTES = 8 * HTB, NXCD = 8, WGM = 8;

__host__ __device__ __forceinline__ int lds_byte(int r, int c) { const int st = (r >> 4) * 2 + (c >> 5), rr = r & 15, cc = c & 31, ob = rr * 64 + cc * 2; return st * 1024 + (ob ^ (((ob >> 9) & 1) << 5)); }
__host__ __device__ __forceinline__ void stage_rc(int b, int& R, int& C) { const int st = b / 1024, sb = b % 1024, swz = sb ^ (((sb >> 9) & 1) << 5); R = (st >> 1) * 16 + swz / 64; C = (st & 1) * 32 + (swz % 64) / 2; }
__host__ __device__ __forceinline__ int perm32(int rho) { const int n = rho >> 4, i = rho & 15; return 8 * (i >> 2) + 4 * n + (i & 3); }

struct Unit { int pm, pn, ab; };
struct Gemm { const bf16_t* A; const bf16_t* Bt; int M, N, K; };

template <int SPLIT = 0>
struct StaticOrderT {
    static constexpr bool HAS_SPLIT = SPLIT != 0;
    int nM, nN, nwg, G, c, nsplit;
    __host__ __device__ void init(int M, int N, int G_, int c_, int Mfull = -1) { if (Mfull < 0) Mfull = M; nM = Mfull / BM; nN = N / BM; nwg = nM * nN; G = G_; c = c_; nsplit = SPLIT ? ((M - Mfull) / BM) * nN * SPLIT : 0; }
    __host__ __device__ bool next(int i, Unit& u) const {
        const long L = (long)i * G + c;
        if (L >= (long)nwg + nsplit) return false;
        int pm, pn, ab;
        if (SPLIT != 0 && L >= nwg) { int q = (int)(L - nwg);
            q = (q % NXCD) * (nsplit / NXCD) + q / NXCD;
            const int t = q / (SPLIT ? SPLIT : 1), s = q % (SPLIT ? SPLIT : 1); pn = t / 4; pm = nM + t % 4; ab = (1 << (s & 1)) | ((SPLIT == 4 ? (1 << (s >> 1)) : 3) << 2);
        } else {
            int wgid = (int)L; { const int q = nwg / NXCD, r = nwg % NXCD, xcd = wgid % NXCD, off = wgid / NXCD; wgid = (xcd < r ? xcd * (q + 1) : r * (q + 1) + (xcd - r) * q) + off; }
            const int nig = WGM * nN, gid = wgid / nig, fm = gid * WGM, gsz = (nM - fm) < WGM ? (nM - fm) : WGM;
            pm = fm + ((wgid % nig) % gsz); pn = (wgid % nig) / gsz; ab = 15; }
        u.pm = pm; u.pn = pn; u.ab = ab; return true;
    }
    __device__ __forceinline__ void a_ready(const Unit&) const {}
    __device__ __forceinline__ void done(const Unit&) const {}
};
typedef StaticOrderT<0> StaticOrder;

__device__ __forceinline__ unsigned cvt_pk_bf16(float lo, float hi) { unsigned r; asm volatile("v_cvt_pk_bf16_f32 %0, %1, %2" : "=v"(r) : "v"(lo), "v"(hi)); return r; }

struct EpiBf16 {
    static constexpr bool PERM = true, AFTER_DRAIN = false;
    bf16_t* O; int ldc;
    __device__ __forceinline__ void operator()(const f32x4 (&acc)[2][2][4][2], const Unit& u, int wr, int wc, int fr, int fq) const {
        const int row0 = u.pm * BM + wr * 64 + fr; const int col0 = u.pn * BM + wc * 32 + 8 * fq;
#pragma unroll
        for (int ai = 0; ai < 2; ++ai)
#pragma unroll
            for (int m = 0; m < 4; ++m) { if (!((u.ab >> ai) & 1)) continue; bf16_t* rowp = O + (size_t)(row0 + ai * HALF + m * 16) * ldc + col0;
#pragma unroll
                for (int bj = 0; bj < 2; ++bj) { if (!((u.ab >> (2 + bj)) & 1)) continue; const f32x4 v0 = acc[ai][bj][m][0], v1 = acc[ai][bj][m][1];
                    u32x4 w; w.x = cvt_pk_bf16(v0[0], v0[1]); w.y = cvt_pk_bf16(v0[2], v0[3]); w.z = cvt_pk_bf16(v1[0], v1[1]); w.w = cvt_pk_bf16(v1[2], v1[3]);
                    *(u32x4*)(rowp + bj * HALF) = w; } }
    }
};
struct EpiGY {
    static constexpr bool PERM = true, AFTER_DRAIN = false;
    bf16_t* Y; const float* g1; int ml;
    __device__ __forceinline__ void operator()(const f32x4 (&acc)[2][2][4][2], const Unit& u, int wr, int wc, int fr, int fq) const {
        const int rbase = u.pm * BM; const int mr = rbase >= ml ? 4 : (rbase >> 12); const float* g = g1 + (size_t)mr * 6144;
        const int row0 = rbase + wr * 64 + fr, col0 = u.pn * BM + wc * 32 + 8 * fq;
        f32x4 gv[2][2];
#pragma unroll
        for (int bj = 0; bj < 2; ++bj)
#pragma unroll
            for (int n = 0; n < 2; ++n) gv[bj][n] = *(const f32x4*)(g + col0 + bj * HALF + n * 4);
#pragma unroll
        for (int ai = 0; ai < 2; ++ai)
#pragma unroll
            for (int m = 0; m < 4; ++m) { bf16_t* rowp = Y + (size_t)(row0 + ai * HALF + m * 16) * 1024 + col0;
#pragma unroll
                for (int bj = 0; bj < 2; ++bj) { const f32x4 v0 = acc[ai][bj][m][0] * gv[bj][0], v1 = acc[ai][bj][m][1] * gv[bj][1];
                    u32x4 w; w.x = cvt_pk_bf16(v0[0], v0[1]); w.y = cvt_pk_bf16(v0[2], v0[3]); w.z = cvt_pk_bf16(v1[0], v1[1]); w.w = cvt_pk_bf16(v1[2], v1[3]);
                    *(u32x4*)(rowp + bj * HALF) = w; } }
    }
};
struct EpiResid {
    static constexpr bool PERM = false, AFTER_DRAIN = false;
    const float* xl; const float* xc; float* X; const float* g1; int ml;
    __device__ __forceinline__ void operator()(const f32x4 (&acc)[2][2][4][2], const Unit& u, int wr, int wc, int fr, int fq) const {
        const int rbase = u.pm * BM; const bool isc = rbase >= ml; const int mr = isc ? 4 : (rbase >> 12);
        const float* xin = isc ? xc - (size_t)ml * 1024 : xl; const float* g = g1 + (size_t)mr * 6144;
        const int col0 = u.pn * BM + wc * 32 + 4 * fq;
        f32x4 gv[2][2];
#pragma unroll
        for (int bj = 0; bj < 2; ++bj)
#pragma unroll
            for (int n = 0; n < 2; ++n) gv[bj][n] = *(const f32x4*)(g + col0 + bj * HALF + n * 16);
#pragma unroll
        for (int ai = 0; ai < 2; ++ai)
#pragma unroll
            for (int m = 0; m < 4; ++m) { const size_t off = (size_t)(rbase + ai * HALF + wr * 64 + m * 16 + fr) * 1024 + col0;
#pragma unroll
                for (int bj = 0; bj < 2; ++bj)
#pragma unroll
                    for (int n = 0; n < 2; ++n) { const f32x4 xi = *(const f32x4*)(xin + off + bj * HALF + n * 16); *(f32x4*)(X + off + bj * HALF + n * 16) = xi + gv[bj][n] * acc[ai][bj][m][n]; } }
    }
};
__device__ __forceinline__ float silu_f(float x) { return x * __builtin_amdgcn_rcpf(1.f + __expf(-x)); }
struct EpiSwiglu {
    static constexpr bool PERM = true, AFTER_DRAIN = false;
    bf16_t* O; int ntn;
    __device__ __forceinline__ void operator()(const f32x4 (&acc)[2][2][4][2], const Unit& u, int wr, int wc, int fr, int fq) const {
        const int row0 = u.pm * BM + wr * 64 + fr; const int col0 = (u.pn % ntn) * HALF + wc * 32 + 8 * fq;
#pragma unroll
        for (int ai = 0; ai < 2; ++ai)
#pragma unroll
            for (int m = 0; m < 4; ++m) { if (!((u.ab >> ai) & 1)) continue; bf16_t* rowp = O + (size_t)(row0 + ai * HALF + m * 16) * 1024 + col0;
                const f32x4 g0 = acc[ai][0][m][0], g1 = acc[ai][0][m][1], u0 = acc[ai][1][m][0], u1 = acc[ai][1][m][1];
                u32x4 w; w.x = cvt_pk_bf16(silu_f(g0[0]) * u0[0], silu_f(g0[1]) * u0[1]); w.y = cvt_pk_bf16(silu_f(g0[2]) * u0[2], silu_f(g0[3]) * u0[3]);
                w.z = cvt_pk_bf16(silu_f(g1[0]) * u1[0], silu_f(g1[1]) * u1[1]); w.w = cvt_pk_bf16(silu_f(g1[2]) * u1[2], silu_f(g1[3]) * u1[3]);
                *(u32x4*)rowp = w; }
    }
};
struct EpiConvIn {
    static constexpr bool PERM = true, AFTER_DRAIN = false;
    bf16_t* O;
    __device__ __forceinline__ void operator()(const f32x4 (&acc)[2][2][4][2], const Unit& u, int wr, int wc, int fr, int fq) const {
        const int row0 = u.pm * BM + wr * 64 + fr;
        if (u.pn < 4) { const int col0 = u.pn * BM + wc * 32 + 8 * fq;
#pragma unroll
            for (int ai = 0; ai < 2; ++ai)
#pragma unroll
                for (int m = 0; m < 4; ++m) { if (!((u.ab >> ai) & 1)) continue; bf16_t* rowp = O + (size_t)(row0 + ai * HALF + m * 16) * 2048 + col0;
#pragma unroll
                    for (int bj = 0; bj < 2; ++bj) { const f32x4 v0 = acc[ai][bj][m][0], v1 = acc[ai][bj][m][1];
                        u32x4 w; w.x = cvt_pk_bf16(v0[0], v0[1]); w.y = cvt_pk_bf16(v0[2], v0[3]); w.z = cvt_pk_bf16(v1[0], v1[1]); w.w = cvt_pk_bf16(v1[2], v1[3]);
                        *(u32x4*)(rowp + bj * HALF) = w; } }
        } else { const int col0 = 1024 + (u.pn - 4) * HALF + wc * 32 + 8 * fq;
#pragma unroll
            for (int ai = 0; ai < 2; ++ai)
#pragma unroll
                for (int m = 0; m < 4; ++m) { if (!((u.ab >> ai) & 1)) continue; bf16_t* rowp = O + (size_t)(row0 + ai * HALF + m * 16) * 2048 + col0;
                    const f32x4 c0 = acc[ai][0][m][0], c1 = acc[ai][0][m][1], v0 = acc[ai][1][m][0], v1 = acc[ai][1][m][1];
                    u32x4 w; w.x = cvt_pk_bf16(c0[0] * v0[0], c0[1] * v0[1]); w.y = cvt_pk_bf16(c0[2] * v0[2], c0[3] * v0[3]); w.z = cvt_pk_bf16(c1[0] * v1[0], c1[1] * v1[1]); w.w = cvt_pk_bf16(c1[2] * v1[2], c1[3] * v1[3]);
                    *(u32x4*)rowp = w; }
        }
    }
};
struct EpiDown {
    static constexpr bool PERM = true, AFTER_DRAIN = false;
    bf16_t* O; const float* gate; int ntn;
    __device__ __forceinline__ void operator()(const f32x4 (&acc)[2][2][4][2], const Unit& u, int wr, int wc, int fr, int fq) const {
        const int row0 = u.pm * BM + wr * 64 + fr; const int col0 = (u.pn % ntn) * BM + wc * 32 + 8 * fq;
#pragma unroll
        for (int ai = 0; ai < 2; ++ai)
#pragma unroll
            for (int m = 0; m < 4; ++m) { if (!((u.ab >> ai) & 1)) continue; const int r = row0 + ai * HALF + m * 16; const float gt = gate[r]; bf16_t* rowp = O + (size_t)r * 1024 + col0;
#pragma unroll
                for (int bj = 0; bj < 2; ++bj) { if (!((u.ab >> (2 + bj)) & 1)) continue; const f32x4 v0 = acc[ai][bj][m][0] * gt, v1 = acc[ai][bj][m][1] * gt;
                    u32x4 w; w.x = cvt_pk_bf16(v0[0], v0[1]); w.y = cvt_pk_bf16(v0[2], v0[3]); w.z = cvt_pk_bf16(v1[0], v1[1]); w.w = cvt_pk_bf16(v1[2], v1[3]);
                    *(u32x4*)(rowp + bj * HALF) = w; } }
    }
};
struct OneUnit { static constexpr bool HAS_SPLIT = false; int pm, pn;
    __device__ bool next(int i, Unit& u) const { if (i > 0) return false; u.pm = pm; u.pn = pn; u.ab = 15; return true; }
    __device__ __forceinline__ void a_ready(const Unit&) const {}
    __device__ __forceinline__ void done(const Unit&) const {}
};
template <int NTN, int QUARTER>
struct GroupOrderT {
    static constexpr bool HAS_SPLIT = true;
    int nfull, nsplit, G, c;
    __device__ void init(int mt_, int ne, int G_, int c_) { nfull = ne * 8 * NTN; nsplit = mt_ > 8 ? ne * NTN * (QUARTER ? 2 : 1) : 0; G = G_; c = c_; }
    __device__ bool next(int i, Unit& u) const { const int L = i * G + c; if (L >= nfull + nsplit) return false;
        int pm, pn, ab;
        if (L < nfull) { const int e = L / (8 * NTN), r = L % (8 * NTN); pm = e * 9 + (r % 8); pn = e * NTN + (r / 8); ab = 15; }
        else { const int q = L - nfull; const int sp = QUARTER ? 2 : 1, t = q / sp, s = q % sp; pm = (t / NTN) * 9 + 8; pn = t; ab = 1 | ((QUARTER ? (1 << s) : 3) << 2); }
        u.pm = pm; u.pn = pn; u.ab = ab; return true; }
    __device__ __forceinline__ void a_ready(const Unit&) const {}
    __device__ __forceinline__ void done(const Unit&) const {}
};

struct DenseA { static constexpr bool GATHER = false;
    __device__ __forceinline__ unsigned off(const Unit&, int h, int R, int C, int K) const { return (unsigned)((h * HALF + R) * K + C) * 2u; }
    __device__ __forceinline__ size_t base(const Unit& u, size_t tstep) const { return (size_t)u.pm * tstep; } };
struct GatherA { static constexpr bool GATHER = true; const int* sel; int sel_ld, tiles_per_e, nvalid;
    __device__ __forceinline__ unsigned off(const Unit& u, int h, int R, int C, int K) const { const int e = u.pm / tiles_per_e, xr = (u.pm % tiles_per_e) * BM + h * HALF + R; const int row = sel[e * sel_ld + (xr < nvalid ? xr : 0)]; return (unsigned)(row * K + C) * 2u; }
    __device__ __forceinline__ size_t base(const Unit&, size_t) const { return 0; } };
template <class Epi, class Sched, bool ALIGN_EPI = false, bool SP2 = false, class AOff = DenseA>
__device__ __forceinline__ void gemm_phase(PG8_LAS unsigned char* lds, const Gemm g, const Sched& S, const Epi& E, const AOff AO = AOff()) {
    const int tid = otid(), wid = __builtin_amdgcn_readfirstlane(tid >> 6), lane = tid & 63, wr = wid >> 2, wc = wid & 3, fr = lane & 15, fq = lane >> 4;
    const int K = g.K, nt = K / BK;
    unsigned voffB[2];
#pragma unroll
    for (int i = 0; i < 2; ++i) { int R, C; stage_rc(tid * 16 + i * 8192, R, C); const int Rb = Epi::PERM ? ((R & ~31) + perm32(R & 31)) : R;
        voffB[i] = (unsigned)(Rb * K + C) * 2u; }
    const size_t kstep = (size_t)(BK * 2);
    const size_t hstep = (size_t)HALF * K * 2;
    const size_t tstep = 2 * hstep;
    const unsigned ldsw = (unsigned)wid * 1024u;
    const int aoff = lds_byte(wr * 64 + fr, fq * 8), boff = lds_byte(wc * 32 + fr, fq * 8);
#define PG8_SA(b, h) (((b) * 2 + (h)) * HTB)
#define PG8_SB(b, h) ((4 + (b) * 2 + (h)) * HTB)
#define PG8_STAGE(bufoff, gbase, voff) do { _Pragma("unroll") for (int _i = 0; _i < 2; ++_i) \
        __builtin_amdgcn_global_load_lds((const unsigned*)((const char*)(gbase) + (voff)[_i]), (PG8_LAS unsigned*)(lds + (bufoff) + ldsw + _i * 8192), 16, 0, 0); } while (0)
#define PG8_STAGE_AC(b, h, base) PG8_STAGE(PG8_SA(b, h), base, roC[h])
#define PG8_STAGE_A2(b, h, base) PG8_STAGE(PG8_SA(b, h), base, r2[h])
#define PG8_LDA(dst, b, h) do { _Pragma("unroll") for (int m = 0; m < 4; ++m) _Pragma("unroll") for (int k = 0; k < 2; ++k) dst[m][k] = *(const PG8_LAS bf16x8*)(lds + PG8_SA(b, h) + aoff + m * 2048 + k * 1024); } while (0)
#define PG8_LDB(dst, b, h) do { _Pragma("unroll") for (int n = 0; n < 2; ++n) _Pragma("unroll") for (int k = 0; k < 2; ++k) dst[n][k] = *(const PG8_LAS bf16x8*)(lds + PG8_SB(b, h) + boff + n * 2048 + k * 1024); } while (0)
#define PG8_MMA(ai, bj, At, Bt) do { if (GATED && !(((cur.ab >> (ai)) & 1) && ((cur.ab >> (2 + (bj))) & 1))) break; __builtin_amdgcn_s_setprio(1); _Pragma("unroll") for (int m = 0; m < 4; ++m) _Pragma("unroll") for (int n = 0; n < 2; ++n) _Pragma("unroll") for (int k = 0; k < 2; ++k) \
        acc[ai][bj][m][n] = __builtin_amdgcn_mfma_f32_16x16x32_bf16(Bt[n][k], At[m][k], acc[ai][bj][m][n], 0, 0, 0); __builtin_amdgcn_s_setprio(0); } while (0)
#define PG8_WAIT_V(n) asm volatile("s_waitcnt vmcnt(" #n ")" ::: "memory")
#define PG8_WAIT_L(n) asm volatile("s_waitcnt lgkmcnt(" #n ")" ::: "memory")
#define PG8_BAR __builtin_amdgcn_s_barrier()
#define PG8_SCHED __builtin_amdgcn_sched_barrier(0)
    Unit cur, nxt; int ui = 0;
    if (!S.next(0, cur)) return;
    f32x4 acc[2][2][4][2];
#pragma unroll
    for (int a = 0; a < 2; ++a)
#pragma unroll
        for (int b = 0; b < 2; ++b)
#pragma unroll
            for (int m = 0; m < 4; ++m)
#pragma unroll
                for (int n = 0; n < 2; ++n) acc[a][b][m][n] = (f32x4){0.f, 0.f, 0.f, 0.f};
    bf16x8 At[4][2], B0[2][2], B1[2][2];
    unsigned roC[2][2], roN[2][2];
#pragma unroll
    for (int h = 0; h < 2; ++h)
#pragma unroll
        for (int i = 0; i < 2; ++i) { int R, C; stage_rc(tid * 16 + i * 8192, R, C); roC[h][i] = AO.off(cur, h, R, C, K); }
    const char* cA = (const char*)g.A + AO.base(cur, tstep); const char* cB = (const char*)g.Bt + (size_t)cur.pn * tstep;
    S.a_ready(cur);
    if constexpr (SP2) {
        PG8_STAGE(PG8_SB(0, 0), cB, voffB); PG8_STAGE(PG8_SB(0, 1), cB + hstep, voffB); PG8_STAGE_AC(0, 0, cA); PG8_STAGE_AC(0, 1, cA);
        if (wr == 1) PG8_BAR;
        PG8_WAIT_V(2); PG8_BAR;
        PG8_STAGE(PG8_SB(1, 0), cB + kstep, voffB); PG8_STAGE_AC(1, 0, cA + kstep); PG8_STAGE(PG8_SB(1, 1), cB + hstep + kstep, voffB);
        PG8_WAIT_V(6); PG8_BAR;
    } else {
        PG8_STAGE(PG8_SB(0, 0), cB, voffB); PG8_STAGE_AC(0, 0, cA); PG8_STAGE(PG8_SB(0, 1), cB + hstep, voffB); PG8_STAGE_AC(0, 1, cA);
        if (wr == 1) PG8_BAR;
        PG8_WAIT_V(4); PG8_BAR;
        PG8_STAGE(PG8_SB(1, 0), cB + kstep, voffB); PG8_STAGE_AC(1, 0, cA + kstep); PG8_STAGE(PG8_SB(1, 1), cB + hstep + kstep, voffB);
        PG8_WAIT_V(6); PG8_BAR;
    }
    for (;;) {
        const bool has_next = S.next(ui + 1, nxt);
        const char* nA = has_next ? (const char*)g.A + AO.base(nxt, tstep) : cA; const char* nB = has_next ? (const char*)g.Bt + (size_t)nxt.pn * tstep : cB;
#pragma unroll
        for (int h = 0; h < 2; ++h)
#pragma unroll
            for (int i = 0; i < 2; ++i) { if (AOff::GATHER && has_next) { int R, C; stage_rc(tid * 16 + i * 8192, R, C); roN[h][i] = AO.off(nxt, h, R, C, K); } else roN[h][i] = roC[h][i]; }
        auto kloop = [&](auto gated_tag) { constexpr bool GATED = decltype(gated_tag)::value;
        for (int t = 0; t < nt; t += 2) {
            const bool last = (t == nt - 2);
            const char* a1 = cA + (size_t)(t + 1) * kstep;
            const char* a2 = last ? nA : cA + (size_t)(t + 2) * kstep; const char* b2 = last ? nB : cB + (size_t)(t + 2) * kstep;
            unsigned r2[2][2];
#pragma unroll
            for (int h = 0; h < 2; ++h)
#pragma unroll
                for (int i = 0; i < 2; ++i) r2[h][i] = (AOff::GATHER && last) ? roN[h][i] : roC[h][i];
            const char* a3 = a2 + kstep; const char* b3 = b2 + kstep;
            if (last && has_next) S.a_ready(nxt);
            if constexpr (SP2) {
            PG8_LDB(B0, 0, 0); PG8_LDB(B1, 0, 1); PG8_SCHED; PG8_LDA(At, 0, 0); PG8_STAGE_AC(1, 1, a1);
            PG8_WAIT_V(8); PG8_WAIT_L(0); PG8_BAR; PG8_MMA(0, 0, At, B0); PG8_MMA(0, 1, At, B1); PG8_BAR; PG8_SCHED;
            PG8_LDA(At, 0, 1); PG8_STAGE(PG8_SB(0, 0), b2, voffB); PG8_STAGE(PG8_SB(0, 1), b2 + hstep, voffB); PG8_STAGE_A2(0, 0, a2);
            PG8_WAIT_V(8); PG8_WAIT_L(0); PG8_BAR; PG8_MMA(1, 0, At, B0); PG8_MMA(1, 1, At, B1); PG8_BAR; PG8_SCHED;
            PG8_LDB(B0, 1, 0); PG8_LDB(B1, 1, 1); PG8_SCHED; PG8_LDA(At, 1, 0); PG8_STAGE_A2(0, 1, a2);
            PG8_WAIT_V(8); PG8_WAIT_L(0); PG8_BAR; PG8_MMA(0, 0, At, B0); PG8_MMA(0, 1, At, B1); PG8_BAR; PG8_SCHED;
            PG8_LDA(At, 1, 1); PG8_STAGE(PG8_SB(1, 0), b3, voffB); PG8_STAGE(PG8_SB(1, 1), b3 + hstep, voffB); PG8_STAGE_A2(1, 0, a3);
            PG8_WAIT_V(8); PG8_WAIT_L(0); PG8_BAR; PG8_MMA(1, 0, At, B0); PG8_MMA(1, 1, At, B1); PG8_BAR; PG8_SCHED;
            } else {
            PG8_LDB(B0, 0, 0); PG8_SCHED; PG8_LDA(At, 0, 0); PG8_STAGE_AC(1, 1, a1);
            PG8_WAIT_L(8); PG8_BAR; PG8_WAIT_L(0); PG8_MMA(0, 0, At, B0); PG8_BAR; PG8_SCHED;
            PG8_LDB(B1, 0, 1); PG8_STAGE(PG8_SB(0, 0), b2, voffB);
            PG8_BAR; PG8_WAIT_L(0); PG8_MMA(0, 1, At, B1); PG8_BAR;
            PG8_LDA(At, 0, 1); PG8_STAGE_A2(0, 0, a2);
            PG8_BAR; PG8_WAIT_L(0); PG8_MMA(1, 0, At, B0); PG8_BAR; PG8_SCHED;
            PG8_STAGE(PG8_SB(0, 1), b2 + hstep, voffB);
            PG8_WAIT_V(6); PG8_BAR; PG8_MMA(1, 1, At, B1); PG8_BAR;
            PG8_LDB(B0, 1, 0); PG8_SCHED; PG8_LDA(At, 1, 0); PG8_STAGE_A2(0, 1, a2);
            PG8_WAIT_L(8); PG8_BAR; PG8_WAIT_L(0); PG8_MMA(0, 0, At, B0); PG8_BAR; PG8_SCHED;
            PG8_LDB(B1, 1, 1); PG8_STAGE(PG8_SB(1, 0), b3, voffB);
            PG8_BAR; PG8_WAIT_L(0); PG8_MMA(0, 1, At, B1); PG8_BAR;
            PG8_LDA(At, 1, 1); PG8_STAGE_A2(1, 0, a3);
            PG8_BAR; PG8_WAIT_L(0); PG8_MMA(1, 0, At, B0); PG8_BAR; PG8_SCHED;
            PG8_STAGE(PG8_SB(1, 1), b3 + hstep, voffB);
            PG8_WAIT_V(6); PG8_BAR; PG8_MMA(1, 1, At, B1); PG8_BAR;
            }
        }
        };
        if constexpr (Sched::HAS_SPLIT) { if (cur.ab == 15) kloop(std::false_type{}); else kloop(std::true_type{}); } else kloop(std::false_type{});
        if constexpr (ALIGN_EPI) { if (wr == 0) PG8_BAR; }
        if constexpr (!Epi::AFTER_DRAIN) { E(acc, cur, wr, wc, fr, fq); S.done(cur); }
        if (!has_next) break;
#pragma unroll
        for (int a = 0; a < 2; ++a)
#pragma unroll
            for (int b = 0; b < 2; ++b)
#pragma unroll
                for (int m = 0; m < 4; ++m)
#pragma unroll
                    for (int n = 0; n < 2; ++n) acc[a][b][m][n] = (f32x4){0.f, 0.f, 0.f, 0.f};
        cur = nxt; cA = nA; cB = nB; ++ui;
#pragma unroll
        for (int h = 0; h < 2; ++h)
#pragma unroll
            for (int i = 0; i < 2; ++i) roC[h][i] = roN[h][i];
        if constexpr (ALIGN_EPI) { if (wr == 1) PG8_BAR; }
    }
    PG8_WAIT_V(0);
    if constexpr (!ALIGN_EPI) { if (wr == 0) PG8_BAR; }
    PG8_BAR;
    if constexpr (Epi::AFTER_DRAIN) { E.fused(acc, cur, wr, wc, fr, fq, lds, wid, lane); S.done(cur); }
#undef PG8_SA
#undef PG8_STAGE_AC
#undef PG8_STAGE_A2
#undef PG8_SB
#undef PG8_STAGE
#undef PG8_LDA
#undef PG8_LDB
#undef PG8_MMA
#undef PG8_WAIT_V
#undef PG8_WAIT_L
#undef PG8_BAR
#undef PG8_SCHED
}
}

__device__ __forceinline__ void mini_barrier(unsigned* ctr, unsigned n) {
    asm volatile("s_waitcnt vmcnt(0)" ::: "memory");
    __syncthreads();
    if (threadIdx.x == 0) {
        __builtin_amdgcn_fence(__ATOMIC_RELEASE, "agent");
        asm volatile("s_waitcnt vmcnt(0)" ::: "memory");
        (void)xb_add(ctr, 1u);
        unsigned sp = 0u; while (xb_ld(ctr) < n) { __builtin_amdgcn_s_sleep(1); if (++sp > XB_SPIN_CAP) break; }
        __builtin_amdgcn_fence(__ATOMIC_ACQUIRE, "agent");
        asm volatile("s_waitcnt vmcnt(0)" ::: "memory");
    }
    __syncthreads();
}
constexpr int CW_MINI = 16384;
__device__ __forceinline__ void ph_setup(const Prm& p, LAS float* lds) {
    float* modv = (float*)(p.ws + WS_MODV);
    float* rope = (float*)(p.ws + WS_ROPE);
    const int tid = otid();
    LAS float* sc = lds;
    LAS float* red = lds + 5 * 1024;
    for (int i = tid; i < 5 * 1024; i += NTHREADS) { const int r = i >> 10, k = i & 1023; const float v = r < 4 ? p.c[r * 1024 + k] : p.c_ctx[k]; sc[i] = siluf_(v); }
    __syncthreads();
    const int nitems = DEPTH * 6144 / 128;
    for (int it = obid(); it < nitems; it += gridDim.x) {
        const int l = it / 48, n0 = (it % 48) * 128;
        const int kp = tid >> 5, q = tid & 31;
        const float* w = p.mod_w + ((size_t)l * 1024 + kp * 64) * 6144 + n0 + 4 * q;
        f32x4 a[5];
#pragma unroll
        for (int r = 0; r < 5; ++r) a[r] = (f32x4){0.f, 0.f, 0.f, 0.f};
#pragma unroll 1
        for (int k0 = 0; k0 < 64; k0 += 8) { f32x4 wv[8];
#pragma unroll
            for (int k = 0; k < 8; ++k) wv[k] = __builtin_nontemporal_load((const f32x4*)(w + (size_t)(k0 + k) * 6144));
#pragma unroll
            for (int k = 0; k < 8; ++k) { const int kk = kp * 64 + k0 + k;
#pragma unroll
                for (int r = 0; r < 5; ++r) a[r] += wv[k] * sc[r * 1024 + kk]; } }
#pragma unroll
        for (int r = 0; r < 5; ++r) *(LAS f32x4*)(red + ((kp * 5 + r) * 128 + 4 * q)) = a[r];
        __syncthreads();
        for (int i = tid; i < 5 * 128; i += NTHREADS) { const int r = i >> 7, n = i & 127; float s = p.mod_b[l * 6144 + n0 + n];
#pragma unroll
            for (int q2 = 0; q2 < 16; ++q2) s += red[(q2 * 5 + r) * 128 + n];
            modv[((size_t)l * 5 + r) * 6144 + n0 + n] = s; }
        __syncthreads();
    }
    if (obid() == gridDim.x - 1) {
        for (int i = tid; i < 64 * 16; i += NTHREADS) { const int pos = i >> 4, f = i & 15; const float inv = exp2f(-(float)f * (13.287712379549449f / 16.f)); const float ang = (float)pos * inv;
            rope[i * 2] = __cosf(ang); rope[i * 2 + 1] = __sinf(ang); }
    }
}

#define CJ(jj) (8 * lane + 512 * ((jj) >> 1) + 4 * ((jj) & 1))
__device__ __forceinline__ void acc_bf16x8(f32x4& lo, f32x4& hi, const u32x4 w, float f) {
    lo.x += f * __uint_as_float(w.x << 16); lo.y += f * __uint_as_float(w.x & 0xffff0000u); lo.z += f * __uint_as_float(w.y << 16); lo.w += f * __uint_as_float(w.y & 0xffff0000u);
    hi.x += f * __uint_as_float(w.z << 16); hi.y += f * __uint_as_float(w.z & 0xffff0000u); hi.z += f * __uint_as_float(w.w << 16); hi.w += f * __uint_as_float(w.w & 0xffff0000u);
}
__device__ __forceinline__ u32x4 pack_bf16x8(const f32x4 lo, const f32x4 hi) { u32x4 o; o.x = pk2(lo.x, lo.y); o.y = pk2(lo.z, lo.w); o.z = pk2(hi.x, hi.y); o.w = pk2(hi.z, hi.w); return o; }
__device__ __forceinline__ void load_xrow(const bf16* xrow, int lane, f32x4 (&v)[4]) {
#pragma unroll
    for (int j2 = 0; j2 < 2; ++j2) { const u32x4 w = __builtin_nontemporal_load((const u32x4*)(xrow + 8 * lane + 512 * j2)); v[2 * j2] = (f32x4){0.f, 0.f, 0.f, 0.f}; v[2 * j2 + 1] = (f32x4){0.f, 0.f, 0.f, 0.f}; acc_bf16x8(v[2 * j2], v[2 * j2 + 1], w, 1.f); }
}
__device__ __forceinline__ void store_xrow(bf16* xrow, int lane, const f32x4 (&v)[4]) {
#pragma unroll
    for (int j2 = 0; j2 < 2; ++j2) *(u32x4*)(xrow + 8 * lane + 512 * j2) = pack_bf16x8(v[2 * j2], v[2 * j2 + 1]);
}
struct Sel4 { const bf16* y[4]; float f[4]; unsigned long long rest; };
__device__ __forceinline__ Sel4 moe_sel4(const bf16* YE, int sl, int lane) {
    Sel4 q; unsigned long long m = __ballot(sl >= 0); int e0 = 0, s0 = 0;
#pragma unroll
    for (int k = 0; k < 4; ++k) { const bool has = m != 0; const int e = has ? __builtin_ctzll(m) : e0; if (has) m &= m - 1; const int s = __builtin_amdgcn_readlane(sl, e);
        if (k == 0) { e0 = e; s0 = has ? s : 0; }
        q.y[k] = YE + ((size_t)(has ? e : e0) * XR + (has ? s : s0)) * D + 8 * lane; q.f[k] = has ? 1.f : 0.f; }
    q.rest = m; return q;
}
__device__ __forceinline__ void moe_load4(const Sel4& q, u32x4 (&w)[4][2]) {
#pragma unroll
    for (int k = 0; k < 4; ++k)
#pragma unroll
        for (int j = 0; j < 2; ++j) w[k][j] = __builtin_nontemporal_load((const u32x4*)(q.y[k] + 512 * j));
}
__device__ __forceinline__ void moe_acc4(const Sel4& q, const u32x4 (&w)[4][2], f32x4 (&a)[4]) {
#pragma unroll
    for (int jj = 0; jj < 4; ++jj) a[jj] = (f32x4){0.f, 0.f, 0.f, 0.f};
#pragma unroll
    for (int k = 0; k < 4; ++k)
#pragma unroll
        for (int j = 0; j < 2; ++j) acc_bf16x8(a[2 * j], a[2 * j + 1], w[k][j], q.f[k]);
}
__device__ __forceinline__ void moe_gather_rest(const bf16* YE, int sl, unsigned long long m, int lane, f32x4 (&a)[4]) {
    while (m) { const int e = __builtin_ctzll(m); m &= m - 1; const int s = __builtin_amdgcn_readlane(sl, e); const bf16* y = YE + ((size_t)e * XR + s) * D + 8 * lane;
#pragma unroll
        for (int j = 0; j < 2; ++j) { const u32x4 w = *(const u32x4*)(y + 512 * j); acc_bf16x8(a[2 * j], a[2 * j + 1], w, 1.f); } }
}
__device__ __forceinline__ void norm1_pair(const Prm& p, int l, int r, int lane, bool comb_ctx, bool wb) {
    const float* modv = (const float*)(p.ws + WS_MODV) + (size_t)l * 5 * 6144;
    const float* modp = (const float*)(p.ws + WS_MODV) + (size_t)(l > 0 ? l - 1 : 0) * 5 * 6144;
    bf16* X = (bf16*)(p.ws + WS_X); bf16* H = (bf16*)(p.ws + WS_H); const int* tokslot = (const int*)(p.ws + WS_TOKSLOT); const bf16* YE = (const bf16*)(p.ws + WS_YE);
    const bool isc = r >= ML; const int mr = isc ? 4 : (r >> 12);
    f32x4 v[2][4];
    if (l == 0) { const float* src = isc ? p.ctx + (size_t)(r - ML) * D : p.x + (size_t)r * D;
#pragma unroll
        for (int u = 0; u < 2; ++u)
#pragma unroll
            for (int j = 0; j < 4; ++j) v[u][j] = __builtin_nontemporal_load((const f32x4*)(src + (size_t)u * D + CJ(j)));
    } else {
        const bool comb = !isc || comb_ctx;
        int sl0 = -1, sl1 = -1; if (comb && lane < NE) { sl0 = tokslot[(size_t)r * NE + lane]; sl1 = tokslot[(size_t)(r + 1) * NE + lane]; }
        load_xrow(X + (size_t)r * D, lane, v[0]); load_xrow(X + (size_t)(r + 1) * D, lane, v[1]);
        if (comb) { const Sel4 q0 = moe_sel4(YE, sl0, lane), q1 = moe_sel4(YE, sl1, lane); u32x4 w0[4][2], w1[4][2]; moe_load4(q0, w0); moe_load4(q1, w1);
            f32x4 a0[4], a1[4]; moe_acc4(q0, w0, a0); moe_acc4(q1, w1, a1);
            if (q0.rest) moe_gather_rest(YE, sl0, q0.rest, lane, a0); if (q1.rest) moe_gather_rest(YE, sl1, q1.rest, lane, a1);
#pragma unroll
            for (int j = 0; j < 4; ++j) { const f32x4 g2 = *(const f32x4*)(modp + (size_t)mr * 6144 + 5 * 1024 + CJ(j)); v[0][j] += g2 * a0[j]; v[1][j] += g2 * a1[j]; }
            if (wb) { store_xrow(X + (size_t)r * D, lane, v[0]); store_xrow(X + (size_t)(r + 1) * D, lane, v[1]); } }
    }
#pragma unroll
    for (int u = 0; u < 2; ++u) { float s = 0.f;
#pragma unroll
        for (int j = 0; j < 4; ++j) s += v[u][j].x * v[u][j].x + v[u][j].y * v[u][j].y + v[u][j].z * v[u][j].z + v[u][j].w * v[u][j].w;
        const float rstd = rsqrtf(wave_sum(s) * (1.f / D) + EPS);
        f32x4 hh[4];
#pragma unroll
        for (int j = 0; j < 4; ++j) { const int c = CJ(j);
            const f32x4 g = *(const f32x4*)(p.norm1_g + l * D + c), sh = *(const f32x4*)(modv + (size_t)mr * 6144 + c), scl = *(const f32x4*)(modv + (size_t)mr * 6144 + 1024 + c);
            hh[j] = (v[u][j] * rstd * g) * (scl + 1.f) + sh; }
#pragma unroll
        for (int j2 = 0; j2 < 2; ++j2) *(u32x4*)(H + (size_t)(r + u) * D + 8 * lane + 512 * j2) = pack_bf16x8(hh[2 * j2], hh[2 * j2 + 1]); }
}
__device__ __forceinline__ void ph_norm1(const Prm& p, int l, bool wb = true) {
    const int lane = otid() & 63, ngw = gridDim.x * 8, gw = ngw - 1 - (obid() * 8 + (otid() >> 6));
    const int nrows = (l <= 2) ? MT : ML;
    const bool comb_ctx = (l >= 1 && l <= 2);
    for (int r = gw * 2; r < nrows; r += ngw * 2) norm1_pair(p, l, r, lane, comb_ctx, wb);
}
__device__ __forceinline__ void ph_final(const Prm& p) {
    const int lane = otid() & 63, gw = obid() * 8 + (otid() >> 6), ngw = gridDim.x * 8;
    const float* modp = (const float*)(p.ws + WS_MODV) + (size_t)3 * 5 * 6144;
    const bf16* X = (const bf16*)(p.ws + WS_X); const int* tokslot = (const int*)(p.ws + WS_TOKSLOT); const bf16* YE = (const bf16*)(p.ws + WS_YE);
    for (int r = gw * 2; r < ML; r += ngw * 2) {
        const int mr = r >> 12; f32x4 v[2][4];
        int sl0 = -1, sl1 = -1; if (lane < NE) { sl0 = tokslot[(size_t)r * NE + lane]; sl1 = tokslot[(size_t)(r + 1) * NE + lane]; }
        load_xrow(X + (size_t)r * D, lane, v[0]); load_xrow(X + (size_t)(r + 1) * D, lane, v[1]);
        const Sel4 q0 = moe_sel4(YE, sl0, lane), q1 = moe_sel4(YE, sl1, lane); u32x4 w0[4][2], w1[4][2]; moe_load4(q0, w0); moe_load4(q1, w1);
        f32x4 a0[4], a1[4]; moe_acc4(q0, w0, a0); moe_acc4(q1, w1, a1);
        if (q0.rest) moe_gather_rest(YE, sl0, q0.rest, lane, a0); if (q1.rest) moe_gather_rest(YE, sl1, q1.rest, lane, a1);
#pragma unroll
        for (int j = 0; j < 4; ++j) { const f32x4 g2 = *(const f32x4*)(modp + (size_t)mr * 6144 + 5 * 1024 + CJ(j));
            *(f32x4*)(p.out + (size_t)r * D + CJ(j)) = v[0][j] + g2 * a0[j]; *(f32x4*)(p.out + (size_t)(r + 1) * D + CJ(j)) = v[1][j] + g2 * a1[j]; }
    }
}

__device__ __forceinline__ unsigned cvtpk_(float lo, float hi) { unsigned r; asm volatile("v_cvt_pk_bf16_f32 %0, %1, %2" : "=v"(r) : "v"(lo), "v"(hi)); return r; }
__device__ __forceinline__ void cvt_item(const float* W, int N, bf16* WT, int gu, LAS unsigned char* img, int item, int tid) {
    const int nblk = N / 512, kb = item / nblk, nb = item % nblk, k0 = 64 * kb, n0 = 512 * nb;
    const int lane = tid & 63, w = tid >> 6;
    const float* src = W + (size_t)(k0 + 8 * w) * N + n0 + 4 * lane;
    f32x4 a[4][2], b[4][2];
#pragma unroll
    for (int j = 0; j < 4; ++j)
#pragma unroll
        for (int hh = 0; hh < 2; ++hh) { a[j][hh] = __builtin_nontemporal_load((const f32x4*)(src + (size_t)(2 * j) * N + 256 * hh)); b[j][hh] = __builtin_nontemporal_load((const f32x4*)(src + (size_t)(2 * j + 1) * N + 256 * hh)); }
    __syncthreads();
    const int sw = (lane >> 1) & 7;
#pragma unroll
    for (int hh = 0; hh < 2; ++hh)
#pragma unroll
        for (int j = 0; j < 4; ++j) { const int wofs = ((w ^ sw) * 4 + j) * 4;
            LAS unsigned char* rowp = img + (size_t)(4 * lane + 256 * hh) * 144 + wofs;
            *(LAS unsigned*)(rowp) = cvtpk_(a[j][hh].x, b[j][hh].x); *(LAS unsigned*)(rowp + 144) = cvtpk_(a[j][hh].y, b[j][hh].y);
            *(LAS unsigned*)(rowp + 288) = cvtpk_(a[j][hh].z, b[j][hh].z); *(LAS unsigned*)(rowp + 432) = cvtpk_(a[j][hh].w, b[j][hh].w); }
    __syncthreads();
    const int jq = tid & 7, nr = tid >> 3;
#pragma unroll
    for (int i = 0; i < 8; ++i) { const int n = nr + 64 * i; const u32x4 v = *(const LAS u32x4*)(img + n * 144 + ((jq ^ ((n >> 3) & 7)) * 16));
        const int ncol = n0 + n; int drow;
        if (gu < 0) drow = ncol; else if (gu < 2) drow = (ncol >> 7) * 256 + (ncol & 127) + gu * 128;
        else { const int ch = (ncol - 1024) & 1023; drow = ncol < 1024 ? ncol : 1024 + (ch >> 7) * 256 + (ncol >= 2048 ? 128 : 0) + (ch & 127); }
        *(u32x4*)(WT + (size_t)drow * 1024 + k0 + 8 * jq) = v; }
}
__device__ __forceinline__ void ph_convert(const Prm& p, int l, LAS unsigned char* lds) {
    const int tid = otid();
    const bool even = (l & 1) == 0; const int Nin = even ? 4096 : 3072;
    const float* Win = even ? p.even_w_in + (size_t)(l / 2) * D * 4096 : p.conv_w_in + (size_t)(l / 2) * D * 3072;
    const float* Wout = even ? p.even_w_out + (size_t)(l / 2) * D * D : p.conv_w_out + (size_t)(l / 2) * D * D;
    const int I_IN = 16 * (Nin / 512), I_OUT = 32, I_E = 32;
    const int total = I_IN + I_OUT + NE * 3 * I_E;
    for (int it = obid(); it < total; it += gridDim.x) {
        int r = it;
        if (r < I_IN) { cvt_item(Win, Nin, (bf16*)(p.ws + WS_WIN), even ? -1 : 2, lds, r, tid); continue; } r -= I_IN;
        if (r < I_OUT) { cvt_item(Wout, D, (bf16*)(p.ws + WS_WOUT), -1, lds, r, tid); continue; } r -= I_OUT;
        const int e = r / (3 * I_E), w = (r / I_E) % 3, item = r % I_E;
        if (w < 2) cvt_item((w == 0 ? p.w_gate : p.w_up) + ((size_t)l * NE + e) * D * FF, FF, (bf16*)(p.ws + WS_WUP) + (size_t)e * 2048 * D, w, lds, item, tid);
        else cvt_item(p.w_down + ((size_t)l * NE + e) * FF * D, D, (bf16*)(p.ws + WS_WDN) + (size_t)e * D * FF, -1, lds, item, tid);
    }
    __syncthreads();
}

template <int MODE> __device__ __forceinline__ void ph_probe_read(const Prm& p, int l) {
    const f32x4* s0 = (const f32x4*)(p.w_gate + (size_t)l * NE * D * FF);
    const f32x4* s1 = (const f32x4*)(p.w_up + (size_t)l * NE * D * FF); const f32x4* s2 = (const f32x4*)(p.w_down + (size_t)l * NE * D * FF);
    const size_t n4 = (size_t)NE * D * FF / 4; f32x4 acc = (f32x4){0.f, 0.f, 0.f, 0.f};
    if (MODE == 0 || MODE == 1) {
        const size_t st = (size_t)gridDim.x * NTHREADS;
        for (size_t i = (size_t)obid() * NTHREADS + otid(); i < n4; i += st * 4) {
#pragma unroll
            for (int t = 0; t < 3; ++t) { const f32x4* s = t == 0 ? s0 : (t == 1 ? s1 : s2);
#pragma unroll
                for (int k = 0; k < 4; ++k) { const size_t j = i + k * st; if (j < n4) acc += (MODE == 1) ? __builtin_nontemporal_load(s + j) : s[j]; } } }
    } else {
        constexpr int NL = MODE == 2 ? 16 : 32; const int lane = otid() & 63; const size_t gw = (size_t)obid() * 8 + (otid() >> 6), ngw = (size_t)gridDim.x * 8;
        const size_t nch = 3 * n4 / (64 * NL);
        for (size_t c = gw; c < nch; c += ngw) { const size_t base = c * 64 * NL; const f32x4* s = base < n4 ? s0 + base : (base < 2 * n4 ? s1 + (base - n4) : s2 + (base - 2 * n4));
            f32x4 v[NL];
#pragma unroll
            for (int k = 0; k < NL; ++k) v[k] = __builtin_nontemporal_load(s + k * 64 + lane);
#pragma unroll
            for (int k = 0; k < NL; ++k) acc += v[k]; }
    }
    if (acc.x + acc.y + acc.z + acc.w == 1.2345e33f) ((float*)(p.ws + WS_OF))[otid()] = acc.x;
}
template <int MODE> __device__ __forceinline__ void ph_probe_cvt(const Prm& p, int l) {
    const int lane = otid() & 63, gw = obid() * 8 + (otid() >> 6), ngw = gridDim.x * 8; f32x4 acc = (f32x4){0.f, 0.f, 0.f, 0.f};
    for (int it = gw; it < NE * 3 * 256; it += ngw) { const int e = it / 768, w = (it / 256) % 3, item = it % 256, kb = item / 16, nb = item % 16;
        if (MODE == 4) { const float* W = (w == 0 ? p.w_gate : (w == 1 ? p.w_up : p.w_down)) + ((size_t)l * NE + e) * D * FF; const float* src = W + (size_t)(64 * kb + 2 * (lane >> 4)) * 1024 + 64 * nb + 4 * (lane & 15);
#pragma unroll
            for (int j = 0; j < 8; ++j) { acc += __builtin_nontemporal_load((const f32x4*)(src + (size_t)(8 * j) * 1024)); acc += __builtin_nontemporal_load((const f32x4*)(src + (size_t)(8 * j + 1) * 1024)); } }
        else { bf16* WT = (bf16*)(p.ws + WS_OF) + (size_t)((e * 3 + w) % 16) * 1024 * 1024; const u32x4 v = {(unsigned)it, 1u, 2u, 3u};
#pragma unroll
            for (int i = 0; i < 8; ++i) { const int n = (lane >> 3) + 8 * i; *(u32x4*)(WT + (size_t)(64 * nb + n) * 1024 + 64 * kb + 8 * (lane & 7)) = v; } } }
    if (acc.x + acc.y + acc.z + acc.w == 1.2345e33f) ((float*)(p.ws + WS_OF))[otid()] = acc.x;
}
__device__ __forceinline__ void ph_gemm_in(const Prm& p, int l, LAS unsigned char* ldsb) {
    const bool even = (l & 1) == 0; const int N = even ? 4096 : 3072; const int M = (l <= 2) ? MT : ML;
    pg8::Gemm g{(const bf16*)(p.ws + WS_H), (const bf16*)(p.ws + WS_WIN), M, N, D};
    if (even) { pg8::StaticOrderT<4> S; S.init(M, N, (int)gridDim.x, obid(), ML); pg8::EpiBf16 E{(bf16*)(p.ws + WS_PROJ), N}; pg8::gemm_phase<pg8::EpiBf16, pg8::StaticOrderT<4>, true, true>(ldsb, g, S, E); }
    else { pg8::StaticOrderT<2> S; S.init(M, N, (int)gridDim.x, obid(), ML); pg8::EpiConvIn E{(bf16*)(p.ws + WS_PROJ)}; pg8::gemm_phase<pg8::EpiConvIn, pg8::StaticOrderT<2>, true, true>(ldsb, g, S, E); }
}
__device__ __forceinline__ void ph_gemm_out(const Prm& p, int l, LAS unsigned char* ldsb) {
    const int M = ML;
    pg8::Gemm g{(const bf16*)(p.ws + WS_MIX), (const bf16*)(p.ws + WS_WOUT), M, D, D}; pg8::StaticOrder S; S.init(M, D, (int)gridDim.x, obid());
    pg8::EpiGY E{(bf16*)(p.ws + WS_H), (const float*)(p.ws + WS_MODV) + (size_t)l * 5 * 6144 + 2 * 1024, ML};
    pg8::gemm_phase<pg8::EpiGY, pg8::StaticOrder, true, true>(ldsb, g, S, E);
}
__device__ __forceinline__ void ph_expert_up(const Prm& p, int l, LAS unsigned char* ldsb) {
    pg8::Gemm g{(const bf16*)(p.ws + WS_H2), (const bf16*)(p.ws + WS_WUP), NE * XR, NE * 2048, D};
    pg8::GroupOrderT<8, 0> S; S.init((l < 2) ? 9 : 8, NE, (int)gridDim.x, vcu_id());
    pg8::EpiSwiglu E{(bf16*)(p.ws + WS_ACT), 8};
    pg8::GatherA AO{(const int*)(p.ws + WS_SEL), XR, 9, (l < 2) ? 2176 : 2048};
    pg8::gemm_phase<pg8::EpiSwiglu, pg8::GroupOrderT<8, 0>, true, true, pg8::GatherA>(ldsb, g, S, E, AO);
}
__device__ __forceinline__ void ph_expert_down(const Prm& p, int l, LAS unsigned char* ldsb) {
    pg8::Gemm g{(const bf16*)(p.ws + WS_ACT), (const bf16*)(p.ws + WS_WDN), NE * XR, NE * 1024, FF};
    pg8::GroupOrderT<4, 1> S; S.init((l < 2) ? 9 : 8, NE, (int)gridDim.x, vcu_id());
    pg8::EpiDown E{(bf16*)(p.ws + WS_YE), (const float*)(p.ws + WS_GATE), 4};
    pg8::gemm_phase<pg8::EpiDown, pg8::GroupOrderT<4, 1>, true, true>(ldsb, g, S, E);
}

__device__ __forceinline__ void ph_qkprep(const Prm& p, int l) {
    const int e = l / 2; bf16* PROJ = (bf16*)(p.ws + WS_PROJ); const float* rope = (const float*)(p.ws + WS_ROPE);
    const int NQK0 = gridDim.x == 256 ? 64 : 0;
    if (obid() < NQK0) return;
    const int j = otid() & 7, ngrp = ((int)gridDim.x - NQK0) * (NTHREADS / 8);
    const float* kg = p.kn_g + e * 64;
    const f32x4 g0 = *(const f32x4*)(kg + 8 * j), g1 = *(const f32x4*)(kg + 8 * j + 4);
    const float gg[8] = {g0.x, g0.y, g0.z, g0.w, g1.x, g1.y, g1.z, g1.w};
    const int total = MT * 8;
    for (int g = ((obid() - NQK0) * NTHREADS + otid()) >> 3; g < total; g += ngrp) {
        const int r = g >> 3, hm = g & 7;
        bf16* ptr = PROJ + (size_t)r * 4096 + 2560 + 512 + hm * 64 + 8 * j;
        const u32x4 w = *(const u32x4*)ptr; const unsigned ww[4] = {w.x, w.y, w.z, w.w};
        float v[8];
#pragma unroll
        for (int m = 0; m < 4; ++m) { v[2 * m] = __uint_as_float(ww[m] << 16); v[2 * m + 1] = __uint_as_float(ww[m] & 0xffff0000u); }
        float s = 0.f;
#pragma unroll
        for (int m = 0; m < 8; ++m) s += v[m] * v[m];
        s += __shfl_xor(s, 1); s += __shfl_xor(s, 2); s += __shfl_xor(s, 4);
        const float rstd = rsqrtf(s * (1.f / 64.f) + EPS);
#pragma unroll
        for (int m = 0; m < 8; ++m) v[m] *= rstd * gg[m];
        if (r < ML) { const int t = r & 4095, pos = (j & 4) ? (t & 63) : (t >> 6);
            const float* rp = rope + (pos * 16 + 8 * (j & 1)) * 2; const f32x4 c0 = *(const f32x4*)rp, c1 = *(const f32x4*)(rp + 4), c2 = *(const f32x4*)(rp + 8), c3 = *(const f32x4*)(rp + 12);
            const float cs[16] = {c0.x, c0.y, c0.z, c0.w, c1.x, c1.y, c1.z, c1.w, c2.x, c2.y, c2.z, c2.w, c3.x, c3.y, c3.z, c3.w};
            const float sg = (j & 2) ? 1.f : -1.f;
#pragma unroll
            for (int m = 0; m < 8; ++m) { const float pv = __shfl_xor(v[m], 2); v[m] = v[m] * cs[2 * m] + sg * pv * cs[2 * m + 1]; } }
        *(u32x4*)ptr = (u32x4){cvtpk_(v[0], v[1]), cvtpk_(v[2], v[3]), cvtpk_(v[4], v[5]), cvtpk_(v[6], v[7])};
    }
}

__device__ __forceinline__ void ph_hgrn_naive(const Prm& p, int l, LAS float* lds) {
    const int ev = l / 2; const bf16* PROJ = (const bf16*)(p.ws + WS_PROJ); float* OF = (float*)(p.ws + WS_OF);
    const int tid = otid(), el = tid >> 4, dg = tid & 15;
    LAS float* sq = lds;
    LAS float* sk = lds + 64 * 128;
    LAS float* sf = lds + 2 * 64 * 128;
    LAS float* sv = lds + 3 * 64 * 128;
    for (int it = obid(); it < 128; it += gridDim.x) {
        const int b = it >> 5, h = (it >> 3) & 3, dir = (it >> 2) & 1, eq = it & 3;
        float S[8];
#pragma unroll
        for (int j = 0; j < 8; ++j) S[j] = 0.f;
        for (int c0 = 0; c0 < (TC + T) / 64; ++c0) {
            const bool isc = c0 < 4; const int step0 = isc ? c0 * 64 : (c0 - 4) * 64; const int len = isc ? TC : T; const int rbase = isc ? ML + b * TC : b * T;
            __syncthreads();
            for (int i = tid; i < 64 * 128; i += NTHREADS) { const int s = i >> 7, d = i & 127; const int tt = dir ? (len - 1 - (step0 + s)) : (step0 + s);
                const bf16* row = PROJ + (size_t)(rbase + tt) * 4096; const int col = h * 128 + d;
                float lb = 0.f;
                if (ev == 1) { const float l0 = p.hgrn_lb[(0 * 2 + dir) * 512 + col], l1 = p.hgrn_lb[(1 * 2 + dir) * 512 + col]; lb = 1.f / (1.f + __expf(l0 - l1)); }
                const float z = bf2f(row[512 + dir * 512 + col]); const float sg = sigmoidf_(z);
                const float f = lb + (1.f - lb) * sg;
                sq[i] = bf2f(row[col]); sf[i] = f; sk[i] = 1.f - f; }
            for (int i = tid; i < 64 * 32; i += NTHREADS) { const int s = i >> 5, e2 = i & 31; const int tt = dir ? (len - 1 - (step0 + s)) : (step0 + s);
                sv[i] = bf2f(PROJ[(size_t)(rbase + tt) * 4096 + 1536 + h * 128 + eq * 32 + e2]); }
            __syncthreads();
#pragma unroll 1
            for (int s = 0; s < 64; ++s) {
                const f32x4 q0 = *(const LAS f32x4*)(sq + s * 128 + dg * 8), q1 = *(const LAS f32x4*)(sq + s * 128 + dg * 8 + 4);
                const f32x4 k0 = *(const LAS f32x4*)(sk + s * 128 + dg * 8), k1 = *(const LAS f32x4*)(sk + s * 128 + dg * 8 + 4);
                const f32x4 f0 = *(const LAS f32x4*)(sf + s * 128 + dg * 8), f1 = *(const LAS f32x4*)(sf + s * 128 + dg * 8 + 4);
                const float v = sv[s * 32 + el];
                S[0] = f0.x * S[0] + k0.x * v; S[1] = f0.y * S[1] + k0.y * v; S[2] = f0.z * S[2] + k0.z * v; S[3] = f0.w * S[3] + k0.w * v;
                S[4] = f1.x * S[4] + k1.x * v; S[5] = f1.y * S[5] + k1.y * v; S[6] = f1.z * S[6] + k1.z * v; S[7] = f1.w * S[7] + k1.w * v;
                float o = q0.x * S[0] + q0.y * S[1] + q0.z * S[2] + q0.w * S[3] + q1.x * S[4] + q1.y * S[5] + q1.z * S[6] + q1.w * S[7];
                o += __shfl_xor(o, 1); o += __shfl_xor(o, 2); o += __shfl_xor(o, 4); o += __shfl_xor(o, 8);
                if (dg == 0) { const int tt = dir ? (len - 1 - (step0 + s)) : (step0 + s); OF[((size_t)dir * MT + rbase + tt) * 512 + h * 128 + eq * 32 + el] = o; }
            }
        }
        __syncthreads();
    }
}
__device__ __forceinline__ void ph_hgrn_readout(const Prm& p, int l) {
    const int ev = l / 2; const bf16* PROJ = (const bf16*)(p.ws + WS_PROJ); const float* OF = (const float*)(p.ws + WS_OF); bf16* MIX = (bf16*)(p.ws + WS_MIX);
    const int lane = otid() & 63, gw = obid() * 8 + (otid() >> 6), ngw = gridDim.x * 8;
    const int nrows = (l < 2) ? MT : ML;
    for (int g = gw; g < nrows * 4; g += ngw) { const int r = g >> 2, h = g & 3;
        const float o0 = OF[(size_t)r * 512 + h * 128 + lane] + OF[((size_t)MT + r) * 512 + h * 128 + lane];
        const float o1 = OF[(size_t)r * 512 + h * 128 + 64 + lane] + OF[((size_t)MT + r) * 512 + h * 128 + 64 + lane];
        const float rstd = rsqrtf(wave_sum(o0 * o0 + o1 * o1) * (1.f / 128.f) + EPS);
        const float g0 = p.hgrn_g[(ev * 4 + h) * 128 + lane], g1 = p.hgrn_g[(ev * 4 + h) * 128 + 64 + lane];
        const float ga0 = bf2f(PROJ[(size_t)r * 4096 + 2048 + h * 128 + lane]), ga1 = bf2f(PROJ[(size_t)r * 4096 + 2048 + h * 128 + 64 + lane]);
        MIX[(size_t)r * D + h * 128 + lane] = f2bf(o0 * rstd * g0 * siluf_(ga0)); MIX[(size_t)r * D + h * 128 + 64 + lane] = f2bf(o1 * rstd * g1 * siluf_(ga1)); }
}

namespace dat {
using bf16x8 = __attribute__((ext_vector_type(8))) short;
using s16x4  = __attribute__((ext_vector_type(4))) short;
using f32x16 = __attribute__((ext_vector_type(16))) float;
constexpr int SHM_V = 64 * 128 * 2, SHM_K = 64 * 128 * 2;
#define DKSWZ(row, colB) ((row) * 256 + ((colB) ^ (((row) & 7) << 4)))
__device__ __forceinline__ int crow(int r, int hi) { return (r & 3) + 8 * (r >> 2) + 4 * hi; }
__device__ __forceinline__ unsigned cvtpk(float lo, float hi) { unsigned r; asm volatile("v_cvt_pk_bf16_f32 %0, %1, %2" : "=v"(r) : "v"(lo), "v"(hi)); return r; }
__device__ __forceinline__ int v_st(int k, int c) { const int kk = (k & ~0xC) | ((k & 4) << 1) | ((k & 8) >> 1); return ((kk >> 3) * 4 + (c >> 5)) * 512 + ((kk & 7) * 32 + (c & 31)) * 2; }
__device__ __forceinline__ int v_rd_base(int lane) { return ((lane & 3) << 3) | (((lane >> 2) & 3) << 6) | (((lane >> 4) & 1) << 5) | (((lane >> 5) & 1) << 8); }
constexpr int v_rd_off(int d0, int ks, int half) { return d0 * 512 + ks * 4096 + half * 2048; }
template <int OFF> __device__ __forceinline__ s16x4 tr_read(int vb) { s16x4 r; asm volatile("ds_read_b64_tr_b16 %0, %1 offset:%2" : "=&v"(r) : "v"(vb), "i"(OFF) : "memory"); return r; }
template <int VAR> __device__ __forceinline__ void softmax_pack(f32x16& p0, f32x16& p1, float negb, float& l, bf16x8& pa0, bf16x8& pa1, bf16x8& pa2, bf16x8& pa3) {
    if (VAR == 5) {
#pragma unroll
    for (int r = 0; r < 16; ++r) { p0[r] = __builtin_amdgcn_exp2f(p0[r]); p1[r] = __builtin_amdgcn_exp2f(p1[r]); } }
    else if (VAR != 1) {
#pragma unroll
    for (int r = 0; r < 16; ++r) { p0[r] = __builtin_amdgcn_exp2f(p0[r] + negb); p1[r] = __builtin_amdgcn_exp2f(p1[r] + negb); } }
    float ps = 0.f;
#pragma unroll
    for (int r = 0; r < 16; ++r) ps += p0[r] + p1[r];
    { auto rr = __builtin_amdgcn_permlane32_swap(__float_as_uint(ps), __float_as_uint(ps), false, false); ps = __uint_as_float(rr[0]) + __uint_as_float(rr[1]); }
    l += ps;
#define DPK4(P, BASE, OUT) do { unsigned a0 = cvtpk(P[BASE + 0], P[BASE + 1]), a1 = cvtpk(P[BASE + 2], P[BASE + 3]);   \
    unsigned b0 = cvtpk(P[BASE + 4], P[BASE + 5]), b1 = cvtpk(P[BASE + 6], P[BASE + 7]);                              \
    auto r0 = __builtin_amdgcn_permlane32_swap(a0, b0, false, false); auto r1 = __builtin_amdgcn_permlane32_swap(a1, b1, false, false); \
    u32x4 w = {r0[0], r1[0], r0[1], r1[1]}; OUT = *reinterpret_cast<bf16x8*>(&w); } while (0)
    DPK4(p0, 0, pa0); DPK4(p0, 8, pa1); DPK4(p1, 0, pa2); DPK4(p1, 8, pa3);
#undef DPK4
}
template <int D0> __device__ __forceinline__ void pv_one(f32x16& oa, int vb, const bf16x8 (&pa)[4]) {
    const s16x4 l0 = tr_read<v_rd_off(D0, 0, 0)>(vb), h0 = tr_read<v_rd_off(D0, 0, 1)>(vb), l1 = tr_read<v_rd_off(D0, 1, 0)>(vb), h1 = tr_read<v_rd_off(D0, 1, 1)>(vb);
    const s16x4 l2 = tr_read<v_rd_off(D0, 2, 0)>(vb), h2 = tr_read<v_rd_off(D0, 2, 1)>(vb), l3 = tr_read<v_rd_off(D0, 3, 0)>(vb), h3 = tr_read<v_rd_off(D0, 3, 1)>(vb);
    asm volatile("s_waitcnt lgkmcnt(0)" ::: "memory"); __builtin_amdgcn_sched_barrier(0);
#define DPK1(L, H) (bf16x8){L[0], L[1], L[2], L[3], H[0], H[1], H[2], H[3]}
    oa = __builtin_amdgcn_mfma_f32_32x32x16_bf16(pa[0], DPK1(l0, h0), oa, 0, 0, 0);
    oa = __builtin_amdgcn_mfma_f32_32x32x16_bf16(pa[1], DPK1(l1, h1), oa, 0, 0, 0);
    oa = __builtin_amdgcn_mfma_f32_32x32x16_bf16(pa[2], DPK1(l2, h2), oa, 0, 0, 0);
    oa = __builtin_amdgcn_mfma_f32_32x32x16_bf16(pa[3], DPK1(l3, h3), oa, 0, 0, 0);
#undef DPK1
}
#define DPK(L, H) (bf16x8){L[0], L[1], L[2], L[3], H[0], H[1], H[2], H[3]}
#define DVRD(KS, l0, h0, l1, h1, l2, h2, l3, h3) do { l0 = tr_read<v_rd_off(0, KS, 0)>(vb); h0 = tr_read<v_rd_off(0, KS, 1)>(vb); l1 = tr_read<v_rd_off(1, KS, 0)>(vb); h1 = tr_read<v_rd_off(1, KS, 1)>(vb); \
        l2 = tr_read<v_rd_off(2, KS, 0)>(vb); h2 = tr_read<v_rd_off(2, KS, 1)>(vb); l3 = tr_read<v_rd_off(3, KS, 0)>(vb); h3 = tr_read<v_rd_off(3, KS, 1)>(vb); } while (0)
#define DVMM(KS, l0, h0, l1, h1, l2, h2, l3, h3) do { o[0] = __builtin_amdgcn_mfma_f32_32x32x16_bf16(pa[KS], DPK(l0, h0), o[0], 0, 0, 0); o[1] = __builtin_amdgcn_mfma_f32_32x32x16_bf16(pa[KS], DPK(l1, h1), o[1], 0, 0, 0); \
        o[2] = __builtin_amdgcn_mfma_f32_32x32x16_bf16(pa[KS], DPK(l2, h2), o[2], 0, 0, 0); o[3] = __builtin_amdgcn_mfma_f32_32x32x16_bf16(pa[KS], DPK(l3, h3), o[3], 0, 0, 0); } while (0)
__device__ __forceinline__ void pv_all(f32x16 (&o)[4], int vb, const bf16x8 (&pa)[4]) {
    s16x4 a0, a1, a2, a3, a4, a5, a6, a7, b0, b1, b2, b3, b4, b5, b6, b7;
    DVRD(0, a0, a1, a2, a3, a4, a5, a6, a7);
    DVRD(1, b0, b1, b2, b3, b4, b5, b6, b7);
    asm volatile("s_waitcnt lgkmcnt(8)" ::: "memory"); __builtin_amdgcn_sched_barrier(0);
    DVMM(0, a0, a1, a2, a3, a4, a5, a6, a7);
    __builtin_amdgcn_sched_barrier(0);
    DVRD(2, a0, a1, a2, a3, a4, a5, a6, a7);
    asm volatile("s_waitcnt lgkmcnt(8)" ::: "memory"); __builtin_amdgcn_sched_barrier(0);
    DVMM(1, b0, b1, b2, b3, b4, b5, b6, b7);
    __builtin_amdgcn_sched_barrier(0);
    DVRD(3, b0, b1, b2, b3, b4, b5, b6, b7);
    asm volatile("s_waitcnt lgkmcnt(8)" ::: "memory"); __builtin_amdgcn_sched_barrier(0);
    DVMM(2, a0, a1, a2, a3, a4, a5, a6, a7);
    asm volatile("s_waitcnt lgkmcnt(0)" ::: "memory"); __builtin_amdgcn_sched_barrier(0);
    DVMM(3, b0, b1, b2, b3, b4, b5, b6, b7);
}
#undef DVRD
#undef DVMM
#undef DPK
template <int VAR> __device__ __forceinline__ void unit(const bf16* __restrict__ PROJ, bf16* __restrict__ MIX, int qrow0, int b, int h, bool ctxq, LAS unsigned char* lds,
                                     float negb, float lam, float onem, const float* __restrict__ sg, const float* __restrict__ qg, const float* __restrict__ ropet) {
    const int tid = otid(), wid = __builtin_amdgcn_readfirstlane(tid >> 6), lane = tid & 63, r32 = lane & 31, hi = lane >> 5, rb = wid >> 1, mp = wid & 1;
    LAS unsigned char* V_lds = lds; LAS unsigned char* K_lds = lds + 4 * SHM_V;
    LAS float* wsf = (LAS float*)(lds + 4 * SHM_V + 3 * SHM_K) + wid * 32;
    f32x16 o[4];
#pragma unroll
    for (int d = 0; d < 4; ++d)
#pragma unroll
        for (int r = 0; r < 16; ++r) o[d][r] = 0.f;
    float l = 0.f; bf16x8 qr[4];
    { const bf16* Qw = PROJ + (size_t)(qrow0 + rb * 32 + r32) * 4096 + 2560 + h * 128 + mp * 64 + hi * 8;
      float q[4][8]; float ss = 0.f;
#pragma unroll
      for (int d = 0; d < 4; ++d) { const u32x4 w = *(const u32x4*)(Qw + d * 16); const unsigned ww[4] = {w.x, w.y, w.z, w.w};
#pragma unroll
          for (int k = 0; k < 4; ++k) { q[d][2 * k] = __uint_as_float(ww[k] << 16); q[d][2 * k + 1] = __uint_as_float(ww[k] & 0xffff0000u); ss += q[d][2 * k] * q[d][2 * k] + q[d][2 * k + 1] * q[d][2 * k + 1]; } }
      { auto rr = __builtin_amdgcn_permlane32_swap(__float_as_uint(ss), __float_as_uint(ss), false, false); ss = __uint_as_float(rr[0]) + __uint_as_float(rr[1]); }
      const float rstd = rsqrtf(ss * (1.f / 64.f) + EPS);
#pragma unroll
      for (int d = 0; d < 4; ++d)
#pragma unroll
          for (int j = 0; j < 8; ++j) q[d][j] *= rstd * qg[d * 16 + hi * 8 + j];
      if (!ctxq) { const int t = (qrow0 + rb * 32 + r32) & (T - 1), pr = t >> 6, pc = t & 63;
#pragma unroll
          for (int j = 0; j < 8; ++j) { const int i = hi * 8 + j; const float c0 = ropet[(pr * 16 + i) * 2], s0 = ropet[(pr * 16 + i) * 2 + 1], c1 = ropet[(pc * 16 + i) * 2], s1 = ropet[(pc * 16 + i) * 2 + 1];
              const float a0 = q[0][j] * c0 - q[1][j] * s0, a1 = q[1][j] * c0 + q[0][j] * s0, a2 = q[2][j] * c1 - q[3][j] * s1, a3 = q[3][j] * c1 + q[2][j] * s1; q[0][j] = a0; q[1][j] = a1; q[2][j] = a2; q[3][j] = a3; } }
      const float qs = 0.125f * 1.4426950408889634f;
#pragma unroll
      for (int d = 0; d < 4; ++d) { u32x4 w; w.x = cvtpk(q[d][0] * qs, q[d][1] * qs); w.y = cvtpk(q[d][2] * qs, q[d][3] * qs); w.z = cvtpk(q[d][4] * qs, q[d][5] * qs); w.w = cvtpk(q[d][6] * qs, q[d][7] * qs); qr[d] = *reinterpret_cast<bf16x8*>(&w); } }
    const int vb0 = (int)(uintptr_t)V_lds + v_rd_base(lane);
    const int NT = ctxq ? (TC / 64) : ((T + TC) / 64);
    const int rb_lat = b * T, rb_ctx = ML + b * TC;
    const int kb0 = (mp * 64 + hi * 8) * 2;
    unsigned ksrc[2], vsrc[2];
#pragma unroll
    for (int i = 0; i < 2; ++i) { const int G = wid * 128 + i * 64 + lane;
        { const int row = G >> 4, ch = (G & 15) ^ (row & 7); ksrc[i] = (unsigned)(row * 8192 + (3072 + h * 128) * 2 + ch * 16); }
        { const int sub = G >> 5, within = G & 31, kk = (sub >> 2) * 8 + (within >> 2), cg = (sub & 3) * 4 + (within & 3); const int k = (kk & ~0xC) | ((kk & 4) << 1) | ((kk & 8) >> 1);
          vsrc[i] = (unsigned)(k * 8192 + (3584 + h * 128) * 2 + cg * 16); } }
#define DROWB(t) ((t) * 64 < T || ctxq ? (ctxq ? rb_ctx + (t) * 64 : rb_lat + (t) * 64) : rb_ctx + ((t) * 64 - T))
#define DDMA(SRC, t, LBUF) do { const char* tb_ = (const char*)PROJ + (size_t)DROWB(t) * 8192; _Pragma("unroll") for (int i_ = 0; i_ < 2; ++i_) \
        __builtin_amdgcn_global_load_lds((const unsigned*)(tb_ + SRC[i_]), (LAS unsigned*)((LBUF) + wid * 2048 + i_ * 1024), 16, 0, 0); } while (0)
#define DQKT(P0, P1, Kt) do { _Pragma("unroll") for (int r = 0; r < 16; ++r) { P0[r] = 0.f; P1[r] = 0.f; } \
        _Pragma("unroll") for (int d = 0; d < 4; ++d) { const int cb = kb0 + d * 32; \
            const bf16x8 b0 = *(const LAS bf16x8*)((Kt) + DKSWZ(r32, cb)); const bf16x8 b1 = *(const LAS bf16x8*)((Kt) + DKSWZ(32 + r32, cb)); \
            P0 = __builtin_amdgcn_mfma_f32_32x32x16_bf16(b0, qr[d], P0, 0, 0, 0); P1 = __builtin_amdgcn_mfma_f32_32x32x16_bf16(b1, qr[d], P1, 0, 0, 0); } } while (0)
#define DBAR() do { asm volatile("s_waitcnt lgkmcnt(0)" ::: "memory"); __builtin_amdgcn_s_barrier(); asm volatile("" ::: "memory"); } while (0)
    const bool late = wid >= 4;
    __syncthreads();
    DDMA(ksrc, 0, K_lds); DDMA(vsrc, 0, V_lds); DDMA(ksrc, 1, K_lds + SHM_K); DDMA(vsrc, 1, V_lds + SHM_V); DDMA(ksrc, 2, K_lds + 2 * SHM_K);
    asm volatile("s_waitcnt vmcnt(0)" ::: "memory"); DBAR();
    f32x16 pA0, pA1, pB0, pB1; bf16x8 pa[4];
    DQKT(pA0, pA1, K_lds);
    DBAR();
#define DSTEP(PC0, PC1, PN0, PN1, t) do { \
        if ((t) + 3 < NT) DDMA(ksrc, (t) + 3, K_lds + ((t) % 3) * SHM_K); if ((t) + 2 < NT) DDMA(vsrc, (t) + 2, V_lds + (((t) + 2) & 3) * SHM_V); \
        if (late && (t) > 0) { const int vbp = vb0 + (((t) - 1) & 3) * SHM_V; pv_one<0>(o[0], vbp, pa); pv_one<1>(o[1], vbp, pa); pv_one<2>(o[2], vbp, pa); pv_one<3>(o[3], vbp, pa); } \
        if ((t) + 1 < NT) DQKT(PN0, PN1, K_lds + (((t) + 1) % 3) * SHM_K); \
        softmax_pack<VAR>(PC0, PC1, negb, l, pa[0], pa[1], pa[2], pa[3]); \
        if (!late) { const int vb = vb0 + ((t) & 3) * SHM_V; pv_one<0>(o[0], vb, pa); pv_one<1>(o[1], vb, pa); pv_one<2>(o[2], vb, pa); pv_one<3>(o[3], vb, pa); } \
        if ((t) + 3 < NT) asm volatile("s_waitcnt vmcnt(4)" ::: "memory"); else asm volatile("s_waitcnt vmcnt(0)" ::: "memory"); \
        DBAR(); } while (0)
    for (int t = 0; t < NT; t += 2) {
        DSTEP(pA0, pA1, pB0, pB1, t);
        DSTEP(pB0, pB1, pA0, pA1, t + 1);
    }
    if (late) { const int vbp = vb0 + ((NT - 1) & 3) * SHM_V; pv_one<0>(o[0], vbp, pa); pv_one<1>(o[1], vbp, pa); pv_one<2>(o[2], vbp, pa); pv_one<3>(o[3], vbp, pa); }
    __syncthreads();
#undef DSTEP
#undef DQKT
#undef DDMA
#undef DBAR
#undef DROWB
    if (hi == 0) wsf[r32] = l;
    asm volatile("s_waitcnt lgkmcnt(0)" ::: "memory");
    LAS float* xch = (LAS float*)lds + rb * (16 * 4 * 64);
    if (mp == 1) {
#pragma unroll
        for (int r = 0; r < 16; ++r) { const float i1 = lam * __builtin_amdgcn_rcpf(wsf[crow(r, hi)]);
#pragma unroll
            for (int d = 0; d < 4; ++d) xch[(r * 4 + d) * 64 + lane] = o[d][r] * i1; }
    }
    __syncthreads();
    if (mp == 0) {
        float g4[4];
#pragma unroll
        for (int d = 0; d < 4; ++d) g4[d] = sg[32 * d + r32] * onem;
        LAS unsigned char* ot = lds + 65536 + (size_t)(rb * 32) * 272;
#pragma unroll
        for (int r = 0; r < 16; ++r) { const int row = crow(r, hi); const float i0 = __builtin_amdgcn_rcpf(wsf[row]);
            float w[4], ss = 0.f;
#pragma unroll
            for (int d = 0; d < 4; ++d) { w[d] = o[d][r] * i0 - xch[(r * 4 + d) * 64 + lane]; ss += w[d] * w[d]; }
            ss += __shfl_xor(ss, 1); ss += __shfl_xor(ss, 2); ss += __shfl_xor(ss, 4); ss += __shfl_xor(ss, 8); ss += __shfl_xor(ss, 16);
            const float rstd = rsqrtf(ss * (1.f / 128.f) + EPS);
#pragma unroll
            for (int d = 0; d < 4; ++d) *(LAS bf16*)(ot + row * 272 + (32 * d + r32) * 2) = f2bf(w[d] * rstd * g4[d]); }
    }
    __syncthreads();
    {
        const int row = tid >> 2, cq = (tid & 3) * 64; const LAS unsigned char* sp = lds + 65536 + row * 272 + cq; bf16* dst = MIX + (size_t)(qrow0 + row) * D + 512 + h * 128 + cq / 2;
#pragma unroll
        for (int k = 0; k < 4; ++k) *(u32x4*)(dst + 8 * k) = *(const LAS u32x4*)(sp + 16 * k); }
}
}
template <int VAR> __device__ __forceinline__ void ph_attn(const Prm& p, int l, LAS unsigned char* ldsb) {
    const int ev = l / 2; const bf16* PROJ = (const bf16*)(p.ws + WS_PROJ); bf16* MIX = (bf16*)(p.ws + ((VAR == 0 || VAR == 5) ? WS_MIX : WS_OF));
    const float lam_init = 0.8f - 0.6f * __expf(-0.3f * (float)l);
    float d0 = 0.f, d1 = 0.f;
    for (int i = 0; i < 64; ++i) { d0 += p.dlam[(ev * 4 + 0) * 64 + i] * p.dlam[(ev * 4 + 1) * 64 + i]; d1 += p.dlam[(ev * 4 + 2) * 64 + i] * p.dlam[(ev * 4 + 3) * 64 + i]; }
    const float lam = __expf(d0) - __expf(d1) + lam_init;
    float gq = 0.f, gk = 0.f;
    for (int i = 0; i < 64; ++i) { gq = fmaxf(gq, fabsf(p.qn_g[ev * 64 + i])); gk = fmaxf(gk, fabsf(p.kn_g[ev * 64 + i])); }
    const float negb = -8.f * gq * gk * 1.4426950408889634f;
    const int vc = vcu_id();
    for (int u = vc; u < 512; u += gridDim.x) { const int v2 = (u < 256) ? u * 2 : (u - 256) * 2 + 1;
        const int b = v2 >> 7, h = (v2 >> 5) & 3, qb = v2 & 31;
        if (VAR == 5 && negb < -48.f) dat::unit<0>(PROJ, MIX, b * T + qb * 128, b, h, false, ldsb, negb, lam, 1.f - lam_init, p.subln_g + ev * 128, p.qn_g + ev * 64, (const float*)(p.ws + WS_ROPE));
        else dat::unit<VAR>(PROJ, MIX, b * T + qb * 128, b, h, false, ldsb, negb, lam, 1.f - lam_init, p.subln_g + ev * 128, p.qn_g + ev * 64, (const float*)(p.ws + WS_ROPE)); }
    if (l == 0) for (int u = vc; u < 32; u += gridDim.x) { const int b = u >> 3, h = (u >> 1) & 3, qb = u & 1;
        if (VAR == 5 && negb < -48.f) dat::unit<0>(PROJ, MIX, ML + b * TC + qb * 128, b, h, true, ldsb, negb, lam, 1.f - lam_init, p.subln_g + ev * 128, p.qn_g + ev * 64, (const float*)(p.ws + WS_ROPE));
        else dat::unit<VAR>(PROJ, MIX, ML + b * TC + qb * 128, b, h, true, ldsb, negb, lam, 1.f - lam_init, p.subln_g + ev * 128, p.qn_g + ev * 64, (const float*)(p.ws + WS_ROPE)); }
    __syncthreads();
}

namespace hg {
using bf16x8 = __attribute__((ext_vector_type(8))) short;
__device__ __forceinline__ int swz256(int row, int colB) { return row * 256 + (colB ^ ((row & 15) << 4)); }
__device__ __forceinline__ int swz128(int row, int colB) { return row * 128 + (colB ^ (((row >> 1) & 7) << 4)); }
constexpr int BFS = 132;
constexpr int L_BF = 0, L_TOT = 33792, L_LB = 35840, L_P = 0, L_RED = 8192, L_QP = 36864, L_KP = 53248, L_QT = 69632, L_VT = 86016, L_ST = 102400;
__device__ __forceinline__ float lbound(const float* lbl, int ev, int dir, int col) {
    if (ev == 0) return 0.f; const float l0 = lbl[(0 * 2 + dir) * 512 + col], l1 = lbl[(1 * 2 + dir) * 512 + col]; return 1.f / (1.f + __expf(l0 - l1)); }
__device__ __forceinline__ void pass1(const bf16* PROJ, const float* lbl, int ev, int dir, int h, int row0, LAS unsigned char* lds, int tid) {
    const int qt = tid >> 7, d = tid & 127; const float lb = lbound(lbl, ev, dir, h * 128 + d);
    LAS float* Bf = (LAS float*)(lds + L_BF); float run = 0.f;
    const bf16* zp = PROJ + (size_t)row0 * 4096 + 512 + dir * 512 + h * 128 + d;
    float zv[16];
#pragma unroll
    for (int i = 0; i < 16; ++i) { const int s = qt * 16 + i, tau = dir ? 63 - s : s; zv[i] = bf2f(zp[(size_t)tau * 4096]); }
#pragma unroll
    for (int i = 0; i < 16; ++i) { const float f = lb + (1.f - lb) * sigmoidf_(zv[i]); run += __logf(fmaxf(f, 1e-30f)); Bf[(qt * 16 + i) * BFS + d] = run; }
    ((LAS float*)(lds + L_TOT))[qt * 128 + d] = run; if (qt == 0) ((LAS float*)(lds + L_LB))[d] = lb;
}
__device__ __forceinline__ void decay4(const LAS unsigned char* lds, int s, int d0, f32x4& b, f32x4& bmid, f32x4& blast, f32x4& lb) {
    const LAS float* Bf = (const LAS float*)(lds + L_BF); const LAS float* tot = (const LAS float*)(lds + L_TOT);
    const f32x4 t0 = *(const LAS f32x4*)(tot + d0), t1 = *(const LAS f32x4*)(tot + 128 + d0), t2 = *(const LAS f32x4*)(tot + 256 + d0), t3 = *(const LAS f32x4*)(tot + 384 + d0);
    const int qt = s >> 4; f32x4 pre = (f32x4){0.f, 0.f, 0.f, 0.f}; if (qt >= 1) pre += t0; if (qt >= 2) pre += t1; if (qt >= 3) pre += t2;
    b = *(const LAS f32x4*)(Bf + s * BFS + d0) + pre; bmid = t0 + t1; blast = (t0 + t1) + (t2 + t3); lb = *(const LAS f32x4*)((const LAS float*)(lds + L_LB) + d0);
}
__device__ __forceinline__ void pass1_pre(const float (&zv)[16], float lb, LAS unsigned char* lds, int tb, int tid) {
    const int qt = tid >> 7, d = tid & 127; LAS float* Bf = (LAS float*)(lds + tb + L_BF); float run = 0.f;
#pragma unroll
    for (int i = 0; i < 16; ++i) { const float f = lb + (1.f - lb) * sigmoidf_(zv[i]); run += __logf(fmaxf(f, 1e-30f)); Bf[(qt * 16 + i) * BFS + d] = run; }
    ((LAS float*)(lds + tb + L_TOT))[qt * 128 + d] = run; if (qt == 0) ((LAS float*)(lds + tb + L_LB))[d] = lb;
}
__device__ __forceinline__ void decay4b(const LAS unsigned char* lds, int tb, int s, int d0, f32x4& b, f32x4& bmid, f32x4& lb) {
    const LAS float* Bf = (const LAS float*)(lds + tb + L_BF); const LAS float* tot = (const LAS float*)(lds + tb + L_TOT);
    const f32x4 t0 = *(const LAS f32x4*)(tot + d0), t1 = *(const LAS f32x4*)(tot + 128 + d0), t2 = *(const LAS f32x4*)(tot + 256 + d0);
    const int qt = s >> 4; f32x4 pre = (f32x4){0.f, 0.f, 0.f, 0.f}; if (qt >= 1) pre += t0; if (qt >= 2) pre += t1; if (qt >= 3) pre += t2;
    b = *(const LAS f32x4*)(Bf + s * BFS + d0) + pre; bmid = t0 + t1; lb = *(const LAS f32x4*)((const LAS float*)(lds + tb + L_LB) + d0);
}
__device__ __forceinline__ void stage_vt(const bf16* PROJ, int h, int row0, LAS unsigned char* lds, int tid) {
    const int tau = tid >> 3, e0 = (tid & 7) * 16; const bf16* vp = PROJ + (size_t)(row0 + tau) * 4096 + 1536 + h * 128 + e0;
    const u32x4 w0 = *(const u32x4*)vp, w1 = *(const u32x4*)(vp + 8); const unsigned ww[8] = {w0.x, w0.y, w0.z, w0.w, w1.x, w1.y, w1.z, w1.w};
#pragma unroll
    for (int i = 0; i < 8; ++i) { *(LAS bf16*)(lds + L_VT + swz128(e0 + 2 * i, tau * 2)) = (bf16)(ww[i] & 0xffffu); *(LAS bf16*)(lds + L_VT + swz128(e0 + 2 * i + 1, tau * 2)) = (bf16)(ww[i] >> 16); }
}
}
template <int LV> __device__ __forceinline__ void ph_hgrn_local(const Prm& p, int l, LAS unsigned char* lds) {
    constexpr int RS = 288, L_VR = hg::L_VT, L_KR = hg::L_QP;
    const int ev = l / 2; const bf16* PROJ = (const bf16*)(p.ws + WS_PROJ); bf16* DS = (bf16*)(p.ws + (LV == 0 ? WS_HDS : WS_XE)); float* G = (float*)(p.ws + (LV == 0 ? WS_HG : WS_OF));
    const int tid = otid(), lane = tid & 63, wv = tid >> 6;
    for (int it = obid(); it < HG_ITEMS; it += gridDim.x) {
        const int c = it % HG_NCH, chain = it / HG_NCH, dir = chain & 1, h = (chain >> 1) & 3, b = chain >> 3;
        const bool isc = c < 4; const int j = isc ? c : c - 4, nt = isc ? 4 : 64, tj = dir ? nt - 1 - j : j; const int row0 = isc ? ML + b * TC + tj * 64 : b * T + tj * 64;
        u32x4 zpre0, zpre1;
        { const int s_ = tid >> 3, tau_ = dir ? 63 - s_ : s_; const bf16* zp_ = PROJ + (size_t)(row0 + tau_) * 4096 + 512 + dir * 512 + h * 128 + (tid & 7) * 16; zpre0 = *(const u32x4*)zp_; zpre1 = *(const u32x4*)(zp_ + 8); }
        float zv[16]; u32x4 vw0, vw1;
        { const int qt = tid >> 7, d = tid & 127; const bf16* zc = PROJ + (size_t)(row0 + (dir ? 63 - qt * 16 : qt * 16)) * 4096 + 512 + dir * 512 + h * 128 + d;
#pragma unroll
          for (int i = 0; i < 16; ++i) zv[i] = bf2f(dir ? *(zc - (size_t)i * 4096) : zc[(size_t)i * 4096]);
          const bf16* vp = PROJ + (size_t)(row0 + (tid >> 3)) * 4096 + 1536 + h * 128 + (tid & 7) * 16; vw0 = *(const u32x4*)vp; vw1 = *(const u32x4*)(vp + 8); }
        const float lbt = hg::lbound(p.hgrn_lb, ev, dir, h * 128 + (tid & 127));
        __syncthreads();
        hg::pass1_pre(zv, lbt, lds, 0, tid);
        { LAS unsigned char* vr = lds + L_VR + (tid >> 3) * RS + (tid & 7) * 32; *(LAS u32x4*)vr = vw0; *(LAS u32x4*)(vr + 16) = vw1; }
        __syncthreads();
        {
            const int s = tid >> 3, dg = (tid & 7) * 16, tau = dir ? 63 - s : s;
            const unsigned zz[8] = {zpre0.x, zpre0.y, zpre0.z, zpre0.w, zpre1.x, zpre1.y, zpre1.z, zpre1.w}; float kh[16];
#pragma unroll
            for (int g4 = 0; g4 < 4; ++g4) { f32x4 bb, bm, bl, lb; hg::decay4(lds, s, dg + g4 * 4, bb, bm, bl, lb);
#pragma unroll
                for (int i = 0; i < 4; ++i) { const int k = g4 * 4 + i, d = dg + k; const float z = (k & 1) ? __uint_as_float(zz[k >> 1] & 0xffff0000u) : __uint_as_float(zz[k >> 1] << 16);
                    const float f = lb[i] + (1.f - lb[i]) * sigmoidf_(z);
                    kh[k] = (1.f - f) * __expf(bl[i] - bb[i]);
                    if (s == 0) G[(size_t)it * 128 + d] = __expf(bl[i]); } }
            LAS unsigned char* kr = lds + L_KR + tau * RS + dg * 2;
            *(LAS u32x4*)kr = (u32x4){dat::cvtpk(kh[0], kh[1]), dat::cvtpk(kh[2], kh[3]), dat::cvtpk(kh[4], kh[5]), dat::cvtpk(kh[6], kh[7])};
            *(LAS u32x4*)(kr + 16) = (u32x4){dat::cvtpk(kh[8], kh[9]), dat::cvtpk(kh[10], kh[11]), dat::cvtpk(kh[12], kh[13]), dat::cvtpk(kh[14], kh[15])};
        }
        __syncthreads();
        {
            f32x4 acc[8];
#pragma unroll
            for (int db = 0; db < 8; ++db) acc[db] = (f32x4){0.f, 0.f, 0.f, 0.f};
            const int r16 = lane & 15, q4 = lane >> 4;
            const int trb = (q4 * 8 + (r16 >> 2)) * RS + (r16 & 3) * 8;
#pragma unroll
            for (int ks = 0; ks < 2; ++ks) { const int kb = trb + ks * 32 * RS;
                dat::s16x4 al, ah, bl_[8], bh_[8];
                { const int ad = (int)(uintptr_t)(lds + L_VR) + kb + wv * 32; asm volatile("ds_read_b64_tr_b16 %0, %1" : "=&v"(al) : "v"(ad) : "memory"); asm volatile("ds_read_b64_tr_b16 %0, %1 offset:1152" : "=&v"(ah) : "v"(ad) : "memory"); }
#pragma unroll
                for (int db = 0; db < 8; ++db) { const int ad = (int)(uintptr_t)(lds + L_KR) + kb + db * 32; asm volatile("ds_read_b64_tr_b16 %0, %1" : "=&v"(bl_[db]) : "v"(ad) : "memory"); asm volatile("ds_read_b64_tr_b16 %0, %1 offset:1152" : "=&v"(bh_[db]) : "v"(ad) : "memory"); }
                asm volatile("s_waitcnt lgkmcnt(0)" ::: "memory"); __builtin_amdgcn_sched_barrier(0);
                const hg::bf16x8 a = (hg::bf16x8){al[0], al[1], al[2], al[3], ah[0], ah[1], ah[2], ah[3]};
#pragma unroll
                for (int db = 0; db < 8; ++db) { const hg::bf16x8 bb = (hg::bf16x8){bl_[db][0], bl_[db][1], bl_[db][2], bl_[db][3], bh_[db][0], bh_[db][1], bh_[db][2], bh_[db][3]};
                    acc[db] = __builtin_amdgcn_mfma_f32_16x16x32_bf16(a, bb, acc[db], 0, 0, 0); } }
            bf16* dst = DS + (size_t)it * 16384;
#pragma unroll
            for (int db = 0; db < 8; ++db)
#pragma unroll
                for (int jj = 0; jj < 4; jj += 2) { const unsigned w2 = pk2_sw(acc[db][jj], acc[db][jj + 1]); dst[(wv * 16 + q4 * 4 + jj) * 128 + db * 16 + r16] = (bf16)(w2 & 0xffffu); dst[(wv * 16 + q4 * 4 + jj + 1) * 128 + db * 16 + r16] = (bf16)(w2 >> 16); }
        }
    }
    __syncthreads();
}
__device__ __forceinline__ void ph_hgrn_scan(const Prm& p) {
    const bf16* DS = (const bf16*)(p.ws + WS_HDS); bf16* ST = (bf16*)(p.ws + WS_HST); const float* G = (const float*)(p.ws + WS_HG);
    for (int gt = obid() * NTHREADS + otid(); gt < 32 * 128 * 32; gt += gridDim.x * NTHREADS) {
        const int chain = gt >> 12, rem = gt & 4095; const size_t eo = (size_t)(rem >> 5) * 128 + (rem & 31) * 4; const int dq = (rem & 31) * 4;
        float s0 = 0.f, s1 = 0.f, s2 = 0.f, s3 = 0.f;
#pragma unroll 4
        for (int c = 0; c < HG_NCH; ++c) { const size_t it = (size_t)chain * HG_NCH + c;
            const u32x2 dv = *(const u32x2*)(DS + it * 16384 + eo); const f32x4 g = *(const f32x4*)(G + it * 128 + dq);
            u32x2 o; o.x = pk2(s0, s1); o.y = pk2(s2, s3); *(u32x2*)(ST + it * 16384 + eo) = o;
            s0 = g.x * s0 + __uint_as_float(dv.x << 16); s1 = g.y * s1 + __uint_as_float(dv.x & 0xffff0000u); s2 = g.z * s2 + __uint_as_float(dv.y << 16); s3 = g.w * s3 + __uint_as_float(dv.y & 0xffff0000u); }
    }
}
template <int HV> __device__ __forceinline__ void ph_hgrn_out(const Prm& p, int l, LAS unsigned char* lds) {
    constexpr int L_P2 = hg::L_ST + 36864;
    constexpr int L_RED2 = L_P2;
    static_assert(L_P2 + 8192 <= LDS_BYTES - 256, "hgrn_out LDS map");
    const int ev = l / 2; const bf16* PROJ = (const bf16*)(p.ws + WS_PROJ); const bf16* ST = (const bf16*)(p.ws + WS_HST); bf16* MIX = (bf16*)(p.ws + (HV == 0 ? WS_MIX : WS_OF));
    const int tid = otid(), lane = tid & 63, wv = tid >> 6, r16 = lane & 15, q4 = lane >> 4;
    const int tt0 = (l < 2) ? 0 : 4;
    const int nitems = 16 * (HG_NCH - tt0);
    const bool bal = gridDim.x == 256 && nitems == 1088;
    for (int k = 0;; ++k) { int it = obid() + k * (int)gridDim.x;
        if (bal && k == 4) { const int m8 = obid() & 7; if (m8 != 1 && m8 != 2) break; it = 1024 + (obid() >> 3) + 32 * (m8 - 1); }
        if (it >= nitems) break;
        const int tt = tt0 + it % (HG_NCH - tt0), bh = it / (HG_NCH - tt0), h = bh & 3, b = bh >> 2;
        const bool isc = tt < 4; const int tj = isc ? tt : tt - 4, nt = isc ? 4 : 64; const int row0 = isc ? ML + b * TC + tj * 64 : b * T + tj * 64;
        const int s2 = tid >> 3, dg = (tid & 7) * 16;
        u32x4 zq[2][2], qq[2][2]; float zv[2][16]; hg::bf16x8 sfr[2][4]; float lbv[2];
        const u32x4 vw0 = *(const u32x4*)(PROJ + (size_t)(row0 + s2) * 4096 + 1536 + h * 128 + dg), vw1 = *(const u32x4*)(PROJ + (size_t)(row0 + s2) * 4096 + 1536 + h * 128 + dg + 8);
#pragma unroll
        for (int dir = 0; dir < 2; ++dir) { const int tau = dir ? 63 - s2 : s2; const bf16* rp = PROJ + (size_t)(row0 + tau) * 4096 + h * 128 + dg;
            zq[dir][0] = *(const u32x4*)(rp + 512 + dir * 512); zq[dir][1] = *(const u32x4*)(rp + 512 + dir * 512 + 8); qq[dir][0] = *(const u32x4*)rp; qq[dir][1] = *(const u32x4*)(rp + 8);
            lbv[dir] = hg::lbound(p.hgrn_lb, ev, dir, h * 128 + (tid & 127));
            const int c = (isc ? 0 : 4) + (dir ? nt - 1 - tj : tj); const bf16* sp = ST + (size_t)(((b * 4 + h) * 2 + dir) * HG_NCH + c) * 16384 + (wv * 16 + r16) * 128 + q4 * 8;
#pragma unroll
            for (int ks = 0; ks < 4; ++ks) sfr[dir][ks] = *(const hg::bf16x8*)(sp + ks * 32); }
        f32x4 o[4];
#pragma unroll
        for (int i = 0; i < 4; ++i) o[i] = (f32x4){0.f, 0.f, 0.f, 0.f};
        { const int qt = tid >> 7, d = tid & 127; const bf16* zp = PROJ + (size_t)(row0 + qt * 16) * 4096 + 512 + h * 128 + d;
#pragma unroll
          for (int i = 0; i < 16; ++i) zv[0][i] = bf2f(zp[(size_t)i * 4096]); }
        __syncthreads();
        { const unsigned ww[8] = {vw0.x, vw0.y, vw0.z, vw0.w, vw1.x, vw1.y, vw1.z, vw1.w};
#pragma unroll
          for (int i = 0; i < 8; ++i) { *(LAS bf16*)(lds + hg::L_VT + hg::swz128(dg + 2 * i, s2 * 2)) = (bf16)(ww[i] & 0xffffu); *(LAS bf16*)(lds + hg::L_VT + hg::swz128(dg + 2 * i + 1, s2 * 2)) = (bf16)(ww[i] >> 16); } }
#pragma unroll
        for (int dir = 0; dir < 2; ++dir) {
            const int qt = tid >> 7, d = tid & 127; const bf16* zp = PROJ + (size_t)(row0 + (dir ? 63 - qt * 16 : qt * 16)) * 4096 + 512 + dir * 512 + h * 128 + d;
            if (dir) {
#pragma unroll
                for (int i = 0; i < 16; ++i) zv[1][i] = bf2f(*(zp - (size_t)i * 4096)); }
            hg::pass1_pre(zv[dir], lbv[dir], lds, dir ? hg::L_ST : 0, tid);
            __builtin_amdgcn_sched_barrier(0); }
        __syncthreads();
        const u32x4 gw0 = *(const u32x4*)(PROJ + (size_t)(row0 + s2) * 4096 + 2048 + h * 128 + dg), gw1 = *(const u32x4*)(PROJ + (size_t)(row0 + s2) * 4096 + 2048 + h * 128 + dg + 8);
#pragma unroll
        for (int dir = 0; dir < 2; ++dir) { const int tb = dir ? hg::L_ST : 0;
            if (HV != 2) {
                const int tau = dir ? 63 - s2 : s2;
                const unsigned zz[8] = {zq[dir][0].x, zq[dir][0].y, zq[dir][0].z, zq[dir][0].w, zq[dir][1].x, zq[dir][1].y, zq[dir][1].z, zq[dir][1].w};
                const unsigned qv[8] = {qq[dir][0].x, qq[dir][0].y, qq[dir][0].z, qq[dir][0].w, qq[dir][1].x, qq[dir][1].y, qq[dir][1].z, qq[dir][1].w};
#pragma unroll
                for (int jj = 0; jj < 2; ++jj) { const int d0 = dg + jj * 8; float qp[8], kp[8], qt[8];
#pragma unroll
                    for (int g4 = 0; g4 < 2; ++g4) { f32x4 bb, bm, lb; hg::decay4b(lds, tb, s2, d0 + g4 * 4, bb, bm, lb);
#pragma unroll
                        for (int i = 0; i < 4; ++i) { const int k = jj * 8 + g4 * 4 + i; const float z = (k & 1) ? __uint_as_float(zz[k >> 1] & 0xffff0000u) : __uint_as_float(zz[k >> 1] << 16);
                            const float qf = (k & 1) ? __uint_as_float(qv[k >> 1] & 0xffff0000u) : __uint_as_float(qv[k >> 1] << 16);
                            const float f = lb[i] + (1.f - lb[i]) * sigmoidf_(z); const float rel = bb[i] - bm[i];
                            qp[g4 * 4 + i] = qf * __expf(fminf(rel, 80.f)); kp[g4 * 4 + i] = (1.f - f) * __expf(fminf(-rel, 80.f)); qt[g4 * 4 + i] = qf * __expf(bb[i]); } }
                    u32x4 w; w.x = dat::cvtpk(qp[0], qp[1]); w.y = dat::cvtpk(qp[2], qp[3]); w.z = dat::cvtpk(qp[4], qp[5]); w.w = dat::cvtpk(qp[6], qp[7]); *(LAS u32x4*)(lds + hg::L_QP + hg::swz256(tau, d0 * 2)) = w;
                    w.x = dat::cvtpk(kp[0], kp[1]); w.y = dat::cvtpk(kp[2], kp[3]); w.z = dat::cvtpk(kp[4], kp[5]); w.w = dat::cvtpk(kp[6], kp[7]); *(LAS u32x4*)(lds + hg::L_KP + hg::swz256(tau, d0 * 2)) = w;
                    w.x = dat::cvtpk(qt[0], qt[1]); w.y = dat::cvtpk(qt[2], qt[3]); w.z = dat::cvtpk(qt[4], qt[5]); w.w = dat::cvtpk(qt[6], qt[7]); *(LAS u32x4*)(lds + hg::L_QT + hg::swz256(tau, d0 * 2)) = w; }
            }
            __syncthreads();
            if (HV != 3) {
#pragma unroll
                for (int k2 = 0; k2 < 2; ++k2) { const int bi = wv * 2 + k2, rbk = bi >> 2, cbk = bi & 3; f32x4 acc = (f32x4){0.f, 0.f, 0.f, 0.f};
#pragma unroll
                    for (int ks = 0; ks < 4; ++ks) { const int cb = (ks * 32 + q4 * 8) * 2;
                        const hg::bf16x8 a = *(const LAS hg::bf16x8*)(lds + hg::L_QP + hg::swz256(rbk * 16 + r16, cb)); const hg::bf16x8 bb = *(const LAS hg::bf16x8*)(lds + hg::L_KP + hg::swz256(cbk * 16 + r16, cb));
                        acc = __builtin_amdgcn_mfma_f32_16x16x32_bf16(a, bb, acc, 0, 0, 0); }
                    const int tcol = cbk * 16 + r16;
#pragma unroll
                    for (int jj = 0; jj < 4; ++jj) { const int trow = rbk * 16 + q4 * 4 + jj; const bool keep = dir ? (tcol >= trow) : (tcol <= trow);
                        *(LAS bf16*)(lds + L_P2 + hg::swz128(trow, tcol * 2)) = keep ? f2bf(acc[jj]) : (bf16)0; } }
            }
            __syncthreads();
            if (HV != 3) {
#pragma unroll
                for (int ks = 0; ks < 2; ++ks) { const int cb = (ks * 32 + q4 * 8) * 2; const hg::bf16x8 bb = *(const LAS hg::bf16x8*)(lds + hg::L_VT + hg::swz128(wv * 16 + r16, cb));
#pragma unroll
                    for (int rbk = 0; rbk < 4; ++rbk) { const hg::bf16x8 a = *(const LAS hg::bf16x8*)(lds + L_P2 + hg::swz128(rbk * 16 + r16, cb)); o[rbk] = __builtin_amdgcn_mfma_f32_16x16x32_bf16(a, bb, o[rbk], 0, 0, 0); } }
#pragma unroll
                for (int ks = 0; ks < 4; ++ks) { const int cb = (ks * 32 + q4 * 8) * 2;
#pragma unroll
                    for (int rbk = 0; rbk < 4; ++rbk) { const hg::bf16x8 a = *(const LAS hg::bf16x8*)(lds + hg::L_QT + hg::swz256(rbk * 16 + r16, cb)); o[rbk] = __builtin_amdgcn_mfma_f32_16x16x32_bf16(a, dir ? sfr[1][ks] : sfr[0][ks], o[rbk], 0, 0, 0); } }
            }
            __syncthreads();
        }
        LAS float* ot = (LAS float*)(lds + hg::L_QP);
#pragma unroll
        for (int rbk = 0; rbk < 4; ++rbk)
#pragma unroll
            for (int jj = 0; jj < 4; ++jj) ot[(rbk * 16 + q4 * 4 + jj) * 132 + wv * 16 + r16] = o[rbk][jj];
        __syncthreads();
        { f32x4 ov[4]; float ss = 0.f;
#pragma unroll
          for (int k = 0; k < 4; ++k) { ov[k] = *(const LAS f32x4*)(ot + s2 * 132 + dg + 4 * k); ss += ov[k].x * ov[k].x + ov[k].y * ov[k].y + ov[k].z * ov[k].z + ov[k].w * ov[k].w; }
          ss += __shfl_xor(ss, 1); ss += __shfl_xor(ss, 2); ss += __shfl_xor(ss, 4);
          const float rstd = rsqrtf(ss * (1.f / 128.f) + EPS);
          const unsigned gwv[8] = {gw0.x, gw0.y, gw0.z, gw0.w, gw1.x, gw1.y, gw1.z, gw1.w}; const float* gp = p.hgrn_g + (ev * 4 + h) * 128 + dg; unsigned ow[8];
#pragma unroll
          for (int k = 0; k < 4; ++k) { const f32x4 g4 = *(const f32x4*)(gp + 4 * k);
              const float a0 = __uint_as_float(gwv[2 * k] << 16), a1 = __uint_as_float(gwv[2 * k] & 0xffff0000u), a2 = __uint_as_float(gwv[2 * k + 1] << 16), a3 = __uint_as_float(gwv[2 * k + 1] & 0xffff0000u);
              ow[2 * k] = pk2(ov[k].x * rstd * g4.x * siluf_(a0), ov[k].y * rstd * g4.y * siluf_(a1)); ow[2 * k + 1] = pk2(ov[k].z * rstd * g4.z * siluf_(a2), ov[k].w * rstd * g4.w * siluf_(a3)); }
          bf16* mp = MIX + (size_t)(row0 + s2) * D + h * 128 + dg;
          *(u32x4*)mp = (u32x4){ow[0], ow[1], ow[2], ow[3]}; *(u32x4*)(mp + 8) = (u32x4){ow[4], ow[5], ow[6], ow[7]}; }
    }
    __syncthreads();
}

__device__ __forceinline__ void ph_conv(const Prm& p, int l) {
    const int j = l / 2; const bf16* PROJ = (const bf16*)(p.ws + WS_PROJ); bf16* MIX = (bf16*)(p.ws + WS_MIX); const float* cw = p.conv_w + (size_t)j * 3 * D;
    const int nrows = (l < 2) ? MT : ML; const int total = (nrows / 8) * 128;
    for (int i = obid() * NTHREADS + otid(); i < total; i += gridDim.x * NTHREADS) {
        const int rb = i >> 7, c = (i & 127) * 8, r0 = rb * 8;
        const bool isc = r0 >= ML; const int t0 = isc ? ((r0 - ML) & (TC - 1)) : (r0 & (T - 1)); const int len = isc ? TC : T;
        float w0[8], w1[8], w2[8];
        { const f32x4 a0 = *(const f32x4*)(cw + c), a1 = *(const f32x4*)(cw + c + 4), b0 = *(const f32x4*)(cw + D + c), b1 = *(const f32x4*)(cw + D + c + 4), c0 = *(const f32x4*)(cw + 2 * D + c), c1 = *(const f32x4*)(cw + 2 * D + c + 4);
          w0[0] = a0.x; w0[1] = a0.y; w0[2] = a0.z; w0[3] = a0.w; w0[4] = a1.x; w0[5] = a1.y; w0[6] = a1.z; w0[7] = a1.w;
          w1[0] = b0.x; w1[1] = b0.y; w1[2] = b0.z; w1[3] = b0.w; w1[4] = b1.x; w1[5] = b1.y; w1[6] = b1.z; w1[7] = b1.w;
          w2[0] = c0.x; w2[1] = c0.y; w2[2] = c0.z; w2[3] = c0.w; w2[4] = c1.x; w2[5] = c1.y; w2[6] = c1.z; w2[7] = c1.w; }
        float up[8], uc[8], un[8];
#define CONV_U(dst, rr, ok) do { if (ok) { const u32x4 uu_ = *(const u32x4*)(PROJ + (size_t)(rr) * 2048 + 1024 + c); const unsigned uw_[4] = {uu_.x, uu_.y, uu_.z, uu_.w}; \
            _Pragma("unroll") for (int q = 0; q < 4; ++q) { dst[2 * q] = __uint_as_float(uw_[q] << 16); dst[2 * q + 1] = __uint_as_float(uw_[q] & 0xffff0000u); } } \
          else { _Pragma("unroll") for (int q = 0; q < 8; ++q) dst[q] = 0.f; } } while (0)
        CONV_U(up, r0 - 1, t0 > 0); CONV_U(uc, r0, true);
#pragma unroll
        for (int k = 0; k < 8; ++k) { const int r = r0 + k; CONV_U(un, r + 1, t0 + k + 1 < len);
            const u32x4 bg = *(const u32x4*)(PROJ + (size_t)r * 2048 + c); const unsigned bw[4] = {bg.x, bg.y, bg.z, bg.w}; u32x4 o; unsigned ow[4];
#pragma unroll
            for (int q = 0; q < 4; ++q) { const float y0 = up[2 * q] * w0[2 * q] + uc[2 * q] * w1[2 * q] + un[2 * q] * w2[2 * q], y1 = up[2 * q + 1] * w0[2 * q + 1] + uc[2 * q + 1] * w1[2 * q + 1] + un[2 * q + 1] * w2[2 * q + 1];
                ow[q] = pk2(__uint_as_float(bw[q] << 16) * y0, __uint_as_float(bw[q] & 0xffff0000u) * y1); }
            o.x = ow[0]; o.y = ow[1]; o.z = ow[2]; o.w = ow[3]; *(u32x4*)(MIX + (size_t)r * D + c) = o;
#pragma unroll
            for (int q = 0; q < 8; ++q) { up[q] = uc[q]; uc[q] = un[q]; } }
#undef CONV_U
    }
}

__device__ __forceinline__ void ph_router(const Prm& p, int l, LAS float* lds) {
    const int tid = otid(), lane = tid & 63, gw = obid() * 8 + (tid >> 6), ngw = gridDim.x * 8;
    const float* modv = (const float*)(p.ws + WS_MODV) + (size_t)l * 5 * 6144;
    bf16* X = (bf16*)(p.ws + WS_X); const bf16* Yb = (const bf16*)(p.ws + WS_H); bf16* H2 = (bf16*)(p.ws + WS_H2); float* AFF = (float*)(p.ws + WS_AFF);
    const float* rw = p.router_w + (size_t)l * D * NE;
    const bool split = (l < 2) && gridDim.x > 32, ctxw = split && obid() < 16;
    if (ctxw) { pg8::Gemm g{(const bf16*)(p.ws + WS_MIX), (const bf16*)(p.ws + WS_WOUT), MT, D, D}; pg8::OneUnit S{ML / 256 + obid() / 4, obid() % 4};
        pg8::EpiGY E{(bf16*)(p.ws + WS_H), (const float*)(p.ws + WS_MODV) + (size_t)l * 5 * 6144 + 2 * 1024, ML};
        pg8::gemm_phase<pg8::EpiGY, pg8::OneUnit, true, true>((LAS unsigned char*)lds, g, S, E);
        mini_barrier((unsigned*)(p.ws + WS_CTL) + CW_MINI + 64 * l, 16u); }
    __syncthreads();
    for (int i = tid; i < D * NE / 4; i += NTHREADS) { const f32x4 w = *(const f32x4*)(rw + (size_t)i * 4); const int c = i >> 2, e0 = (i & 3) * 4;
        const int pos = ((((c >> 9) << 1) | ((c >> 2) & 1)) * 256) + (((c & 511) >> 3) * 4) + (c & 3);
        lds[(e0 + 0) * D + pos] = w.x; lds[(e0 + 1) * D + pos] = w.y; lds[(e0 + 2) * D + pos] = w.z; lds[(e0 + 3) * D + pos] = w.w; }
    __syncthreads();
    int ebeg, eend, estep;
    if (!split) { ebeg = gw; eend = ((l < 2) ? MT : ML) / 2; estep = ngw; }
    else if (ctxw) { ebeg = ML / 2 + gw; eend = ebeg + 1; estep = 1; }
    else { ebeg = gw - 16 * 8; eend = ML / 2 + 384; estep = ngw - 16 * 8; }
    bool seen = false;
    for (int en = ebeg; en < eend; en += estep) {
        const int r0 = (split && !ctxw && en >= ML / 2) ? (en + 128) * 2 : en * 2;
        if (split && !ctxw && en >= ML / 2 && !seen) { unsigned* ctr = (unsigned*)(p.ws + WS_CTL) + CW_MINI + 64 * l; unsigned sp = 0u;
            while (xb_ld(ctr) < 16u) { __builtin_amdgcn_s_sleep(1); if (++sp > XB_SPIN_CAP) break; }
            __builtin_amdgcn_fence(__ATOMIC_ACQUIRE, "agent"); seen = true; }
        f32x4 hv[2][4]; float my0 = 0.f, my1 = 0.f;
#pragma unroll
        for (int u = 0; u < 2; ++u) { const int r = r0 + u; const bool isc = r >= ML; const int mr = isc ? 4 : (r >> 12);
            f32x4 v[4]; float s = 0.f;
            u32x4 yw[2];
#pragma unroll
            for (int j2 = 0; j2 < 2; ++j2) yw[j2] = __builtin_nontemporal_load((const u32x4*)(Yb + (size_t)r * D + 8 * lane + 512 * j2));
            if (l == 0) { const float* xin = isc ? p.ctx + (size_t)(r - ML) * D : p.x + (size_t)r * D;
#pragma unroll
                for (int j = 0; j < 4; ++j) v[j] = __builtin_nontemporal_load((const f32x4*)(xin + CJ(j))); }
            else load_xrow(X + (size_t)r * D, lane, v);
#pragma unroll
            for (int j2 = 0; j2 < 2; ++j2) acc_bf16x8(v[2 * j2], v[2 * j2 + 1], yw[j2], 1.f);
            store_xrow(X + (size_t)r * D, lane, v);
#pragma unroll
            for (int j = 0; j < 4; ++j) s += v[j].x * v[j].x + v[j].y * v[j].y + v[j].z * v[j].z + v[j].w * v[j].w;
            const float rstd = rsqrtf(wave_sum(s) * (1.f / D) + EPS);
#pragma unroll
            for (int j = 0; j < 4; ++j) { const int c = CJ(j);
                const f32x4 g = *(const f32x4*)(p.norm2_g + l * D + c), sh = *(const f32x4*)(modv + (size_t)mr * 6144 + 3 * 1024 + c), scl = *(const f32x4*)(modv + (size_t)mr * 6144 + 4 * 1024 + c);
                hv[u][j] = (v[j] * rstd * g) * (scl + 1.f) + sh; }
#pragma unroll
            for (int j2 = 0; j2 < 2; ++j2) *(u32x4*)(H2 + (size_t)r * D + 8 * lane + 512 * j2) = pack_bf16x8(hv[u][2 * j2], hv[u][2 * j2 + 1]); }
#pragma unroll 2
        for (int e = 0; e < 16; ++e) { float a0 = 0.f, a1 = 0.f;
#pragma unroll
            for (int j = 0; j < 4; ++j) { const f32x4 w = *(const LAS f32x4*)(lds + e * D + j * 256 + 4 * lane);
                a0 += hv[0][j].x * w.x + hv[0][j].y * w.y + hv[0][j].z * w.z + hv[0][j].w * w.w; a1 += hv[1][j].x * w.x + hv[1][j].y * w.y + hv[1][j].z * w.z + hv[1][j].w * w.w; }
            a0 = wave_sum(a0); a1 = wave_sum(a1); if (lane == e) { my0 = a0; my1 = a1; } }
#pragma unroll
        for (int u = 0; u < 2; ++u) { const int r = r0 + u; const bool isc = r >= ML; const float lgt = u ? my1 : my0;
            float mx = lgt; mx = fmaxf(mx, __shfl_xor(mx, 1)); mx = fmaxf(mx, __shfl_xor(mx, 2)); mx = fmaxf(mx, __shfl_xor(mx, 4)); mx = fmaxf(mx, __shfl_xor(mx, 8));
            const float ex = __expf(lgt - mx); float den = ex; den += __shfl_xor(den, 1); den += __shfl_xor(den, 2); den += __shfl_xor(den, 4); den += __shfl_xor(den, 8);
            if (lane < 16) { const float a = ex / den;
                if (!isc) AFF[((size_t)(r >> 12) * NE + lane) * T + (r & (T - 1))] = a;
                else { const int rc = r - ML; AFF[(size_t)NB * NE * T + ((size_t)(rc >> 8) * NE + lane) * TC + (rc & (TC - 1))] = a; } } }
    }
    __syncthreads();
}

__device__ __forceinline__ void ph_topk(const Prm& p, int l, LAS float* lds) {
    const float* AFF = (const float*)(p.ws + WS_AFF); float* GATE = (float*)(p.ws + WS_GATE); int* SEL = (int*)(p.ws + WS_SEL); int* TOKSLOT = (int*)(p.ws + WS_TOKSLOT);
    const int tid = otid(), lane = tid & 63, wv = tid >> 6; const int nitems = (l < 2) ? 128 : 64;
    LAS unsigned* hist = (LAS unsigned*)lds;
    LAS unsigned* ctl = hist + 256;
    LAS unsigned* wtot = hist + 272;
    for (int it = obid(); it < nitems; it += gridDim.x) {
        const bool isc = it >= 64; const int be = it & 63, b = be >> 4, e = be & 15; const int n = isc ? TC : T, cap = isc ? CAPC : CAP;
        const float* a = AFF + (isc ? (size_t)NB * NE * T + (size_t)be * TC : (size_t)be * T);
        const bool valid = tid * 8 < n;
        unsigned bits[8];
        if (valid) { const u32x4 w0 = *(const u32x4*)(a + tid * 8), w1 = *(const u32x4*)(a + tid * 8 + 4); bits[0] = w0.x; bits[1] = w0.y; bits[2] = w0.z; bits[3] = w0.w; bits[4] = w1.x; bits[5] = w1.y; bits[6] = w1.z; bits[7] = w1.w; }
        else {
#pragma unroll
            for (int j = 0; j < 8; ++j) bits[j] = 0u; }
        unsigned prefix = 0u, remaining = (unsigned)cap;
#pragma unroll 1
        for (int pass = 0; pass < 4; ++pass) { const int shift = 24 - 8 * pass;
            __syncthreads();
            if (tid < 256) hist[tid] = 0u;
            __syncthreads();
            if (valid) {
#pragma unroll
                for (int j = 0; j < 8; ++j) { const bool m = (pass == 0) || ((bits[j] >> (shift + 8)) == prefix); if (m) __hip_atomic_fetch_add(&hist[(bits[j] >> shift) & 255u], 1u, __ATOMIC_RELAXED, __HIP_MEMORY_SCOPE_WORKGROUP); } }
            __syncthreads();
            if (wv == 0) { const unsigned c0 = hist[4 * lane], c1 = hist[4 * lane + 1], c2 = hist[4 * lane + 2], c3 = hist[4 * lane + 3]; const unsigned s = c0 + c1 + c2 + c3;
                unsigned incl = s;
#pragma unroll
                for (int o = 1; o < 64; o <<= 1) { const unsigned t = __shfl_down(incl, o); if (lane + o < 64) incl += t; }
                unsigned above = incl - s;
                if (above < remaining && remaining <= above + s) { unsigned B;
                    if (above + c3 >= remaining) B = 4 * lane + 3; else { above += c3; if (above + c2 >= remaining) B = 4 * lane + 2; else { above += c2; if (above + c1 >= remaining) B = 4 * lane + 1; else { above += c1; B = 4 * lane; } } }
                    ctl[0] = (prefix << 8) | B; ctl[1] = remaining - above; } }
            __syncthreads();
            prefix = ctl[0]; remaining = ctl[1];
        }
        const unsigned thr = prefix;
        unsigned cg = 0u, ce = 0u;
#pragma unroll
        for (int j = 0; j < 8; ++j) { cg += (valid && bits[j] > thr) ? 1u : 0u; ce += (valid && bits[j] == thr) ? 1u : 0u; }
        unsigned pk = cg | (ce << 16), incl = pk;
#pragma unroll
        for (int o = 1; o < 64; o <<= 1) { const unsigned t = __shfl_up(incl, o); if (lane >= o) incl += t; }
        __syncthreads();
        if (lane == 63) wtot[wv] = incl;
        __syncthreads();
        unsigned base = 0u, total = 0u;
#pragma unroll
        for (int w = 0; w < 8; ++w) { const unsigned t = wtot[w]; if (w < wv) base += t; total += t; }
        const unsigned excl = base + incl - pk; unsigned gpos = excl & 0xffffu, epos = excl >> 16; const unsigned ngt = total & 0xffffu;
        if (valid) {
#pragma unroll
            for (int j = 0; j < 8; ++j) { const int t0 = tid * 8 + j; const int row = isc ? ML + b * TC + t0 : b * T + t0; int slot = -1;
                if (bits[j] > thr) { slot = (int)gpos; ++gpos; } else if (bits[j] == thr) { if (epos < remaining) slot = (int)(ngt + epos); ++epos; }
                if (slot >= 0) { const int xr = isc ? 2048 + b * CAPC + slot : b * CAP + slot; SEL[e * XR + xr] = row; GATE[e * XR + xr] = __uint_as_float(bits[j]); TOKSLOT[(size_t)row * NE + e] = xr; }
                else TOKSLOT[(size_t)row * NE + e] = -1; } }
    }
    __syncthreads();
}
__device__ __forceinline__ void ph_dispatch(const Prm& p, int l) {
    const int lane = otid() & 63, gw = obid() * 8 + (otid() >> 6), ngw = gridDim.x * 8;
    const int* SEL = (const int*)(p.ws + WS_SEL); const bf16* H2 = (const bf16*)(p.ws + WS_H2); bf16* XE = (bf16*)(p.ws + WS_XE);
    const int rows_e = (l < 2) ? 2176 : 2048;
    for (int g = gw; g < NE * rows_e; g += ngw) { const int e = g / rows_e, xr = g % rows_e; const int src = SEL[e * XR + xr];
        const u32x4* s4 = (const u32x4*)(H2 + (size_t)src * D); u32x4* d4 = (u32x4*)(XE + ((size_t)e * XR + xr) * D);
        d4[lane] = s4[lane]; d4[lane + 64] = s4[lane + 64]; }
}

__global__ void __launch_bounds__(NTHREADS, 2) mega(Prm p) {
    extern __shared__ __attribute__((aligned(16))) unsigned char lds_raw[];
    LAS unsigned char* ldsb = (LAS unsigned char*)lds_raw;
    LAS float* lds = (LAS float*)ldsb;
    volatile LAS unsigned* misc = (volatile LAS unsigned*)(ldsb + LDS_BYTES - 256);
    if (threadIdx.x < 32) misc[threadIdx.x] = 0u;
    __syncthreads();
    XcdBarrier bar = xcd_barrier_post((unsigned*)(p.ws + WS_CTL) + 1024, misc + 8);
#define GRID_BAR() do { XcdBarrier b_; { unsigned long long w_ = (unsigned long long)p.ws; asm volatile("" : "+s"(w_)); b_.bar = (unsigned*)((unsigned char*)w_ + WS_CTL) + 1024; } b_.x = xb_xcc_id(); b_.st = misc + 8; xcd_barrier(b_); } while (0)
    (void)bar;
    ph_setup(p, lds);
    ph_convert(p, 0, ldsb);
    GRID_BAR();
    if (DUP_PHASE == 13) { ph_setup(p, lds); GRID_BAR(); ph_setup(p, lds); GRID_BAR(); ph_setup(p, lds); GRID_BAR(); }
    for (int l = 0; l < DEPTH; ++l) {
        if (l > 0) ph_convert(p, l, ldsb);
        ph_norm1(p, l);
        GRID_BAR();
        ph_gemm_in(p, l, ldsb);
        GRID_BAR();
        if (DUP_PHASE == 1) { ph_gemm_in(p, l, ldsb); GRID_BAR(); }
        if (DUP_PHASE == 2) { ph_convert(p, l, ldsb); GRID_BAR(); }
        if (DUP_PHASE == 14) { ph_probe_read<0>(p, l); GRID_BAR(); }
        if (DUP_PHASE == 41) { ph_probe_read<1>(p, l); GRID_BAR(); }
        if (DUP_PHASE == 42) { ph_probe_read<2>(p, l); GRID_BAR(); }
        if (DUP_PHASE == 43) { ph_probe_read<3>(p, l); GRID_BAR(); }
        if (DUP_PHASE == 44) { ph_probe_cvt<4>(p, l); GRID_BAR(); }
        if (DUP_PHASE == 45) { ph_probe_cvt<5>(p, l); GRID_BAR(); }
        if (DUP_PHASE == 18 && l >= 1) { ph_norm1(p, l, false); GRID_BAR(); }
        if ((l & 1) == 0) {
            if (DUP_PHASE == 5 || DUP_PHASE == 7) { ph_hgrn_local<9>(p, l, ldsb); GRID_BAR(); }
            if (DUP_PHASE == 7) { ph_hgrn_local<9>(p, l, ldsb); GRID_BAR(); }
            ph_qkprep(p, l);
            ph_hgrn_local<0>(p, l, ldsb);
            GRID_BAR();
            ph_hgrn_scan(p);
            GRID_BAR();
            if (DUP_PHASE == 3) { ph_hgrn_local<9>(p, l, ldsb); GRID_BAR(); }
            if (DUP_PHASE == 4) { ph_hgrn_scan(p); GRID_BAR(); }
            ph_attn<5>(p, l, ldsb);
            ph_hgrn_out<0>(p, l, ldsb);
            GRID_BAR();
            if (DUP_PHASE == 5) { ph_attn<0>(p, l, ldsb); GRID_BAR(); }
            if (DUP_PHASE == 21) { ph_attn<1>(p, l, ldsb); GRID_BAR(); }
            if (DUP_PHASE == 22) { ph_attn<2>(p, l, ldsb); GRID_BAR(); }
            if (DUP_PHASE == 23) { ph_attn<3>(p, l, ldsb); GRID_BAR(); }
            if (DUP_PHASE == 24) { ph_attn<4>(p, l, ldsb); GRID_BAR(); }
            if (DUP_PHASE == 6) { ph_hgrn_out<5>(p, l, ldsb); GRID_BAR(); }
            if (DUP_PHASE == 31) { ph_hgrn_out<1>(p, l, ldsb); GRID_BAR(); }
            if (DUP_PHASE == 32) { ph_hgrn_out<2>(p, l, ldsb); GRID_BAR(); }
            if (DUP_PHASE == 33) { ph_hgrn_out<3>(p, l, ldsb); GRID_BAR(); }
        } else {
            ph_conv(p, l);
            GRID_BAR();
            if (DUP_PHASE == 17) { ph_conv(p, l); GRID_BAR(); }
        }
        ph_gemm_out(p, l, ldsb);
        GRID_BAR();
        ph_router(p, l, lds);
        GRID_BAR();
        ph_topk(p, l, lds);
        GRID_BAR();
        if (DUP_PHASE == 7) { ph_topk(p, l, lds); GRID_BAR(); }
        ph_expert_up(p, l, ldsb);
        GRID_BAR();
        if (DUP_PHASE == 10) { ph_expert_up(p, l, ldsb); GRID_BAR(); }
        ph_expert_down(p, l, ldsb);
        GRID_BAR();
        if (DUP_PHASE == 11) { ph_expert_down(p, l, ldsb); GRID_BAR(); }
        if (DUP_PHASE == 12) { GRID_BAR(); GRID_BAR(); GRID_BAR(); GRID_BAR(); GRID_BAR(); GRID_BAR(); GRID_BAR(); GRID_BAR(); GRID_BAR(); GRID_BAR(); }
    }
    ph_final(p);
    if (DUP_PHASE == 19) { GRID_BAR(); ph_final(p); GRID_BAR(); ph_final(p); }
}

extern "C" void kernel_launch(void* const* d_in, const int* in_sizes, int n_in, void* d_out, int out_size, void* d_ws, size_t ws_size, hipStream_t stream) {
    static int grid = 0;
    if (grid == 0) {
        if (n_in != 23 || out_size != ML * D || ws_size < WS_END) { fprintf(stderr, "kernel_launch: unexpected shapes: n_in %d out %d ws %zu (need %zu)\n", n_in, out_size, ws_size, (size_t)WS_END); grid = -1; return; }
        int dev = 0, cus = 0, per_cu = 0;
        if (hipGetDevice(&dev) != hipSuccess || hipDeviceGetAttribute(&cus, hipDeviceAttributeMultiprocessorCount, dev) != hipSuccess) { grid = -1; return; }
        if (hipFuncSetAttribute((const void*)mega, hipFuncAttributeMaxDynamicSharedMemorySize, LDS_BYTES) != hipSuccess) { fprintf(stderr, "kernel_launch: hipFuncSetAttribute failed\n"); grid = -1; return; }
        if (hipOccupancyMaxActiveBlocksPerMultiprocessor(&per_cu, (const void*)mega, NTHREADS, LDS_BYTES) != hipSuccess || per_cu < 1) fprintf(stderr, "kernel_launch: occupancy query says %d\n", per_cu);
        (void)hipGetLastError();
        grid = cus;
    }
    if (grid < 0) return;
    (void)hipMemsetAsync((char*)d_ws + WS_CTL, 0, 1 * MiB, stream);
    Prm p{};
    const float** pp = (const float**)&p;
    for (int i = 0; i < 23; ++i) pp[i] = (const float*)d_in[i];
    p.out = (float*)d_out; p.ws = (unsigned char*)d_ws;
    hipLaunchKernelGGL(mega, dim3(grid), dim3(NTHREADS), LDS_BYTES, stream, p);
}
```

```cpp
#include <hip/hip_runtime.h>
#include <type_traits>
#ifndef DUP_PHASE
#define DUP_PHASE 0
#endif
#include <cstdint>
#include <cstdio>

#define GAS __attribute__((address_space(1)))
#define LAS __attribute__((address_space(3)))
typedef unsigned short bf16;
typedef float f32x4 __attribute__((ext_vector_type(4)));
typedef unsigned u32x4 __attribute__((ext_vector_type(4)));
typedef unsigned u32x2 __attribute__((ext_vector_type(2)));

constexpr int D = 1024, NB = 4, T = 4096, TC = 256, DEPTH = 4;
constexpr int ML = NB * T, MC = NB * TC, MT = ML + MC;
constexpr int NE = 16, FF = 1024, CAP = 512, CAPC = 32;
constexpr int XR = 2304;
constexpr int NTHREADS = 512;
constexpr float EPS = 1e-6f;

constexpr size_t MiB = 1u << 20;
constexpr size_t WS_CTL = 0;
constexpr size_t WS_MODV = 1 * MiB;
constexpr size_t WS_ROPE = WS_MODV + 512 * 1024;
constexpr size_t WS_X = 2 * MiB;
constexpr size_t WS_H = WS_X + (size_t)MT * D * 4;
constexpr size_t WS_H2 = WS_H + (size_t)MT * D * 2;
constexpr size_t WS_PROJ = WS_H2 + (size_t)MT * D * 2;
constexpr size_t WS_MIX = WS_PROJ + (size_t)MT * 4096 * 2;
constexpr size_t WS_OF = WS_MIX + (size_t)MT * D * 2;
constexpr size_t WS_AFF = WS_OF + (size_t)2 * MT * 512 * 4;
constexpr size_t WS_GATE = WS_AFF + 2 * MiB;
constexpr size_t WS_SEL = WS_GATE + 1 * MiB;
constexpr size_t WS_TOKSLOT = WS_SEL + 1 * MiB;
constexpr size_t WS_XE = WS_TOKSLOT + 2 * MiB;
constexpr size_t WS_ACT = WS_XE + (size_t)NE * XR * D * 2;
constexpr size_t WS_YE = WS_ACT + (size_t)NE * XR * D * 2;
constexpr size_t WS_WIN = WS_YE + (size_t)NE * XR * D * 2;
constexpr size_t WS_WOUT = WS_WIN + (size_t)4096 * D * 2;
constexpr size_t WS_WUP = WS_WOUT + (size_t)D * D * 2;
constexpr size_t WS_WDN = WS_WUP + (size_t)NE * 2048 * D * 2;
constexpr int HG_NCH = 68, HG_ITEMS = NB * 4 * 2 * HG_NCH;
constexpr size_t WS_HDS = WS_WDN + (size_t)NE * D * FF * 2;
constexpr size_t WS_HST = WS_HDS + (size_t)HG_ITEMS * 128 * 128 * 2;
constexpr size_t WS_HG = WS_HST + (size_t)HG_ITEMS * 128 * 128 * 2;
constexpr size_t WS_END = WS_HG + (size_t)HG_ITEMS * 128 * 4;

constexpr int LDS_BYTES = 155648;

struct Prm {
    const float *x, *c, *ctx, *c_ctx, *mod_w, *mod_b, *norm1_g, *norm2_g, *even_w_in, *even_w_out, *hgrn_lb, *hgrn_g, *qn_g, *kn_g, *dlam, *subln_g,
        *conv_w_in, *conv_w, *conv_w_out, *router_w, *w_gate, *w_up, *w_down;
    float* out; unsigned char* ws;
};

__device__ __forceinline__ float bf2f(bf16 v) { return __uint_as_float((unsigned)v << 16); }
__device__ __forceinline__ bf16 f2bf(float f) { unsigned u = __float_as_uint(f); return (bf16)((u + 0x7fffu + ((u >> 16) & 1u)) >> 16); }
__device__ __forceinline__ unsigned pk2_sw(float lo, float hi) { return (unsigned)f2bf(lo) | ((unsigned)f2bf(hi) << 16); }
__device__ __forceinline__ unsigned pk2(float lo, float hi) { unsigned r; asm volatile("v_cvt_pk_bf16_f32 %0, %1, %2" : "=v"(r) : "v"(lo), "v"(hi)); return r; }
__device__ __forceinline__ float wave_sum(float v) {
#pragma unroll
    for (int o = 1; o < 64; o <<= 1) v += __shfl_xor(v, o);
    return v;
}
__device__ __forceinline__ int otid() { int t = threadIdx.x; asm volatile("" : "+v"(t)); return t; }
__device__ __forceinline__ int obid() { int b = blockIdx.x; asm volatile("" : "+s"(b)); return b; }
__device__ __forceinline__ int vcu_id() { const int G = gridDim.x, bx = obid(); return (G % 8 == 0) ? (bx % 8) * (G / 8) + bx / 8 : bx; }
__device__ __forceinline__ float sigmoidf_(float x) { return __builtin_amdgcn_rcpf(1.f + __expf(-x)); }
__device__ __forceinline__ float siluf_(float x) { return x * __builtin_amdgcn_rcpf(1.f + __expf(-x)); }

#define XB_TMO      128
#define XB_XCNT(j)  (256  + 64 * (j))
#define XB_XSUB(j)  (1280 + 64 * (j))
#define XB_XGEN(j)  (2304 + 64 * (j))
#define XB_TOP      3328
#define XB_TOPGEN   3392
#define XCD_BAR_WORDS 3456
#define XB_SPIN_CAP (1u << 28)
__device__ __forceinline__ unsigned xb_ld(unsigned* p)              { return __hip_atomic_load(p, __ATOMIC_RELAXED, __HIP_MEMORY_SCOPE_AGENT); }
__device__ __forceinline__ unsigned xb_add(unsigned* p, unsigned v) { return __hip_atomic_fetch_add(p, v, __ATOMIC_RELAXED, __HIP_MEMORY_SCOPE_AGENT); }
__device__ __forceinline__ unsigned xb_xcc_id() { return (unsigned)__builtin_amdgcn_s_getreg((3 << 11) | 20) & 0xFu; }
#define XB_SPIN(cond, bar) do { unsigned _sp = 0; while (cond) { __builtin_amdgcn_s_sleep(1); \
    if ((++_sp & 255u) == 0u) { if (xb_ld(&(bar)[XB_TMO])) break; if (_sp > XB_SPIN_CAP) { atomicAdd(&(bar)[XB_TMO], 1u); break; } } } } while (0)
struct XcdBarrier { unsigned* bar; unsigned x; volatile LAS unsigned* st; };
__device__ __forceinline__ XcdBarrier xcd_barrier_post(unsigned* bar, volatile LAS unsigned* st) {
    XcdBarrier b; b.bar = bar; b.x = xb_xcc_id(); b.st = st;
    if (threadIdx.x == 0) (void)xb_add(&bar[XB_XCNT(b.x)], 1u);
    return b;
}
__device__ __forceinline__ void xcd_barrier_complete(unsigned* bar, unsigned x, unsigned& nloc, unsigned& nx) {
    const unsigned G = gridDim.x * gridDim.y * gridDim.z;
    unsigned sum, cnt, mine, sp = 0u;
    for (;;) {
        sum = 0u; cnt = 0u; mine = 0u;
#pragma unroll
        for (unsigned j = 0; j < 16; ++j) { const unsigned c = xb_ld(&bar[XB_XCNT(j)]); sum += c; cnt += (c > 0u) ? 1u : 0u; mine = (j == x) ? c : mine; }
        if (sum == G) break;
        __builtin_amdgcn_s_sleep(1);
        if ((++sp & 255u) == 0u) { if (xb_ld(&bar[XB_TMO])) break; if (sp > XB_SPIN_CAP) { atomicAdd(&bar[XB_TMO], 1u); break; } }
    }
    nloc = mine > 0u ? mine : 1u; nx = cnt > 0u ? cnt : 1u;
}
__device__ __forceinline__ void xcd_barrier(const XcdBarrier& b) {
    asm volatile("s_waitcnt vmcnt(0)" ::: "memory");
    __syncthreads();
    if (threadIdx.x == 0) {
        unsigned* bar = b.bar;
        __builtin_amdgcn_s_waitcnt(0);
        unsigned nloc = b.st[0], nx = b.st[1];
        if (nloc == 0u) { xcd_barrier_complete(bar, b.x, nloc, nx); b.st[0] = nloc; b.st[1] = nx; }
        const unsigned old = xb_add(&bar[XB_XSUB(b.x)], 1u);
        const unsigned gen = old / nloc;
        if (old + 1u == (gen + 1u) * nloc) {
            __builtin_amdgcn_fence(__ATOMIC_RELEASE, "agent");
            asm volatile("s_waitcnt vmcnt(0)" ::: "memory");
            const unsigned og = xb_add(&bar[XB_TOP], 1u);
            const unsigned tg = og / nx;
            if (og + 1u == (tg + 1u) * nx) xb_add(&bar[XB_TOPGEN], 1u);
            else XB_SPIN(xb_ld(&bar[XB_TOPGEN]) == tg, bar);
            __builtin_amdgcn_fence(__ATOMIC_ACQUIRE, "agent");
            xb_add(&bar[XB_XGEN(b.x)], 1u);
            asm volatile("s_waitcnt vmcnt(0)" ::: "memory");
        } else {
            XB_SPIN(xb_ld(&bar[XB_XGEN(b.x)]) == gen, bar);
            __builtin_amdgcn_fence(__ATOMIC_ACQUIRE, "agent");
            asm volatile("s_waitcnt vmcnt(0)" ::: "memory");
        }
    }
    __syncthreads();
}

namespace pg8 {
#define PG8_LAS __attribute__((address_space(3)))
typedef unsigned short bf16_t;
typedef short bf16x8 __attribute__((ext_vector_type(8)));
typedef float f32x4 __attribute__((ext_vector_type(4)));
typedef unsigned u32x4 __attribute__((ext_vector_type(4)));
constexpr int BM = 256, BK = 64, HALF = 128, HTB = HALF * BK * 2  , STAGE_BYTES = 8 * HTB, NXCD = 8, WGM = 8;

__host__ __device__ __forceinline__ int lds_byte(int r, int c) { const int st = (r >> 4) * 2 + (c >> 5), rr = r & 15, cc = c & 31, ob = rr * 64 + cc * 2; return st * 1024 + (ob ^ (((ob >> 9) & 1) << 5)); }
__host__ __device__ __forceinline__ void stage_rc(int b, int& R, int& C) { const int st = b / 1024, sb = b % 1024, swz = sb ^ (((sb >> 9) & 1) << 5); R = (st >> 1) * 16 + swz / 64; C = (st & 1) * 32 + (swz % 64) / 2; }
__host__ __device__ __forceinline__ int perm32(int rho) { const int n = rho >> 4, i = rho & 15; return 8 * (i >> 2) + 4 * n + (i & 3); }

struct Unit { int pm, pn, ab; };
struct Gemm { const bf16_t* A; const bf16_t* Bt; int M, N, K; };

template <int SPLIT = 0>
struct StaticOrderT {
    static constexpr bool HAS_SPLIT = SPLIT != 0;
    int nM, nN, nwg, G, c, nsplit;
    __host__ __device__ void init(int M, int N, int G_, int c_, int Mfull = -1) { if (Mfull < 0) Mfull = M; nM = Mfull / BM; nN = N / BM; nwg = nM * nN; G = G_; c = c_; nsplit = SPLIT ? ((M - Mfull) / BM) * nN * SPLIT : 0; }
    __host__ __device__ bool next(int i, Unit& u) const {
        const long L = (long)i * G + c;
        if (L >= (long)nwg + nsplit) return false;
        int pm, pn, ab;
        if (SPLIT != 0 && L >= nwg) { int q = (int)(L - nwg);
            q = (q % NXCD) * (nsplit / NXCD) + q / NXCD;
            const int t = q / (SPLIT ? SPLIT : 1), s = q % (SPLIT ? SPLIT : 1); pn = t / 4; pm = nM + t % 4; ab = (1 << (s & 1)) | ((SPLIT == 4 ? (1 << (s >> 1)) : 3) << 2);
        } else {
            int wgid = (int)L; { const int q = nwg / NXCD, r = nwg % NXCD, xcd = wgid % NXCD, off = wgid / NXCD; wgid = (xcd < r ? xcd * (q + 1) : r * (q + 1) + (xcd - r) * q) + off; }
            const int nig = WGM * nN, gid = wgid / nig, fm = gid * WGM, gsz = (nM - fm) < WGM ? (nM - fm) : WGM;
            pm = fm + ((wgid % nig) % gsz); pn = (wgid % nig) / gsz; ab = 15; }
        u.pm = pm; u.pn = pn; u.ab = ab; return true;
    }
    __device__ __forceinline__ void a_ready(const Unit&) const {}
    __device__ __forceinline__ void done(const Unit&) const {}
};
typedef StaticOrderT<0> StaticOrder;

__device__ __forceinline__ unsigned cvt_pk_bf16(float lo, float hi) { unsigned r; asm volatile("v_cvt_pk_bf16_f32 %0, %1, %2" : "=v"(r) : "v"(lo), "v"(hi)); return r; }

struct EpiBf16 {
    static constexpr bool PERM = true, AFTER_DRAIN = false;
    bf16_t* O; int ldc;
    __device__ __forceinline__ void operator()(const f32x4 (&acc)[2][2][4][2], const Unit& u, int wr, int wc, int fr, int fq) const {
        const int row0 = u.pm * BM + wr * 64 + fr; const int col0 = u.pn * BM + wc * 32 + 8 * fq;
#pragma unroll
        for (int ai = 0; ai < 2; ++ai)
#pragma unroll
            for (int m = 0; m < 4; ++m) { if (!((u.ab >> ai) & 1)) continue; bf16_t* rowp = O + (size_t)(row0 + ai * HALF + m * 16) * ldc + col0;
#pragma unroll
                for (int bj = 0; bj < 2; ++bj) { if (!((u.ab >> (2 + bj)) & 1)) continue; const f32x4 v0 = acc[ai][bj][m][0], v1 = acc[ai][bj][m][1];
                    u32x4 w; w.x = cvt_pk_bf16(v0[0], v0[1]); w.y = cvt_pk_bf16(v0[2], v0[3]); w.z = cvt_pk_bf16(v1[0], v1[1]); w.w = cvt_pk_bf16(v1[2], v1[3]);
                    *(u32x4*)(rowp + bj * HALF) = w; } }
    }
};
struct EpiGY {
    static constexpr bool PERM = true, AFTER_DRAIN = false;
    bf16_t* Y; const float* g1; int ml;
    __device__ __forceinline__ void operator()(const f32x4 (&acc)[2][2][4][2], const Unit& u, int wr, int wc, int fr, int fq) const {
        const int rbase = u.pm * BM; const int mr = rbase >= ml ? 4 : (rbase >> 12); const float* g = g1 + (size_t)mr * 6144;
        const int row0 = rbase + wr * 64 + fr, col0 = u.pn * BM + wc * 32 + 8 * fq;
        f32x4 gv[2][2];
#pragma unroll
        for (int bj = 0; bj < 2; ++bj)
#pragma unroll
            for (int n = 0; n < 2; ++n) gv[bj][n] = *(const f32x4*)(g + col0 + bj * HALF + n * 4);
#pragma unroll
        for (int ai = 0; ai < 2; ++ai)
#pragma unroll
            for (int m = 0; m < 4; ++m) { bf16_t* rowp = Y + (size_t)(row0 + ai * HALF + m * 16) * 1024 + col0;
#pragma unroll
                for (int bj = 0; bj < 2; ++bj) { const f32x4 v0 = acc[ai][bj][m][0] * gv[bj][0], v1 = acc[ai][bj][m][1] * gv[bj][1];
                    u32x4 w; w.x = cvt_pk_bf16(v0[0], v0[1]); w.y = cvt_pk_bf16(v0[2], v0[3]); w.z = cvt_pk_bf16(v1[0], v1[1]); w.w = cvt_pk_bf16(v1[2], v1[3]);
                    *(u32x4*)(rowp + bj * HALF) = w; } }
    }
};
struct EpiResid {
    static constexpr bool PERM = false, AFTER_DRAIN = false;
    const float* xl; const float* xc; float* X; const float* g1; int ml;
    __device__ __forceinline__ void operator()(const f32x4 (&acc)[2][2][4][2], const Unit& u, int wr, int wc, int fr, int fq) const {
        const int rbase = u.pm * BM; const bool isc = rbase >= ml; const int mr = isc ? 4 : (rbase >> 12);
        const float* xin = isc ? xc - (size_t)ml * 1024 : xl; const float* g = g1 + (size_t)mr * 6144;
        const int col0 = u.pn * BM + wc * 32 + 4 * fq;
        f32x4 gv[2][2];
#pragma unroll
        for (int bj = 0; bj < 2; ++bj)
#pragma unroll
            for (int n = 0; n < 2; ++n) gv[bj][n] = *(const f32x4*)(g + col0 + bj * HALF + n * 16);
#pragma unroll
        for (int ai = 0; ai < 2; ++ai)
#pragma unroll
            for (int m = 0; m < 4; ++m) { const size_t off = (size_t)(rbase + ai * HALF + wr * 64 + m * 16 + fr) * 1024 + col0;
#pragma unroll
                for (int bj = 0; bj < 2; ++bj)
#pragma unroll
                    for (int n = 0; n < 2; ++n) { const f32x4 xi = *(const f32x4*)(xin + off + bj * HALF + n * 16); *(f32x4*)(X + off + bj * HALF + n * 16) = xi + gv[bj][n] * acc[ai][bj][m][n]; } }
    }
};
__device__ __forceinline__ float silu_f(float x) { return x * __builtin_amdgcn_rcpf(1.f + __expf(-x)); }
struct EpiSwiglu {
    static constexpr bool PERM = true, AFTER_DRAIN = false;
    bf16_t* O; int ntn;
    __device__ __forceinline__ void operator()(const f32x4 (&acc)[2][2][4][2], const Unit& u, int wr, int wc, int fr, int fq) const {
        const int row0 = u.pm * BM + wr * 64 + fr; const int col0 = (u.pn % ntn) * HALF + wc * 32 + 8 * fq;
#pragma unroll
        for (int ai = 0; ai < 2; ++ai)
#pragma unroll
            for (int m = 0; m < 4; ++m) { if (!((u.ab >> ai) & 1)) continue; bf16_t* rowp = O + (size_t)(row0 + ai * HALF + m * 16) * 1024 + col0;
                const f32x4 g0 = acc[ai][0][m][0], g1 = acc[ai][0][m][1], u0 = acc[ai][1][m][0], u1 = acc[ai][1][m][1];
                u32x4 w; w.x = cvt_pk_bf16(silu_f(g0[0]) * u0[0], silu_f(g0[1]) * u0[1]); w.y = cvt_pk_bf16(silu_f(g0[2]) * u0[2], silu_f(g0[3]) * u0[3]);
                w.z = cvt_pk_bf16(silu_f(g1[0]) * u1[0], silu_f(g1[1]) * u1[1]); w.w = cvt_pk_bf16(silu_f(g1[2]) * u1[2], silu_f(g1[3]) * u1[3]);
                *(u32x4*)rowp = w; }
    }
};
struct EpiConvIn {
    static constexpr bool PERM = true, AFTER_DRAIN = false;
    bf16_t* O;
    __device__ __forceinline__ void operator()(const f32x4 (&acc)[2][2][4][2], const Unit& u, int wr, int wc, int fr, int fq) const {
        const int row0 = u.pm * BM + wr * 64 + fr;
        if (u.pn < 4) { const int col0 = u.pn * BM + wc * 32 + 8 * fq;
#pragma unroll
            for (int ai = 0; ai < 2; ++ai)
#pragma unroll
                for (int m = 0; m < 4; ++m) { if (!((u.ab >> ai) & 1)) continue; bf16_t* rowp = O + (size_t)(row0 + ai * HALF + m * 16) * 2048 + col0;
#pragma unroll
                    for (int bj = 0; bj < 2; ++bj) { const f32x4 v0 = acc[ai][bj][m][0], v1 = acc[ai][bj][m][1];
                        u32x4 w; w.x = cvt_pk_bf16(v0[0], v0[1]); w.y = cvt_pk_bf16(v0[2], v0[3]); w.z = cvt_pk_bf16(v1[0], v1[1]); w.w = cvt_pk_bf16(v1[2], v1[3]);
                        *(u32x4*)(rowp + bj * HALF) = w; } }
        } else { const int col0 = 1024 + (u.pn - 4) * HALF + wc * 32 + 8 * fq;
#pragma unroll
            for (int ai = 0; ai < 2; ++ai)
#pragma unroll
                for (int m = 0; m < 4; ++m) { if (!((u.ab >> ai) & 1)) continue; bf16_t* rowp = O + (size_t)(row0 + ai * HALF + m * 16) * 2048 + col0;
                    const f32x4 c0 = acc[ai][0][m][0], c1 = acc[ai][0][m][1], v0 = acc[ai][1][m][0], v1 = acc[ai][1][m][1];
                    u32x4 w; w.x = cvt_pk_bf16(c0[0] * v0[0], c0[1] * v0[1]); w.y = cvt_pk_bf16(c0[2] * v0[2], c0[3] * v0[3]); w.z = cvt_pk_bf16(c1[0] * v1[0], c1[1] * v1[1]); w.w = cvt_pk_bf16(c1[2] * v1[2], c1[3] * v1[3]);
                    *(u32x4*)rowp = w; }
        }
    }
};
struct EpiDown {
    static constexpr bool PERM = true, AFTER_DRAIN = false;
    bf16_t* O; const float* gate; int ntn;
    __device__ __forceinline__ void operator()(const f32x4 (&acc)[2][2][4][2], const Unit& u, int wr, int wc, int fr, int fq) const {
        const int row0 = u.pm * BM + wr * 64 + fr; const int col0 = (u.pn % ntn) * BM + wc * 32 + 8 * fq;
#pragma unroll
        for (int ai = 0; ai < 2; ++ai)
#pragma unroll
            for (int m = 0; m < 4; ++m) { if (!((u.ab >> ai) & 1)) continue; const int r = row0 + ai * HALF + m * 16; const float gt = gate[r]; bf16_t* rowp = O + (size_t)r * 1024 + col0;
#pragma unroll
                for (int bj = 0; bj < 2; ++bj) { if (!((u.ab >> (2 + bj)) & 1)) continue; const f32x4 v0 = acc[ai][bj][m][0] * gt, v1 = acc[ai][bj][m][1] * gt;
                    u32x4 w; w.x = cvt_pk_bf16(v0[0], v0[1]); w.y = cvt_pk_bf16(v0[2], v0[3]); w.z = cvt_pk_bf16(v1[0], v1[1]); w.w = cvt_pk_bf16(v1[2], v1[3]);
                    *(u32x4*)(rowp + bj * HALF) = w; } }
    }
};
struct OneUnit { static constexpr bool HAS_SPLIT = false; int pm, pn;
    __device__ bool next(int i, Unit& u) const { if (i > 0) return false; u.pm = pm; u.pn = pn; u.ab = 15; return true; }
    __device__ __forceinline__ void a_ready(const Unit&) const {}
    __device__ __forceinline__ void done(const Unit&) const {}
};
template <int NTN, int QUARTER>
struct GroupOrderT {
    static constexpr bool HAS_SPLIT = true;
    int nfull, nsplit, G, c;
    __device__ void init(int mt_, int ne, int G_, int c_) { nfull = ne * 8 * NTN; nsplit = mt_ > 8 ? ne * NTN * (QUARTER ? 2 : 1) : 0; G = G_; c = c_; }
    __device__ bool next(int i, Unit& u) const { const int L = i * G + c; if (L >= nfull + nsplit) return false;
        int pm, pn, ab;
        if (L < nfull) { const int e = L / (8 * NTN), r = L % (8 * NTN); pm = e * 9 + (r % 8); pn = e * NTN + (r / 8); ab = 15; }
        else { const int q = L - nfull; const int sp = QUARTER ? 2 : 1, t = q / sp, s = q % sp; pm = (t / NTN) * 9 + 8; pn = t; ab = 1 | ((QUARTER ? (1 << s) : 3) << 2); }
        u.pm = pm; u.pn = pn; u.ab = ab; return true; }
    __device__ __forceinline__ void a_ready(const Unit&) const {}
    __device__ __forceinline__ void done(const Unit&) const {}
};

struct DenseA { static constexpr bool GATHER = false;
    __device__ __forceinline__ unsigned off(const Unit&, int h, int R, int C, int K) const { return (unsigned)((h * HALF + R) * K + C) * 2u; }
    __device__ __forceinline__ size_t base(const Unit& u, size_t tstep) const { return (size_t)u.pm * tstep; } };
struct GatherA { static constexpr bool GATHER = true; const int* sel; int sel_ld, tiles_per_e, nvalid;
    __device__ __forceinline__ unsigned off(const Unit& u, int h, int R, int C, int K) const { const int e = u.pm / tiles_per_e, xr = (u.pm % tiles_per_e) * BM + h * HALF + R; const int row = sel[e * sel_ld + (xr < nvalid ? xr : 0)]; return (unsigned)(row * K + C) * 2u; }
    __device__ __forceinline__ size_t base(const Unit&, size_t) const { return 0; } };
template <class Epi, class Sched, bool ALIGN_EPI = false, bool SP2 = false, class AOff = DenseA>
__device__ __forceinline__ void gemm_phase(PG8_LAS unsigned char* lds, const Gemm g, const Sched& S, const Epi& E, const AOff AO = AOff()) {
    const int tid = otid(), wid = __builtin_amdgcn_readfirstlane(tid >> 6), lane = tid & 63, wr = wid >> 2, wc = wid & 3, fr = lane & 15, fq = lane >> 4;
    const int K = g.K, nt = K / BK;
    unsigned voffB[2];
#pragma unroll
    for (int i = 0; i < 2; ++i) { int R, C; stage_rc(tid * 16 + i * 8192, R, C); const int Rb = Epi::PERM ? ((R & ~31) + perm32(R & 31)) : R;
        voffB[i] = (unsigned)(Rb * K + C) * 2u; }
    const size_t kstep = (size_t)(BK * 2);
    const size_t hstep = (size_t)HALF * K * 2;
    const size_t tstep = 2 * hstep;
    const unsigned ldsw = (unsigned)wid * 1024u;
    const int aoff = lds_byte(wr * 64 + fr, fq * 8), boff = lds_byte(wc * 32 + fr, fq * 8);
#define PG8_SA(b, h) (((b) * 2 + (h)) * HTB)
#define PG8_SB(b, h) ((4 + (b) * 2 + (h)) * HTB)
#define PG8_STAGE(bufoff, gbase, voff) do { _Pragma("unroll") for (int _i = 0; _i < 2; ++_i) \
        __builtin_amdgcn_global_load_lds((const unsigned*)((const char*)(gbase) + (voff)[_i]), (PG8_LAS unsigned*)(lds + (bufoff) + ldsw + _i * 8192), 16, 0, 0); } while (0)
#define PG8_STAGE_AC(b, h, base) PG8_STAGE(PG8_SA(b, h), base, roC[h])
#define PG8_STAGE_A2(b, h, base) PG8_STAGE(PG8_SA(b, h), base, r2[h])
#define PG8_LDA(dst, b, h) do { _Pragma("unroll") for (int m = 0; m < 4; ++m) _Pragma("unroll") for (int k = 0; k < 2; ++k) dst[m][k] = *(const PG8_LAS bf16x8*)(lds + PG8_SA(b, h) + aoff + m * 2048 + k * 1024); } while (0)
#define PG8_LDB(dst, b, h) do { _Pragma("unroll") for (int n = 0; n < 2; ++n) _Pragma("unroll") for (int k = 0; k < 2; ++k) dst[n][k] = *(const PG8_LAS bf16x8*)(lds + PG8_SB(b, h) + boff + n * 2048 + k * 1024); } while (0)
#define PG8_MMA(ai, bj, At, Bt) do { if (GATED && !(((cur.ab >> (ai)) & 1) && ((cur.ab >> (2 + (bj))) & 1))) break; __builtin_amdgcn_s_setprio(1); _Pragma("unroll") for (int m = 0; m < 4; ++m) _Pragma("unroll") for (int n = 0; n < 2; ++n) _Pragma("unroll") for (int k = 0; k < 2; ++k) \
        acc[ai][bj][m][n] = __builtin_amdgcn_mfma_f32_16x16x32_bf16(Bt[n][k], At[m][k], acc[ai][bj][m][n], 0, 0, 0); __builtin_amdgcn_s_setprio(0); } while (0)
#define PG8_WAIT_V(n) asm volatile("s_waitcnt vmcnt(" #n ")" ::: "memory")
#define PG8_WAIT_L(n) asm volatile("s_waitcnt lgkmcnt(" #n ")" ::: "memory")
#define PG8_BAR __builtin_amdgcn_s_barrier()
#define PG8_SCHED __builtin_amdgcn_sched_barrier(0)
    Unit cur, nxt; int ui = 0;
    if (!S.next(0, cur)) return;
    f32x4 acc[2][2][4][2];
#pragma unroll
    for (int a = 0; a < 2; ++a)
#pragma unroll
        for (int b = 0; b < 2; ++b)
#pragma unroll
            for (int m = 0; m < 4; ++m)
#pragma unroll
                for (int n = 0; n < 2; ++n) acc[a][b][m][n] = (f32x4){0.f, 0.f, 0.f, 0.f};
    bf16x8 At[4][2], B0[2][2], B1[2][2];
    unsigned roC[2][2], roN[2][2];
#pragma unroll
    for (int h = 0; h < 2; ++h)
#pragma unroll
        for (int i = 0; i < 2; ++i) { int R, C; stage_rc(tid * 16 + i * 8192, R, C); roC[h][i] = AO.off(cur, h, R, C, K); }
    const char* cA = (const char*)g.A + AO.base(cur, tstep); const char* cB = (const char*)g.Bt + (size_t)cur.pn * tstep;
    S.a_ready(cur);
    if constexpr (SP2) {
        PG8_STAGE(PG8_SB(0, 0), cB, voffB); PG8_STAGE(PG8_SB(0, 1), cB + hstep, voffB); PG8_STAGE_AC(0, 0, cA); PG8_STAGE_AC(0, 1, cA);
        if (wr == 1) PG8_BAR;
        PG8_WAIT_V(2); PG8_BAR;
        PG8_STAGE(PG8_SB(1, 0), cB + kstep, voffB); PG8_STAGE_AC(1, 0, cA + kstep); PG8_STAGE(PG8_SB(1, 1), cB + hstep + kstep, voffB);
        PG8_WAIT_V(6); PG8_BAR;
    } else {
        PG8_STAGE(PG8_SB(0, 0), cB, voffB); PG8_STAGE_AC(0, 0, cA); PG8_STAGE(PG8_SB(0, 1), cB + hstep, voffB); PG8_STAGE_AC(0, 1, cA);
        if (wr == 1) PG8_BAR;
        PG8_WAIT_V(4); PG8_BAR;
        PG8_STAGE(PG8_SB(1, 0), cB + kstep, voffB); PG8_STAGE_AC(1, 0, cA + kstep); PG8_STAGE(PG8_SB(1, 1), cB + hstep + kstep, voffB);
        PG8_WAIT_V(6); PG8_BAR;
    }
    for (;;) {
        const bool has_next = S.next(ui + 1, nxt);
        const char* nA = has_next ? (const char*)g.A + AO.base(nxt, tstep) : cA; const char* nB = has_next ? (const char*)g.Bt + (size_t)nxt.pn * tstep : cB;
#pragma unroll
        for (int h = 0; h < 2; ++h)
#pragma unroll
            for (int i = 0; i < 2; ++i) { if (AOff::GATHER && has_next) { int R, C; stage_rc(tid * 16 + i * 8192, R, C); roN[h][i] = AO.off(nxt, h, R, C, K); } else roN[h][i] = roC[h][i]; }
        auto kloop = [&](auto gated_tag) { constexpr bool GATED = decltype(gated_tag)::value;
        for (int t = 0; t < nt; t += 2) {
            const bool last = (t == nt - 2);
            const char* a1 = cA + (size_t)(t + 1) * kstep;
            const char* a2 = last ? nA : cA + (size_t)(t + 2) * kstep; const char* b2 = last ? nB : cB + (size_t)(t + 2) * kstep;
            unsigned r2[2][2];
#pragma unroll
            for (int h = 0; h < 2; ++h)
#pragma unroll
                for (int i = 0; i < 2; ++i) r2[h][i] = (AOff::GATHER && last) ? roN[h][i] : roC[h][i];
            const char* a3 = a2 + kstep; const char* b3 = b2 + kstep;
            if (last && has_next) S.a_ready(nxt);
            if constexpr (SP2) {
            PG8_LDB(B0, 0, 0); PG8_LDB(B1, 0, 1); PG8_SCHED; PG8_LDA(At, 0, 0); PG8_STAGE_AC(1, 1, a1);
            PG8_WAIT_V(8); PG8_WAIT_L(0); PG8_BAR; PG8_MMA(0, 0, At, B0); PG8_MMA(0, 1, At, B1); PG8_BAR; PG8_SCHED;
            PG8_LDA(At, 0, 1); PG8_STAGE(PG8_SB(0, 0), b2, voffB); PG8_STAGE(PG8_SB(0, 1), b2 + hstep, voffB); PG8_STAGE_A2(0, 0, a2);
            PG8_WAIT_V(8); PG8_WAIT_L(0); PG8_BAR; PG8_MMA(1, 0, At, B0); PG8_MMA(1, 1, At, B1); PG8_BAR; PG8_SCHED;
            PG8_LDB(B0, 1, 0); PG8_LDB(B1, 1, 1); PG8_SCHED; PG8_LDA(At, 1, 0); PG8_STAGE_A2(0, 1, a2);
            PG8_WAIT_V(8); PG8_WAIT_L(0); PG8_BAR; PG8_MMA(0, 0, At, B0); PG8_MMA(0, 1, At, B1); PG8_BAR; PG8_SCHED;
            PG8_LDA(At, 1, 1); PG8_STAGE(PG8_SB(1, 0), b3, voffB); PG8_STAGE(PG8_SB(1, 1), b3 + hstep, voffB); PG8_STAGE_A2(1, 0, a3);
            PG8_WAIT_V(8); PG8_WAIT_L(0); PG8_BAR; PG8_MMA(1, 0, At, B0); PG8_MMA(1, 1, At, B1); PG8_BAR; PG8_SCHED;
            } else {
            PG8_LDB(B0, 0, 0); PG8_SCHED; PG8_LDA(At, 0, 0); PG8_STAGE_AC(1, 1, a1);
            PG8_WAIT_L(8); PG8_BAR; PG8_WAIT_L(0); PG8_MMA(0, 0, At, B0); PG8_BAR; PG8_SCHED;
            PG8_LDB(B1, 0, 1); PG8_STAGE(PG8_SB(0, 0), b2, voffB);
            PG8_BAR; PG8_WAIT_L(0); PG8_MMA(0, 1, At, B1); PG8_BAR;
            PG8_LDA(At, 0, 1); PG8_STAGE_A2(0, 0, a2);
            PG8_BAR; PG8_WAIT_L(0); PG8_MMA(1, 0, At, B0); PG8_BAR; PG8_SCHED;
            PG8_STAGE(PG8_SB(0, 1), b2 + hstep, voffB);
            PG8_WAIT_V(6); PG8_BAR; PG8_MMA(1, 1, At, B1); PG8_BAR;
            PG8_LDB(B0, 1, 0); PG8_SCHED; PG8_LDA(At, 1, 0); PG8_STAGE_A2(0, 1, a2);
            PG8_WAIT_L(8); PG8_BAR; PG8_WAIT_L(0); PG8_MMA(0, 0, At, B0); PG8_BAR; PG8_SCHED;
            PG8_LDB(B1, 1, 1); PG8_STAGE(PG8_SB(1, 0), b3, voffB);
            PG8_BAR; PG8_WAIT_L(0); PG8_MMA(0, 1, At, B1); PG8_BAR;
            PG8_LDA(At, 1, 1); PG8_STAGE_A2(1, 0, a3);
            PG8_BAR; PG8_WAIT_L(0); PG8_MMA(1, 0, At, B0); PG8_BAR; PG8_SCHED;
            PG8_STAGE(PG8_SB(1, 1), b3 + hstep, voffB);
            PG8_WAIT_V(6); PG8_BAR; PG8_MMA(1, 1, At, B1); PG8_BAR;
            }
        }
        };
        if constexpr (Sched::HAS_SPLIT) { if (cur.ab == 15) kloop(std::false_type{}); else kloop(std::true_type{}); } else kloop(std::false_type{});
        if constexpr (ALIGN_EPI) { if (wr == 0) PG8_BAR; }
        if constexpr (!Epi::AFTER_DRAIN) { E(acc, cur, wr, wc, fr, fq); S.done(cur); }
        if (!has_next) break;
#pragma unroll
        for (int a = 0; a < 2; ++a)
#pragma unroll
            for (int b = 0; b < 2; ++b)
#pragma unroll
                for (int m = 0; m < 4; ++m)
#pragma unroll
                    for (int n = 0; n < 2; ++n) acc[a][b][m][n] = (f32x4){0.f, 0.f, 0.f, 0.f};
        cur = nxt; cA = nA; cB = nB; ++ui;
#pragma unroll
        for (int h = 0; h < 2; ++h)
#pragma unroll
            for (int i = 0; i < 2; ++i) roC[h][i] = roN[h][i];
        if constexpr (ALIGN_EPI) { if (wr == 1) PG8_BAR; }
    }
    PG8_WAIT_V(0);
    if constexpr (!ALIGN_EPI) { if (wr == 0) PG8_BAR; }
    PG8_BAR;
    if constexpr (Epi::AFTER_DRAIN) { E.fused(acc, cur, wr, wc, fr, fq, lds, wid, lane); S.done(cur); }
#undef PG8_SA
#undef PG8_STAGE_AC
#undef PG8_STAGE_A2
#undef PG8_SB
#undef PG8_STAGE
#undef PG8_LDA
#undef PG8_LDB
#undef PG8_MMA
#undef PG8_WAIT_V
#undef PG8_WAIT_L
#undef PG8_BAR
#undef PG8_SCHED
}
}

__device__ __forceinline__ void mini_barrier(unsigned* ctr, unsigned n) {
    asm volatile("s_waitcnt vmcnt(0)" ::: "memory");
    __syncthreads();
    if (threadIdx.x == 0) {
        __builtin_amdgcn_fence(__ATOMIC_RELEASE, "agent");
        asm volatile("s_waitcnt vmcnt(0)" ::: "memory");
        (void)xb_add(ctr, 1u);
        unsigned sp = 0u; while (xb_ld(ctr) < n) { __builtin_amdgcn_s_sleep(1); if (++sp > XB_SPIN_CAP) break; }
        __builtin_amdgcn_fence(__ATOMIC_ACQUIRE, "agent");
        asm volatile("s_waitcnt vmcnt(0)" ::: "memory");
    }
    __syncthreads();
}
constexpr int CW_MINI = 16384;
__device__ __forceinline__ void ph_setup(const Prm& p, LAS float* lds) {
    float* modv = (float*)(p.ws + WS_MODV);
    float* rope = (float*)(p.ws + WS_ROPE);
    const int tid = otid();
    LAS float* sc = lds;
    LAS float* red = lds + 5 * 1024;
    for (int i = tid; i < 5 * 1024; i += NTHREADS) { const int r = i >> 10, k = i & 1023; const float v = r < 4 ? p.c[r * 1024 + k] : p.c_ctx[k]; sc[i] = siluf_(v); }
    __syncthreads();
    const int nitems = DEPTH * 6144 / 128;
    for (int it = obid(); it < nitems; it += gridDim.x) {
        const int l = it / 48, n0 = (it % 48) * 128;
        const int kp = tid >> 5, q = tid & 31;
        const float* w = p.mod_w + ((size_t)l * 1024 + kp * 64) * 6144 + n0 + 4 * q;
        f32x4 a[5];
#pragma unroll
        for (int r = 0; r < 5; ++r) a[r] = (f32x4){0.f, 0.f, 0.f, 0.f};
#pragma unroll 1
        for (int k0 = 0; k0 < 64; k0 += 8) { f32x4 wv[8];
#pragma unroll
            for (int k = 0; k < 8; ++k) wv[k] = __builtin_nontemporal_load((const f32x4*)(w + (size_t)(k0 + k) * 6144));
#pragma unroll
            for (int k = 0; k < 8; ++k) { const int kk = kp * 64 + k0 + k;
#pragma unroll
                for (int r = 0; r < 5; ++r) a[r] += wv[k] * sc[r * 1024 + kk]; } }
#pragma unroll
        for (int r = 0; r < 5; ++r) *(LAS f32x4*)(red + ((kp * 5 + r) * 128 + 4 * q)) = a[r];
        __syncthreads();
        for (int i = tid; i < 5 * 128; i += NTHREADS) { const int r = i >> 7, n = i & 127; float s = p.mod_b[l * 6144 + n0 + n];
#pragma unroll
            for (int q2 = 0; q2 < 16; ++q2) s += red[(q2 * 5 + r) * 128 + n];
            modv[((size_t)l * 5 + r) * 6144 + n0 + n] = s; }
        __syncthreads();
    }
    if (obid() == gridDim.x - 1) {
        for (int i = tid; i < 64 * 16; i += NTHREADS) { const int pos = i >> 4, f = i & 15; const float inv = exp2f(-(float)f * (13.287712379549449f / 16.f)); const float ang = (float)pos * inv;
            rope[i * 2] = __cosf(ang); rope[i * 2 + 1] = __sinf(ang); }
    }
}

#define CJ(jj) (8 * lane + 512 * ((jj) >> 1) + 4 * ((jj) & 1))
__device__ __forceinline__ void acc_bf16x8(f32x4& lo, f32x4& hi, const u32x4 w, float f) {
    lo.x += f * __uint_as_float(w.x << 16); lo.y += f * __uint_as_float(w.x & 0xffff0000u); lo.z += f * __uint_as_float(w.y << 16); lo.w += f * __uint_as_float(w.y & 0xffff0000u);
    hi.x += f * __uint_as_float(w.z << 16); hi.y += f * __uint_as_float(w.z & 0xffff0000u); hi.z += f * __uint_as_float(w.w << 16); hi.w += f * __uint_as_float(w.w & 0xffff0000u);
}
__device__ __forceinline__ u32x4 pack_bf16x8(const f32x4 lo, const f32x4 hi) { u32x4 o; o.x = pk2(lo.x, lo.y); o.y = pk2(lo.z, lo.w); o.z = pk2(hi.x, hi.y); o.w = pk2(hi.z, hi.w); return o; }
__device__ __forceinline__ void load_xrow(const bf16* xrow, int lane, f32x4 (&v)[4]) {
#pragma unroll
    for (int j2 = 0; j2 < 2; ++j2) { const u32x4 w = __builtin_nontemporal_load((const u32x4*)(xrow + 8 * lane + 512 * j2)); v[2 * j2] = (f32x4){0.f, 0.f, 0.f, 0.f}; v[2 * j2 + 1] = (f32x4){0.f, 0.f, 0.f, 0.f}; acc_bf16x8(v[2 * j2], v[2 * j2 + 1], w, 1.f); }
}
__device__ __forceinline__ void store_xrow(bf16* xrow, int lane, const f32x4 (&v)[4]) {
#pragma unroll
    for (int j2 = 0; j2 < 2; ++j2) *(u32x4*)(xrow + 8 * lane + 512 * j2) = pack_bf16x8(v[2 * j2], v[2 * j2 + 1]);
}
struct Sel4 { const bf16* y[4]; float f[4]; unsigned long long rest; };
__device__ __forceinline__ Sel4 moe_sel4(const bf16* YE, int sl, int lane) {
    Sel4 q; unsigned long long m = __ballot(sl >= 0); int e0 = 0, s0 = 0;
#pragma unroll
    for (int k = 0; k < 4; ++k) { const bool has = m != 0; const int e = has ? __builtin_ctzll(m) : e0; if (has) m &= m - 1; const int s = __builtin_amdgcn_readlane(sl, e);
        if (k == 0) { e0 = e; s0 = has ? s : 0; }
        q.y[k] = YE + ((size_t)(has ? e : e0) * XR + (has ? s : s0)) * D + 8 * lane; q.f[k] = has ? 1.f : 0.f; }
    q.rest = m; return q;
}
__device__ __forceinline__ void moe_load4(const Sel4& q, u32x4 (&w)[4][2]) {
#pragma unroll
    for (int k = 0; k < 4; ++k)
#pragma unroll
        for (int j = 0; j < 2; ++j) w[k][j] = __builtin_nontemporal_load((const u32x4*)(q.y[k] + 512 * j));
}
__device__ __forceinline__ void moe_acc4(const Sel4& q, const u32x4 (&w)[4][2], f32x4 (&a)[4]) {
#pragma unroll
    for (int jj = 0; jj < 4; ++jj) a[jj] = (f32x4){0.f, 0.f, 0.f, 0.f};
#pragma unroll
    for (int k = 0; k < 4; ++k)
#pragma unroll
        for (int j = 0; j < 2; ++j) acc_bf16x8(a[2 * j], a[2 * j + 1], w[k][j], q.f[k]);
}
__device__ __forceinline__ void moe_gather_rest(const bf16* YE, int sl, unsigned long long m, int lane, f32x4 (&a)[4]) {
    while (m) { const int e = __builtin_ctzll(m); m &= m - 1; const int s = __builtin_amdgcn_readlane(sl, e); const bf16* y = YE + ((size_t)e * XR + s) * D + 8 * lane;
#pragma unroll
        for (int j = 0; j < 2; ++j) { const u32x4 w = *(const u32x4*)(y + 512 * j); acc_bf16x8(a[2 * j], a[2 * j + 1], w, 1.f); } }
}
__device__ __forceinline__ void norm1_pair(const Prm& p, int l, int r, int lane, bool comb_ctx, bool wb) {
    const float* modv = (const float*)(p.ws + WS_MODV) + (size_t)l * 5 * 6144;
    const float* modp = (const float*)(p.ws + WS_MODV) + (size_t)(l > 0 ? l - 1 : 0) * 5 * 6144;
    bf16* X = (bf16*)(p.ws + WS_X); bf16* H = (bf16*)(p.ws + WS_H); const int* tokslot = (const int*)(p.ws + WS_TOKSLOT); const bf16* YE = (const bf16*)(p.ws + WS_YE);
    const bool isc = r >= ML; const int mr = isc ? 4 : (r >> 12);
    f32x4 v[2][4];
    if (l == 0) { const float* src = isc ? p.ctx + (size_t)(r - ML) * D : p.x + (size_t)r * D;
#pragma unroll
        for (int u = 0; u < 2; ++u)
#pragma unroll
            for (int j = 0; j < 4; ++j) v[u][j] = __builtin_nontemporal_load((const f32x4*)(src + (size_t)u * D + CJ(j)));
    } else {
        const bool comb = !isc || comb_ctx;
        int sl0 = -1, sl1 = -1; if (comb && lane < NE) { sl0 = tokslot[(size_t)r * NE + lane]; sl1 = tokslot[(size_t)(r + 1) * NE + lane]; }
        load_xrow(X + (size_t)r * D, lane, v[0]); load_xrow(X + (size_t)(r + 1) * D, lane, v[1]);
        if (comb) { const Sel4 q0 = moe_sel4(YE, sl0, lane), q1 = moe_sel4(YE, sl1, lane); u32x4 w0[4][2], w1[4][2]; moe_load4(q0, w0); moe_load4(q1, w1);
            f32x4 a0[4], a1[4]; moe_acc4(q0, w0, a0); moe_acc4(q1, w1, a1);
            if (q0.rest) moe_gather_rest(YE, sl0, q0.rest, lane, a0); if (q1.rest) moe_gather_rest(YE, sl1, q1.rest, lane, a1);
#pragma unroll
            for (int j = 0; j < 4; ++j) { const f32x4 g2 = *(const f32x4*)(modp + (size_t)mr * 6144 + 5 * 1024 + CJ(j)); v[0][j] += g2 * a0[j]; v[1][j] += g2 * a1[j]; }
            if (wb) { store_xrow(X + (size_t)r * D, lane, v[0]); store_xrow(X + (size_t)(r + 1) * D, lane, v[1]); } }
    }
#pragma unroll
    for (int u = 0; u < 2; ++u) { float s = 0.f;
#pragma unroll
        for (int j = 0; j < 4; ++j) s += v[u][j].x * v[u][j].x + v[u][j].y * v[u][j].y + v[u][j].z * v[u][j].z + v[u][j].w * v[u][j].w;
        const float rstd = rsqrtf(wave_sum(s) * (1.f / D) + EPS);
        f32x4 hh[4];
#pragma unroll
        for (int j = 0; j < 4; ++j) { const int c = CJ(j);
            const f32x4 g = *(const f32x4*)(p.norm1_g + l * D + c), sh = *(const f32x4*)(modv + (size_t)mr * 6144 + c), scl = *(const f32x4*)(modv + (size_t)mr * 6144 + 1024 + c);
            hh[j] = (v[u][j] * rstd * g) * (scl + 1.f) + sh; }
#pragma unroll
        for (int j2 = 0; j2 < 2; ++j2) *(u32x4*)(H + (size_t)(r + u) * D + 8 * lane + 512 * j2) = pack_bf16x8(hh[2 * j2], hh[2 * j2 + 1]); }
}
__device__ __forceinline__ void ph_norm1(const Prm& p, int l, bool wb = true) {
    const int lane = otid() & 63, ngw = gridDim.x * 8, gw = ngw - 1 - (obid() * 8 + (otid() >> 6));
    const int nrows = (l <= 2) ? MT : ML;
    const bool comb_ctx = (l >= 1 && l <= 2);
    for (int r = gw * 2; r < nrows; r += ngw * 2) norm1_pair(p, l, r, lane, comb_ctx, wb);
}
__device__ __forceinline__ void ph_final(const Prm& p) {
    const int lane = otid() & 63, gw = obid() * 8 + (otid() >> 6), ngw = gridDim.x * 8;
    const float* modp = (const float*)(p.ws + WS_MODV) + (size_t)3 * 5 * 6144;
    const bf16* X = (const bf16*)(p.ws + WS_X); const int* tokslot = (const int*)(p.ws + WS_TOKSLOT); const bf16* YE = (const bf16*)(p.ws + WS_YE);
    for (int r = gw * 2; r < ML; r += ngw * 2) {
        const int mr = r >> 12; f32x4 v[2][4];
        int sl0 = -1, sl1 = -1; if (lane < NE) { sl0 = tokslot[(size_t)r * NE + lane]; sl1 = tokslot[(size_t)(r + 1) * NE + lane]; }
        load_xrow(X + (size_t)r * D, lane, v[0]); load_xrow(X + (size_t)(r + 1) * D, lane, v[1]);
        const Sel4 q0 = moe_sel4(YE, sl0, lane), q1 = moe_sel4(YE, sl1, lane); u32x4 w0[4][2], w1[4][2]; moe_load4(q0, w0); moe_load4(q1, w1);
        f32x4 a0[4], a1[4]; moe_acc4(q0, w0, a0); moe_acc4(q1, w1, a1);
        if (q0.rest) moe_gather_rest(YE, sl0, q0.rest, lane, a0); if (q1.rest) moe_gather_rest(YE, sl1, q1.rest, lane, a1);
#pragma unroll
        for (int j = 0; j < 4; ++j) { const f32x4 g2 = *(const f32x4*)(modp + (size_t)mr * 6144 + 5 * 1024 + CJ(j));
            *(f32x4*)(p.out + (size_t)r * D + CJ(j)) = v[0][j] + g2 * a0[j]; *(f32x4*)(p.out + (size_t)(r + 1) * D + CJ(j)) = v[1][j] + g2 * a1[j]; }
    }
}

__device__ __forceinline__ unsigned cvtpk_(float lo, float hi) { unsigned r; asm volatile("v_cvt_pk_bf16_f32 %0, %1, %2" : "=v"(r) : "v"(lo), "v"(hi)); return r; }
__device__ __forceinline__ void cvt_item(const float* W, int N, bf16* WT, int gu, LAS unsigned char* img, int item, int tid) {
    const int nblk = N / 512, kb = item / nblk, nb = item % nblk, k0 = 64 * kb, n0 = 512 * nb;
    const int lane = tid & 63, w = tid >> 6;
    const float* src = W + (size_t)(k0 + 8 * w) * N + n0 + 4 * lane;
    f32x4 a[4][2], b[4][2];
#pragma unroll
    for (int j = 0; j < 4; ++j)
#pragma unroll
        for (int hh = 0; hh < 2; ++hh) { a[j][hh] = __builtin_nontemporal_load((const f32x4*)(src + (size_t)(2 * j) * N + 256 * hh)); b[j][hh] = __builtin_nontemporal_load((const f32x4*)(src + (size_t)(2 * j + 1) * N + 256 * hh)); }
    __syncthreads();
    const int sw = (lane >> 1) & 7;
#pragma unroll
    for (int hh = 0; hh < 2; ++hh)
#pragma unroll
        for (int j = 0; j < 4; ++j) { const int wofs = ((w ^ sw) * 4 + j) * 4;
            LAS unsigned char* rowp = img + (size_t)(4 * lane + 256 * hh) * 144 + wofs;
            *(LAS unsigned*)(rowp) = cvtpk_(a[j][hh].x, b[j][hh].x); *(LAS unsigned*)(rowp + 144) = cvtpk_(a[j][hh].y, b[j][hh].y);
            *(LAS unsigned*)(rowp + 288) = cvtpk_(a[j][hh].z, b[j][hh].z); *(LAS unsigned*)(rowp + 432) = cvtpk_(a[j][hh].w, b[j][hh].w); }
    __syncthreads();
    const int jq = tid & 7, nr = tid >> 3;
#pragma unroll
    for (int i = 0; i < 8; ++i) { const int n = nr + 64 * i; const u32x4 v = *(const LAS u32x4*)(img + n * 144 + ((jq ^ ((n >> 3) & 7)) * 16));
        const int ncol = n0 + n; int drow;
        if (gu < 0) drow = ncol; else if (gu < 2) drow = (ncol >> 7) * 256 + (ncol & 127) + gu * 128;
        else { const int ch = (ncol - 1024) & 1023; drow = ncol < 1024 ? ncol : 1024 + (ch >> 7) * 256 + (ncol >= 2048 ? 128 : 0) + (ch & 127); }
        *(u32x4*)(WT + (size_t)drow * 1024 + k0 + 8 * jq) = v; }
}
__device__ __forceinline__ void ph_convert(const Prm& p, int l, LAS unsigned char* lds) {
    const int tid = otid();
    const bool even = (l & 1) == 0; const int Nin = even ? 4096 : 3072;
    const float* Win = even ? p.even_w_in + (size_t)(l / 2) * D * 4096 : p.conv_w_in + (size_t)(l / 2) * D * 3072;
    const float* Wout = even ? p.even_w_out + (size_t)(l / 2) * D * D : p.conv_w_out + (size_t)(l / 2) * D * D;
    const int I_IN = 16 * (Nin / 512), I_OUT = 32, I_E = 32;
    const int total = I_IN + I_OUT + NE * 3 * I_E;
    for (int it = obid(); it < total; it += gridDim.x) {
        int r = it;
        if (r < I_IN) { cvt_item(Win, Nin, (bf16*)(p.ws + WS_WIN), even ? -1 : 2, lds, r, tid); continue; } r -= I_IN;
        if (r < I_OUT) { cvt_item(Wout, D, (bf16*)(p.ws + WS_WOUT), -1, lds, r, tid); continue; } r -= I_OUT;
        const int e = r / (3 * I_E), w = (r / I_E) % 3, item = r % I_E;
        if (w < 2) cvt_item((w == 0 ? p.w_gate : p.w_up) + ((size_t)l * NE + e) * D * FF, FF, (bf16*)(p.ws + WS_WUP) + (size_t)e * 2048 * D, w, lds, item, tid);
        else cvt_item(p.w_down + ((size_t)l * NE + e) * FF * D, D, (bf16*)(p.ws + WS_WDN) + (size_t)e * D * FF, -1, lds, item, tid);
    }
    __syncthreads();
}

template <int MODE> __device__ __forceinline__ void ph_probe_read(const Prm& p, int l) {
    const f32x4* s0 = (const f32x4*)(p.w_gate + (size_t)l * NE * D * FF);
    const f32x4* s1 = (const f32x4*)(p.w_up + (size_t)l * NE * D * FF); const f32x4* s2 = (const f32x4*)(p.w_down + (size_t)l * NE * D * FF);
    const size_t n4 = (size_t)NE * D * FF / 4; f32x4 acc = (f32x4){0.f, 0.f, 0.f, 0.f};
    if (MODE == 0 || MODE == 1) {
        const size_t st = (size_t)gridDim.x * NTHREADS;
        for (size_t i = (size_t)obid() * NTHREADS + otid(); i < n4; i += st * 4) {
#pragma unroll
            for (int t = 0; t < 3; ++t) { const f32x4* s = t == 0 ? s0 : (t == 1 ? s1 : s2);
#pragma unroll
                for (int k = 0; k < 4; ++k) { const size_t j = i + k * st; if (j < n4) acc += (MODE == 1) ? __builtin_nontemporal_load(s + j) : s[j]; } } }
    } else {
        constexpr int NL = MODE == 2 ? 16 : 32; const int lane = otid() & 63; const size_t gw = (size_t)obid() * 8 + (otid() >> 6), ngw = (size_t)gridDim.x * 8;
        const size_t nch = 3 * n4 / (64 * NL);
        for (size_t c = gw; c < nch; c += ngw) { const size_t base = c * 64 * NL; const f32x4* s = base < n4 ? s0 + base : (base < 2 * n4 ? s1 + (base - n4) : s2 + (base - 2 * n4));
            f32x4 v[NL];
#pragma unroll
            for (int k = 0; k < NL; ++k) v[k] = __builtin_nontemporal_load(s + k * 64 + lane);
#pragma unroll
            for (int k = 0; k < NL; ++k) acc += v[k]; }
    }
    if (acc.x + acc.y + acc.z + acc.w == 1.2345e33f) ((float*)(p.ws + WS_OF))[otid()] = acc.x;
}
template <int MODE> __device__ __forceinline__ void ph_probe_cvt(const Prm& p, int l) {
    const int lane = otid() & 63, gw = obid() * 8 + (otid() >> 6), ngw = gridDim.x * 8; f32x4 acc = (f32x4){0.f, 0.f, 0.f, 0.f};
    for (int it = gw; it < NE * 3 * 256; it += ngw) { const int e = it / 768, w = (it / 256) % 3, item = it % 256, kb = item / 16, nb = item % 16;
        if (MODE == 4) { const float* W = (w == 0 ? p.w_gate : (w == 1 ? p.w_up : p.w_down)) + ((size_t)l * NE + e) * D * FF; const float* src = W + (size_t)(64 * kb + 2 * (lane >> 4)) * 1024 + 64 * nb + 4 * (lane & 15);
#pragma unroll
            for (int j = 0; j < 8; ++j) { acc += __builtin_nontemporal_load((const f32x4*)(src + (size_t)(8 * j) * 1024)); acc += __builtin_nontemporal_load((const f32x4*)(src + (size_t)(8 * j + 1) * 1024)); } }
        else { bf16* WT = (bf16*)(p.ws + WS_OF) + (size_t)((e * 3 + w) % 16) * 1024 * 1024; const u32x4 v = {(unsigned)it, 1u, 2u, 3u};
#pragma unroll
            for (int i = 0; i < 8; ++i) { const int n = (lane >> 3) + 8 * i; *(u32x4*)(WT + (size_t)(64 * nb + n) * 1024 + 64 * kb + 8 * (lane & 7)) = v; } } }
    if (acc.x + acc.y + acc.z + acc.w == 1.2345e33f) ((float*)(p.ws + WS_OF))[otid()] = acc.x;
}
__device__ __forceinline__ void ph_gemm_in(const Prm& p, int l, LAS unsigned char* ldsb) {
    const bool even = (l & 1) == 0; const int N = even ? 4096 : 3072; const int M = (l <= 2) ? MT : ML;
    pg8::Gemm g{(const bf16*)(p.ws + WS_H), (const bf16*)(p.ws + WS_WIN), M, N, D};
    if (even) { pg8::StaticOrderT<4> S; S.init(M, N, (int)gridDim.x, obid(), ML); pg8::EpiBf16 E{(bf16*)(p.ws + WS_PROJ), N}; pg8::gemm_phase<pg8::EpiBf16, pg8::StaticOrderT<4>, true, true>(ldsb, g, S, E); }
    else { pg8::StaticOrderT<2> S; S.init(M, N, (int)gridDim.x, obid(), ML); pg8::EpiConvIn E{(bf16*)(p.ws + WS_PROJ)}; pg8::gemm_phase<pg8::EpiConvIn, pg8::StaticOrderT<2>, true, true>(ldsb, g, S, E); }
}
__device__ __forceinline__ void ph_gemm_out(const Prm& p, int l, LAS unsigned char* ldsb) {
    const int M = ML;
    pg8::Gemm g{(const bf16*)(p.ws + WS_MIX), (const bf16*)(p.ws + WS_WOUT), M, D, D}; pg8::StaticOrder S; S.init(M, D, (int)gridDim.x, obid());
    pg8::EpiGY E{(bf16*)(p.ws + WS_H), (const float*)(p.ws + WS_MODV) + (size_t)l * 5 * 6144 + 2 * 1024, ML};
    pg8::gemm_phase<pg8::EpiGY, pg8::StaticOrder, true, true>(ldsb, g, S, E);
}
__device__ __forceinline__ void ph_expert_up(const Prm& p, int l, LAS unsigned char* ldsb) {
    pg8::Gemm g{(const bf16*)(p.ws + WS_H2), (const bf16*)(p.ws + WS_WUP), NE * XR, NE * 2048, D};
    pg8::GroupOrderT<8, 0> S; S.init((l < 2) ? 9 : 8, NE, (int)gridDim.x, vcu_id());
    pg8::EpiSwiglu E{(bf16*)(p.ws + WS_ACT), 8};
    pg8::GatherA AO{(const int*)(p.ws + WS_SEL), XR, 9, (l < 2) ? 2176 : 2048};
    pg8::gemm_phase<pg8::EpiSwiglu, pg8::GroupOrderT<8, 0>, true, true, pg8::GatherA>(ldsb, g, S, E, AO);
}
__device__ __forceinline__ void ph_expert_down(const Prm& p, int l, LAS unsigned char* ldsb) {
    pg8::Gemm g{(const bf16*)(p.ws + WS_ACT), (const bf16*)(p.ws + WS_WDN), NE * XR, NE * 1024, FF};
    pg8::GroupOrderT<4, 1> S; S.init((l < 2) ? 9 : 8, NE, (int)gridDim.x, vcu_id());
    pg8::EpiDown E{(bf16*)(p.ws + WS_YE), (const float*)(p.ws + WS_GATE), 4};
    pg8::gemm_phase<pg8::EpiDown, pg8::GroupOrderT<4, 1>, true, true>(ldsb, g, S, E);
}

__device__ __forceinline__ void ph_qkprep(const Prm& p, int l) {
    const int e = l / 2; bf16* PROJ = (bf16*)(p.ws + WS_PROJ); const float* rope = (const float*)(p.ws + WS_ROPE);
    const int NQK0 = gridDim.x == 256 ? 64 : 0;
    if (obid() < NQK0) return;
    const int j = otid() & 7, ngrp = ((int)gridDim.x - NQK0) * (NTHREADS / 8);
    const float* kg = p.kn_g + e * 64;
    const f32x4 g0 = *(const f32x4*)(kg + 8 * j), g1 = *(const f32x4*)(kg + 8 * j + 4);
    const float gg[8] = {g0.x, g0.y, g0.z, g0.w, g1.x, g1.y, g1.z, g1.w};
    const int total = MT * 8;
    for (int g = ((obid() - NQK0) * NTHREADS + otid()) >> 3; g < total; g += ngrp) {
        const int r = g >> 3, hm = g & 7;
        bf16* ptr = PROJ + (size_t)r * 4096 + 2560 + 512 + hm * 64 + 8 * j;
        const u32x4 w = *(const u32x4*)ptr; const unsigned ww[4] = {w.x, w.y, w.z, w.w};
        float v[8];
#pragma unroll
        for (int m = 0; m < 4; ++m) { v[2 * m] = __uint_as_float(ww[m] << 16); v[2 * m + 1] = __uint_as_float(ww[m] & 0xffff0000u); }
        float s = 0.f;
#pragma unroll
        for (int m = 0; m < 8; ++m) s += v[m] * v[m];
        s += __shfl_xor(s, 1); s += __shfl_xor(s, 2); s += __shfl_xor(s, 4);
        const float rstd = rsqrtf(s * (1.f / 64.f) + EPS);
#pragma unroll
        for (int m = 0; m < 8; ++m) v[m] *= rstd * gg[m];
        if (r < ML) { const int t = r & 4095, pos = (j & 4) ? (t & 63) : (t >> 6);
            const float* rp = rope + (pos * 16 + 8 * (j & 1)) * 2; const f32x4 c0 = *(const f32x4*)rp, c1 = *(const f32x4*)(rp + 4), c2 = *(const f32x4*)(rp + 8), c3 = *(const f32x4*)(rp + 12);
            const float cs[16] = {c0.x, c0.y, c0.z, c0.w, c1.x, c1.y, c1.z, c1.w, c2.x, c2.y, c2.z, c2.w, c3.x, c3.y, c3.z, c3.w};
            const float sg = (j & 2) ? 1.f : -1.f;
#pragma unroll
            for (int m = 0; m < 8; ++m) { const float pv = __shfl_xor(v[m], 2); v[m] = v[m] * cs[2 * m] + sg * pv * cs[2 * m + 1]; } }
        *(u32x4*)ptr = (u32x4){cvtpk_(v[0], v[1]), cvtpk_(v[2], v[3]), cvtpk_(v[4], v[5]), cvtpk_(v[6], v[7])};
    }
}

__device__ __forceinline__ void ph_hgrn_naive(const Prm& p, int l, LAS float* lds) {
    const int ev = l / 2; const bf16* PROJ = (const bf16*)(p.ws + WS_PROJ); float* OF = (float*)(p.ws + WS_OF);
    const int tid = otid(), el = tid >> 4, dg = tid & 15;
    LAS float* sq = lds;
    LAS float* sk = lds + 64 * 128;
    LAS float* sf = lds + 2 * 64 * 128;
    LAS float* sv = lds + 3 * 64 * 128;
    for (int it = obid(); it < 128; it += gridDim.x) {
        const int b = it >> 5, h = (it >> 3) & 3, dir = (it >> 2) & 1, eq = it & 3;
        float S[8];
#pragma unroll
        for (int j = 0; j < 8; ++j) S[j] = 0.f;
        for (int c0 = 0; c0 < (TC + T) / 64; ++c0) {
            const bool isc = c0 < 4; const int step0 = isc ? c0 * 64 : (c0 - 4) * 64; const int len = isc ? TC : T; const int rbase = isc ? ML + b * TC : b * T;
            __syncthreads();
            for (int i = tid; i < 64 * 128; i += NTHREADS) { const int s = i >> 7, d = i & 127; const int tt = dir ? (len - 1 - (step0 + s)) : (step0 + s);
                const bf16* row = PROJ + (size_t)(rbase + tt) * 4096; const int col = h * 128 + d;
                float lb = 0.f;
                if (ev == 1) { const float l0 = p.hgrn_lb[(0 * 2 + dir) * 512 + col], l1 = p.hgrn_lb[(1 * 2 + dir) * 512 + col]; lb = 1.f / (1.f + __expf(l0 - l1)); }
                const float z = bf2f(row[512 + dir * 512 + col]); const float sg = sigmoidf_(z);
                const float f = lb + (1.f - lb) * sg;
                sq[i] = bf2f(row[col]); sf[i] = f; sk[i] = 1.f - f; }
            for (int i = tid; i < 64 * 32; i += NTHREADS) { const int s = i >> 5, e2 = i & 31; const int tt = dir ? (len - 1 - (step0 + s)) : (step0 + s);
                sv[i] = bf2f(PROJ[(size_t)(rbase + tt) * 4096 + 1536 + h * 128 + eq * 32 + e2]); }
            __syncthreads();
#pragma unroll 1
            for (int s = 0; s < 64; ++s) {
                const f32x4 q0 = *(const LAS f32x4*)(sq + s * 128 + dg * 8), q1 = *(const LAS f32x4*)(sq + s * 128 + dg * 8 + 4);
                const f32x4 k0 = *(const LAS f32x4*)(sk + s * 128 + dg * 8), k1 = *(const LAS f32x4*)(sk + s * 128 + dg * 8 + 4);
                const f32x4 f0 = *(const LAS f32x4*)(sf + s * 128 + dg * 8), f1 = *(const LAS f32x4*)(sf + s * 128 + dg * 8 + 4);
                const float v = sv[s * 32 + el];
                S[0] = f0.x * S[0] + k0.x * v; S[1] = f0.y * S[1] + k0.y * v; S[2] = f0.z * S[2] + k0.z * v; S[3] = f0.w * S[3] + k0.w * v;
                S[4] = f1.x * S[4] + k1.x * v; S[5] = f1.y * S[5] + k1.y * v; S[6] = f1.z * S[6] + k1.z * v; S[7] = f1.w * S[7] + k1.w * v;
                float o = q0.x * S[0] + q0.y * S[1] + q0.z * S[2] + q0.w * S[3] + q1.x * S[4] + q1.y * S[5] + q1.z * S[6] + q1.w * S[7];
                o += __shfl_xor(o, 1); o += __shfl_xor(o, 2); o += __shfl_xor(o, 4); o += __shfl_xor(o, 8);
                if (dg == 0) { const int tt = dir ? (len - 1 - (step0 + s)) : (step0 + s); OF[((size_t)dir * MT + rbase + tt) * 512 + h * 128 + eq * 32 + el] = o; }
            }
        }
        __syncthreads();
    }
}
__device__ __forceinline__ void ph_hgrn_readout(const Prm& p, int l) {
    const int ev = l / 2; const bf16* PROJ = (const bf16*)(p.ws + WS_PROJ); const float* OF = (const float*)(p.ws + WS_OF); bf16* MIX = (bf16*)(p.ws + WS_MIX);
    const int lane = otid() & 63, gw = obid() * 8 + (otid() >> 6), ngw = gridDim.x * 8;
    const int nrows = (l < 2) ? MT : ML;
    for (int g = gw; g < nrows * 4; g += ngw) { const int r = g >> 2, h = g & 3;
        const float o0 = OF[(size_t)r * 512 + h * 128 + lane] + OF[((size_t)MT + r) * 512 + h * 128 + lane];
        const float o1 = OF[(size_t)r * 512 + h * 128 + 64 + lane] + OF[((size_t)MT + r) * 512 + h * 128 + 64 + lane];
        const float rstd = rsqrtf(wave_sum(o0 * o0 + o1 * o1) * (1.f / 128.f) + EPS);
        const float g0 = p.hgrn_g[(ev * 4 + h) * 128 + lane], g1 = p.hgrn_g[(ev * 4 + h) * 128 + 64 + lane];
        const float ga0 = bf2f(PROJ[(size_t)r * 4096 + 2048 + h * 128 + lane]), ga1 = bf2f(PROJ[(size_t)r * 4096 + 2048 + h * 128 + 64 + lane]);
        MIX[(size_t)r * D + h * 128 + lane] = f2bf(o0 * rstd * g0 * siluf_(ga0)); MIX[(size_t)r * D + h * 128 + 64 + lane] = f2bf(o1 * rstd * g1 * siluf_(ga1)); }
}

namespace dat {
using bf16x8 = __attribute__((ext_vector_type(8))) short;
using s16x4  = __attribute__((ext_vector_type(4))) short;
using f32x16 = __attribute__((ext_vector_type(16))) float;
constexpr int SHM_V = 64 * 128 * 2, SHM_K = 64 * 128 * 2;
#define DKSWZ(row, colB) ((row) * 256 + ((colB) ^ (((row) & 7) << 4)))
__device__ __forceinline__ int crow(int r, int hi) { return (r & 3) + 8 * (r >> 2) + 4 * hi; }
__device__ __forceinline__ unsigned cvtpk(float lo, float hi) { unsigned r; asm volatile("v_cvt_pk_bf16_f32 %0, %1, %2" : "=v"(r) : "v"(lo), "v"(hi)); return r; }
__device__ __forceinline__ int v_st(int k, int c) { const int kk = (k & ~0xC) | ((k & 4) << 1) | ((k & 8) >> 1); return ((kk >> 3) * 4 + (c >> 5)) * 512 + ((kk & 7) * 32 + (c & 31)) * 2; }
__device__ __forceinline__ int v_rd_base(int lane) { return ((lane & 3) << 3) | (((lane >> 2) & 3) << 6) | (((lane >> 4) & 1) << 5) | (((lane >> 5) & 1) << 8); }
constexpr int v_rd_off(int d0, int ks, int half) { return d0 * 512 + ks * 4096 + half * 2048; }
template <int OFF> __device__ __forceinline__ s16x4 tr_read(int vb) { s16x4 r; asm volatile("ds_read_b64_tr_b16 %0, %1 offset:%2" : "=&v"(r) : "v"(vb), "i"(OFF) : "memory"); return r; }
template <int VAR> __device__ __forceinline__ void softmax_pack(f32x16& p0, f32x16& p1, float negb, float& l, bf16x8& pa0, bf16x8& pa1, bf16x8& pa2, bf16x8& pa3) {
    if (VAR == 5) {
#pragma unroll
    for (int r = 0; r < 16; ++r) { p0[r] = __builtin_amdgcn_exp2f(p0[r]); p1[r] = __builtin_amdgcn_exp2f(p1[r]); } }
    else if (VAR != 1) {
#pragma unroll
    for (int r = 0; r < 16; ++r) { p0[r] = __builtin_amdgcn_exp2f(p0[r] + negb); p1[r] = __builtin_amdgcn_exp2f(p1[r] + negb); } }
    float ps = 0.f;
#pragma unroll
    for (int r = 0; r < 16; ++r) ps += p0[r] + p1[r];
    { auto rr = __builtin_amdgcn_permlane32_swap(__float_as_uint(ps), __float_as_uint(ps), false, false); ps = __uint_as_float(rr[0]) + __uint_as_float(rr[1]); }
    l += ps;
#define DPK4(P, BASE, OUT) do { unsigned a0 = cvtpk(P[BASE + 0], P[BASE + 1]), a1 = cvtpk(P[BASE + 2], P[BASE + 3]);   \
    unsigned b0 = cvtpk(P[BASE + 4], P[BASE + 5]), b1 = cvtpk(P[BASE + 6], P[BASE + 7]);                              \
    auto r0 = __builtin_amdgcn_permlane32_swap(a0, b0, false, false); auto r1 = __builtin_amdgcn_permlane32_swap(a1, b1, false, false); \
    u32x4 w = {r0[0], r1[0], r0[1], r1[1]}; OUT = *reinterpret_cast<bf16x8*>(&w); } while (0)
    DPK4(p0, 0, pa0); DPK4(p0, 8, pa1); DPK4(p1, 0, pa2); DPK4(p1, 8, pa3);
#undef DPK4
}
template <int D0> __device__ __forceinline__ void pv_one(f32x16& oa, int vb, const bf16x8 (&pa)[4]) {
    const s16x4 l0 = tr_read<v_rd_off(D0, 0, 0)>(vb), h0 = tr_read<v_rd_off(D0, 0, 1)>(vb), l1 = tr_read<v_rd_off(D0, 1, 0)>(vb), h1 = tr_read<v_rd_off(D0, 1, 1)>(vb);
    const s16x4 l2 = tr_read<v_rd_off(D0, 2, 0)>(vb), h2 = tr_read<v_rd_off(D0, 2, 1)>(vb), l3 = tr_read<v_rd_off(D0, 3, 0)>(vb), h3 = tr_read<v_rd_off(D0, 3, 1)>(vb);
    asm volatile("s_waitcnt lgkmcnt(0)" ::: "memory"); __builtin_amdgcn_sched_barrier(0);
#define DPK1(L, H) (bf16x8){L[0], L[1], L[2], L[3], H[0], H[1], H[2], H[3]}
    oa = __builtin_amdgcn_mfma_f32_32x32x16_bf16(pa[0], DPK1(l0, h0), oa, 0, 0, 0);
    oa = __builtin_amdgcn_mfma_f32_32x32x16_bf16(pa[1], DPK1(l1, h1), oa, 0, 0, 0);
    oa = __builtin_amdgcn_mfma_f32_32x32x16_bf16(pa[2], DPK1(l2, h2), oa, 0, 0, 0);
    oa = __builtin_amdgcn_mfma_f32_32x32x16_bf16(pa[3], DPK1(l3, h3), oa, 0, 0, 0);
#undef DPK1
}
#define DPK(L, H) (bf16x8){L[0], L[1], L[2], L[3], H[0], H[1], H[2], H[3]}
#define DVRD(KS, l0, h0, l1, h1, l2, h2, l3, h3) do { l0 = tr_read<v_rd_off(0, KS, 0)>(vb); h0 = tr_read<v_rd_off(0, KS, 1)>(vb); l1 = tr_read<v_rd_off(1, KS, 0)>(vb); h1 = tr_read<v_rd_off(1, KS, 1)>(vb); \
        l2 = tr_read<v_rd_off(2, KS, 0)>(vb); h2 = tr_read<v_rd_off(2, KS, 1)>(vb); l3 = tr_read<v_rd_off(3, KS, 0)>(vb); h3 = tr_read<v_rd_off(3, KS, 1)>(vb); } while (0)
#define DVMM(KS, l0, h0, l1, h1, l2, h2, l3, h3) do { o[0] = __builtin_amdgcn_mfma_f32_32x32x16_bf16(pa[KS], DPK(l0, h0), o[0], 0, 0, 0); o[1] = __builtin_amdgcn_mfma_f32_32x32x16_bf16(pa[KS], DPK(l1, h1), o[1], 0, 0, 0); \
        o[2] = __builtin_amdgcn_mfma_f32_32x32x16_bf16(pa[KS], DPK(l2, h2), o[2], 0, 0, 0); o[3] = __builtin_amdgcn_mfma_f32_32x32x16_bf16(pa[KS], DPK(l3, h3), o[3], 0, 0, 0); } while (0)
__device__ __forceinline__ void pv_all(f32x16 (&o)[4], int vb, const bf16x8 (&pa)[4]) {
    s16x4 a0, a1, a2, a3, a4, a5, a6, a7, b0, b1, b2, b3, b4, b5, b6, b7;
    DVRD(0, a0, a1, a2, a3, a4, a5, a6, a7);
    DVRD(1, b0, b1, b2, b3, b4, b5, b6, b7);
    asm volatile("s_waitcnt lgkmcnt(8)" ::: "memory"); __builtin_amdgcn_sched_barrier(0);
    DVMM(0, a0, a1, a2, a3, a4, a5, a6, a7);
    __builtin_amdgcn_sched_barrier(0);
    DVRD(2, a0, a1, a2, a3, a4, a5, a6, a7);
    asm volatile("s_waitcnt lgkmcnt(8)" ::: "memory"); __builtin_amdgcn_sched_barrier(0);
    DVMM(1, b0, b1, b2, b3, b4, b5, b6, b7);
    __builtin_amdgcn_sched_barrier(0);
    DVRD(3, b0, b1, b2, b3, b4, b5, b6, b7);
    asm volatile("s_waitcnt lgkmcnt(8)" ::: "memory"); __builtin_amdgcn_sched_barrier(0);
    DVMM(2, a0, a1, a2, a3, a4, a5, a6, a7);
    asm volatile("s_waitcnt lgkmcnt(0)" ::: "memory"); __builtin_amdgcn_sched_barrier(0);
    DVMM(3, b0, b1, b2, b3, b4, b5, b6, b7);
}
#undef DVRD
#undef DVMM
#undef DPK
template <int VAR> __device__ __forceinline__ void unit(const bf16* __restrict__ PROJ, bf16* __restrict__ MIX, int qrow0, int b, int h, bool ctxq, LAS unsigned char* lds,
                                     float negb, float lam, float onem, const float* __restrict__ sg, const float* __restrict__ qg, const float* __restrict__ ropet) {
    const int tid = otid(), wid = __builtin_amdgcn_readfirstlane(tid >> 6), lane = tid & 63, r32 = lane & 31, hi = lane >> 5, rb = wid >> 1, mp = wid & 1;
    LAS unsigned char* V_lds = lds; LAS unsigned char* K_lds = lds + 4 * SHM_V;
    LAS float* wsf = (LAS float*)(lds + 4 * SHM_V + 3 * SHM_K) + wid * 32;
    f32x16 o[4];
#pragma unroll
    for (int d = 0; d < 4; ++d)
#pragma unroll
        for (int r = 0; r < 16; ++r) o[d][r] = 0.f;
    float l = 0.f; bf16x8 qr[4];
    { const bf16* Qw = PROJ + (size_t)(qrow0 + rb * 32 + r32) * 4096 + 2560 + h * 128 + mp * 64 + hi * 8;
      float q[4][8]; float ss = 0.f;
#pragma unroll
      for (int d = 0; d < 4; ++d) { const u32x4 w = *(const u32x4*)(Qw + d * 16); const unsigned ww[4] = {w.x, w.y, w.z, w.w};
#pragma unroll
          for (int k = 0; k < 4; ++k) { q[d][2 * k] = __uint_as_float(ww[k] << 16); q[d][2 * k + 1] = __uint_as_float(ww[k] & 0xffff0000u); ss += q[d][2 * k] * q[d][2 * k] + q[d][2 * k + 1] * q[d][2 * k + 1]; } }
      { auto rr = __builtin_amdgcn_permlane32_swap(__float_as_uint(ss), __float_as_uint(ss), false, false); ss = __uint_as_float(rr[0]) + __uint_as_float(rr[1]); }
      const float rstd = rsqrtf(ss * (1.f / 64.f) + EPS);
#pragma unroll
      for (int d = 0; d < 4; ++d)
#pragma unroll
          for (int j = 0; j < 8; ++j) q[d][j] *= rstd * qg[d * 16 + hi * 8 + j];
      if (!ctxq) { const int t = (qrow0 + rb * 32 + r32) & (T - 1), pr = t >> 6, pc = t & 63;
#pragma unroll
          for (int j = 0; j < 8; ++j) { const int i = hi * 8 + j; const float c0 = ropet[(pr * 16 + i) * 2], s0 = ropet[(pr * 16 + i) * 2 + 1], c1 = ropet[(pc * 16 + i) * 2], s1 = ropet[(pc * 16 + i) * 2 + 1];
              const float a0 = q[0][j] * c0 - q[1][j] * s0, a1 = q[1][j] * c0 + q[0][j] * s0, a2 = q[2][j] * c1 - q[3][j] * s1, a3 = q[3][j] * c1 + q[2][j] * s1; q[0][j] = a0; q[1][j] = a1; q[2][j] = a2; q[3][j] = a3; } }
      const float qs = 0.125f * 1.4426950408889634f;
#pragma unroll
      for (int d = 0; d < 4; ++d) { u32x4 w; w.x = cvtpk(q[d][0] * qs, q[d][1] * qs); w.y = cvtpk(q[d][2] * qs, q[d][3] * qs); w.z = cvtpk(q[d][4] * qs, q[d][5] * qs); w.w = cvtpk(q[d][6] * qs, q[d][7] * qs); qr[d] = *reinterpret_cast<bf16x8*>(&w); } }
    const int vb0 = (int)(uintptr_t)V_lds + v_rd_base(lane);
    const int NT = ctxq ? (TC / 64) : ((T + TC) / 64);
    const int rb_lat = b * T, rb_ctx = ML + b * TC;
    const int kb0 = (mp * 64 + hi * 8) * 2;
    unsigned ksrc[2], vsrc[2];
#pragma unroll
    for (int i = 0; i < 2; ++i) { const int G = wid * 128 + i * 64 + lane;
        { const int row = G >> 4, ch = (G & 15) ^ (row & 7); ksrc[i] = (unsigned)(row * 8192 + (3072 + h * 128) * 2 + ch * 16); }
        { const int sub = G >> 5, within = G & 31, kk = (sub >> 2) * 8 + (within >> 2), cg = (sub & 3) * 4 + (within & 3); const int k = (kk & ~0xC) | ((kk & 4) << 1) | ((kk & 8) >> 1);
          vsrc[i] = (unsigned)(k * 8192 + (3584 + h * 128) * 2 + cg * 16); } }
#define DROWB(t) ((t) * 64 < T || ctxq ? (ctxq ? rb_ctx + (t) * 64 : rb_lat + (t) * 64) : rb_ctx + ((t) * 64 - T))
#define DDMA(SRC, t, LBUF) do { const char* tb_ = (const char*)PROJ + (size_t)DROWB(t) * 8192; _Pragma("unroll") for (int i_ = 0; i_ < 2; ++i_) \
        __builtin_amdgcn_global_load_lds((const unsigned*)(tb_ + SRC[i_]), (LAS unsigned*)((LBUF) + wid * 2048 + i_ * 1024), 16, 0, 0); } while (0)
#define DQKT(P0, P1, Kt) do { _Pragma("unroll") for (int r = 0; r < 16; ++r) { P0[r] = 0.f; P1[r] = 0.f; } \
        _Pragma("unroll") for (int d = 0; d < 4; ++d) { const int cb = kb0 + d * 32; \
            const bf16x8 b0 = *(const LAS bf16x8*)((Kt) + DKSWZ(r32, cb)); const bf16x8 b1 = *(const LAS bf16x8*)((Kt) + DKSWZ(32 + r32, cb)); \
            P0 = __builtin_amdgcn_mfma_f32_32x32x16_bf16(b0, qr[d], P0, 0, 0, 0); P1 = __builtin_amdgcn_mfma_f32_32x32x16_bf16(b1, qr[d], P1, 0, 0, 0); } } while (0)
#define DBAR() do { asm volatile("s_waitcnt lgkmcnt(0)" ::: "memory"); __builtin_amdgcn_s_barrier(); asm volatile("" ::: "memory"); } while (0)
    const bool late = wid >= 4;
    __syncthreads();
    DDMA(ksrc, 0, K_lds); DDMA(vsrc, 0, V_lds); DDMA(ksrc, 1, K_lds + SHM_K); DDMA(vsrc, 1, V_lds + SHM_V); DDMA(ksrc, 2, K_lds + 2 * SHM_K);
    asm volatile("s_waitcnt vmcnt(0)" ::: "memory"); DBAR();
    f32x16 pA0, pA1, pB0, pB1; bf16x8 pa[4];
    DQKT(pA0, pA1, K_lds);
    DBAR();
#define DSTEP(PC0, PC1, PN0, PN1, t) do { \
        if ((t) + 3 < NT) DDMA(ksrc, (t) + 3, K_lds + ((t) % 3) * SHM_K); if ((t) + 2 < NT) DDMA(vsrc, (t) + 2, V_lds + (((t) + 2) & 3) * SHM_V); \
        if (late && (t) > 0) { const int vbp = vb0 + (((t) - 1) & 3) * SHM_V; pv_one<0>(o[0], vbp, pa); pv_one<1>(o[1], vbp, pa); pv_one<2>(o[2], vbp, pa); pv_one<3>(o[3], vbp, pa); } \
        if ((t) + 1 < NT) DQKT(PN0, PN1, K_lds + (((t) + 1) % 3) * SHM_K); \
        softmax_pack<VAR>(PC0, PC1, negb, l, pa[0], pa[1], pa[2], pa[3]); \
        if (!late) { const int vb = vb0 + ((t) & 3) * SHM_V; pv_one<0>(o[0], vb, pa); pv_one<1>(o[1], vb, pa); pv_one<2>(o[2], vb, pa); pv_one<3>(o[3], vb, pa); } \
        if ((t) + 3 < NT) asm volatile("s_waitcnt vmcnt(4)" ::: "memory"); else asm volatile("s_waitcnt vmcnt(0)" ::: "memory"); \
        DBAR(); } while (0)
    for (int t = 0; t < NT; t += 2) {
        DSTEP(pA0, pA1, pB0, pB1, t);
        DSTEP(pB0, pB1, pA0, pA1, t + 1);
    }
    if (late) { const int vbp = vb0 + ((NT - 1) & 3) * SHM_V; pv_one<0>(o[0], vbp, pa); pv_one<1>(o[1], vbp, pa); pv_one<2>(o[2], vbp, pa); pv_one<3>(o[3], vbp, pa); }
    __syncthreads();
#undef DSTEP
#undef DQKT
#undef DDMA
#undef DBAR
#undef DROWB
    if (hi == 0) wsf[r32] = l;
    asm volatile("s_waitcnt lgkmcnt(0)" ::: "memory");
    LAS float* xch = (LAS float*)lds + rb * (16 * 4 * 64);
    if (mp == 1) {
#pragma unroll
        for (int r = 0; r < 16; ++r) { const float i1 = lam * __builtin_amdgcn_rcpf(wsf[crow(r, hi)]);
#pragma unroll
            for (int d = 0; d < 4; ++d) xch[(r * 4 + d) * 64 + lane] = o[d][r] * i1; }
    }
    __syncthreads();
    if (mp == 0) {
        float g4[4];
#pragma unroll
        for (int d = 0; d < 4; ++d) g4[d] = sg[32 * d + r32] * onem;
        LAS unsigned char* ot = lds + 65536 + (size_t)(rb * 32) * 272;
#pragma unroll
        for (int r = 0; r < 16; ++r) { const int row = crow(r, hi); const float i0 = __builtin_amdgcn_rcpf(wsf[row]);
            float w[4], ss = 0.f;
#pragma unroll
            for (int d = 0; d < 4; ++d) { w[d] = o[d][r] * i0 - xch[(r * 4 + d) * 64 + lane]; ss += w[d] * w[d]; }
            ss += __shfl_xor(ss, 1); ss += __shfl_xor(ss, 2); ss += __shfl_xor(ss, 4); ss += __shfl_xor(ss, 8); ss += __shfl_xor(ss, 16);
            const float rstd = rsqrtf(ss * (1.f / 128.f) + EPS);
#pragma unroll
            for (int d = 0; d < 4; ++d) *(LAS bf16*)(ot + row * 272 + (32 * d + r32) * 2) = f2bf(w[d] * rstd * g4[d]); }
    }
    __syncthreads();
    {
        const int row = tid >> 2, cq = (tid & 3) * 64; const LAS unsigned char* sp = lds + 65536 + row * 272 + cq; bf16* dst = MIX + (size_t)(qrow0 + row) * D + 512 + h * 128 + cq / 2;
#pragma unroll
        for (int k = 0; k < 4; ++k) *(u32x4*)(dst + 8 * k) = *(const LAS u32x4*)(sp + 16 * k); }
}
}
template <int VAR> __device__ __forceinline__ void ph_attn(const Prm& p, int l, LAS unsigned char* ldsb) {
    const int ev = l / 2; const bf16* PROJ = (const bf16*)(p.ws + WS_PROJ); bf16* MIX = (bf16*)(p.ws + ((VAR == 0 || VAR == 5) ? WS_MIX : WS_OF));
    const float lam_init = 0.8f - 0.6f * __expf(-0.3f * (float)l);
    float d0 = 0.f, d1 = 0.f;
    for (int i = 0; i < 64; ++i) { d0 += p.dlam[(ev * 4 + 0) * 64 + i] * p.dlam[(ev * 4 + 1) * 64 + i]; d1 += p.dlam[(ev * 4 + 2) * 64 + i] * p.dlam[(ev * 4 + 3) * 64 + i]; }
    const float lam = __expf(d0) - __expf(d1) + lam_init;
    float gq = 0.f, gk = 0.f;
    for (int i = 0; i < 64; ++i) { gq = fmaxf(gq, fabsf(p.qn_g[ev * 64 + i])); gk = fmaxf(gk, fabsf(p.kn_g[ev * 64 + i])); }
    const float negb = -8.f * gq * gk * 1.4426950408889634f;
    const int vc = vcu_id();
    for (int u = vc; u < 512; u += gridDim.x) { const int v2 = (u < 256) ? u * 2 : (u - 256) * 2 + 1;
        const int b = v2 >> 7, h = (v2 >> 5) & 3, qb = v2 & 31;
        if (VAR == 5 && negb < -48.f) dat::unit<0>(PROJ, MIX, b * T + qb * 128, b, h, false, ldsb, negb, lam, 1.f - lam_init, p.subln_g + ev * 128, p.qn_g + ev * 64, (const float*)(p.ws + WS_ROPE));
        else dat::unit<VAR>(PROJ, MIX, b * T + qb * 128, b, h, false, ldsb, negb, lam, 1.f - lam_init, p.subln_g + ev * 128, p.qn_g + ev * 64, (const float*)(p.ws + WS_ROPE)); }
    if (l == 0) for (int u = vc; u < 32; u += gridDim.x) { const int b = u >> 3, h = (u >> 1) & 3, qb = u & 1;
        if (VAR == 5 && negb < -48.f) dat::unit<0>(PROJ, MIX, ML + b * TC + qb * 128, b, h, true, ldsb, negb, lam, 1.f - lam_init, p.subln_g + ev * 128, p.qn_g + ev * 64, (const float*)(p.ws + WS_ROPE));
        else dat::unit<VAR>(PROJ, MIX, ML + b * TC + qb * 128, b, h, true, ldsb, negb, lam, 1.f - lam_init, p.subln_g + ev * 128, p.qn_g + ev * 64, (const float*)(p.ws + WS_ROPE)); }
    __syncthreads();
}

namespace hg {
using bf16x8 = __attribute__((ext_vector_type(8))) short;
__device__ __forceinline__ int swz256(int row, int colB) { return row * 256 + (colB ^ ((row & 15) << 4)); }
__device__ __forceinline__ int swz128(int row, int colB) { return row * 128 + (colB ^ (((row >> 1) & 7) << 4)); }
constexpr int BFS = 132;
constexpr int L_BF = 0, L_TOT = 33792, L_LB = 35840, L_P = 0, L_RED = 8192, L_QP = 36864, L_KP = 53248, L_QT = 69632, L_VT = 86016, L_ST = 102400;
__device__ __forceinline__ float lbound(const float* lbl, int ev, int dir, int col) {
    if (ev == 0) return 0.f; const float l0 = lbl[(0 * 2 + dir) * 512 + col], l1 = lbl[(1 * 2 + dir) * 512 + col]; return 1.f / (1.f + __expf(l0 - l1)); }
__device__ __forceinline__ void pass1(const bf16* PROJ, const float* lbl, int ev, int dir, int h, int row0, LAS unsigned char* lds, int tid) {
    const int qt = tid >> 7, d = tid & 127; const float lb = lbound(lbl, ev, dir, h * 128 + d);
    LAS float* Bf = (LAS float*)(lds + L_BF); float run = 0.f;
    const bf16* zp = PROJ + (size_t)row0 * 4096 + 512 + dir * 512 + h * 128 + d;
    float zv[16];
#pragma unroll
    for (int i = 0; i < 16; ++i) { const int s = qt * 16 + i, tau = dir ? 63 - s : s; zv[i] = bf2f(zp[(size_t)tau * 4096]); }
#pragma unroll
    for (int i = 0; i < 16; ++i) { const float f = lb + (1.f - lb) * sigmoidf_(zv[i]); run += __builtin_amdgcn_logf(fmaxf(f, 1e-30f)) * 0.6931471805599453f;     Bf[(qt * 16 + i) * BFS + d] = run; }
    ((LAS float*)(lds + L_TOT))[qt * 128 + d] = run; if (qt == 0) ((LAS float*)(lds + L_LB))[d] = lb;
}
__device__ __forceinline__ void decay4(const LAS unsigned char* lds, int s, int d0, f32x4& b, f32x4& bmid, f32x4& blast, f32x4& lb) {
    const LAS float* Bf = (const LAS float*)(lds + L_BF); const LAS float* tot = (const LAS float*)(lds + L_TOT);
    const f32x4 t0 = *(const LAS f32x4*)(tot + d0), t1 = *(const LAS f32x4*)(tot + 128 + d0), t2 = *(const LAS f32x4*)(tot + 256 + d0), t3 = *(const LAS f32x4*)(tot + 384 + d0);
    const int qt = s >> 4; f32x4 pre = (f32x4){0.f, 0.f, 0.f, 0.f}; if (qt >= 1) pre += t0; if (qt >= 2) pre += t1; if (qt >= 3) pre += t2;
    b = *(const LAS f32x4*)(Bf + s * BFS + d0) + pre; bmid = t0 + t1; blast = (t0 + t1) + (t2 + t3); lb = *(const LAS f32x4*)((const LAS float*)(lds + L_LB) + d0);
}
__device__ __forceinline__ void pass1_pre(const float (&zv)[16], float lb, LAS unsigned char* lds, int tb, int tid) {
    const int qt = tid >> 7, d = tid & 127; LAS float* Bf = (LAS float*)(lds + tb + L_BF); float run = 0.f;
#pragma unroll
    for (int i = 0; i < 16; ++i) { const float f = lb + (1.f - lb) * sigmoidf_(zv[i]); run += __builtin_amdgcn_logf(fmaxf(f, 1e-30f)) * 0.6931471805599453f;     Bf[(qt * 16 + i) * BFS + d] = run; }
    ((LAS float*)(lds + tb + L_TOT))[qt * 128 + d] = run; if (qt == 0) ((LAS float*)(lds + tb + L_LB))[d] = lb;
}
__device__ __forceinline__ void decay4b(const LAS unsigned char* lds, int tb, int s, int d0, f32x4& b, f32x4& bmid, f32x4& lb) {
    const LAS float* Bf = (const LAS float*)(lds + tb + L_BF); const LAS float* tot = (const LAS float*)(lds + tb + L_TOT);
    const f32x4 t0 = *(const LAS f32x4*)(tot + d0), t1 = *(const LAS f32x4*)(tot + 128 + d0), t2 = *(const LAS f32x4*)(tot + 256 + d0);
    const int qt = s >> 4; f32x4 pre = (f32x4){0.f, 0.f, 0.f, 0.f}; if (qt >= 1) pre += t0; if (qt >= 2) pre += t1; if (qt >= 3) pre += t2;
    b = *(const LAS f32x4*)(Bf + s * BFS + d0) + pre; bmid = t0 + t1; lb = *(const LAS f32x4*)((const LAS float*)(lds + tb + L_LB) + d0);
}
__device__ __forceinline__ void stage_vt(const bf16* PROJ, int h, int row0, LAS unsigned char* lds, int tid) {
    const int tau = tid >> 3, e0 = (tid & 7) * 16; const bf16* vp = PROJ + (size_t)(row0 + tau) * 4096 + 1536 + h * 128 + e0;
    const u32x4 w0 = *(const u32x4*)vp, w1 = *(const u32x4*)(vp + 8); const unsigned ww[8] = {w0.x, w0.y, w0.z, w0.w, w1.x, w1.y, w1.z, w1.w};
#pragma unroll
    for (int i = 0; i < 8; ++i) { *(LAS bf16*)(lds + L_VT + swz128(e0 + 2 * i, tau * 2)) = (bf16)(ww[i] & 0xffffu); *(LAS bf16*)(lds + L_VT + swz128(e0 + 2 * i + 1, tau * 2)) = (bf16)(ww[i] >> 16); }
}
}
template <int LV> __device__ __forceinline__ void ph_hgrn_local(const Prm& p, int l, LAS unsigned char* lds) {
    constexpr int RS = 288, L_VR = hg::L_VT, L_KR = hg::L_QP;
    const int ev = l / 2; const bf16* PROJ = (const bf16*)(p.ws + WS_PROJ); bf16* DS = (bf16*)(p.ws + (LV == 0 ? WS_HDS : WS_XE)); float* G = (float*)(p.ws + (LV == 0 ? WS_HG : WS_OF));
    const int tid = otid(), lane = tid & 63, wv = tid >> 6;
    for (int it = obid(); it < HG_ITEMS; it += gridDim.x) {
        const int c = it % HG_NCH, chain = it / HG_NCH, dir = chain & 1, h = (chain >> 1) & 3, b = chain >> 3;
        const bool isc = c < 4; const int j = isc ? c : c - 4, nt = isc ? 4 : 64, tj = dir ? nt - 1 - j : j; const int row0 = isc ? ML + b * TC + tj * 64 : b * T + tj * 64;
        u32x4 zpre0, zpre1;
        { const int s_ = tid >> 3, tau_ = dir ? 63 - s_ : s_; const bf16* zp_ = PROJ + (size_t)(row0 + tau_) * 4096 + 512 + dir * 512 + h * 128 + (tid & 7) * 16; zpre0 = *(const u32x4*)zp_; zpre1 = *(const u32x4*)(zp_ + 8); }
        float zv[16]; u32x4 vw0, vw1;
        { const int qt = tid >> 7, d = tid & 127; const bf16* zc = PROJ + (size_t)(row0 + (dir ? 63 - qt * 16 : qt * 16)) * 4096 + 512 + dir * 512 + h * 128 + d;
#pragma unroll
          for (int i = 0; i < 16; ++i) zv[i] = bf2f(dir ? *(zc - (size_t)i * 4096) : zc[(size_t)i * 4096]);
          const bf16* vp = PROJ + (size_t)(row0 + (tid >> 3)) * 4096 + 1536 + h * 128 + (tid & 7) * 16; vw0 = *(const u32x4*)vp; vw1 = *(const u32x4*)(vp + 8); }
        const float lbt = hg::lbound(p.hgrn_lb, ev, dir, h * 128 + (tid & 127));
        __syncthreads();
        hg::pass1_pre(zv, lbt, lds, 0, tid);
        { LAS unsigned char* vr = lds + L_VR + (tid >> 3) * RS + (tid & 7) * 32; *(LAS u32x4*)vr = vw0; *(LAS u32x4*)(vr + 16) = vw1; }
        __syncthreads();
        {
            const int s = tid >> 3, dg = (tid & 7) * 16, tau = dir ? 63 - s : s;
            const unsigned zz[8] = {zpre0.x, zpre0.y, zpre0.z, zpre0.w, zpre1.x, zpre1.y, zpre1.z, zpre1.w}; float kh[16];
#pragma unroll
            for (int g4 = 0; g4 < 4; ++g4) { f32x4 bb, bm, bl, lb; hg::decay4(lds, s, dg + g4 * 4, bb, bm, bl, lb);
#pragma unroll
                for (int i = 0; i < 4; ++i) { const int k = g4 * 4 + i, d = dg + k; const float z = (k & 1) ? __uint_as_float(zz[k >> 1] & 0xffff0000u) : __uint_as_float(zz[k >> 1] << 16);
                    const float f = lb[i] + (1.f - lb[i]) * sigmoidf_(z);
                    kh[k] = (1.f - f) * __expf(bl[i] - bb[i]);
                    if (s == 0) G[(size_t)it * 128 + d] = __expf(bl[i]); } }
            LAS unsigned char* kr = lds + L_KR + tau * RS + dg * 2;
            *(LAS u32x4*)kr = (u32x4){dat::cvtpk(kh[0], kh[1]), dat::cvtpk(kh[2], kh[3]), dat::cvtpk(kh[4], kh[5]), dat::cvtpk(kh[6], kh[7])};
            *(LAS u32x4*)(kr + 16) = (u32x4){dat::cvtpk(kh[8], kh[9]), dat::cvtpk(kh[10], kh[11]), dat::cvtpk(kh[12], kh[13]), dat::cvtpk(kh[14], kh[15])};
        }
        __syncthreads();
        {
            f32x4 acc[8];
#pragma unroll
            for (int db = 0; db < 8; ++db) acc[db] = (f32x4){0.f, 0.f, 0.f, 0.f};
            const int r16 = lane & 15, q4 = lane >> 4;
            const int trb = (q4 * 8 + (r16 >> 2)) * RS + (r16 & 3) * 8;
#pragma unroll
            for (int ks = 0; ks < 2; ++ks) { const int kb = trb + ks * 32 * RS;
                dat::s16x4 al, ah, bl_[8], bh_[8];
                { const int ad = (int)(uintptr_t)(lds + L_VR) + kb + wv * 32; asm volatile("ds_read_b64_tr_b16 %0, %1" : "=&v"(al) : "v"(ad) : "memory"); asm volatile("ds_read_b64_tr_b16 %0, %1 offset:1152" : "=&v"(ah) : "v"(ad) : "memory"); }
#pragma unroll
                for (int db = 0; db < 8; ++db) { const int ad = (int)(uintptr_t)(lds + L_KR) + kb + db * 32; asm volatile("ds_read_b64_tr_b16 %0, %1" : "=&v"(bl_[db]) : "v"(ad) : "memory"); asm volatile("ds_read_b64_tr_b16 %0, %1 offset:1152" : "=&v"(bh_[db]) : "v"(ad) : "memory"); }
                asm volatile("s_waitcnt lgkmcnt(0)" ::: "memory"); __builtin_amdgcn_sched_barrier(0);
                const hg::bf16x8 a = (hg::bf16x8){al[0], al[1], al[2], al[3], ah[0], ah[1], ah[2], ah[3]};
#pragma unroll
                for (int db = 0; db < 8; ++db) { const hg::bf16x8 bb = (hg::bf16x8){bl_[db][0], bl_[db][1], bl_[db][2], bl_[db][3], bh_[db][0], bh_[db][1], bh_[db][2], bh_[db][3]};
                    acc[db] = __builtin_amdgcn_mfma_f32_16x16x32_bf16(a, bb, acc[db], 0, 0, 0); } }
            bf16* dst = DS + (size_t)it * 16384;
            __builtin_amdgcn_sched_barrier(0); asm volatile("s_nop 15\n\ts_nop 7" ::: "memory"); __builtin_amdgcn_sched_barrier(0);
#pragma unroll
            for (int db = 0; db < 8; ++db)
#pragma unroll
                for (int jj = 0; jj < 4; jj += 2) { const unsigned w2 = pk2(acc[db][jj], acc[db][jj + 1]); dst[(wv * 16 + q4 * 4 + jj) * 128 + db * 16 + r16] = (bf16)(w2 & 0xffffu); dst[(wv * 16 + q4 * 4 + jj + 1) * 128 + db * 16 + r16] = (bf16)(w2 >> 16); }
        }
    }
    __syncthreads();
}
__device__ __forceinline__ void ph_hgrn_scan(const Prm& p) {
    const bf16* DS = (const bf16*)(p.ws + WS_HDS); bf16* ST = (bf16*)(p.ws + WS_HST); const float* G = (const float*)(p.ws + WS_HG);
    for (int gt = obid() * NTHREADS + otid(); gt < 32 * 128 * 32; gt += gridDim.x * NTHREADS) {
        const int chain = gt >> 12, rem = gt & 4095; const size_t eo = (size_t)(rem >> 5) * 128 + (rem & 31) * 4; const int dq = (rem & 31) * 4;
        float s0 = 0.f, s1 = 0.f, s2 = 0.f, s3 = 0.f;
#pragma unroll 4
        for (int c = 0; c < HG_NCH; ++c) { const size_t it = (size_t)chain * HG_NCH + c;
            const u32x2 dv = *(const u32x2*)(DS + it * 16384 + eo); const f32x4 g = *(const f32x4*)(G + it * 128 + dq);
            u32x2 o; o.x = pk2(s0, s1); o.y = pk2(s2, s3); *(u32x2*)(ST + it * 16384 + eo) = o;
            s0 = g.x * s0 + __uint_as_float(dv.x << 16); s1 = g.y * s1 + __uint_as_float(dv.x & 0xffff0000u); s2 = g.z * s2 + __uint_as_float(dv.y << 16); s3 = g.w * s3 + __uint_as_float(dv.y & 0xffff0000u); }
    }
}
template <int HV> __device__ __forceinline__ void ph_hgrn_out(const Prm& p, int l, LAS unsigned char* lds) {
    constexpr int L_P2 = hg::L_ST + 36864;
    constexpr int L_RED2 = L_P2;
    static_assert(L_P2 + 8192 <= LDS_BYTES - 256, "hgrn_out LDS map");
    const int ev = l / 2; const bf16* PROJ = (const bf16*)(p.ws + WS_PROJ); const bf16* ST = (const bf16*)(p.ws + WS_HST); bf16* MIX = (bf16*)(p.ws + (HV == 0 ? WS_MIX : WS_OF));
    const int tid = otid(), lane = tid & 63, wv = tid >> 6, r16 = lane & 15, q4 = lane >> 4;
    const int tt0 = (l < 2) ? 0 : 4;
    const int nitems = 16 * (HG_NCH - tt0);
    const bool bal = gridDim.x == 256 && nitems == 1088;
    for (int k = 0;; ++k) { int it = obid() + k * (int)gridDim.x;
        if (bal && k == 4) { const int m8 = obid() & 7; if (m8 != 1 && m8 != 2) break; it = 1024 + (obid() >> 3) + 32 * (m8 - 1); }
        if (it >= nitems) break;
        const int tt = tt0 + it % (HG_NCH - tt0), bh = it / (HG_NCH - tt0), h = bh & 3, b = bh >> 2;
        const bool isc = tt < 4; const int tj = isc ? tt : tt - 4, nt = isc ? 4 : 64; const int row0 = isc ? ML + b * TC + tj * 64 : b * T + tj * 64;
        const int s2 = tid >> 3, dg = (tid & 7) * 16;
        u32x4 zq[2][2], qq[2][2]; float zv[2][16]; hg::bf16x8 sfr[2][4]; float lbv[2];
        const u32x4 vw0 = *(const u32x4*)(PROJ + (size_t)(row0 + s2) * 4096 + 1536 + h * 128 + dg), vw1 = *(const u32x4*)(PROJ + (size_t)(row0 + s2) * 4096 + 1536 + h * 128 + dg + 8);
#pragma unroll
        for (int dir = 0; dir < 2; ++dir) { const int tau = dir ? 63 - s2 : s2; const bf16* rp = PROJ + (size_t)(row0 + tau) * 4096 + h * 128 + dg;
            zq[dir][0] = *(const u32x4*)(rp + 512 + dir * 512); zq[dir][1] = *(const u32x4*)(rp + 512 + dir * 512 + 8); qq[dir][0] = *(const u32x4*)rp; qq[dir][1] = *(const u32x4*)(rp + 8);
            lbv[dir] = hg::lbound(p.hgrn_lb, ev, dir, h * 128 + (tid & 127));
            const int c = (isc ? 0 : 4) + (dir ? nt - 1 - tj : tj); const bf16* sp = ST + (size_t)(((b * 4 + h) * 2 + dir) * HG_NCH + c) * 16384 + (wv * 16 + r16) * 128 + q4 * 8;
#pragma unroll
            for (int ks = 0; ks < 4; ++ks) sfr[dir][ks] = *(const hg::bf16x8*)(sp + ks * 32); }
        f32x4 o[4];
#pragma unroll
        for (int i = 0; i < 4; ++i) o[i] = (f32x4){0.f, 0.f, 0.f, 0.f};
        { const int qt = tid >> 7, d = tid & 127; const bf16* zp = PROJ + (size_t)(row0 + qt * 16) * 4096 + 512 + h * 128 + d;
#pragma unroll
          for (int i = 0; i < 16; ++i) zv[0][i] = bf2f(zp[(size_t)i * 4096]); }
        __syncthreads();
        { const unsigned ww[8] = {vw0.x, vw0.y, vw0.z, vw0.w, vw1.x, vw1.y, vw1.z, vw1.w};
#pragma unroll
          for (int i = 0; i < 8; ++i) { *(LAS bf16*)(lds + hg::L_VT + hg::swz128(dg + 2 * i, s2 * 2)) = (bf16)(ww[i] & 0xffffu); *(LAS bf16*)(lds + hg::L_VT + hg::swz128(dg + 2 * i + 1, s2 * 2)) = (bf16)(ww[i] >> 16); } }
        { const int qt = tid >> 7, d = tid & 127; const bf16* zp = PROJ + (size_t)(row0 + 63 - qt * 16) * 4096 + 512 + 512 + h * 128 + d;
#pragma unroll
          for (int i = 0; i < 16; ++i) zv[1][i] = bf2f(*(zp - (size_t)i * 4096)); }
        __builtin_amdgcn_sched_barrier(0);
        hg::pass1_pre(zv[0], lbv[0], lds, 0, tid);
        __builtin_amdgcn_sched_barrier(0);
        hg::pass1_pre(zv[1], lbv[1], lds, hg::L_ST, tid);
        __builtin_amdgcn_sched_barrier(0);
        __syncthreads();
        const u32x4 gw0 = *(const u32x4*)(PROJ + (size_t)(row0 + s2) * 4096 + 2048 + h * 128 + dg), gw1 = *(const u32x4*)(PROJ + (size_t)(row0 + s2) * 4096 + 2048 + h * 128 + dg + 8);
#pragma unroll
        for (int dir = 0; dir < 2; ++dir) { const int tb = dir ? hg::L_ST : 0;
            if (HV != 2) {
                const int tau = dir ? 63 - s2 : s2;
                const unsigned zz[8] = {zq[dir][0].x, zq[dir][0].y, zq[dir][0].z, zq[dir][0].w, zq[dir][1].x, zq[dir][1].y, zq[dir][1].z, zq[dir][1].w};
                const unsigned qv[8] = {qq[dir][0].x, qq[dir][0].y, qq[dir][0].z, qq[dir][0].w, qq[dir][1].x, qq[dir][1].y, qq[dir][1].z, qq[dir][1].w};
#pragma unroll
                for (int jj = 0; jj < 2; ++jj) { const int d0 = dg + jj * 8; float qp[8], kp[8], qt[8];
#pragma unroll
                    for (int g4 = 0; g4 < 2; ++g4) { f32x4 bb, bm, lb; hg::decay4b(lds, tb, s2, d0 + g4 * 4, bb, bm, lb);
#pragma unroll
                        for (int i = 0; i < 4; ++i) { const int k = jj * 8 + g4 * 4 + i; const float z = (k & 1) ? __uint_as_float(zz[k >> 1] & 0xffff0000u) : __uint_as_float(zz[k >> 1] << 16);
                            const float qf = (k & 1) ? __uint_as_float(qv[k >> 1] & 0xffff0000u) : __uint_as_float(qv[k >> 1] << 16);
                            const float f = lb[i] + (1.f - lb[i]) * sigmoidf_(z); const float rel = bb[i] - bm[i];
                            qp[g4 * 4 + i] = qf * __expf(fminf(rel, 80.f)); kp[g4 * 4 + i] = (1.f - f) * __expf(fminf(-rel, 80.f)); qt[g4 * 4 + i] = qf * __expf(bb[i]); } }
                    u32x4 w; w.x = dat::cvtpk(qp[0], qp[1]); w.y = dat::cvtpk(qp[2], qp[3]); w.z = dat::cvtpk(qp[4], qp[5]); w.w = dat::cvtpk(qp[6], qp[7]); *(LAS u32x4*)(lds + hg::L_QP + hg::swz256(tau, d0 * 2)) = w;
                    w.x = dat::cvtpk(kp[0], kp[1]); w.y = dat::cvtpk(kp[2], kp[3]); w.z = dat::cvtpk(kp[4], kp[5]); w.w = dat::cvtpk(kp[6], kp[7]); *(LAS u32x4*)(lds + hg::L_KP + hg::swz256(tau, d0 * 2)) = w;
                    w.x = dat::cvtpk(qt[0], qt[1]); w.y = dat::cvtpk(qt[2], qt[3]); w.z = dat::cvtpk(qt[4], qt[5]); w.w = dat::cvtpk(qt[6], qt[7]); *(LAS u32x4*)(lds + hg::L_QT + hg::swz256(tau, d0 * 2)) = w; }
            }
            __syncthreads();
            if (HV != 3) {
#pragma unroll
                for (int k2 = 0; k2 < 2; ++k2) { const int bi = wv * 2 + k2, rbk = bi >> 2, cbk = bi & 3; f32x4 acc = (f32x4){0.f, 0.f, 0.f, 0.f};
#pragma unroll
                    for (int ks = 0; ks < 4; ++ks) { const int cb = (ks * 32 + q4 * 8) * 2;
                        const hg::bf16x8 a = *(const LAS hg::bf16x8*)(lds + hg::L_QP + hg::swz256(rbk * 16 + r16, cb)); const hg::bf16x8 bb = *(const LAS hg::bf16x8*)(lds + hg::L_KP + hg::swz256(cbk * 16 + r16, cb));
                        acc = __builtin_amdgcn_mfma_f32_16x16x32_bf16(a, bb, acc, 0, 0, 0); }
                    const int tcol = cbk * 16 + r16;
#pragma unroll
                    for (int jj = 0; jj < 4; ++jj) { const int trow = rbk * 16 + q4 * 4 + jj; const bool keep = dir ? (tcol >= trow) : (tcol <= trow);
                        *(LAS bf16*)(lds + L_P2 + hg::swz128(trow, tcol * 2)) = keep ? f2bf(acc[jj]) : (bf16)0; } }
            }
            __syncthreads();
            if (HV != 3) {
#pragma unroll
                for (int ks = 0; ks < 2; ++ks) { const int cb = (ks * 32 + q4 * 8) * 2; const hg::bf16x8 bb = *(const LAS hg::bf16x8*)(lds + hg::L_VT + hg::swz128(wv * 16 + r16, cb));
#pragma unroll
                    for (int rbk = 0; rbk < 4; ++rbk) { const hg::bf16x8 a = *(const LAS hg::bf16x8*)(lds + L_P2 + hg::swz128(rbk * 16 + r16, cb)); o[rbk] = __builtin_amdgcn_mfma_f32_16x16x32_bf16(a, bb, o[rbk], 0, 0, 0); } }
#pragma unroll
                for (int ks = 0; ks < 4; ++ks) { const int cb = (ks * 32 + q4 * 8) * 2;
#pragma unroll
                    for (int rbk = 0; rbk < 4; ++rbk) { const hg::bf16x8 a = *(const LAS hg::bf16x8*)(lds + hg::L_QT + hg::swz256(rbk * 16 + r16, cb)); o[rbk] = __builtin_amdgcn_mfma_f32_16x16x32_bf16(a, dir ? sfr[1][ks] : sfr[0][ks], o[rbk], 0, 0, 0); } }
            }
            __syncthreads();
        }
        LAS float* ot = (LAS float*)(lds + hg::L_QP);
#pragma unroll
        for (int rbk = 0; rbk < 4; ++rbk)
#pragma unroll
            for (int jj = 0; jj < 4; ++jj) ot[(rbk * 16 + q4 * 4 + jj) * 132 + wv * 16 + r16] = o[rbk][jj];
        __syncthreads();
        { f32x4 ov[4]; float ss = 0.f;
#pragma unroll
          for (int k = 0; k < 4; ++k) { ov[k] = *(const LAS f32x4*)(ot + s2 * 132 + dg + 4 * k); ss += ov[k].x * ov[k].x + ov[k].y * ov[k].y + ov[k].z * ov[k].z + ov[k].w * ov[k].w; }
          ss += __shfl_xor(ss, 1); ss += __shfl_xor(ss, 2); ss += __shfl_xor(ss, 4);
          const float rstd = rsqrtf(ss * (1.f / 128.f) + EPS);
          const unsigned gwv[8] = {gw0.x, gw0.y, gw0.z, gw0.w, gw1.x, gw1.y, gw1.z, gw1.w}; const float* gp = p.hgrn_g + (ev * 4 + h) * 128 + dg; unsigned ow[8];
#pragma unroll
          for (int k = 0; k < 4; ++k) { const f32x4 g4 = *(const f32x4*)(gp + 4 * k);
              const float a0 = __uint_as_float(gwv[2 * k] << 16), a1 = __uint_as_float(gwv[2 * k] & 0xffff0000u), a2 = __uint_as_float(gwv[2 * k + 1] << 16), a3 = __uint_as_float(gwv[2 * k + 1] & 0xffff0000u);
              ow[2 * k] = pk2(ov[k].x * rstd * g4.x * siluf_(a0), ov[k].y * rstd * g4.y * siluf_(a1)); ow[2 * k + 1] = pk2(ov[k].z * rstd * g4.z * siluf_(a2), ov[k].w * rstd * g4.w * siluf_(a3)); }
          bf16* mp = MIX + (size_t)(row0 + s2) * D + h * 128 + dg;
          *(u32x4*)mp = (u32x4){ow[0], ow[1], ow[2], ow[3]}; *(u32x4*)(mp + 8) = (u32x4){ow[4], ow[5], ow[6], ow[7]}; }
    }
    __syncthreads();
}

__device__ __forceinline__ void ph_conv(const Prm& p, int l) {
    const int j = l / 2; const bf16* PROJ = (const bf16*)(p.ws + WS_PROJ); bf16* MIX = (bf16*)(p.ws + WS_MIX); const float* cw = p.conv_w + (size_t)j * 3 * D;
    const int nrows = (l < 2) ? MT : ML; const int total = (nrows / 8) * 128;
    for (int i = obid() * NTHREADS + otid(); i < total; i += gridDim.x * NTHREADS) {
        const int rb = i >> 7, c = (i & 127) * 8, r0 = rb * 8;
        const bool isc = r0 >= ML; const int t0 = isc ? ((r0 - ML) & (TC - 1)) : (r0 & (T - 1)); const int len = isc ? TC : T;
        float w0[8], w1[8], w2[8];
        { const f32x4 a0 = *(const f32x4*)(cw + c), a1 = *(const f32x4*)(cw + c + 4), b0 = *(const f32x4*)(cw + D + c), b1 = *(const f32x4*)(cw + D + c + 4), c0 = *(const f32x4*)(cw + 2 * D + c), c1 = *(const f32x4*)(cw + 2 * D + c + 4);
          w0[0] = a0.x; w0[1] = a0.y; w0[2] = a0.z; w0[3] = a0.w; w0[4] = a1.x; w0[5] = a1.y; w0[6] = a1.z; w0[7] = a1.w;
          w1[0] = b0.x; w1[1] = b0.y; w1[2] = b0.z; w1[3] = b0.w; w1[4] = b1.x; w1[5] = b1.y; w1[6] = b1.z; w1[7] = b1.w;
          w2[0] = c0.x; w2[1] = c0.y; w2[2] = c0.z; w2[3] = c0.w; w2[4] = c1.x; w2[5] = c1.y; w2[6] = c1.z; w2[7] = c1.w; }
        float up[8], uc[8], un[8];
#define CONV_U(dst, rr, ok) do { if (ok) { const u32x4 uu_ = *(const u32x4*)(PROJ + (size_t)(rr) * 2048 + 1024 + c); const unsigned uw_[4] = {uu_.x, uu_.y, uu_.z, uu_.w}; \
            _Pragma("unroll") for (int q = 0; q < 4; ++q) { dst[2 * q] = __uint_as_float(uw_[q] << 16); dst[2 * q + 1] = __uint_as_float(uw_[q] & 0xffff0000u); } } \
          else { _Pragma("unroll") for (int q = 0; q < 8; ++q) dst[q] = 0.f; } } while (0)
        CONV_U(up, r0 - 1, t0 > 0); CONV_U(uc, r0, true);
#pragma unroll
        for (int k = 0; k < 8; ++k) { const int r = r0 + k; CONV_U(un, r + 1, t0 + k + 1 < len);
            const u32x4 bg = *(const u32x4*)(PROJ + (size_t)r * 2048 + c); const unsigned bw[4] = {bg.x, bg.y, bg.z, bg.w}; u32x4 o; unsigned ow[4];
#pragma unroll
            for (int q = 0; q < 4; ++q) { const float y0 = up[2 * q] * w0[2 * q] + uc[2 * q] * w1[2 * q] + un[2 * q] * w2[2 * q], y1 = up[2 * q + 1] * w0[2 * q + 1] + uc[2 * q + 1] * w1[2 * q + 1] + un[2 * q + 1] * w2[2 * q + 1];
                ow[q] = pk2(__uint_as_float(bw[q] << 16) * y0, __uint_as_float(bw[q] & 0xffff0000u) * y1); }
            o.x = ow[0]; o.y = ow[1]; o.z = ow[2]; o.w = ow[3]; *(u32x4*)(MIX + (size_t)r * D + c) = o;
#pragma unroll
            for (int q = 0; q < 8; ++q) { up[q] = uc[q]; uc[q] = un[q]; } }
#undef CONV_U
    }
}

__device__ __forceinline__ void ph_router(const Prm& p, int l, LAS float* lds) {
    const int tid = otid(), lane = tid & 63, gw = obid() * 8 + (tid >> 6), ngw = gridDim.x * 8;
    const float* modv = (const float*)(p.ws + WS_MODV) + (size_t)l * 5 * 6144;
    bf16* X = (bf16*)(p.ws + WS_X); const bf16* Yb = (const bf16*)(p.ws + WS_H); bf16* H2 = (bf16*)(p.ws + WS_H2); float* AFF = (float*)(p.ws + WS_AFF);
    const float* rw = p.router_w + (size_t)l * D * NE;
    const bool split = (l < 2) && gridDim.x > 32, ctxw = split && obid() < 16;
    if (ctxw) { pg8::Gemm g{(const bf16*)(p.ws + WS_MIX), (const bf16*)(p.ws + WS_WOUT), MT, D, D}; pg8::OneUnit S{ML / 256 + obid() / 4, obid() % 4};
        pg8::EpiGY E{(bf16*)(p.ws + WS_H), (const float*)(p.ws + WS_MODV) + (size_t)l * 5 * 6144 + 2 * 1024, ML};
        pg8::gemm_phase<pg8::EpiGY, pg8::OneUnit, true, true>((LAS unsigned char*)lds, g, S, E);
        mini_barrier((unsigned*)(p.ws + WS_CTL) + CW_MINI + 64 * l, 16u); }
    __syncthreads();
    for (int i = tid; i < D * NE / 4; i += NTHREADS) { const f32x4 w = *(const f32x4*)(rw + (size_t)i * 4); const int c = i >> 2, e0 = (i & 3) * 4;
        const int pos = ((((c >> 9) << 1) | ((c >> 2) & 1)) * 256) + (((c & 511) >> 3) * 4) + (c & 3);
        lds[(e0 + 0) * D + pos] = w.x; lds[(e0 + 1) * D + pos] = w.y; lds[(e0 + 2) * D + pos] = w.z; lds[(e0 + 3) * D + pos] = w.w; }
    __syncthreads();
    int ebeg, eend, estep;
    if (!split) { ebeg = gw; eend = ((l < 2) ? MT : ML) / 2; estep = ngw; }
    else if (ctxw) { ebeg = ML / 2 + gw; eend = ebeg + 1; estep = 1; }
    else { ebeg = gw - 16 * 8; eend = ML / 2 + 384; estep = ngw - 16 * 8; }
    bool seen = false;
    for (int en = ebeg; en < eend; en += estep) {
        const int r0 = (split && !ctxw && en >= ML / 2) ? (en + 128) * 2 : en * 2;
        if (split && !ctxw && en >= ML / 2 && !seen) { unsigned* ctr = (unsigned*)(p.ws + WS_CTL) + CW_MINI + 64 * l; unsigned sp = 0u;
            while (xb_ld(ctr) < 16u) { __builtin_amdgcn_s_sleep(1); if (++sp > XB_SPIN_CAP) break; }
            __builtin_amdgcn_fence(__ATOMIC_ACQUIRE, "agent"); seen = true; }
        f32x4 hv[2][4]; float my0 = 0.f, my1 = 0.f;
#pragma unroll
        for (int u = 0; u < 2; ++u) { const int r = r0 + u; const bool isc = r >= ML; const int mr = isc ? 4 : (r >> 12);
            f32x4 v[4]; float s = 0.f;
            u32x4 yw[2];
#pragma unroll
            for (int j2 = 0; j2 < 2; ++j2) yw[j2] = __builtin_nontemporal_load((const u32x4*)(Yb + (size_t)r * D + 8 * lane + 512 * j2));
            if (l == 0) { const float* xin = isc ? p.ctx + (size_t)(r - ML) * D : p.x + (size_t)r * D;
#pragma unroll
                for (int j = 0; j < 4; ++j) v[j] = __builtin_nontemporal_load((const f32x4*)(xin + CJ(j))); }
            else load_xrow(X + (size_t)r * D, lane, v);
#pragma unroll
            for (int j2 = 0; j2 < 2; ++j2) acc_bf16x8(v[2 * j2], v[2 * j2 + 1], yw[j2], 1.f);
            store_xrow(X + (size_t)r * D, lane, v);
#pragma unroll
            for (int j = 0; j < 4; ++j) s += v[j].x * v[j].x + v[j].y * v[j].y + v[j].z * v[j].z + v[j].w * v[j].w;
            const float rstd = rsqrtf(wave_sum(s) * (1.f / D) + EPS);
#pragma unroll
            for (int j = 0; j < 4; ++j) { const int c = CJ(j);
                const f32x4 g = *(const f32x4*)(p.norm2_g + l * D + c), sh = *(const f32x4*)(modv + (size_t)mr * 6144 + 3 * 1024 + c), scl = *(const f32x4*)(modv + (size_t)mr * 6144 + 4 * 1024 + c);
                hv[u][j] = (v[j] * rstd * g) * (scl + 1.f) + sh; }
#pragma unroll
            for (int j2 = 0; j2 < 2; ++j2) *(u32x4*)(H2 + (size_t)r * D + 8 * lane + 512 * j2) = pack_bf16x8(hv[u][2 * j2], hv[u][2 * j2 + 1]); }
#pragma unroll 2
        for (int e = 0; e < 16; ++e) { float a0 = 0.f, a1 = 0.f;
#pragma unroll
            for (int j = 0; j < 4; ++j) { const f32x4 w = *(const LAS f32x4*)(lds + e * D + j * 256 + 4 * lane);
                a0 += hv[0][j].x * w.x + hv[0][j].y * w.y + hv[0][j].z * w.z + hv[0][j].w * w.w; a1 += hv[1][j].x * w.x + hv[1][j].y * w.y + hv[1][j].z * w.z + hv[1][j].w * w.w; }
            a0 = wave_sum(a0); a1 = wave_sum(a1); if (lane == e) { my0 = a0; my1 = a1; } }
#pragma unroll
        for (int u = 0; u < 2; ++u) { const int r = r0 + u; const bool isc = r >= ML; const float lgt = u ? my1 : my0;
            float mx = lgt; mx = fmaxf(mx, __shfl_xor(mx, 1)); mx = fmaxf(mx, __shfl_xor(mx, 2)); mx = fmaxf(mx, __shfl_xor(mx, 4)); mx = fmaxf(mx, __shfl_xor(mx, 8));
            const float ex = __expf(lgt - mx); float den = ex; den += __shfl_xor(den, 1); den += __shfl_xor(den, 2); den += __shfl_xor(den, 4); den += __shfl_xor(den, 8);
            if (lane < 16) { const float a = ex / den;
                if (!isc) AFF[((size_t)(r >> 12) * NE + lane) * T + (r & (T - 1))] = a;
                else { const int rc = r - ML; AFF[(size_t)NB * NE * T + ((size_t)(rc >> 8) * NE + lane) * TC + (rc & (TC - 1))] = a; } } }
    }
    __syncthreads();
}

__device__ __forceinline__ void ph_topk(const Prm& p, int l, LAS float* lds) {
    const float* AFF = (const float*)(p.ws + WS_AFF); float* GATE = (float*)(p.ws + WS_GATE); int* SEL = (int*)(p.ws + WS_SEL); int* TOKSLOT = (int*)(p.ws + WS_TOKSLOT);
    const int tid = otid(), lane = tid & 63, wv = tid >> 6; const int nitems = (l < 2) ? 128 : 64;
    LAS unsigned* hist = (LAS unsigned*)lds;
    LAS unsigned* ctl = hist + 256;
    LAS unsigned* wtot = hist + 272;
    for (int it = obid(); it < nitems; it += gridDim.x) {
        const bool isc = it >= 64; const int be = it & 63, b = be >> 4, e = be & 15; const int n = isc ? TC : T, cap = isc ? CAPC : CAP;
        const float* a = AFF + (isc ? (size_t)NB * NE * T + (size_t)be * TC : (size_t)be * T);
        const bool valid = tid * 8 < n;
        unsigned bits[8];
        if (valid) { const u32x4 w0 = *(const u32x4*)(a + tid * 8), w1 = *(const u32x4*)(a + tid * 8 + 4); bits[0] = w0.x; bits[1] = w0.y; bits[2] = w0.z; bits[3] = w0.w; bits[4] = w1.x; bits[5] = w1.y; bits[6] = w1.z; bits[7] = w1.w; }
        else {
#pragma unroll
            for (int j = 0; j < 8; ++j) bits[j] = 0u; }
        unsigned prefix = 0u, remaining = (unsigned)cap;
#pragma unroll 1
        for (int pass = 0; pass < 4; ++pass) { const int shift = 24 - 8 * pass;
            __syncthreads();
            if (tid < 256) hist[tid] = 0u;
            __syncthreads();
            if (valid) {
#pragma unroll
                for (int j = 0; j < 8; ++j) { const bool m = (pass == 0) || ((bits[j] >> (shift + 8)) == prefix); if (m) __hip_atomic_fetch_add(&hist[(bits[j] >> shift) & 255u], 1u, __ATOMIC_RELAXED, __HIP_MEMORY_SCOPE_WORKGROUP); } }
            __syncthreads();
            if (wv == 0) { const unsigned c0 = hist[4 * lane], c1 = hist[4 * lane + 1], c2 = hist[4 * lane + 2], c3 = hist[4 * lane + 3]; const unsigned s = c0 + c1 + c2 + c3;
                unsigned incl = s;
#pragma unroll
                for (int o = 1; o < 64; o <<= 1) { const unsigned t = __shfl_down(incl, o); if (lane + o < 64) incl += t; }
                unsigned above = incl - s;
                if (above < remaining && remaining <= above + s) { unsigned B;
                    if (above + c3 >= remaining) B = 4 * lane + 3; else { above += c3; if (above + c2 >= remaining) B = 4 * lane + 2; else { above += c2; if (above + c1 >= remaining) B = 4 * lane + 1; else { above += c1; B = 4 * lane; } } }
                    ctl[0] = (prefix << 8) | B; ctl[1] = remaining - above; } }
            __syncthreads();
            prefix = ctl[0]; remaining = ctl[1];
        }
        const unsigned thr = prefix;
        unsigned cg = 0u, ce = 0u;
#pragma unroll
        for (int j = 0; j < 8; ++j) { cg += (valid && bits[j] > thr) ? 1u : 0u; ce += (valid && bits[j] == thr) ? 1u : 0u; }
        unsigned pk = cg | (ce << 16), incl = pk;
#pragma unroll
        for (int o = 1; o < 64; o <<= 1) { const unsigned t = __shfl_up(incl, o); if (lane >= o) incl += t; }
        __syncthreads();
        if (lane == 63) wtot[wv] = incl;
        __syncthreads();
        unsigned base = 0u, total = 0u;
#pragma unroll
        for (int w = 0; w < 8; ++w) { const unsigned t = wtot[w]; if (w < wv) base += t; total += t; }
        const unsigned excl = base + incl - pk; unsigned gpos = excl & 0xffffu, epos = excl >> 16; const unsigned ngt = total & 0xffffu;
        if (valid) {
#pragma unroll
            for (int j = 0; j < 8; ++j) { const int t0 = tid * 8 + j; const int row = isc ? ML + b * TC + t0 : b * T + t0; int slot = -1;
                if (bits[j] > thr) { slot = (int)gpos; ++gpos; } else if (bits[j] == thr) { if (epos < remaining) slot = (int)(ngt + epos); ++epos; }
                if (slot >= 0) { const int xr = isc ? 2048 + b * CAPC + slot : b * CAP + slot; SEL[e * XR + xr] = row; GATE[e * XR + xr] = __uint_as_float(bits[j]); TOKSLOT[(size_t)row * NE + e] = xr; }
                else TOKSLOT[(size_t)row * NE + e] = -1; } }
    }
    __syncthreads();
}
__device__ __forceinline__ void ph_dispatch(const Prm& p, int l) {
    const int lane = otid() & 63, gw = obid() * 8 + (otid() >> 6), ngw = gridDim.x * 8;
    const int* SEL = (const int*)(p.ws + WS_SEL); const bf16* H2 = (const bf16*)(p.ws + WS_H2); bf16* XE = (bf16*)(p.ws + WS_XE);
    const int rows_e = (l < 2) ? 2176 : 2048;
    for (int g = gw; g < NE * rows_e; g += ngw) { const int e = g / rows_e, xr = g % rows_e; const int src = SEL[e * XR + xr];
        const u32x4* s4 = (const u32x4*)(H2 + (size_t)src * D); u32x4* d4 = (u32x4*)(XE + ((size_t)e * XR + xr) * D);
        d4[lane] = s4[lane]; d4[lane + 64] = s4[lane + 64]; }
}

__global__ void __launch_bounds__(NTHREADS, 2) mega(Prm p) {
    extern __shared__ __attribute__((aligned(16))) unsigned char lds_raw[];
    LAS unsigned char* ldsb = (LAS unsigned char*)lds_raw;
    LAS float* lds = (LAS float*)ldsb;
    volatile LAS unsigned* misc = (volatile LAS unsigned*)(ldsb + LDS_BYTES - 256);
    if (threadIdx.x < 32) misc[threadIdx.x] = 0u;
    __syncthreads();
    XcdBarrier bar = xcd_barrier_post((unsigned*)(p.ws + WS_CTL) + 1024, misc + 8);
#define GRID_BAR() do { XcdBarrier b_; { unsigned long long w_ = (unsigned long long)p.ws; asm volatile("" : "+s"(w_)); b_.bar = (unsigned*)((unsigned char*)w_ + WS_CTL) + 1024; } b_.x = xb_xcc_id(); b_.st = misc + 8; xcd_barrier(b_); } while (0)
    (void)bar;
    ph_setup(p, lds);
    ph_convert(p, 0, ldsb);
    GRID_BAR();
    if (DUP_PHASE == 13) { ph_setup(p, lds); GRID_BAR(); ph_setup(p, lds); GRID_BAR(); ph_setup(p, lds); GRID_BAR(); }
    for (int l = 0; l < DEPTH; ++l) {
        if (l > 0) ph_convert(p, l, ldsb);
        ph_norm1(p, l);
        GRID_BAR();
        ph_gemm_in(p, l, ldsb);
        GRID_BAR();
        if (DUP_PHASE == 1) { ph_gemm_in(p, l, ldsb); GRID_BAR(); }
        if (DUP_PHASE == 2) { ph_convert(p, l, ldsb); GRID_BAR(); }
        if (DUP_PHASE == 14) { ph_probe_read<0>(p, l); GRID_BAR(); }
        if (DUP_PHASE == 41) { ph_probe_read<1>(p, l); GRID_BAR(); }
        if (DUP_PHASE == 42) { ph_probe_read<2>(p, l); GRID_BAR(); }
        if (DUP_PHASE == 43) { ph_probe_read<3>(p, l); GRID_BAR(); }
        if (DUP_PHASE == 44) { ph_probe_cvt<4>(p, l); GRID_BAR(); }
        if (DUP_PHASE == 45) { ph_probe_cvt<5>(p, l); GRID_BAR(); }
        if (DUP_PHASE == 18 && l >= 1) { ph_norm1(p, l, false); GRID_BAR(); }
        if ((l & 1) == 0) {
            if (DUP_PHASE == 5 || DUP_PHASE == 7) { ph_hgrn_local<9>(p, l, ldsb); GRID_BAR(); }
            if (DUP_PHASE == 7) { ph_hgrn_local<9>(p, l, ldsb); GRID_BAR(); }
            ph_qkprep(p, l);
            ph_hgrn_local<0>(p, l, ldsb);
            GRID_BAR();
            ph_hgrn_scan(p);
            GRID_BAR();
            if (DUP_PHASE == 3) { ph_hgrn_local<9>(p, l, ldsb); GRID_BAR(); }
            if (DUP_PHASE == 4) { ph_hgrn_scan(p); GRID_BAR(); }
            ph_attn<5>(p, l, ldsb);
            ph_hgrn_out<0>(p, l, ldsb);
            GRID_BAR();
            if (DUP_PHASE == 5) { ph_attn<0>(p, l, ldsb); GRID_BAR(); }
            if (DUP_PHASE == 21) { ph_attn<1>(p, l, ldsb); GRID_BAR(); }
            if (DUP_PHASE == 22) { ph_attn<2>(p, l, ldsb); GRID_BAR(); }
            if (DUP_PHASE == 23) { ph_attn<3>(p, l, ldsb); GRID_BAR(); }
            if (DUP_PHASE == 24) { ph_attn<4>(p, l, ldsb); GRID_BAR(); }
            if (DUP_PHASE == 6) { ph_hgrn_out<5>(p, l, ldsb); GRID_BAR(); }
            if (DUP_PHASE == 31) { ph_hgrn_out<1>(p, l, ldsb); GRID_BAR(); }
            if (DUP_PHASE == 32) { ph_hgrn_out<2>(p, l, ldsb); GRID_BAR(); }
            if (DUP_PHASE == 33) { ph_hgrn_out<3>(p, l, ldsb); GRID_BAR(); }
        } else {
            ph_conv(p, l);
            GRID_BAR();
            if (DUP_PHASE == 17) { ph_conv(p, l); GRID_BAR(); }
        }
        ph_gemm_out(p, l, ldsb);
        GRID_BAR();
        ph_router(p, l, lds);
        GRID_BAR();
        ph_topk(p, l, lds);
        GRID_BAR();
        if (DUP_PHASE == 7) { ph_topk(p, l, lds); GRID_BAR(); }
        ph_expert_up(p, l, ldsb);
        GRID_BAR();
        if (DUP_PHASE == 10) { ph_expert_up(p, l, ldsb); GRID_BAR(); }
        ph_expert_down(p, l, ldsb);
        GRID_BAR();
        if (DUP_PHASE == 11) { ph_expert_down(p, l, ldsb); GRID_BAR(); }
        if (DUP_PHASE == 12) { GRID_BAR(); GRID_BAR(); GRID_BAR(); GRID_BAR(); GRID_BAR(); GRID_BAR(); GRID_BAR(); GRID_BAR(); GRID_BAR(); GRID_BAR(); }
    }
    ph_final(p);
    if (DUP_PHASE == 19) { GRID_BAR(); ph_final(p); GRID_BAR(); ph_final(p); }
}

extern "C" void kernel_launch(void* const* d_in, const int* in_sizes, int n_in, void* d_out, int out_size, void* d_ws, size_t ws_size, hipStream_t stream) {
    static int grid = 0;
    if (grid == 0) {
        if (n_in != 23 || out_size != ML * D || ws_size < WS_END) { fprintf(stderr, "kernel_launch: unexpected shapes: n_in %d out %d ws %zu (need %zu)\n", n_in, out_size, ws_size, (size_t)WS_END); grid = -1; return; }
        int dev = 0, cus = 0, per_cu = 0;
        if (hipGetDevice(&dev) != hipSuccess || hipDeviceGetAttribute(&cus, hipDeviceAttributeMultiprocessorCount, dev) != hipSuccess) { grid = -1; return; }
        if (hipFuncSetAttribute((const void*)mega, hipFuncAttributeMaxDynamicSharedMemorySize, LDS_BYTES) != hipSuccess) { fprintf(stderr, "kernel_launch: hipFuncSetAttribute failed\n"); grid = -1; return; }
        if (hipOccupancyMaxActiveBlocksPerMultiprocessor(&per_cu, (const void*)mega, NTHREADS, LDS_BYTES) != hipSuccess || per_cu < 1) fprintf(stderr, "kernel_launch: occupancy query says %d\n", per_cu);
        (void)hipGetLastError();
        grid = cus;
    }
    if (grid < 0) return;
    (void)hipMemsetAsync((char*)d_ws + WS_CTL, 0, 1 * MiB, stream);
    Prm p{};
    const float** pp = (const float**)&p;
    for (int i = 0; i < 23; ++i) pp[i] = (const float*)d_in[i];
    p.out = (float*)d_out; p.ws = (unsigned char*)d_ws;
    hipLaunchKernelGGL(mega, dim3(grid), dim3(NTHREADS), LDS_BYTES, stream, p);
}
```

```cpp
#include <hip/hip_runtime.h>
#include <type_traits>
#ifndef DUP_PHASE
#define DUP_PHASE 0
#endif
#include <cstdint>
#include <cstdio>

#define GAS __attribute__((address_space(1)))
#define LAS __attribute__((address_space(3)))
typedef unsigned short bf16;
typedef float f32x4 __attribute__((ext_vector_type(4)));
typedef unsigned u32x4 __attribute__((ext_vector_type(4)));
typedef unsigned u32x2 __attribute__((ext_vector_type(2)));

constexpr int D = 1024, NB = 4, T = 4096, TC = 256, DEPTH = 4;
constexpr int ML = NB * T, MC = NB * TC, MT = ML + MC;
constexpr int NE = 16, FF = 1024, CAP = 512, CAPC = 32;
constexpr int XR = 2304;
constexpr int NTHREADS = 512;
constexpr float EPS = 1e-6f;

constexpr size_t MiB = 1u << 20;
constexpr size_t WS_CTL = 0;
constexpr size_t WS_MODV = 1 * MiB;
constexpr size_t WS_ROPE = WS_MODV + 512 * 1024;
constexpr size_t WS_X = 2 * MiB;
constexpr size_t WS_H = WS_X + (size_t)MT * D * 4;
constexpr size_t WS_H2 = WS_H + (size_t)MT * D * 2;
constexpr size_t WS_PROJ = WS_H2 + (size_t)MT * D * 2;
constexpr size_t WS_MIX = WS_PROJ + (size_t)MT * 4096 * 2;
constexpr size_t WS_OF = WS_MIX + (size_t)MT * D * 2;
constexpr size_t WS_AFF = WS_OF + (size_t)2 * MT * 512 * 4;
constexpr size_t WS_GATE = WS_AFF + 2 * MiB;
constexpr size_t WS_SEL = WS_GATE + 1 * MiB;
constexpr size_t WS_TOKSLOT = WS_SEL + 1 * MiB;
constexpr size_t WS_XE = WS_TOKSLOT + 2 * MiB;
constexpr size_t WS_ACT = WS_XE + (size_t)NE * XR * D * 2;
constexpr size_t WS_YE = WS_ACT + (size_t)NE * XR * D * 2;
constexpr size_t WS_WIN = WS_YE + (size_t)NE * XR * D * 2;
constexpr size_t WS_WOUT = WS_WIN + (size_t)4096 * D * 2;
constexpr size_t WS_WUP = WS_WOUT + (size_t)D * D * 2;
constexpr size_t WS_WDN = WS_WUP + (size_t)NE * 2048 * D * 2;
constexpr int HG_NCH = 68, HG_ITEMS = NB * 4 * 2 * HG_NCH;
constexpr size_t WS_HDS = WS_WDN + (size_t)NE * D * FF * 2;
constexpr size_t WS_HST = WS_HDS + (size_t)HG_ITEMS * 128 * 128 * 2;
constexpr size_t WS_HG = WS_HST + (size_t)HG_ITEMS * 128 * 128 * 2;
constexpr size_t WS_END = WS_HG + (size_t)HG_ITEMS * 128 * 4;

constexpr int LDS_BYTES = 155648;

struct Prm {
    const float *x, *c, *ctx, *c_ctx, *mod_w, *mod_b, *norm1_g, *norm2_g, *even_w_in, *even_w_out, *hgrn_lb, *hgrn_g, *qn_g, *kn_g, *dlam, *subln_g,
        *conv_w_in, *conv_w, *conv_w_out, *router_w, *w_gate, *w_up, *w_down;
    float* out; unsigned char* ws;
};

__device__ __forceinline__ float bf2f(bf16 v) { return __uint_as_float((unsigned)v << 16); }
__device__ __forceinline__ bf16 f2bf(float f) { unsigned u = __float_as_uint(f); return (bf16)((u + 0x7fffu + ((u >> 16) & 1u)) >> 16); }
__device__ __forceinline__ unsigned pk2_sw(float lo, float hi) { return (unsigned)f2bf(lo) | ((unsigned)f2bf(hi) << 16); }
__device__ __forceinline__ unsigned pk2(float lo, float hi) { unsigned r; asm volatile("v_cvt_pk_bf16_f32 %0, %1, %2" : "=v"(r) : "v"(lo), "v"(hi)); return r; }
__device__ __forceinline__ float wave_sum(float v) {
#define WS_DPP(ctrl) v += __int_as_float(__builtin_amdgcn_update_dpp(0, __float_as_int(v), ctrl, 0xf, 0xf, true))
    WS_DPP(0xB1); WS_DPP(0x4E); WS_DPP(0x141); WS_DPP(0x140);
#undef WS_DPP
    const int b = __float_as_int(v);
    return (__int_as_float(__builtin_amdgcn_readlane(b, 0)) + __int_as_float(__builtin_amdgcn_readlane(b, 16))) + (__int_as_float(__builtin_amdgcn_readlane(b, 32)) + __int_as_float(__builtin_amdgcn_readlane(b, 48)));
}
__device__ __forceinline__ int otid() { int t = threadIdx.x; asm volatile("" : "+v"(t)); return t; }
__device__ __forceinline__ int obid() { int b = blockIdx.x; asm volatile("" : "+s"(b)); return b; }
__device__ __forceinline__ int vcu_id() { const int G = gridDim.x, bx = obid(); return (G % 8 == 0) ? (bx % 8) * (G / 8) + bx / 8 : bx; }
__device__ __forceinline__ float sigmoidf_(float x) { return __builtin_amdgcn_rcpf(1.f + __expf(-x)); }
__device__ __forceinline__ float siluf_(float x) { return x * __builtin_amdgcn_rcpf(1.f + __expf(-x)); }

#define XB_TMO      128
#define XB_XCNT(j)  (256  + 64 * (j))
#define XB_XSUB(j)  (1280 + 64 * (j))
#define XB_XGEN(j)  (2304 + 64 * (j))
#define XB_TOP      3328
#define XB_TOPGEN   3392
#define XCD_BAR_WORDS 3456
#define XB_SPIN_CAP (1u << 28)
__device__ __forceinline__ unsigned xb_ld(unsigned* p)              { return __hip_atomic_load(p, __ATOMIC_RELAXED, __HIP_MEMORY_SCOPE_AGENT); }
__device__ __forceinline__ unsigned xb_add(unsigned* p, unsigned v) { return __hip_atomic_fetch_add(p, v, __ATOMIC_RELAXED, __HIP_MEMORY_SCOPE_AGENT); }
__device__ __forceinline__ unsigned xb_xcc_id() { return (unsigned)__builtin_amdgcn_s_getreg((3 << 11) | 20) & 0xFu; }
#define XB_SPIN(cond, bar) do { unsigned _sp = 0; while (cond) { __builtin_amdgcn_s_sleep(1); \
    if ((++_sp & 255u) == 0u) { if (xb_ld(&(bar)[XB_TMO])) break; if (_sp > XB_SPIN_CAP) { atomicAdd(&(bar)[XB_TMO], 1u); break; } } } } while (0)
struct XcdBarrier { unsigned* bar; unsigned x; volatile LAS unsigned* st; };
__device__ __forceinline__ XcdBarrier xcd_barrier_post(unsigned* bar, volatile LAS unsigned* st) {
    XcdBarrier b; b.bar = bar; b.x = xb_xcc_id(); b.st = st;
    if (threadIdx.x == 0) (void)xb_add(&bar[XB_XCNT(b.x)], 1u);
    return b;
}
__device__ __forceinline__ void xcd_barrier_complete(unsigned* bar, unsigned x, unsigned& nloc, unsigned& nx) {
    const unsigned G = gridDim.x * gridDim.y * gridDim.z;
    unsigned sum, cnt, mine, sp = 0u;
    for (;;) {
        sum = 0u; cnt = 0u; mine = 0u;
#pragma unroll
        for (unsigned j = 0; j < 16; ++j) { const unsigned c = xb_ld(&bar[XB_XCNT(j)]); sum += c; cnt += (c > 0u) ? 1u : 0u; mine = (j == x) ? c : mine; }
        if (sum == G) break;
        __builtin_amdgcn_s_sleep(1);
        if ((++sp & 255u) == 0u) { if (xb_ld(&bar[XB_TMO])) break; if (sp > XB_SPIN_CAP) { atomicAdd(&bar[XB_TMO], 1u); break; } }
    }
    nloc = mine > 0u ? mine : 1u; nx = cnt > 0u ? cnt : 1u;
}
__device__ __forceinline__ void xcd_barrier(const XcdBarrier& b) {
    asm volatile("s_waitcnt vmcnt(0)" ::: "memory");
    __syncthreads();
    if (threadIdx.x == 0) {
        unsigned* bar = b.bar;
        __builtin_amdgcn_s_waitcnt(0);
        unsigned nloc = b.st[0], nx = b.st[1];
        if (nloc == 0u) { xcd_barrier_complete(bar, b.x, nloc, nx); b.st[0] = nloc; b.st[1] = nx; }
        const unsigned old = xb_add(&bar[XB_XSUB(b.x)], 1u);
        const unsigned gen = old / nloc;
        if (old + 1u == (gen + 1u) * nloc) {
            __builtin_amdgcn_fence(__ATOMIC_RELEASE, "agent");
            asm volatile("s_waitcnt vmcnt(0)" ::: "memory");
            const unsigned og = xb_add(&bar[XB_TOP], 1u);
            const unsigned tg = og / nx;
            asm volatile("buffer_inv sc1" ::: "memory");
            if (og + 1u == (tg + 1u) * nx) xb_add(&bar[XB_TOPGEN], 1u);
            else XB_SPIN(xb_ld(&bar[XB_TOPGEN]) == tg, bar);
            xb_add(&bar[XB_XGEN(b.x)], 1u);
            asm volatile("s_waitcnt vmcnt(0)" ::: "memory");
        } else {
            asm volatile("buffer_inv sc1" ::: "memory");
            XB_SPIN(xb_ld(&bar[XB_XGEN(b.x)]) == gen, bar);
            asm volatile("s_waitcnt vmcnt(0)" ::: "memory");
        }
    }
    __syncthreads();
}

namespace pg8 {
#define PG8_LAS __attribute__((address_space(3)))
typedef unsigned short bf16_t;
typedef short bf16x8 __attribute__((ext_vector_type(8)));
typedef float f32x4 __attribute__((ext_vector_type(4)));
typedef unsigned u32x4 __attribute__((ext_vector_type(4)));
constexpr int BM = 256, BK = 64, HALF = 128, HTB = HALF * BK * 2  , STAGE_BYTES = 8 * HTB, NXCD = 8, WGM = 8;

__host__ __device__ __forceinline__ int lds_byte(int r, int c) { const int st = (r >> 4) * 2 + (c >> 5), rr = r & 15, cc = c & 31, ob = rr * 64 + cc * 2; return st * 1024 + (ob ^ (((ob >> 9) & 1) << 5)); }
__host__ __device__ __forceinline__ void stage_rc(int b, int& R, int& C) { const int st = b / 1024, sb = b % 1024, swz = sb ^ (((sb >> 9) & 1) << 5); R = (st >> 1) * 16 + swz / 64; C = (st & 1) * 32 + (swz % 64) / 2; }
__host__ __device__ __forceinline__ int perm32(int rho) { const int n = rho >> 4, i = rho & 15; return 8 * (i >> 2) + 4 * n + (i & 3); }

struct Unit { int pm, pn, ab; };
struct Gemm { const bf16_t* A; const bf16_t* Bt; int M, N, K; };

template <int SPLIT = 0>
struct StaticOrderT {
    static constexpr bool HAS_SPLIT = SPLIT != 0;
    int nM, nN, nwg, G, c, nsplit;
    __host__ __device__ void init(int M, int N, int G_, int c_, int Mfull = -1) { if (Mfull < 0) Mfull = M; nM = Mfull / BM; nN = N / BM; nwg = nM * nN; G = G_; c = c_; nsplit = SPLIT ? ((M - Mfull) / BM) * nN * SPLIT : 0; }
    __host__ __device__ bool next(int i, Unit& u) const {
        const long L = (long)i * G + c;
        if (L >= (long)nwg + nsplit) return false;
        int pm, pn, ab;
        if (SPLIT != 0 && L >= nwg) { int q = (int)(L - nwg);
            q = (q % NXCD) * (nsplit / NXCD) + q / NXCD;
            const int t = q / (SPLIT ? SPLIT : 1), s = q % (SPLIT ? SPLIT : 1); pn = t / 4; pm = nM + t % 4; ab = (1 << (s & 1)) | ((SPLIT == 4 ? (1 << (s >> 1)) : 3) << 2);
        } else {
            int wgid = (int)L; { const int q = nwg / NXCD, r = nwg % NXCD, xcd = wgid % NXCD, off = wgid / NXCD; wgid = (xcd < r ? xcd * (q + 1) : r * (q + 1) + (xcd - r) * q) + off; }
            const int nig = WGM * nN, gid = wgid / nig, fm = gid * WGM, gsz = (nM - fm) < WGM ? (nM - fm) : WGM;
            pm = fm + ((wgid % nig) % gsz); pn = (wgid % nig) / gsz; ab = 15; }
        u.pm = pm; u.pn = pn; u.ab = ab; return true;
    }
    __device__ __forceinline__ void a_ready(const Unit&) const {}
    __device__ __forceinline__ void done(const Unit&) const {}
};
typedef StaticOrderT<0> StaticOrder;

__device__ __forceinline__ unsigned cvt_pk_bf16(float lo, float hi) { unsigned r; asm volatile("v_cvt_pk_bf16_f32 %0, %1, %2" : "=v"(r) : "v"(lo), "v"(hi)); return r; }

struct EpiBf16 {
    static constexpr bool PERM = true, AFTER_DRAIN = false;
    bf16_t* O; int ldc;
    __device__ __forceinline__ void operator()(const f32x4 (&acc)[2][2][4][2], const Unit& u, int wr, int wc, int fr, int fq) const {
        const int row0 = u.pm * BM + wr * 64 + fr; const int col0 = u.pn * BM + wc * 32 + 8 * fq;
#pragma unroll
        for (int ai = 0; ai < 2; ++ai)
#pragma unroll
            for (int m = 0; m < 4; ++m) { if (!((u.ab >> ai) & 1)) continue; bf16_t* rowp = O + (size_t)(row0 + ai * HALF + m * 16) * ldc + col0;
#pragma unroll
                for (int bj = 0; bj < 2; ++bj) { if (!((u.ab >> (2 + bj)) & 1)) continue; const f32x4 v0 = acc[ai][bj][m][0], v1 = acc[ai][bj][m][1];
                    u32x4 w; w.x = cvt_pk_bf16(v0[0], v0[1]); w.y = cvt_pk_bf16(v0[2], v0[3]); w.z = cvt_pk_bf16(v1[0], v1[1]); w.w = cvt_pk_bf16(v1[2], v1[3]);
                    *(u32x4*)(rowp + bj * HALF) = w; } }
    }
};
struct EpiGY {
    static constexpr bool PERM = true, AFTER_DRAIN = false;
    bf16_t* Y; const float* g1; int ml;
    __device__ __forceinline__ void operator()(const f32x4 (&acc)[2][2][4][2], const Unit& u, int wr, int wc, int fr, int fq) const {
        const int rbase = u.pm * BM; const int mr = rbase >= ml ? 4 : (rbase >> 12); const float* g = g1 + (size_t)mr * 6144;
        const int row0 = rbase + wr * 64 + fr, col0 = u.pn * BM + wc * 32 + 8 * fq;
        f32x4 gv[2][2];
#pragma unroll
        for (int bj = 0; bj < 2; ++bj)
#pragma unroll
            for (int n = 0; n < 2; ++n) gv[bj][n] = *(const f32x4*)(g + col0 + bj * HALF + n * 4);
#pragma unroll
        for (int ai = 0; ai < 2; ++ai)
#pragma unroll
            for (int m = 0; m < 4; ++m) { bf16_t* rowp = Y + (size_t)(row0 + ai * HALF + m * 16) * 1024 + col0;
#pragma unroll
                for (int bj = 0; bj < 2; ++bj) { const f32x4 v0 = acc[ai][bj][m][0] * gv[bj][0], v1 = acc[ai][bj][m][1] * gv[bj][1];
                    u32x4 w; w.x = cvt_pk_bf16(v0[0], v0[1]); w.y = cvt_pk_bf16(v0[2], v0[3]); w.z = cvt_pk_bf16(v1[0], v1[1]); w.w = cvt_pk_bf16(v1[2], v1[3]);
                    *(u32x4*)(rowp + bj * HALF) = w; } }
    }
};
struct EpiResid {
    static constexpr bool PERM = false, AFTER_DRAIN = false;
    const float* xl; const float* xc; float* X; const float* g1; int ml;
    __device__ __forceinline__ void operator()(const f32x4 (&acc)[2][2][4][2], const Unit& u, int wr, int wc, int fr, int fq) const {
        const int rbase = u.pm * BM; const bool isc = rbase >= ml; const int mr = isc ? 4 : (rbase >> 12);
        const float* xin = isc ? xc - (size_t)ml * 1024 : xl; const float* g = g1 + (size_t)mr * 6144;
        const int col0 = u.pn * BM + wc * 32 + 4 * fq;
        f32x4 gv[2][2];
#pragma unroll
        for (int bj = 0; bj < 2; ++bj)
#pragma unroll
            for (int n = 0; n < 2; ++n) gv[bj][n] = *(const f32x4*)(g + col0 + bj * HALF + n * 16);
#pragma unroll
        for (int ai = 0; ai < 2; ++ai)
#pragma unroll
            for (int m = 0; m < 4; ++m) { const size_t off = (size_t)(rbase + ai * HALF + wr * 64 + m * 16 + fr) * 1024 + col0;
#pragma unroll
                for (int bj = 0; bj < 2; ++bj)
#pragma unroll
                    for (int n = 0; n < 2; ++n) { const f32x4 xi = *(const f32x4*)(xin + off + bj * HALF + n * 16); *(f32x4*)(X + off + bj * HALF + n * 16) = xi + gv[bj][n] * acc[ai][bj][m][n]; } }
    }
};
__device__ __forceinline__ float silu_f(float x) { return x * __builtin_amdgcn_rcpf(1.f + __expf(-x)); }
struct EpiSwiglu {
    static constexpr bool PERM = true, AFTER_DRAIN = false;
    bf16_t* O; int ntn;
    __device__ __forceinline__ void operator()(const f32x4 (&acc)[2][2][4][2], const Unit& u, int wr, int wc, int fr, int fq) const {
        const int row0 = u.pm * BM + wr * 64 + fr; const int col0 = (u.pn % ntn) * HALF + wc * 32 + 8 * fq;
#pragma unroll
        for (int ai = 0; ai < 2; ++ai)
#pragma unroll
            for (int m = 0; m < 4; ++m) { if (!((u.ab >> ai) & 1)) continue; bf16_t* rowp = O + (size_t)(row0 + ai * HALF + m * 16) * 1024 + col0;
                const f32x4 g0 = acc[ai][0][m][0], g1 = acc[ai][0][m][1], u0 = acc[ai][1][m][0], u1 = acc[ai][1][m][1];
                u32x4 w; w.x = cvt_pk_bf16(silu_f(g0[0]) * u0[0], silu_f(g0[1]) * u0[1]); w.y = cvt_pk_bf16(silu_f(g0[2]) * u0[2], silu_f(g0[3]) * u0[3]);
                w.z = cvt_pk_bf16(silu_f(g1[0]) * u1[0], silu_f(g1[1]) * u1[1]); w.w = cvt_pk_bf16(silu_f(g1[2]) * u1[2], silu_f(g1[3]) * u1[3]);
                *(u32x4*)rowp = w; }
    }
};
struct EpiConvIn {
    static constexpr bool PERM = true, AFTER_DRAIN = false;
    bf16_t* O;
    __device__ __forceinline__ void operator()(const f32x4 (&acc)[2][2][4][2], const Unit& u, int wr, int wc, int fr, int fq) const {
        const int row0 = u.pm * BM + wr * 64 + fr;
        if (u.pn < 4) { const int col0 = u.pn * BM + wc * 32 + 8 * fq;
#pragma unroll
            for (int ai = 0; ai < 2; ++ai)
#pragma unroll
                for (int m = 0; m < 4; ++m) { if (!((u.ab >> ai) & 1)) continue; bf16_t* rowp = O + (size_t)(row0 + ai * HALF + m * 16) * 2048 + col0;
#pragma unroll
                    for (int bj = 0; bj < 2; ++bj) { const f32x4 v0 = acc[ai][bj][m][0], v1 = acc[ai][bj][m][1];
                        u32x4 w; w.x = cvt_pk_bf16(v0[0], v0[1]); w.y = cvt_pk_bf16(v0[2], v0[3]); w.z = cvt_pk_bf16(v1[0], v1[1]); w.w = cvt_pk_bf16(v1[2], v1[3]);
                        *(u32x4*)(rowp + bj * HALF) = w; } }
        } else { const int col0 = 1024 + (u.pn - 4) * HALF + wc * 32 + 8 * fq;
#pragma unroll
            for (int ai = 0; ai < 2; ++ai)
#pragma unroll
                for (int m = 0; m < 4; ++m) { if (!((u.ab >> ai) & 1)) continue; bf16_t* rowp = O + (size_t)(row0 + ai * HALF + m * 16) * 2048 + col0;
                    const f32x4 c0 = acc[ai][0][m][0], c1 = acc[ai][0][m][1], v0 = acc[ai][1][m][0], v1 = acc[ai][1][m][1];
                    u32x4 w; w.x = cvt_pk_bf16(c0[0] * v0[0], c0[1] * v0[1]); w.y = cvt_pk_bf16(c0[2] * v0[2], c0[3] * v0[3]); w.z = cvt_pk_bf16(c1[0] * v1[0], c1[1] * v1[1]); w.w = cvt_pk_bf16(c1[2] * v1[2], c1[3] * v1[3]);
                    *(u32x4*)rowp = w; }
        }
    }
};
struct EpiDown {
    static constexpr bool PERM = true, AFTER_DRAIN = false;
    bf16_t* O; const float* gate; int ntn;
    __device__ __forceinline__ void operator()(const f32x4 (&acc)[2][2][4][2], const Unit& u, int wr, int wc, int fr, int fq) const {
        const int row0 = u.pm * BM + wr * 64 + fr; const int col0 = (u.pn % ntn) * BM + wc * 32 + 8 * fq;
#pragma unroll
        for (int ai = 0; ai < 2; ++ai)
#pragma unroll
            for (int m = 0; m < 4; ++m) { if (!((u.ab >> ai) & 1)) continue; const int r = row0 + ai * HALF + m * 16; const float gt = gate[r]; bf16_t* rowp = O + (size_t)r * 1024 + col0;
#pragma unroll
                for (int bj = 0; bj < 2; ++bj) { if (!((u.ab >> (2 + bj)) & 1)) continue; const f32x4 v0 = acc[ai][bj][m][0] * gt, v1 = acc[ai][bj][m][1] * gt;
                    u32x4 w; w.x = cvt_pk_bf16(v0[0], v0[1]); w.y = cvt_pk_bf16(v0[2], v0[3]); w.z = cvt_pk_bf16(v1[0], v1[1]); w.w = cvt_pk_bf16(v1[2], v1[3]);
                    *(u32x4*)(rowp + bj * HALF) = w; } }
    }
};
struct OneUnit { static constexpr bool HAS_SPLIT = false; int pm, pn;
    __device__ bool next(int i, Unit& u) const { if (i > 0) return false; u.pm = pm; u.pn = pn; u.ab = 15; return true; }
    __device__ __forceinline__ void a_ready(const Unit&) const {}
    __device__ __forceinline__ void done(const Unit&) const {}
};
template <int NTN, int QUARTER>
struct GroupOrderT {
    static constexpr bool HAS_SPLIT = true;
    int nfull, nsplit, G, c;
    __device__ void init(int mt_, int ne, int G_, int c_) { nfull = ne * 8 * NTN; nsplit = mt_ > 8 ? ne * NTN * (QUARTER ? 2 : 1) : 0; G = G_; c = c_; }
    __device__ bool next(int i, Unit& u) const { const int L = i * G + c; if (L >= nfull + nsplit) return false;
        int pm, pn, ab;
        if (L < nfull) { const int e = L / (8 * NTN), r = L % (8 * NTN); pm = e * 9 + (r % 8); pn = e * NTN + (r / 8); ab = 15; }
        else { const int q = L - nfull; const int sp = QUARTER ? 2 : 1, t = q / sp, s = q % sp; pm = (t / NTN) * 9 + 8; pn = t; ab = 1 | ((QUARTER ? (1 << s) : 3) << 2); }
        u.pm = pm; u.pn = pn; u.ab = ab; return true; }
    __device__ __forceinline__ void a_ready(const Unit&) const {}
    __device__ __forceinline__ void done(const Unit&) const {}
};

struct DenseA { static constexpr bool GATHER = false;
    __device__ __forceinline__ unsigned off(const Unit&, int h, int R, int C, int K) const { return (unsigned)((h * HALF + R) * K + C) * 2u; }
    __device__ __forceinline__ size_t base(const Unit& u, size_t tstep) const { return (size_t)u.pm * tstep; } };
struct GatherA { static constexpr bool GATHER = true; const int* sel; int sel_ld, tiles_per_e, nvalid;
    __device__ __forceinline__ unsigned off(const Unit& u, int h, int R, int C, int K) const { const int e = u.pm / tiles_per_e, xr = (u.pm % tiles_per_e) * BM + h * HALF + R; const int row = sel[e * sel_ld + (xr < nvalid ? xr : 0)]; return (unsigned)(row * K + C) * 2u; }
    __device__ __forceinline__ size_t base(const Unit&, size_t) const { return 0; } };
template <class Epi, class Sched, bool ALIGN_EPI = false, bool SP2 = false, class AOff = DenseA>
__device__ __forceinline__ void gemm_phase(PG8_LAS unsigned char* lds, const Gemm g, const Sched& S, const Epi& E, const AOff AO = AOff()) {
    const int tid = otid(), wid = __builtin_amdgcn_readfirstlane(tid >> 6), lane = tid & 63, wr = wid >> 2, wc = wid & 3, fr = lane & 15, fq = lane >> 4;
    const int K = g.K, nt = K / BK;
    unsigned voffB[2];
#pragma unroll
    for (int i = 0; i < 2; ++i) { int R, C; stage_rc(tid * 16 + i * 8192, R, C); const int Rb = Epi::PERM ? ((R & ~31) + perm32(R & 31)) : R;
        voffB[i] = (unsigned)(Rb * K + C) * 2u; }
    const size_t kstep = (size_t)(BK * 2);
    const size_t hstep = (size_t)HALF * K * 2;
    const size_t tstep = 2 * hstep;
    const unsigned ldsw = (unsigned)wid * 1024u;
    const int aoff = lds_byte(wr * 64 + fr, fq * 8), boff = lds_byte(wc * 32 + fr, fq * 8);
#define PG8_SA(b, h) (((b) * 2 + (h)) * HTB)
#define PG8_SB(b, h) ((4 + (b) * 2 + (h)) * HTB)
#define PG8_STAGE(bufoff, gbase, voff) do { _Pragma("unroll") for (int _i = 0; _i < 2; ++_i) \
        __builtin_amdgcn_global_load_lds((const unsigned*)((const char*)(gbase) + (voff)[_i]), (PG8_LAS unsigned*)(lds + (bufoff) + ldsw + _i * 8192), 16, 0, 0); } while (0)
#define PG8_STAGE_AC(b, h, base) PG8_STAGE(PG8_SA(b, h), base, roC[h])
#define PG8_STAGE_A2(b, h, base) PG8_STAGE(PG8_SA(b, h), base, r2[h])
#define PG8_LDA(dst, b, h) do { _Pragma("unroll") for (int m = 0; m < 4; ++m) _Pragma("unroll") for (int k = 0; k < 2; ++k) dst[m][k] = *(const PG8_LAS bf16x8*)(lds + PG8_SA(b, h) + aoff + m * 2048 + k * 1024); } while (0)
#define PG8_LDB(dst, b, h) do { _Pragma("unroll") for (int n = 0; n < 2; ++n) _Pragma("unroll") for (int k = 0; k < 2; ++k) dst[n][k] = *(const PG8_LAS bf16x8*)(lds + PG8_SB(b, h) + boff + n * 2048 + k * 1024); } while (0)
#define PG8_MMA(ai, bj, At, Bt) do { if (GATED && !(((cur.ab >> (ai)) & 1) && ((cur.ab >> (2 + (bj))) & 1))) break; __builtin_amdgcn_s_setprio(1); _Pragma("unroll") for (int m = 0; m < 4; ++m) _Pragma("unroll") for (int n = 0; n < 2; ++n) _Pragma("unroll") for (int k = 0; k < 2; ++k) \
        acc[ai][bj][m][n] = __builtin_amdgcn_mfma_f32_16x16x32_bf16(Bt[n][k], At[m][k], acc[ai][bj][m][n], 0, 0, 0); __builtin_amdgcn_s_setprio(0); } while (0)
#define PG8_WAIT_V(n) asm volatile("s_waitcnt vmcnt(" #n ")" ::: "memory")
#define PG8_WAIT_L(n) asm volatile("s_waitcnt lgkmcnt(" #n ")" ::: "memory")
#define PG8_BAR __builtin_amdgcn_s_barrier()
#define PG8_SCHED __builtin_amdgcn_sched_barrier(0)
    Unit cur, nxt; int ui = 0;
    if (!S.next(0, cur)) return;
    f32x4 acc[2][2][4][2];
#pragma unroll
    for (int a = 0; a < 2; ++a)
#pragma unroll
        for (int b = 0; b < 2; ++b)
#pragma unroll
            for (int m = 0; m < 4; ++m)
#pragma unroll
                for (int n = 0; n < 2; ++n) acc[a][b][m][n] = (f32x4){0.f, 0.f, 0.f, 0.f};
    bf16x8 At[4][2], B0[2][2], B1[2][2];
    unsigned roC[2][2], roN[2][2];
#pragma unroll
    for (int h = 0; h < 2; ++h)
#pragma unroll
        for (int i = 0; i < 2; ++i) { int R, C; stage_rc(tid * 16 + i * 8192, R, C); roC[h][i] = AO.off(cur, h, R, C, K); }
    const char* cA = (const char*)g.A + AO.base(cur, tstep); const char* cB = (const char*)g.Bt + (size_t)cur.pn * tstep;
    S.a_ready(cur);
    if constexpr (SP2) {
        PG8_STAGE(PG8_SB(0, 0), cB, voffB); PG8_STAGE(PG8_SB(0, 1), cB + hstep, voffB); PG8_STAGE_AC(0, 0, cA); PG8_STAGE_AC(0, 1, cA);
        if (wr == 1) PG8_BAR;
        PG8_WAIT_V(2); PG8_BAR;
        PG8_STAGE(PG8_SB(1, 0), cB + kstep, voffB); PG8_STAGE_AC(1, 0, cA + kstep); PG8_STAGE(PG8_SB(1, 1), cB + hstep + kstep, voffB);
        PG8_WAIT_V(6); PG8_BAR;
    } else {
        PG8_STAGE(PG8_SB(0, 0), cB, voffB); PG8_STAGE_AC(0, 0, cA); PG8_STAGE(PG8_SB(0, 1), cB + hstep, voffB); PG8_STAGE_AC(0, 1, cA);
        if (wr == 1) PG8_BAR;
        PG8_WAIT_V(4); PG8_BAR;
        PG8_STAGE(PG8_SB(1, 0), cB + kstep, voffB); PG8_STAGE_AC(1, 0, cA + kstep); PG8_STAGE(PG8_SB(1, 1), cB + hstep + kstep, voffB);
        PG8_WAIT_V(6); PG8_BAR;
    }
    for (;;) {
        const bool has_next = S.next(ui + 1, nxt);
        const char* nA = has_next ? (const char*)g.A + AO.base(nxt, tstep) : cA; const char* nB = has_next ? (const char*)g.Bt + (size_t)nxt.pn * tstep : cB;
#pragma unroll
        for (int h = 0; h < 2; ++h)
#pragma unroll
            for (int i = 0; i < 2; ++i) { if (AOff::GATHER && has_next) { int R, C; stage_rc(tid * 16 + i * 8192, R, C); roN[h][i] = AO.off(nxt, h, R, C, K); } else roN[h][i] = roC[h][i]; }
        auto kloop = [&](auto gated_tag) { constexpr bool GATED = decltype(gated_tag)::value;
        for (int t = 0; t < nt; t += 2) {
            const bool last = (t == nt - 2);
            const char* a1 = cA + (size_t)(t + 1) * kstep;
            const char* a2 = last ? nA : cA + (size_t)(t + 2) * kstep; const char* b2 = last ? nB : cB + (size_t)(t + 2) * kstep;
            unsigned r2[2][2];
#pragma unroll
            for (int h = 0; h < 2; ++h)
#pragma unroll
                for (int i = 0; i < 2; ++i) r2[h][i] = (AOff::GATHER && last) ? roN[h][i] : roC[h][i];
            const char* a3 = a2 + kstep; const char* b3 = b2 + kstep;
            if (last && has_next) S.a_ready(nxt);
            if constexpr (SP2) {
            PG8_LDB(B0, 0, 0); PG8_LDB(B1, 0, 1); PG8_SCHED; PG8_LDA(At, 0, 0); PG8_STAGE_AC(1, 1, a1);
            PG8_WAIT_V(8); PG8_WAIT_L(0); PG8_BAR; PG8_MMA(0, 0, At, B0); PG8_MMA(0, 1, At, B1); PG8_BAR; PG8_SCHED;
            PG8_LDA(At, 0, 1); PG8_STAGE(PG8_SB(0, 0), b2, voffB); PG8_STAGE(PG8_SB(0, 1), b2 + hstep, voffB); PG8_STAGE_A2(0, 0, a2);
            PG8_WAIT_V(8); PG8_WAIT_L(0); PG8_BAR; PG8_MMA(1, 0, At, B0); PG8_MMA(1, 1, At, B1); PG8_BAR; PG8_SCHED;
            PG8_LDB(B0, 1, 0); PG8_LDB(B1, 1, 1); PG8_SCHED; PG8_LDA(At, 1, 0); PG8_STAGE_A2(0, 1, a2);
            PG8_WAIT_V(8); PG8_WAIT_L(0); PG8_BAR; PG8_MMA(0, 0, At, B0); PG8_MMA(0, 1, At, B1); PG8_BAR; PG8_SCHED;
            PG8_LDA(At, 1, 1); PG8_STAGE(PG8_SB(1, 0), b3, voffB); PG8_STAGE(PG8_SB(1, 1), b3 + hstep, voffB); PG8_STAGE_A2(1, 0, a3);
            PG8_WAIT_V(8); PG8_WAIT_L(0); PG8_BAR; PG8_MMA(1, 0, At, B0); PG8_MMA(1, 1, At, B1); PG8_BAR; PG8_SCHED;
            } else {
            PG8_LDB(B0, 0, 0); PG8_SCHED; PG8_LDA(At, 0, 0); PG8_STAGE_AC(1, 1, a1);
            PG8_WAIT_L(8); PG8_BAR; PG8_WAIT_L(0); PG8_MMA(0, 0, At, B0); PG8_BAR; PG8_SCHED;
            PG8_LDB(B1, 0, 1); PG8_STAGE(PG8_SB(0, 0), b2, voffB);
            PG8_BAR; PG8_WAIT_L(0); PG8_MMA(0, 1, At, B1); PG8_BAR;
            PG8_LDA(At, 0, 1); PG8_STAGE_A2(0, 0, a2);
            PG8_BAR; PG8_WAIT_L(0); PG8_MMA(1, 0, At, B0); PG8_BAR; PG8_SCHED;
            PG8_STAGE(PG8_SB(0, 1), b2 + hstep, voffB);
            PG8_WAIT_V(6); PG8_BAR; PG8_MMA(1, 1, At, B1); PG8_BAR;
            PG8_LDB(B0, 1, 0); PG8_SCHED; PG8_LDA(At, 1, 0); PG8_STAGE_A2(0, 1, a2);
            PG8_WAIT_L(8); PG8_BAR; PG8_WAIT_L(0); PG8_MMA(0, 0, At, B0); PG8_BAR; PG8_SCHED;
            PG8_LDB(B1, 1, 1); PG8_STAGE(PG8_SB(1, 0), b3, voffB);
            PG8_BAR; PG8_WAIT_L(0); PG8_MMA(0, 1, At, B1); PG8_BAR;
            PG8_LDA(At, 1, 1); PG8_STAGE_A2(1, 0, a3);
            PG8_BAR; PG8_WAIT_L(0); PG8_MMA(1, 0, At, B0); PG8_BAR; PG8_SCHED;
            PG8_STAGE(PG8_SB(1, 1), b3 + hstep, voffB);
            PG8_WAIT_V(6); PG8_BAR; PG8_MMA(1, 1, At, B1); PG8_BAR;
            }
        }
        };
        if constexpr (Sched::HAS_SPLIT) { if (cur.ab == 15) kloop(std::false_type{}); else kloop(std::true_type{}); } else kloop(std::false_type{});
        if constexpr (ALIGN_EPI) { if (wr == 0) PG8_BAR; }
        if constexpr (!Epi::AFTER_DRAIN) { E(acc, cur, wr, wc, fr, fq); S.done(cur); }
        if (!has_next) break;
#pragma unroll
        for (int a = 0; a < 2; ++a)
#pragma unroll
            for (int b = 0; b < 2; ++b)
#pragma unroll
                for (int m = 0; m < 4; ++m)
#pragma unroll
                    for (int n = 0; n < 2; ++n) acc[a][b][m][n] = (f32x4){0.f, 0.f, 0.f, 0.f};
        cur = nxt; cA = nA; cB = nB; ++ui;
#pragma unroll
        for (int h = 0; h < 2; ++h)
#pragma unroll
            for (int i = 0; i < 2; ++i) roC[h][i] = roN[h][i];
        if constexpr (ALIGN_EPI) { if (wr == 1) PG8_BAR; }
    }
    PG8_WAIT_V(0);
    if constexpr (!ALIGN_EPI) { if (wr == 0) PG8_BAR; }
    PG8_BAR;
    if constexpr (Epi::AFTER_DRAIN) { E.fused(acc, cur, wr, wc, fr, fq, lds, wid, lane); S.done(cur); }
#undef PG8_SA
#undef PG8_STAGE_AC
#undef PG8_STAGE_A2
#undef PG8_SB
#undef PG8_STAGE
#undef PG8_LDA
#undef PG8_LDB
#undef PG8_MMA
#undef PG8_WAIT_V
#undef PG8_WAIT_L
#undef PG8_BAR
#undef PG8_SCHED
}
}

__device__ __forceinline__ void mini_barrier(unsigned* ctr, unsigned n) {
    asm volatile("s_waitcnt vmcnt(0)" ::: "memory");
    __syncthreads();
    if (threadIdx.x == 0) {
        __builtin_amdgcn_fence(__ATOMIC_RELEASE, "agent");
        asm volatile("s_waitcnt vmcnt(0)" ::: "memory");
        (void)xb_add(ctr, 1u);
        unsigned sp = 0u; while (xb_ld(ctr) < n) { __builtin_amdgcn_s_sleep(1); if (++sp > XB_SPIN_CAP) break; }
        __builtin_amdgcn_fence(__ATOMIC_ACQUIRE, "agent");
        asm volatile("s_waitcnt vmcnt(0)" ::: "memory");
    }
    __syncthreads();
}
constexpr int CW_MINI = 16384;
__device__ __forceinline__ void ph_setup(const Prm& p, LAS float* lds) {
    float* modv = (float*)(p.ws + WS_MODV);
    float* rope = (float*)(p.ws + WS_ROPE);
    const int tid = otid();
    LAS float* sc = lds;
    LAS float* red = lds + 5 * 1024;
    for (int i = tid; i < 5 * 1024; i += NTHREADS) { const int r = i >> 10, k = i & 1023; const float v = r < 4 ? p.c[r * 1024 + k] : p.c_ctx[k]; sc[i] = siluf_(v); }
    __syncthreads();
    const int nitems = DEPTH * 6144 / 128;
    for (int it = obid(); it < nitems; it += gridDim.x) {
        const int l = it / 48, n0 = (it % 48) * 128;
        const int kp = tid >> 5, q = tid & 31;
        const float* w = p.mod_w + ((size_t)l * 1024 + kp * 64) * 6144 + n0 + 4 * q;
        f32x4 a[5];
#pragma unroll
        for (int r = 0; r < 5; ++r) a[r] = (f32x4){0.f, 0.f, 0.f, 0.f};
#pragma unroll 1
        for (int k0 = 0; k0 < 64; k0 += 8) { f32x4 wv[8];
#pragma unroll
            for (int k = 0; k < 8; ++k) wv[k] = __builtin_nontemporal_load((const f32x4*)(w + (size_t)(k0 + k) * 6144));
#pragma unroll
            for (int k = 0; k < 8; ++k) { const int kk = kp * 64 + k0 + k;
#pragma unroll
                for (int r = 0; r < 5; ++r) a[r] += wv[k] * sc[r * 1024 + kk]; } }
#pragma unroll
        for (int r = 0; r < 5; ++r) *(LAS f32x4*)(red + ((kp * 5 + r) * 128 + 4 * q)) = a[r];
        __syncthreads();
        for (int i = tid; i < 5 * 128; i += NTHREADS) { const int r = i >> 7, n = i & 127; float s = p.mod_b[l * 6144 + n0 + n];
#pragma unroll
            for (int q2 = 0; q2 < 16; ++q2) s += red[(q2 * 5 + r) * 128 + n];
            modv[((size_t)l * 5 + r) * 6144 + n0 + n] = s; }
        __syncthreads();
    }
    if (obid() == gridDim.x - 1) {
        for (int i = tid; i < 64 * 16; i += NTHREADS) { const int pos = i >> 4, f = i & 15; const float inv = exp2f(-(float)f * (13.287712379549449f / 16.f)); const float ang = (float)pos * inv;
            rope[i * 2] = __cosf(ang); rope[i * 2 + 1] = __sinf(ang); }
    }
}

#define CJ(jj) (8 * lane + 512 * ((jj) >> 1) + 4 * ((jj) & 1))
__device__ __forceinline__ void acc_bf16x8(f32x4& lo, f32x4& hi, const u32x4 w, float f) {
    lo.x += f * __uint_as_float(w.x << 16); lo.y += f * __uint_as_float(w.x & 0xffff0000u); lo.z += f * __uint_as_float(w.y << 16); lo.w += f * __uint_as_float(w.y & 0xffff0000u);
    hi.x += f * __uint_as_float(w.z << 16); hi.y += f * __uint_as_float(w.z & 0xffff0000u); hi.z += f * __uint_as_float(w.w << 16); hi.w += f * __uint_as_float(w.w & 0xffff0000u);
}
__device__ __forceinline__ u32x4 pack_bf16x8(const f32x4 lo, const f32x4 hi) { u32x4 o; o.x = pk2(lo.x, lo.y); o.y = pk2(lo.z, lo.w); o.z = pk2(hi.x, hi.y); o.w = pk2(hi.z, hi.w); return o; }
__device__ __forceinline__ void load_xrow(const bf16* xrow, int lane, f32x4 (&v)[4]) {
#pragma unroll
    for (int j2 = 0; j2 < 2; ++j2) { const u32x4 w = __builtin_nontemporal_load((const u32x4*)(xrow + 8 * lane + 512 * j2)); v[2 * j2] = (f32x4){0.f, 0.f, 0.f, 0.f}; v[2 * j2 + 1] = (f32x4){0.f, 0.f, 0.f, 0.f}; acc_bf16x8(v[2 * j2], v[2 * j2 + 1], w, 1.f); }
}
__device__ __forceinline__ void store_xrow(bf16* xrow, int lane, const f32x4 (&v)[4]) {
#pragma unroll
    for (int j2 = 0; j2 < 2; ++j2) *(u32x4*)(xrow + 8 * lane + 512 * j2) = pack_bf16x8(v[2 * j2], v[2 * j2 + 1]);
}
struct Sel4 { const bf16* y[4]; float f[4]; unsigned long long rest; };
__device__ __forceinline__ Sel4 moe_sel4(const bf16* YE, int sl, int lane) {
    Sel4 q; unsigned long long m = __ballot(sl >= 0); int e0 = 0, s0 = 0;
#pragma unroll
    for (int k = 0; k < 4; ++k) { const bool has = m != 0; const int e = has ? __builtin_ctzll(m) : e0; if (has) m &= m - 1; const int s = __builtin_amdgcn_readlane(sl, e);
        if (k == 0) { e0 = e; s0 = has ? s : 0; }
        q.y[k] = YE + ((size_t)(has ? e : e0) * XR + (has ? s : s0)) * D + 8 * lane; q.f[k] = has ? 1.f : 0.f; }
    q.rest = m; return q;
}
__device__ __forceinline__ void moe_load4(const Sel4& q, u32x4 (&w)[4][2]) {
#pragma unroll
    for (int k = 0; k < 4; ++k)
#pragma unroll
        for (int j = 0; j < 2; ++j) w[k][j] = __builtin_nontemporal_load((const u32x4*)(q.y[k] + 512 * j));
}
__device__ __forceinline__ void moe_acc4(const Sel4& q, const u32x4 (&w)[4][2], f32x4 (&a)[4]) {
#pragma unroll
    for (int jj = 0; jj < 4; ++jj) a[jj] = (f32x4){0.f, 0.f, 0.f, 0.f};
#pragma unroll
    for (int k = 0; k < 4; ++k)
#pragma unroll
        for (int j = 0; j < 2; ++j) acc_bf16x8(a[2 * j], a[2 * j + 1], w[k][j], q.f[k]);
}
__device__ __forceinline__ void moe_gather_rest(const bf16* YE, int sl, unsigned long long m, int lane, f32x4 (&a)[4]) {
    while (m) { const int e = __builtin_ctzll(m); m &= m - 1; const int s = __builtin_amdgcn_readlane(sl, e); const bf16* y = YE + ((size_t)e * XR + s) * D + 8 * lane;
#pragma unroll
        for (int j = 0; j < 2; ++j) { const u32x4 w = *(const u32x4*)(y + 512 * j); acc_bf16x8(a[2 * j], a[2 * j + 1], w, 1.f); } }
}
struct N1Pre { u32x4 x[2][4]; int sl0, sl1; };
__device__ __forceinline__ void norm1_issue(const Prm& p, int l, int r, int lane, bool comb_ctx, N1Pre& q) {
    const bf16* X = (const bf16*)(p.ws + WS_X); const int* tokslot = (const int*)(p.ws + WS_TOKSLOT); const bool isc = r >= ML;
    q.sl0 = -1; q.sl1 = -1;
    if (l == 0) { const float* src = isc ? p.ctx + (size_t)(r - ML) * D : p.x + (size_t)r * D;
#pragma unroll
        for (int u = 0; u < 2; ++u)
#pragma unroll
            for (int j = 0; j < 4; ++j) q.x[u][j] = __builtin_nontemporal_load((const u32x4*)(src + (size_t)u * D + CJ(j)));
    } else { const bool comb = !isc || comb_ctx;
        if (comb && lane < NE) { q.sl0 = tokslot[(size_t)r * NE + lane]; q.sl1 = tokslot[(size_t)(r + 1) * NE + lane]; }
#pragma unroll
        for (int u = 0; u < 2; ++u) {
#pragma unroll
            for (int j2 = 0; j2 < 2; ++j2) q.x[u][j2] = __builtin_nontemporal_load((const u32x4*)(X + (size_t)(r + u) * D + 8 * lane + 512 * j2));
            q.x[u][2] = q.x[u][0]; q.x[u][3] = q.x[u][1]; } }
}
__device__ __forceinline__ void norm1_pair(const Prm& p, int l, int r, int lane, bool comb_ctx, bool wb, const N1Pre& q) {
    const float* modv = (const float*)(p.ws + WS_MODV) + (size_t)l * 5 * 6144;
    const float* modp = (const float*)(p.ws + WS_MODV) + (size_t)(l > 0 ? l - 1 : 0) * 5 * 6144;
    bf16* X = (bf16*)(p.ws + WS_X); bf16* H = (bf16*)(p.ws + WS_H); const bf16* YE = (const bf16*)(p.ws + WS_YE);
    const bool isc = r >= ML; const int mr = isc ? 4 : (r >> 12);
    f32x4 v[2][4];
    if (l == 0) {
#pragma unroll
        for (int u = 0; u < 2; ++u)
#pragma unroll
            for (int j = 0; j < 4; ++j) v[u][j] = (f32x4){__uint_as_float(q.x[u][j].x), __uint_as_float(q.x[u][j].y), __uint_as_float(q.x[u][j].z), __uint_as_float(q.x[u][j].w)};
    } else {
        const bool comb = !isc || comb_ctx;
        const int sl0 = q.sl0, sl1 = q.sl1;
#pragma unroll
        for (int u = 0; u < 2; ++u)
#pragma unroll
            for (int j2 = 0; j2 < 2; ++j2) { v[u][2 * j2] = (f32x4){0.f, 0.f, 0.f, 0.f}; v[u][2 * j2 + 1] = (f32x4){0.f, 0.f, 0.f, 0.f}; acc_bf16x8(v[u][2 * j2], v[u][2 * j2 + 1], q.x[u][j2], 1.f); }
        if (comb) { const Sel4 q0 = moe_sel4(YE, sl0, lane), q1 = moe_sel4(YE, sl1, lane); u32x4 w0[4][2], w1[4][2]; moe_load4(q0, w0); moe_load4(q1, w1);
            f32x4 a0[4], a1[4]; moe_acc4(q0, w0, a0); moe_acc4(q1, w1, a1);
            if (q0.rest) moe_gather_rest(YE, sl0, q0.rest, lane, a0); if (q1.rest) moe_gather_rest(YE, sl1, q1.rest, lane, a1);
#pragma unroll
            for (int j = 0; j < 4; ++j) { const f32x4 g2 = *(const f32x4*)(modp + (size_t)mr * 6144 + 5 * 1024 + CJ(j)); v[0][j] += g2 * a0[j]; v[1][j] += g2 * a1[j]; }
            if (wb) { store_xrow(X + (size_t)r * D, lane, v[0]); store_xrow(X + (size_t)(r + 1) * D, lane, v[1]); } }
    }
#pragma unroll
    for (int u = 0; u < 2; ++u) { float s = 0.f;
#pragma unroll
        for (int j = 0; j < 4; ++j) s += v[u][j].x * v[u][j].x + v[u][j].y * v[u][j].y + v[u][j].z * v[u][j].z + v[u][j].w * v[u][j].w;
        const float rstd = rsqrtf(wave_sum(s) * (1.f / D) + EPS);
        f32x4 hh[4];
#pragma unroll
        for (int j = 0; j < 4; ++j) { const int c = CJ(j);
            const f32x4 g = *(const f32x4*)(p.norm1_g + l * D + c), sh = *(const f32x4*)(modv + (size_t)mr * 6144 + c), scl = *(const f32x4*)(modv + (size_t)mr * 6144 + 1024 + c);
            hh[j] = (v[u][j] * rstd * g) * (scl + 1.f) + sh; }
#pragma unroll
        for (int j2 = 0; j2 < 2; ++j2) *(u32x4*)(H + (size_t)(r + u) * D + 8 * lane + 512 * j2) = pack_bf16x8(hh[2 * j2], hh[2 * j2 + 1]); }
}
__device__ __forceinline__ void ph_norm1(const Prm& p, int l, bool wb = true) {
    const int lane = otid() & 63, ngw = gridDim.x * 8, gw = ngw - 1 - (obid() * 8 + (otid() >> 6));
    const int nrows = (l <= 2) ? MT : ML;
    const bool comb_ctx = (l >= 1 && l <= 2);
    N1Pre nx; if (gw * 2 < nrows) norm1_issue(p, l, gw * 2, lane, comb_ctx, nx);
    for (int r = gw * 2; r < nrows; r += ngw * 2) { const N1Pre cur = nx; if (r + ngw * 2 < nrows) norm1_issue(p, l, r + ngw * 2, lane, comb_ctx, nx); norm1_pair(p, l, r, lane, comb_ctx, wb, cur); }
}
__device__ __forceinline__ void ph_final(const Prm& p) {
    const int lane = otid() & 63, gw = obid() * 8 + (otid() >> 6), ngw = gridDim.x * 8;
    const float* modp = (const float*)(p.ws + WS_MODV) + (size_t)3 * 5 * 6144;
    const bf16* X = (const bf16*)(p.ws + WS_X); const int* tokslot = (const int*)(p.ws + WS_TOKSLOT); const bf16* YE = (const bf16*)(p.ws + WS_YE);
    int nsl0 = -1, nsl1 = -1; u32x4 nxw[2][2];
#define FINAL_ISSUE(rr_) do { if (lane < NE) { nsl0 = tokslot[(size_t)(rr_) * NE + lane]; nsl1 = tokslot[(size_t)((rr_) + 1) * NE + lane]; } \
        _Pragma("unroll") for (int u = 0; u < 2; ++u) _Pragma("unroll") for (int j2 = 0; j2 < 2; ++j2) nxw[u][j2] = __builtin_nontemporal_load((const u32x4*)(X + (size_t)((rr_) + u) * D + 8 * lane + 512 * j2)); } while (0)
    if (gw * 2 < ML) FINAL_ISSUE(gw * 2);
    for (int r = gw * 2; r < ML; r += ngw * 2) {
        const int mr = r >> 12; f32x4 v[2][4];
        const int sl0 = nsl0, sl1 = nsl1;
#pragma unroll
        for (int u = 0; u < 2; ++u)
#pragma unroll
            for (int j2 = 0; j2 < 2; ++j2) { v[u][2 * j2] = (f32x4){0.f, 0.f, 0.f, 0.f}; v[u][2 * j2 + 1] = (f32x4){0.f, 0.f, 0.f, 0.f}; acc_bf16x8(v[u][2 * j2], v[u][2 * j2 + 1], nxw[u][j2], 1.f); }
        if (r + ngw * 2 < ML) FINAL_ISSUE(r + ngw * 2);
        const Sel4 q0 = moe_sel4(YE, sl0, lane), q1 = moe_sel4(YE, sl1, lane); u32x4 w0[4][2], w1[4][2]; moe_load4(q0, w0); moe_load4(q1, w1);
        f32x4 a0[4], a1[4]; moe_acc4(q0, w0, a0); moe_acc4(q1, w1, a1);
        if (q0.rest) moe_gather_rest(YE, sl0, q0.rest, lane, a0); if (q1.rest) moe_gather_rest(YE, sl1, q1.rest, lane, a1);
#pragma unroll
        for (int j = 0; j < 4; ++j) { const f32x4 g2 = *(const f32x4*)(modp + (size_t)mr * 6144 + 5 * 1024 + CJ(j));
            *(f32x4*)(p.out + (size_t)r * D + CJ(j)) = v[0][j] + g2 * a0[j]; *(f32x4*)(p.out + (size_t)(r + 1) * D + CJ(j)) = v[1][j] + g2 * a1[j]; }
    }
}

__device__ __forceinline__ unsigned cvtpk_(float lo, float hi) { unsigned r; asm volatile("v_cvt_pk_bf16_f32 %0, %1, %2" : "=v"(r) : "v"(lo), "v"(hi)); return r; }
__device__ __forceinline__ void cvt_item(const float* W, int N, bf16* WT, int gu, LAS unsigned char* img, int item, int tid) {
    const int nblk = N / 512, kb = item / nblk, nb = item % nblk, k0 = 64 * kb, n0 = 512 * nb;
    const int lane = tid & 63, w = tid >> 6;
    const float* src = W + (size_t)(k0 + 8 * w) * N + n0 + 4 * lane;
    f32x4 a[4][2], b[4][2];
#pragma unroll
    for (int j = 0; j < 4; ++j)
#pragma unroll
        for (int hh = 0; hh < 2; ++hh) { a[j][hh] = __builtin_nontemporal_load((const f32x4*)(src + (size_t)(2 * j) * N + 256 * hh)); b[j][hh] = __builtin_nontemporal_load((const f32x4*)(src + (size_t)(2 * j + 1) * N + 256 * hh)); }
    __syncthreads();
    const int sw = (lane >> 1) & 7;
#pragma unroll
    for (int hh = 0; hh < 2; ++hh)
#pragma unroll
        for (int j = 0; j < 4; ++j) { const int wofs = ((w ^ sw) * 4 + j) * 4;
            LAS unsigned char* rowp = img + (size_t)(4 * lane + 256 * hh) * 144 + wofs;
            *(LAS unsigned*)(rowp) = cvtpk_(a[j][hh].x, b[j][hh].x); *(LAS unsigned*)(rowp + 144) = cvtpk_(a[j][hh].y, b[j][hh].y);
            *(LAS unsigned*)(rowp + 288) = cvtpk_(a[j][hh].z, b[j][hh].z); *(LAS unsigned*)(rowp + 432) = cvtpk_(a[j][hh].w, b[j][hh].w); }
    __syncthreads();
    const int jq = tid & 7, nr = tid >> 3;
#pragma unroll
    for (int i = 0; i < 8; ++i) { const int n = nr + 64 * i; const u32x4 v = *(const LAS u32x4*)(img + n * 144 + ((jq ^ ((n >> 3) & 7)) * 16));
        const int ncol = n0 + n; int drow;
        if (gu < 0) drow = ncol; else if (gu < 2) drow = (ncol >> 7) * 256 + (ncol & 127) + gu * 128;
        else { const int ch = (ncol - 1024) & 1023; drow = ncol < 1024 ? ncol : 1024 + (ch >> 7) * 256 + (ncol >= 2048 ? 128 : 0) + (ch & 127); }
        *(u32x4*)(WT + (size_t)drow * 1024 + k0 + 8 * jq) = v; }
}
__device__ __forceinline__ void ph_convert(const Prm& p, int l, LAS unsigned char* lds) {
    const int tid = otid();
    const bool even = (l & 1) == 0; const int Nin = even ? 4096 : 3072;
    const float* Win = even ? p.even_w_in + (size_t)(l / 2) * D * 4096 : p.conv_w_in + (size_t)(l / 2) * D * 3072;
    const float* Wout = even ? p.even_w_out + (size_t)(l / 2) * D * D : p.conv_w_out + (size_t)(l / 2) * D * D;
    const int I_IN = 16 * (Nin / 512), I_OUT = 32, I_E = 32;
    const int total = I_IN + I_OUT + NE * 3 * I_E;
    for (int it = obid(); it < total; it += gridDim.x) {
        int r = it;
        if (r < I_IN) { cvt_item(Win, Nin, (bf16*)(p.ws + WS_WIN), even ? -1 : 2, lds, r, tid); continue; } r -= I_IN;
        if (r < I_OUT) { cvt_item(Wout, D, (bf16*)(p.ws + WS_WOUT), -1, lds, r, tid); continue; } r -= I_OUT;
        const int e = r / (3 * I_E), w = (r / I_E) % 3, item = r % I_E;
        if (w < 2) cvt_item((w == 0 ? p.w_gate : p.w_up) + ((size_t)l * NE + e) * D * FF, FF, (bf16*)(p.ws + WS_WUP) + (size_t)e * 2048 * D, w, lds, item, tid);
        else cvt_item(p.w_down + ((size_t)l * NE + e) * FF * D, D, (bf16*)(p.ws + WS_WDN) + (size_t)e * D * FF, -1, lds, item, tid);
    }
    __syncthreads();
}

template <int MODE> __device__ __forceinline__ void ph_probe_read(const Prm& p, int l) {
    const f32x4* s0 = (const f32x4*)(p.w_gate + (size_t)l * NE * D * FF);
    const f32x4* s1 = (const f32x4*)(p.w_up + (size_t)l * NE * D * FF); const f32x4* s2 = (const f32x4*)(p.w_down + (size_t)l * NE * D * FF);
    const size_t n4 = (size_t)NE * D * FF / 4; f32x4 acc = (f32x4){0.f, 0.f, 0.f, 0.f};
    if (MODE == 0 || MODE == 1) {
        const size_t st = (size_t)gridDim.x * NTHREADS;
        for (size_t i = (size_t)obid() * NTHREADS + otid(); i < n4; i += st * 4) {
#pragma unroll
            for (int t = 0; t < 3; ++t) { const f32x4* s = t == 0 ? s0 : (t == 1 ? s1 : s2);
#pragma unroll
                for (int k = 0; k < 4; ++k) { const size_t j = i + k * st; if (j < n4) acc += (MODE == 1) ? __builtin_nontemporal_load(s + j) : s[j]; } } }
    } else {
        constexpr int NL = MODE == 2 ? 16 : 32; const int lane = otid() & 63; const size_t gw = (size_t)obid() * 8 + (otid() >> 6), ngw = (size_t)gridDim.x * 8;
        const size_t nch = 3 * n4 / (64 * NL);
        for (size_t c = gw; c < nch; c += ngw) { const size_t base = c * 64 * NL; const f32x4* s = base < n4 ? s0 + base : (base < 2 * n4 ? s1 + (base - n4) : s2 + (base - 2 * n4));
            f32x4 v[NL];
#pragma unroll
            for (int k = 0; k < NL; ++k) v[k] = __builtin_nontemporal_load(s + k * 64 + lane);
#pragma unroll
            for (int k = 0; k < NL; ++k) acc += v[k]; }
    }
    if (acc.x + acc.y + acc.z + acc.w == 1.2345e33f) ((float*)(p.ws + WS_OF))[otid()] = acc.x;
}
template <int MODE> __device__ __forceinline__ void ph_probe_cvt(const Prm& p, int l) {
    const int lane = otid() & 63, gw = obid() * 8 + (otid() >> 6), ngw = gridDim.x * 8; f32x4 acc = (f32x4){0.f, 0.f, 0.f, 0.f};
    for (int it = gw; it < NE * 3 * 256; it += ngw) { const int e = it / 768, w = (it / 256) % 3, item = it % 256, kb = item / 16, nb = item % 16;
        if (MODE == 4) { const float* W = (w == 0 ? p.w_gate : (w == 1 ? p.w_up : p.w_down)) + ((size_t)l * NE + e) * D * FF; const float* src = W + (size_t)(64 * kb + 2 * (lane >> 4)) * 1024 + 64 * nb + 4 * (lane & 15);
#pragma unroll
            for (int j = 0; j < 8; ++j) { acc += __builtin_nontemporal_load((const f32x4*)(src + (size_t)(8 * j) * 1024)); acc += __builtin_nontemporal_load((const f32x4*)(src + (size_t)(8 * j + 1) * 1024)); } }
        else { bf16* WT = (bf16*)(p.ws + WS_OF) + (size_t)((e * 3 + w) % 16) * 1024 * 1024; const u32x4 v = {(unsigned)it, 1u, 2u, 3u};
#pragma unroll
            for (int i = 0; i < 8; ++i) { const int n = (lane >> 3) + 8 * i; *(u32x4*)(WT + (size_t)(64 * nb + n) * 1024 + 64 * kb + 8 * (lane & 7)) = v; } } }
    if (acc.x + acc.y + acc.z + acc.w == 1.2345e33f) ((float*)(p.ws + WS_OF))[otid()] = acc.x;
}
__device__ __forceinline__ void ph_gemm_in(const Prm& p, int l, LAS unsigned char* ldsb) {
    const bool even = (l & 1) == 0; const int N = even ? 4096 : 3072; const int M = (l <= 2) ? MT : ML;
    pg8::Gemm g{(const bf16*)(p.ws + WS_H), (const bf16*)(p.ws + WS_WIN), M, N, D};
    if (even) { pg8::StaticOrderT<4> S; S.init(M, N, (int)gridDim.x, obid(), ML); pg8::EpiBf16 E{(bf16*)(p.ws + WS_PROJ), N}; pg8::gemm_phase<pg8::EpiBf16, pg8::StaticOrderT<4>, true, true>(ldsb, g, S, E); }
    else { pg8::StaticOrderT<2> S; S.init(M, N, (int)gridDim.x, obid(), ML); pg8::EpiConvIn E{(bf16*)(p.ws + WS_PROJ)}; pg8::gemm_phase<pg8::EpiConvIn, pg8::StaticOrderT<2>, true, true>(ldsb, g, S, E); }
}
__device__ __forceinline__ void ph_gemm_out(const Prm& p, int l, LAS unsigned char* ldsb) {
    const int M = ML;
    pg8::Gemm g{(const bf16*)(p.ws + WS_MIX), (const bf16*)(p.ws + WS_WOUT), M, D, D}; pg8::StaticOrder S; S.init(M, D, (int)gridDim.x, obid());
    pg8::EpiGY E{(bf16*)(p.ws + WS_H), (const float*)(p.ws + WS_MODV) + (size_t)l * 5 * 6144 + 2 * 1024, ML};
    pg8::gemm_phase<pg8::EpiGY, pg8::StaticOrder, true, true>(ldsb, g, S, E);
}
__device__ __forceinline__ void ph_expert_up(const Prm& p, int l, LAS unsigned char* ldsb) {
    pg8::Gemm g{(const bf16*)(p.ws + WS_H2), (const bf16*)(p.ws + WS_WUP), NE * XR, NE * 2048, D};
    pg8::GroupOrderT<8, 0> S; S.init((l < 2) ? 9 : 8, NE, (int)gridDim.x, vcu_id());
    pg8::EpiSwiglu E{(bf16*)(p.ws + WS_ACT), 8};
    pg8::GatherA AO{(const int*)(p.ws + WS_SEL), XR, 9, (l < 2) ? 2176 : 2048};
    pg8::gemm_phase<pg8::EpiSwiglu, pg8::GroupOrderT<8, 0>, true, true, pg8::GatherA>(ldsb, g, S, E, AO);
}
__device__ __forceinline__ void ph_expert_down(const Prm& p, int l, LAS unsigned char* ldsb) {
    pg8::Gemm g{(const bf16*)(p.ws + WS_ACT), (const bf16*)(p.ws + WS_WDN), NE * XR, NE * 1024, FF};
    pg8::GroupOrderT<4, 1> S; S.init((l < 2) ? 9 : 8, NE, (int)gridDim.x, vcu_id());
    pg8::EpiDown E{(bf16*)(p.ws + WS_YE), (const float*)(p.ws + WS_GATE), 4};
    pg8::gemm_phase<pg8::EpiDown, pg8::GroupOrderT<4, 1>, true, true>(ldsb, g, S, E);
}

__device__ __forceinline__ void ph_qkprep(const Prm& p, int l) {
    const int e = l / 2; bf16* PROJ = (bf16*)(p.ws + WS_PROJ); const float* rope = (const float*)(p.ws + WS_ROPE);
    const int NQK0 = gridDim.x == 256 ? 64 : 0;
    if (obid() < NQK0) return;
    const int j = otid() & 7, ngrp = ((int)gridDim.x - NQK0) * (NTHREADS / 8);
    const float* kg = p.kn_g + e * 64;
    const f32x4 g0 = *(const f32x4*)(kg + 8 * j), g1 = *(const f32x4*)(kg + 8 * j + 4);
    const float gg[8] = {g0.x, g0.y, g0.z, g0.w, g1.x, g1.y, g1.z, g1.w};
    const int total = MT * 8;
    for (int g0 = ((obid() - NQK0) * NTHREADS + otid()) >> 3; g0 < total; g0 += 4 * ngrp) {
        u32x4 w4[4]; f32x4 cr[4][4];
#pragma unroll
        for (int k = 0; k < 4; ++k) { const int g = g0 + k * ngrp; if (g < total) { const int r = g >> 3, hm = g & 7;
            w4[k] = *(const u32x4*)(PROJ + (size_t)r * 4096 + 2560 + 512 + hm * 64 + 8 * j);
            if (r < ML) { const int t = r & 4095, pos = (j & 4) ? (t & 63) : (t >> 6); const float* rp = rope + (pos * 16 + 8 * (j & 1)) * 2;
                cr[k][0] = *(const f32x4*)rp; cr[k][1] = *(const f32x4*)(rp + 4); cr[k][2] = *(const f32x4*)(rp + 8); cr[k][3] = *(const f32x4*)(rp + 12); } } }
#pragma unroll
        for (int k = 0; k < 4; ++k) { const int g = g0 + k * ngrp; if (g < total) { const int r = g >> 3, hm = g & 7;
            bf16* ptr = PROJ + (size_t)r * 4096 + 2560 + 512 + hm * 64 + 8 * j;
            const unsigned ww[4] = {w4[k].x, w4[k].y, w4[k].z, w4[k].w};
            float v[8];
#pragma unroll
            for (int m = 0; m < 4; ++m) { v[2 * m] = __uint_as_float(ww[m] << 16); v[2 * m + 1] = __uint_as_float(ww[m] & 0xffff0000u); }
            float s = 0.f;
#pragma unroll
            for (int m = 0; m < 8; ++m) s += v[m] * v[m];
            s += __shfl_xor(s, 1); s += __shfl_xor(s, 2); s += __shfl_xor(s, 4);
            const float rstd = rsqrtf(s * (1.f / 64.f) + EPS);
#pragma unroll
            for (int m = 0; m < 8; ++m) v[m] *= rstd * gg[m];
            if (r < ML) {
                const float cs[16] = {cr[k][0].x, cr[k][0].y, cr[k][0].z, cr[k][0].w, cr[k][1].x, cr[k][1].y, cr[k][1].z, cr[k][1].w, cr[k][2].x, cr[k][2].y, cr[k][2].z, cr[k][2].w, cr[k][3].x, cr[k][3].y, cr[k][3].z, cr[k][3].w};
                const float sg = (j & 2) ? 1.f : -1.f;
#pragma unroll
                for (int m = 0; m < 8; ++m) { const float pv = __shfl_xor(v[m], 2); v[m] = v[m] * cs[2 * m] + sg * pv * cs[2 * m + 1]; } }
            *(u32x4*)ptr = (u32x4){cvtpk_(v[0], v[1]), cvtpk_(v[2], v[3]), cvtpk_(v[4], v[5]), cvtpk_(v[6], v[7])}; } }
    }
}

__device__ __forceinline__ void ph_hgrn_naive(const Prm& p, int l, LAS float* lds) {
    const int ev = l / 2; const bf16* PROJ = (const bf16*)(p.ws + WS_PROJ); float* OF = (float*)(p.ws + WS_OF);
    const int tid = otid(), el = tid >> 4, dg = tid & 15;
    LAS float* sq = lds;
    LAS float* sk = lds + 64 * 128;
    LAS float* sf = lds + 2 * 64 * 128;
    LAS float* sv = lds + 3 * 64 * 128;
    for (int it = obid(); it < 128; it += gridDim.x) {
        const int b = it >> 5, h = (it >> 3) & 3, dir = (it >> 2) & 1, eq = it & 3;
        float S[8];
#pragma unroll
        for (int j = 0; j < 8; ++j) S[j] = 0.f;
        for (int c0 = 0; c0 < (TC + T) / 64; ++c0) {
            const bool isc = c0 < 4; const int step0 = isc ? c0 * 64 : (c0 - 4) * 64; const int len = isc ? TC : T; const int rbase = isc ? ML + b * TC : b * T;
            __syncthreads();
            for (int i = tid; i < 64 * 128; i += NTHREADS) { const int s = i >> 7, d = i & 127; const int tt = dir ? (len - 1 - (step0 + s)) : (step0 + s);
                const bf16* row = PROJ + (size_t)(rbase + tt) * 4096; const int col = h * 128 + d;
                float lb = 0.f;
                if (ev == 1) { const float l0 = p.hgrn_lb[(0 * 2 + dir) * 512 + col], l1 = p.hgrn_lb[(1 * 2 + dir) * 512 + col]; lb = 1.f / (1.f + __expf(l0 - l1)); }
                const float z = bf2f(row[512 + dir * 512 + col]); const float sg = sigmoidf_(z);
                const float f = lb + (1.f - lb) * sg;
                sq[i] = bf2f(row[col]); sf[i] = f; sk[i] = 1.f - f; }
            for (int i = tid; i < 64 * 32; i += NTHREADS) { const int s = i >> 5, e2 = i & 31; const int tt = dir ? (len - 1 - (step0 + s)) : (step0 + s);
                sv[i] = bf2f(PROJ[(size_t)(rbase + tt) * 4096 + 1536 + h * 128 + eq * 32 + e2]); }
            __syncthreads();
#pragma unroll 1
            for (int s = 0; s < 64; ++s) {
                const f32x4 q0 = *(const LAS f32x4*)(sq + s * 128 + dg * 8), q1 = *(const LAS f32x4*)(sq + s * 128 + dg * 8 + 4);
                const f32x4 k0 = *(const LAS f32x4*)(sk + s * 128 + dg * 8), k1 = *(const LAS f32x4*)(sk + s * 128 + dg * 8 + 4);
                const f32x4 f0 = *(const LAS f32x4*)(sf + s * 128 + dg * 8), f1 = *(const LAS f32x4*)(sf + s * 128 + dg * 8 + 4);
                const float v = sv[s * 32 + el];
                S[0] = f0.x * S[0] + k0.x * v; S[1] = f0.y * S[1] + k0.y * v; S[2] = f0.z * S[2] + k0.z * v; S[3] = f0.w * S[3] + k0.w * v;
                S[4] = f1.x * S[4] + k1.x * v; S[5] = f1.y * S[5] + k1.y * v; S[6] = f1.z * S[6] + k1.z * v; S[7] = f1.w * S[7] + k1.w * v;
                float o = q0.x * S[0] + q0.y * S[1] + q0.z * S[2] + q0.w * S[3] + q1.x * S[4] + q1.y * S[5] + q1.z * S[6] + q1.w * S[7];
                o += __shfl_xor(o, 1); o += __shfl_xor(o, 2); o += __shfl_xor(o, 4); o += __shfl_xor(o, 8);
                if (dg == 0) { const int tt = dir ? (len - 1 - (step0 + s)) : (step0 + s); OF[((size_t)dir * MT + rbase + tt) * 512 + h * 128 + eq * 32 + el] = o; }
            }
        }
        __syncthreads();
    }
}
__device__ __forceinline__ void ph_hgrn_readout(const Prm& p, int l) {
    const int ev = l / 2; const bf16* PROJ = (const bf16*)(p.ws + WS_PROJ); const float* OF = (const float*)(p.ws + WS_OF); bf16* MIX = (bf16*)(p.ws + WS_MIX);
    const int lane = otid() & 63, gw = obid() * 8 + (otid() >> 6), ngw = gridDim.x * 8;
    const int nrows = (l < 2) ? MT : ML;
    for (int g = gw; g < nrows * 4; g += ngw) { const int r = g >> 2, h = g & 3;
        const float o0 = OF[(size_t)r * 512 + h * 128 + lane] + OF[((size_t)MT + r) * 512 + h * 128 + lane];
        const float o1 = OF[(size_t)r * 512 + h * 128 + 64 + lane] + OF[((size_t)MT + r) * 512 + h * 128 + 64 + lane];
        const float rstd = rsqrtf(wave_sum(o0 * o0 + o1 * o1) * (1.f / 128.f) + EPS);
        const float g0 = p.hgrn_g[(ev * 4 + h) * 128 + lane], g1 = p.hgrn_g[(ev * 4 + h) * 128 + 64 + lane];
        const float ga0 = bf2f(PROJ[(size_t)r * 4096 + 2048 + h * 128 + lane]), ga1 = bf2f(PROJ[(size_t)r * 4096 + 2048 + h * 128 + 64 + lane]);
        MIX[(size_t)r * D + h * 128 + lane] = f2bf(o0 * rstd * g0 * siluf_(ga0)); MIX[(size_t)r * D + h * 128 + 64 + lane] = f2bf(o1 * rstd * g1 * siluf_(ga1)); }
}

namespace dat {
using bf16x8 = __attribute__((ext_vector_type(8))) short;
using s16x4  = __attribute__((ext_vector_type(4))) short;
using f32x16 = __attribute__((ext_vector_type(16))) float;
constexpr int SHM_V = 64 * 128 * 2, SHM_K = 64 * 128 * 2;
#define DKSWZ(row, colB) ((row) * 256 + ((colB) ^ (((row) & 7) << 4)))
__device__ __forceinline__ int crow(int r, int hi) { return (r & 3) + 8 * (r >> 2) + 4 * hi; }
__device__ __forceinline__ unsigned cvtpk(float lo, float hi) { unsigned r; asm volatile("v_cvt_pk_bf16_f32 %0, %1, %2" : "=v"(r) : "v"(lo), "v"(hi)); return r; }
__device__ __forceinline__ int v_st(int k, int c) { const int kk = (k & ~0xC) | ((k & 4) << 1) | ((k & 8) >> 1); return ((kk >> 3) * 4 + (c >> 5)) * 512 + ((kk & 7) * 32 + (c & 31)) * 2; }
__device__ __forceinline__ int v_rd_base(int lane) { return ((lane & 3) << 3) | (((lane >> 2) & 3) << 6) | (((lane >> 4) & 1) << 5) | (((lane >> 5) & 1) << 8); }
constexpr int v_rd_off(int d0, int ks, int half) { return d0 * 512 + ks * 4096 + half * 2048; }
template <int OFF> __device__ __forceinline__ s16x4 tr_read(int vb) { s16x4 r; asm volatile("ds_read_b64_tr_b16 %0, %1 offset:%2" : "=&v"(r) : "v"(vb), "i"(OFF) : "memory"); return r; }
template <int VAR> __device__ __forceinline__ void softmax_pack(f32x16& p0, f32x16& p1, float negb, float& l, bf16x8& pa0, bf16x8& pa1, bf16x8& pa2, bf16x8& pa3) {
    if (VAR == 5) {
#pragma unroll
    for (int r = 0; r < 16; ++r) { p0[r] = __builtin_amdgcn_exp2f(p0[r]); p1[r] = __builtin_amdgcn_exp2f(p1[r]); } }
    else if (VAR != 1) {
#pragma unroll
    for (int r = 0; r < 16; ++r) { p0[r] = __builtin_amdgcn_exp2f(p0[r] + negb); p1[r] = __builtin_amdgcn_exp2f(p1[r] + negb); } }
    float ps = 0.f;
#pragma unroll
    for (int r = 0; r < 16; ++r) ps += p0[r] + p1[r];
    { auto rr = __builtin_amdgcn_permlane32_swap(__float_as_uint(ps), __float_as_uint(ps), false, false); ps = __uint_as_float(rr[0]) + __uint_as_float(rr[1]); }
    l += ps;
#define DPK4(P, BASE, OUT) do { unsigned a0 = cvtpk(P[BASE + 0], P[BASE + 1]), a1 = cvtpk(P[BASE + 2], P[BASE + 3]);   \
    unsigned b0 = cvtpk(P[BASE + 4], P[BASE + 5]), b1 = cvtpk(P[BASE + 6], P[BASE + 7]);                              \
    auto r0 = __builtin_amdgcn_permlane32_swap(a0, b0, false, false); auto r1 = __builtin_amdgcn_permlane32_swap(a1, b1, false, false); \
    u32x4 w = {r0[0], r1[0], r0[1], r1[1]}; OUT = *reinterpret_cast<bf16x8*>(&w); } while (0)
    DPK4(p0, 0, pa0); DPK4(p0, 8, pa1); DPK4(p1, 0, pa2); DPK4(p1, 8, pa3);
#undef DPK4
}
template <int D0> __device__ __forceinline__ void pv_one(f32x16& oa, int vb, const bf16x8 (&pa)[4]) {
    const s16x4 l0 = tr_read<v_rd_off(D0, 0, 0)>(vb), h0 = tr_read<v_rd_off(D0, 0, 1)>(vb), l1 = tr_read<v_rd_off(D0, 1, 0)>(vb), h1 = tr_read<v_rd_off(D0, 1, 1)>(vb);
    const s16x4 l2 = tr_read<v_rd_off(D0, 2, 0)>(vb), h2 = tr_read<v_rd_off(D0, 2, 1)>(vb), l3 = tr_read<v_rd_off(D0, 3, 0)>(vb), h3 = tr_read<v_rd_off(D0, 3, 1)>(vb);
    asm volatile("s_waitcnt lgkmcnt(0)" ::: "memory"); __builtin_amdgcn_sched_barrier(0);
#define DPK1(L, H) (bf16x8){L[0], L[1], L[2], L[3], H[0], H[1], H[2], H[3]}
    oa = __builtin_amdgcn_mfma_f32_32x32x16_bf16(pa[0], DPK1(l0, h0), oa, 0, 0, 0);
    oa = __builtin_amdgcn_mfma_f32_32x32x16_bf16(pa[1], DPK1(l1, h1), oa, 0, 0, 0);
    oa = __builtin_amdgcn_mfma_f32_32x32x16_bf16(pa[2], DPK1(l2, h2), oa, 0, 0, 0);
    oa = __builtin_amdgcn_mfma_f32_32x32x16_bf16(pa[3], DPK1(l3, h3), oa, 0, 0, 0);
#undef DPK1
}
#define DPK(L, H) (bf16x8){L[0], L[1], L[2], L[3], H[0], H[1], H[2], H[3]}
#define DVRD(KS, l0, h0, l1, h1, l2, h2, l3, h3) do { l0 = tr_read<v_rd_off(0, KS, 0)>(vb); h0 = tr_read<v_rd_off(0, KS, 1)>(vb); l1 = tr_read<v_rd_off(1, KS, 0)>(vb); h1 = tr_read<v_rd_off(1, KS, 1)>(vb); \
        l2 = tr_read<v_rd_off(2, KS, 0)>(vb); h2 = tr_read<v_rd_off(2, KS, 1)>(vb); l3 = tr_read<v_rd_off(3, KS, 0)>(vb); h3 = tr_read<v_rd_off(3, KS, 1)>(vb); } while (0)
#define DVMM(KS, l0, h0, l1, h1, l2, h2, l3, h3) do { o[0] = __builtin_amdgcn_mfma_f32_32x32x16_bf16(pa[KS], DPK(l0, h0), o[0], 0, 0, 0); o[1] = __builtin_amdgcn_mfma_f32_32x32x16_bf16(pa[KS], DPK(l1, h1), o[1], 0, 0, 0); \
        o[2] = __builtin_amdgcn_mfma_f32_32x32x16_bf16(pa[KS], DPK(l2, h2), o[2], 0, 0, 0); o[3] = __builtin_amdgcn_mfma_f32_32x32x16_bf16(pa[KS], DPK(l3, h3), o[3], 0, 0, 0); } while (0)
__device__ __forceinline__ void pv_all(f32x16 (&o)[4], int vb, const bf16x8 (&pa)[4]) {
    s16x4 a0, a1, a2, a3, a4, a5, a6, a7, b0, b1, b2, b3, b4, b5, b6, b7;
    DVRD(0, a0, a1, a2, a3, a4, a5, a6, a7);
    DVRD(1, b0, b1, b2, b3, b4, b5, b6, b7);
    asm volatile("s_waitcnt lgkmcnt(8)" ::: "memory"); __builtin_amdgcn_sched_barrier(0);
    DVMM(0, a0, a1, a2, a3, a4, a5, a6, a7);
    __builtin_amdgcn_sched_barrier(0);
    DVRD(2, a0, a1, a2, a3, a4, a5, a6, a7);
    asm volatile("s_waitcnt lgkmcnt(8)" ::: "memory"); __builtin_amdgcn_sched_barrier(0);
    DVMM(1, b0, b1, b2, b3, b4, b5, b6, b7);
    __builtin_amdgcn_sched_barrier(0);
    DVRD(3, b0, b1, b2, b3, b4, b5, b6, b7);
    asm volatile("s_waitcnt lgkmcnt(8)" ::: "memory"); __builtin_amdgcn_sched_barrier(0);
    DVMM(2, a0, a1, a2, a3, a4, a5, a6, a7);
    asm volatile("s_waitcnt lgkmcnt(0)" ::: "memory"); __builtin_amdgcn_sched_barrier(0);
    DVMM(3, b0, b1, b2, b3, b4, b5, b6, b7);
}
__device__ __forceinline__ void late_step5(f32x16& pc0, f32x16& pc1, f32x16& pn0, f32x16& pn1, f32x16 (&o)[4], bf16x8 (&pa)[4], float& l, const bf16x8 (&qr)[4],
                                           const LAS unsigned char* Kt, int kb0, int r32, int vb) {
#define LSB __builtin_amdgcn_sched_barrier(0)
#define LKRD(KS, f0, f1) do { const int cb_ = kb0 + (KS) * 32; const int ad0_ = (int)(uintptr_t)(Kt + DKSWZ(r32, cb_)), ad1_ = (int)(uintptr_t)(Kt + DKSWZ(32 + r32, cb_)); \
        asm volatile("ds_read_b128 %0, %1" : "=&v"(f0) : "v"(ad0_) : "memory"); asm volatile("ds_read_b128 %0, %1" : "=&v"(f1) : "v"(ad1_) : "memory"); } while (0)
#define LPV(KS, P, BASE) do { \
        o[0] = __builtin_amdgcn_mfma_f32_32x32x16_bf16(pa[KS], DPK(a0, a1), o[0], 0, 0, 0); LSB; \
        P[BASE + 0] = __builtin_amdgcn_exp2f(P[BASE + 0]); P[BASE + 1] = __builtin_amdgcn_exp2f(P[BASE + 1]); LSB; \
        o[1] = __builtin_amdgcn_mfma_f32_32x32x16_bf16(pa[KS], DPK(a2, a3), o[1], 0, 0, 0); LSB; \
        P[BASE + 2] = __builtin_amdgcn_exp2f(P[BASE + 2]); P[BASE + 3] = __builtin_amdgcn_exp2f(P[BASE + 3]); LSB; \
        o[2] = __builtin_amdgcn_mfma_f32_32x32x16_bf16(pa[KS], DPK(a4, a5), o[2], 0, 0, 0); LSB; \
        P[BASE + 4] = __builtin_amdgcn_exp2f(P[BASE + 4]); P[BASE + 5] = __builtin_amdgcn_exp2f(P[BASE + 5]); LSB; \
        o[3] = __builtin_amdgcn_mfma_f32_32x32x16_bf16(pa[KS], DPK(a6, a7), o[3], 0, 0, 0); LSB; \
        P[BASE + 6] = __builtin_amdgcn_exp2f(P[BASE + 6]); P[BASE + 7] = __builtin_amdgcn_exp2f(P[BASE + 7]); LSB; } while (0)
#define LQK(KS, P, BASE) do { \
        pn0 = __builtin_amdgcn_mfma_f32_32x32x16_bf16(kf0, qr[KS], pn0, 0, 0, 0); LSB; \
        ps += ((P[BASE + 0] + P[BASE + 1]) + (P[BASE + 2] + P[BASE + 3])) + ((P[BASE + 4] + P[BASE + 5]) + (P[BASE + 6] + P[BASE + 7])); \
        const unsigned c0_ = cvtpk(P[BASE + 0], P[BASE + 1]), c1_ = cvtpk(P[BASE + 2], P[BASE + 3]); LSB; \
        pn1 = __builtin_amdgcn_mfma_f32_32x32x16_bf16(kf1, qr[KS], pn1, 0, 0, 0); LSB; \
        { const unsigned c2_ = cvtpk(P[BASE + 4], P[BASE + 5]), c3_ = cvtpk(P[BASE + 6], P[BASE + 7]); auto r0_ = __builtin_amdgcn_permlane32_swap(c0_, c2_, false, false); auto r1_ = __builtin_amdgcn_permlane32_swap(c1_, c3_, false, false); \
          u32x4 w_ = {r0_[0], r1_[0], r0_[1], r1_[1]}; pa[KS] = *reinterpret_cast<bf16x8*>(&w_); } LSB; } while (0)
#define LGRP(KS, P, BASE, NEXTV) do { LKRD(KS, kf0, kf1); asm volatile("s_waitcnt lgkmcnt(2)" ::: "memory"); LSB; LPV(KS, P, BASE); asm volatile("s_waitcnt lgkmcnt(0)" ::: "memory"); LSB; NEXTV; LQK(KS, P, BASE); } while (0)
    s16x4 a0, a1, a2, a3, a4, a5, a6, a7; bf16x8 kf0, kf1; float ps = 0.f;
#pragma unroll
    for (int r = 0; r < 16; ++r) { pn0[r] = 0.f; pn1[r] = 0.f; }
    DVRD(0, a0, a1, a2, a3, a4, a5, a6, a7);
    LGRP(0, pc0, 0, DVRD(1, a0, a1, a2, a3, a4, a5, a6, a7));
    LGRP(1, pc0, 8, DVRD(2, a0, a1, a2, a3, a4, a5, a6, a7));
    LGRP(2, pc1, 0, DVRD(3, a0, a1, a2, a3, a4, a5, a6, a7));
    LGRP(3, pc1, 8, (void)0);
    { auto rr = __builtin_amdgcn_permlane32_swap(__float_as_uint(ps), __float_as_uint(ps), false, false); ps = __uint_as_float(rr[0]) + __uint_as_float(rr[1]); }
    l += ps;
#undef LGRP
#undef LQK
#undef LPV
#undef LKRD
#undef LSB
}
__device__ __forceinline__ void early_step5(f32x16& pc0, f32x16& pc1, f32x16& pn0, f32x16& pn1, f32x16 (&o)[4], bf16x8 (&pa)[4], float& l, const bf16x8 (&qr)[4],
                                            const LAS unsigned char* Kt, int kb0, int r32, int vb) {
#define ESB __builtin_amdgcn_sched_barrier(0)
#define EKRD(KS, f0, f1) do { const int cb_ = kb0 + (KS) * 32; const int ad0_ = (int)(uintptr_t)(Kt + DKSWZ(r32, cb_)), ad1_ = (int)(uintptr_t)(Kt + DKSWZ(32 + r32, cb_)); \
        asm volatile("ds_read_b128 %0, %1" : "=&v"(f0) : "v"(ad0_) : "memory"); asm volatile("ds_read_b128 %0, %1" : "=&v"(f1) : "v"(ad1_) : "memory"); } while (0)
#define EWAIT(n) do { asm volatile("s_waitcnt lgkmcnt(" #n ")" ::: "memory"); ESB; } while (0)
#define EEXP2(P, i) do { P[i] = __builtin_amdgcn_exp2f(P[i]); P[(i) + 1] = __builtin_amdgcn_exp2f(P[(i) + 1]); ESB; } while (0)
#define EPACK(KS, P, BASE) do { ps += ((P[BASE + 0] + P[BASE + 1]) + (P[BASE + 2] + P[BASE + 3])) + ((P[BASE + 4] + P[BASE + 5]) + (P[BASE + 6] + P[BASE + 7])); \
        const unsigned c0_ = cvtpk(P[BASE + 0], P[BASE + 1]), c1_ = cvtpk(P[BASE + 2], P[BASE + 3]), c2_ = cvtpk(P[BASE + 4], P[BASE + 5]), c3_ = cvtpk(P[BASE + 6], P[BASE + 7]); \
        auto r0_ = __builtin_amdgcn_permlane32_swap(c0_, c2_, false, false); auto r1_ = __builtin_amdgcn_permlane32_swap(c1_, c3_, false, false); \
        u32x4 w_ = {r0_[0], r1_[0], r0_[1], r1_[1]}; pa[KS] = *reinterpret_cast<bf16x8*>(&w_); ESB; } while (0)
#define EQK(KS, f0, f1, P, i) do { pn0 = __builtin_amdgcn_mfma_f32_32x32x16_bf16(f0, qr[KS], pn0, 0, 0, 0); ESB; EEXP2(P, i); \
        pn1 = __builtin_amdgcn_mfma_f32_32x32x16_bf16(f1, qr[KS], pn1, 0, 0, 0); ESB; EEXP2(P, (i) + 2); } while (0)
#define EPVX(KS, P, BASE) do { \
        o[0] = __builtin_amdgcn_mfma_f32_32x32x16_bf16(pa[KS], DPK(a0, a1), o[0], 0, 0, 0); ESB; EEXP2(P, BASE + 0); \
        o[1] = __builtin_amdgcn_mfma_f32_32x32x16_bf16(pa[KS], DPK(a2, a3), o[1], 0, 0, 0); ESB; EEXP2(P, BASE + 2); \
        o[2] = __builtin_amdgcn_mfma_f32_32x32x16_bf16(pa[KS], DPK(a4, a5), o[2], 0, 0, 0); ESB; EEXP2(P, BASE + 4); \
        o[3] = __builtin_amdgcn_mfma_f32_32x32x16_bf16(pa[KS], DPK(a6, a7), o[3], 0, 0, 0); ESB; EEXP2(P, BASE + 6); } while (0)
#define EPV(KS) do { \
        o[0] = __builtin_amdgcn_mfma_f32_32x32x16_bf16(pa[KS], DPK(a0, a1), o[0], 0, 0, 0); o[1] = __builtin_amdgcn_mfma_f32_32x32x16_bf16(pa[KS], DPK(a2, a3), o[1], 0, 0, 0); \
        o[2] = __builtin_amdgcn_mfma_f32_32x32x16_bf16(pa[KS], DPK(a4, a5), o[2], 0, 0, 0); o[3] = __builtin_amdgcn_mfma_f32_32x32x16_bf16(pa[KS], DPK(a6, a7), o[3], 0, 0, 0); ESB; } while (0)
    s16x4 a0, a1, a2, a3, a4, a5, a6, a7; bf16x8 kf0, kf1, kg0, kg1; float ps = 0.f;
#pragma unroll
    for (int r = 0; r < 16; ++r) { pn0[r] = 0.f; pn1[r] = 0.f; }
    EKRD(0, kf0, kf1); EKRD(1, kg0, kg1);
    EWAIT(2); EQK(0, kf0, kf1, pc0, 0);
    EWAIT(0); EKRD(2, kf0, kf1); EQK(1, kg0, kg1, pc0, 4);
    EPACK(0, pc0, 0);
    EKRD(3, kg0, kg1);
    EWAIT(2); EQK(2, kf0, kf1, pc0, 8);
    EWAIT(0); DVRD(0, a0, a1, a2, a3, a4, a5, a6, a7); EQK(3, kg0, kg1, pc0, 12);
    EPACK(1, pc0, 8);
    EWAIT(0); EPVX(0, pc1, 0); DVRD(1, a0, a1, a2, a3, a4, a5, a6, a7);
    EPACK(2, pc1, 0);
    EWAIT(0); EPVX(1, pc1, 8); DVRD(2, a0, a1, a2, a3, a4, a5, a6, a7);
    EPACK(3, pc1, 8);
    EWAIT(0); EPV(2); DVRD(3, a0, a1, a2, a3, a4, a5, a6, a7);
    EWAIT(0); EPV(3);
    { auto rr = __builtin_amdgcn_permlane32_swap(__float_as_uint(ps), __float_as_uint(ps), false, false); ps = __uint_as_float(rr[0]) + __uint_as_float(rr[1]); }
    l += ps;
#undef EPV
#undef EPVX
#undef EQK
#undef EPACK
#undef EEXP2
#undef EWAIT
#undef EKRD
#undef ESB
}
#undef DVRD
#undef DVMM
#undef DPK
template <int VAR> __device__ __forceinline__ void unit(const bf16* __restrict__ PROJ, bf16* __restrict__ MIX, int qrow0, int b, int h, bool ctxq, LAS unsigned char* lds,
                                     float negb, float lam, float onem, const float* __restrict__ sg, const float* __restrict__ qg, const float* __restrict__ ropet) {
    const int tid = otid(), wid = __builtin_amdgcn_readfirstlane(tid >> 6), lane = tid & 63, r32 = lane & 31, hi = lane >> 5, rb = wid >> 1, mp = wid & 1;
    LAS unsigned char* V_lds = lds; LAS unsigned char* K_lds = lds + 4 * SHM_V;
    LAS float* wsf = (LAS float*)(lds + 4 * SHM_V + 3 * SHM_K) + wid * 32;
    f32x16 o[4];
#pragma unroll
    for (int d = 0; d < 4; ++d)
#pragma unroll
        for (int r = 0; r < 16; ++r) o[d][r] = 0.f;
    float l = 0.f; bf16x8 qr[4];
    { const bf16* Qw = PROJ + (size_t)(qrow0 + rb * 32 + r32) * 4096 + 2560 + h * 128 + mp * 64 + hi * 8;
      float q[4][8]; float ss = 0.f;
#pragma unroll
      for (int d = 0; d < 4; ++d) { const u32x4 w = *(const u32x4*)(Qw + d * 16); const unsigned ww[4] = {w.x, w.y, w.z, w.w};
#pragma unroll
          for (int k = 0; k < 4; ++k) { q[d][2 * k] = __uint_as_float(ww[k] << 16); q[d][2 * k + 1] = __uint_as_float(ww[k] & 0xffff0000u); ss += q[d][2 * k] * q[d][2 * k] + q[d][2 * k + 1] * q[d][2 * k + 1]; } }
      { auto rr = __builtin_amdgcn_permlane32_swap(__float_as_uint(ss), __float_as_uint(ss), false, false); ss = __uint_as_float(rr[0]) + __uint_as_float(rr[1]); }
      const float rstd = rsqrtf(ss * (1.f / 64.f) + EPS);
#pragma unroll
      for (int d = 0; d < 4; ++d)
#pragma unroll
          for (int j = 0; j < 8; ++j) q[d][j] *= rstd * qg[d * 16 + hi * 8 + j];
      if (!ctxq) { const int t = (qrow0 + rb * 32 + r32) & (T - 1), pr = t >> 6, pc = t & 63;
#pragma unroll
          for (int j = 0; j < 8; ++j) { const int i = hi * 8 + j; const float c0 = ropet[(pr * 16 + i) * 2], s0 = ropet[(pr * 16 + i) * 2 + 1], c1 = ropet[(pc * 16 + i) * 2], s1 = ropet[(pc * 16 + i) * 2 + 1];
              const float a0 = q[0][j] * c0 - q[1][j] * s0, a1 = q[1][j] * c0 + q[0][j] * s0, a2 = q[2][j] * c1 - q[3][j] * s1, a3 = q[3][j] * c1 + q[2][j] * s1; q[0][j] = a0; q[1][j] = a1; q[2][j] = a2; q[3][j] = a3; } }
      const float qs = 0.125f * 1.4426950408889634f;
#pragma unroll
      for (int d = 0; d < 4; ++d) { u32x4 w; w.x = cvtpk(q[d][0] * qs, q[d][1] * qs); w.y = cvtpk(q[d][2] * qs, q[d][3] * qs); w.z = cvtpk(q[d][4] * qs, q[d][5] * qs); w.w = cvtpk(q[d][6] * qs, q[d][7] * qs); qr[d] = *reinterpret_cast<bf16x8*>(&w); } }
    const int vb0 = (int)(uintptr_t)V_lds + v_rd_base(lane);
    const int NT = ctxq ? (TC / 64) : ((T + TC) / 64);
    const int rb_lat = b * T, rb_ctx = ML + b * TC;
    const int kb0 = (mp * 64 + hi * 8) * 2;
    unsigned ksrc[2], vsrc[2];
#pragma unroll
    for (int i = 0; i < 2; ++i) { const int G = wid * 128 + i * 64 + lane;
        { const int row = G >> 4, ch = (G & 15) ^ (row & 7); ksrc[i] = (unsigned)(row * 8192 + (3072 + h * 128) * 2 + ch * 16); }
        { const int sub = G >> 5, within = G & 31, kk = (sub >> 2) * 8 + (within >> 2), cg = (sub & 3) * 4 + (within & 3); const int k = (kk & ~0xC) | ((kk & 4) << 1) | ((kk & 8) >> 1);
          vsrc[i] = (unsigned)(k * 8192 + (3584 + h * 128) * 2 + cg * 16); } }
#define DROWB(t) ((t) * 64 < T || ctxq ? (ctxq ? rb_ctx + (t) * 64 : rb_lat + (t) * 64) : rb_ctx + ((t) * 64 - T))
#define DDMA(SRC, t, LBUF) do { const char* tb_ = (const char*)PROJ + (size_t)DROWB(t) * 8192; _Pragma("unroll") for (int i_ = 0; i_ < 2; ++i_) \
        __builtin_amdgcn_global_load_lds((const unsigned*)(tb_ + SRC[i_]), (LAS unsigned*)((LBUF) + wid * 2048 + i_ * 1024), 16, 0, 0); } while (0)
#define DQKT(P0, P1, Kt) do { _Pragma("unroll") for (int r = 0; r < 16; ++r) { P0[r] = 0.f; P1[r] = 0.f; } \
        _Pragma("unroll") for (int d = 0; d < 4; ++d) { const int cb = kb0 + d * 32; \
            const bf16x8 b0 = *(const LAS bf16x8*)((Kt) + DKSWZ(r32, cb)); const bf16x8 b1 = *(const LAS bf16x8*)((Kt) + DKSWZ(32 + r32, cb)); \
            P0 = __builtin_amdgcn_mfma_f32_32x32x16_bf16(b0, qr[d], P0, 0, 0, 0); P1 = __builtin_amdgcn_mfma_f32_32x32x16_bf16(b1, qr[d], P1, 0, 0, 0); } } while (0)
#define DBAR() do { asm volatile("s_waitcnt lgkmcnt(0)" ::: "memory"); __builtin_amdgcn_s_barrier(); asm volatile("" ::: "memory"); } while (0)
    const bool late = wid >= 4;
    __syncthreads();
    DDMA(ksrc, 0, K_lds); DDMA(vsrc, 0, V_lds); DDMA(ksrc, 1, K_lds + SHM_K); DDMA(vsrc, 1, V_lds + SHM_V); DDMA(ksrc, 2, K_lds + 2 * SHM_K);
    asm volatile("s_waitcnt vmcnt(0)" ::: "memory"); DBAR();
    f32x16 pA0, pA1, pB0, pB1; bf16x8 pa[4];
    DQKT(pA0, pA1, K_lds);
    DBAR();
#define DSTEP(PC0, PC1, PN0, PN1, t) do { \
        if ((t) + 3 < NT) DDMA(ksrc, (t) + 3, K_lds + ((t) % 3) * SHM_K); if ((t) + 2 < NT) DDMA(vsrc, (t) + 2, V_lds + (((t) + 2) & 3) * SHM_V); \
        if (late && (t) > 0) { const int vbp = vb0 + (((t) - 1) & 3) * SHM_V; pv_one<0>(o[0], vbp, pa); pv_one<1>(o[1], vbp, pa); pv_one<2>(o[2], vbp, pa); pv_one<3>(o[3], vbp, pa); } \
        if ((t) + 1 < NT) DQKT(PN0, PN1, K_lds + (((t) + 1) % 3) * SHM_K); \
        softmax_pack<VAR>(PC0, PC1, negb, l, pa[0], pa[1], pa[2], pa[3]); \
        if (!late) { const int vb = vb0 + ((t) & 3) * SHM_V; pv_one<0>(o[0], vb, pa); pv_one<1>(o[1], vb, pa); pv_one<2>(o[2], vb, pa); pv_one<3>(o[3], vb, pa); } \
        if ((t) + 3 < NT) asm volatile("s_waitcnt vmcnt(4)" ::: "memory"); else asm volatile("s_waitcnt vmcnt(0)" ::: "memory"); \
        DBAR(); } while (0)
#define DSTEPL(PC0, PC1, PN0, PN1, t) do { \
        if ((t) + 3 < NT) DDMA(ksrc, (t) + 3, K_lds + ((t) % 3) * SHM_K); if ((t) + 2 < NT) DDMA(vsrc, (t) + 2, V_lds + (((t) + 2) & 3) * SHM_V); \
        late_step5(PC0, PC1, PN0, PN1, o, pa, l, qr, K_lds + (((t) + 1) % 3) * SHM_K, kb0, r32, vb0 + (((t) - 1) & 3) * SHM_V); \
        if ((t) + 3 < NT) asm volatile("s_waitcnt vmcnt(4)" ::: "memory"); else asm volatile("s_waitcnt vmcnt(0)" ::: "memory"); \
        DBAR(); } while (0)
    if (VAR == 5 && late && NT >= 4) {
        DSTEP(pA0, pA1, pB0, pB1, 0);
        for (int t = 1; t + 2 < NT; t += 2) {
            DSTEPL(pB0, pB1, pA0, pA1, t);
            DSTEPL(pA0, pA1, pB0, pB1, t + 1);
        }
        DSTEP(pB0, pB1, pA0, pA1, NT - 1);
    } else if (VAR == 5 && !late && NT >= 4) {
#define DSTEPE(PC0, PC1, PN0, PN1, t) do { \
        if ((t) + 3 < NT) DDMA(ksrc, (t) + 3, K_lds + ((t) % 3) * SHM_K); if ((t) + 2 < NT) DDMA(vsrc, (t) + 2, V_lds + (((t) + 2) & 3) * SHM_V); \
        early_step5(PC0, PC1, PN0, PN1, o, pa, l, qr, K_lds + (((t) + 1) % 3) * SHM_K, kb0, r32, vb0 + ((t) & 3) * SHM_V); \
        if ((t) + 3 < NT) asm volatile("s_waitcnt vmcnt(4)" ::: "memory"); else asm volatile("s_waitcnt vmcnt(0)" ::: "memory"); \
        DBAR(); } while (0)
        for (int t = 0; t + 2 < NT; t += 2) {
            DSTEPE(pA0, pA1, pB0, pB1, t);
            DSTEPE(pB0, pB1, pA0, pA1, t + 1);
        }
        DSTEPE(pA0, pA1, pB0, pB1, NT - 2);
        DSTEP(pB0, pB1, pA0, pA1, NT - 1);
#undef DSTEPE
    } else
    for (int t = 0; t < NT; t += 2) {
        DSTEP(pA0, pA1, pB0, pB1, t);
        DSTEP(pB0, pB1, pA0, pA1, t + 1);
    }
#undef DSTEPL
    if (late) { const int vbp = vb0 + ((NT - 1) & 3) * SHM_V; pv_one<0>(o[0], vbp, pa); pv_one<1>(o[1], vbp, pa); pv_one<2>(o[2], vbp, pa); pv_one<3>(o[3], vbp, pa); }
    __syncthreads();
#undef DSTEP
#undef DQKT
#undef DDMA
#undef DBAR
#undef DROWB
    if (hi == 0) wsf[r32] = l;
    asm volatile("s_waitcnt lgkmcnt(0)" ::: "memory");
    LAS float* xch = (LAS float*)lds + rb * (16 * 4 * 64);
    if (mp == 1) {
#pragma unroll
        for (int r = 0; r < 16; ++r) { const float i1 = lam * __builtin_amdgcn_rcpf(wsf[crow(r, hi)]);
#pragma unroll
            for (int d = 0; d < 4; ++d) xch[(r * 4 + d) * 64 + lane] = o[d][r] * i1; }
    }
    __syncthreads();
    if (mp == 0) {
        float g4[4];
#pragma unroll
        for (int d = 0; d < 4; ++d) g4[d] = sg[32 * d + r32] * onem;
        LAS unsigned char* ot = lds + 65536 + (size_t)(rb * 32) * 272;
#pragma unroll
        for (int r = 0; r < 16; ++r) { const int row = crow(r, hi); const float i0 = __builtin_amdgcn_rcpf(wsf[row]);
            float w[4], ss = 0.f;
#pragma unroll
            for (int d = 0; d < 4; ++d) { w[d] = o[d][r] * i0 - xch[(r * 4 + d) * 64 + lane]; ss += w[d] * w[d]; }
            ss += __shfl_xor(ss, 1); ss += __shfl_xor(ss, 2); ss += __shfl_xor(ss, 4); ss += __shfl_xor(ss, 8); ss += __shfl_xor(ss, 16);
            const float rstd = rsqrtf(ss * (1.f / 128.f) + EPS);
#pragma unroll
            for (int d = 0; d < 4; ++d) *(LAS bf16*)(ot + row * 272 + (32 * d + r32) * 2) = f2bf(w[d] * rstd * g4[d]); }
    }
    __syncthreads();
    {
        const int row = tid >> 2, cq = (tid & 3) * 64; const LAS unsigned char* sp = lds + 65536 + row * 272 + cq; bf16* dst = MIX + (size_t)(qrow0 + row) * D + 512 + h * 128 + cq / 2;
#pragma unroll
        for (int k = 0; k < 4; ++k) *(u32x4*)(dst + 8 * k) = *(const LAS u32x4*)(sp + 16 * k); }
}
}
template <int VAR> __device__ __forceinline__ void ph_attn(const Prm& p, int l, LAS unsigned char* ldsb) {
    const int ev = l / 2; const bf16* PROJ = (const bf16*)(p.ws + WS_PROJ); bf16* MIX = (bf16*)(p.ws + ((VAR == 0 || VAR == 5) ? WS_MIX : WS_OF));
    const float lam_init = 0.8f - 0.6f * __expf(-0.3f * (float)l);
    float d0 = 0.f, d1 = 0.f;
    for (int i = 0; i < 64; ++i) { d0 += p.dlam[(ev * 4 + 0) * 64 + i] * p.dlam[(ev * 4 + 1) * 64 + i]; d1 += p.dlam[(ev * 4 + 2) * 64 + i] * p.dlam[(ev * 4 + 3) * 64 + i]; }
    const float lam = __expf(d0) - __expf(d1) + lam_init;
    float gq = 0.f, gk = 0.f;
    for (int i = 0; i < 64; ++i) { gq = fmaxf(gq, fabsf(p.qn_g[ev * 64 + i])); gk = fmaxf(gk, fabsf(p.kn_g[ev * 64 + i])); }
    const float negb = -8.f * gq * gk * 1.4426950408889634f;
    const int vc = vcu_id();
    for (int u = vc; u < 512; u += gridDim.x) { const int v2 = (u < 256) ? u * 2 : (u - 256) * 2 + 1;
        const int b = v2 >> 7, h = (v2 >> 5) & 3, qb = v2 & 31;
        if (VAR == 5 && negb < -48.f) dat::unit<0>(PROJ, MIX, b * T + qb * 128, b, h, false, ldsb, negb, lam, 1.f - lam_init, p.subln_g + ev * 128, p.qn_g + ev * 64, (const float*)(p.ws + WS_ROPE));
        else dat::unit<VAR>(PROJ, MIX, b * T + qb * 128, b, h, false, ldsb, negb, lam, 1.f - lam_init, p.subln_g + ev * 128, p.qn_g + ev * 64, (const float*)(p.ws + WS_ROPE)); }
    if (l == 0) for (int u = vc; u < 32; u += gridDim.x) { const int b = u >> 3, h = (u >> 1) & 3, qb = u & 1;
        if (VAR == 5 && negb < -48.f) dat::unit<0>(PROJ, MIX, ML + b * TC + qb * 128, b, h, true, ldsb, negb, lam, 1.f - lam_init, p.subln_g + ev * 128, p.qn_g + ev * 64, (const float*)(p.ws + WS_ROPE));
        else dat::unit<VAR>(PROJ, MIX, ML + b * TC + qb * 128, b, h, true, ldsb, negb, lam, 1.f - lam_init, p.subln_g + ev * 128, p.qn_g + ev * 64, (const float*)(p.ws + WS_ROPE)); }
    __syncthreads();
}

namespace hg {
using bf16x8 = __attribute__((ext_vector_type(8))) short;
__device__ __forceinline__ int swz256(int row, int colB) { return row * 256 + (colB ^ ((row & 15) << 4)); }
__device__ __forceinline__ int swz128(int row, int colB) { return row * 128 + (colB ^ (((row >> 1) & 7) << 4)); }
constexpr int BFS = 132;
constexpr int L_BF = 0, L_TOT = 33792, L_LB = 35840, L_P = 0, L_RED = 8192, L_QP = 36864, L_KP = 53248, L_QT = 69632, L_VT = 86016, L_ST = 102400;
__device__ __forceinline__ float lbound(const float* lbl, int ev, int dir, int col) {
    if (ev == 0) return 0.f; const float l0 = lbl[(0 * 2 + dir) * 512 + col], l1 = lbl[(1 * 2 + dir) * 512 + col]; return 1.f / (1.f + __expf(l0 - l1)); }
__device__ __forceinline__ void pass1(const bf16* PROJ, const float* lbl, int ev, int dir, int h, int row0, LAS unsigned char* lds, int tid) {
    const int qt = tid >> 7, d = tid & 127; const float lb = lbound(lbl, ev, dir, h * 128 + d);
    LAS float* Bf = (LAS float*)(lds + L_BF); float run = 0.f;
    const bf16* zp = PROJ + (size_t)row0 * 4096 + 512 + dir * 512 + h * 128 + d;
    float zv[16];
#pragma unroll
    for (int i = 0; i < 16; ++i) { const int s = qt * 16 + i, tau = dir ? 63 - s : s; zv[i] = bf2f(zp[(size_t)tau * 4096]); }
#pragma unroll
    for (int i = 0; i < 16; ++i) { const float f = lb + (1.f - lb) * sigmoidf_(zv[i]); run += __builtin_amdgcn_logf(fmaxf(f, 1e-30f)) * 0.6931471805599453f;     Bf[(qt * 16 + i) * BFS + d] = run; }
    ((LAS float*)(lds + L_TOT))[qt * 128 + d] = run; if (qt == 0) ((LAS float*)(lds + L_LB))[d] = lb;
}
__device__ __forceinline__ void decay4(const LAS unsigned char* lds, int s, int d0, f32x4& b, f32x4& bmid, f32x4& blast, f32x4& lb) {
    const LAS float* Bf = (const LAS float*)(lds + L_BF); const LAS float* tot = (const LAS float*)(lds + L_TOT);
    const f32x4 t0 = *(const LAS f32x4*)(tot + d0), t1 = *(const LAS f32x4*)(tot + 128 + d0), t2 = *(const LAS f32x4*)(tot + 256 + d0), t3 = *(const LAS f32x4*)(tot + 384 + d0);
    const int qt = s >> 4; f32x4 pre = (f32x4){0.f, 0.f, 0.f, 0.f}; if (qt >= 1) pre += t0; if (qt >= 2) pre += t1; if (qt >= 3) pre += t2;
    b = *(const LAS f32x4*)(Bf + s * BFS + d0) + pre; bmid = t0 + t1; blast = (t0 + t1) + (t2 + t3); lb = *(const LAS f32x4*)((const LAS float*)(lds + L_LB) + d0);
}
__device__ __forceinline__ void pass1_pre(const float (&zv)[16], float lb, LAS unsigned char* lds, int tb, int tid) {
    const int qt = tid >> 7, d = tid & 127; LAS float* Bf = (LAS float*)(lds + tb + L_BF); float run = 0.f;
#pragma unroll
    for (int i = 0; i < 16; ++i) { const float f = lb + (1.f - lb) * sigmoidf_(zv[i]); run += __builtin_amdgcn_logf(fmaxf(f, 1e-30f)) * 0.6931471805599453f;     Bf[(qt * 16 + i) * BFS + d] = run; }
    ((LAS float*)(lds + tb + L_TOT))[qt * 128 + d] = run; if (qt == 0) ((LAS float*)(lds + tb + L_LB))[d] = lb;
}
__device__ __forceinline__ void decay4b(const LAS unsigned char* lds, int tb, int s, int d0, f32x4& b, f32x4& bmid, f32x4& lb) {
    const LAS float* Bf = (const LAS float*)(lds + tb + L_BF); const LAS float* tot = (const LAS float*)(lds + tb + L_TOT);
    const f32x4 t0 = *(const LAS f32x4*)(tot + d0), t1 = *(const LAS f32x4*)(tot + 128 + d0), t2 = *(const LAS f32x4*)(tot + 256 + d0);
    const int qt = s >> 4; f32x4 pre = (f32x4){0.f, 0.f, 0.f, 0.f}; if (qt >= 1) pre += t0; if (qt >= 2) pre += t1; if (qt >= 3) pre += t2;
    b = *(const LAS f32x4*)(Bf + s * BFS + d0) + pre; bmid = t0 + t1; lb = *(const LAS f32x4*)((const LAS float*)(lds + tb + L_LB) + d0);
}
__device__ __forceinline__ void stage_vt(const bf16* PROJ, int h, int row0, LAS unsigned char* lds, int tid) {
    const int tau = tid >> 3, e0 = (tid & 7) * 16; const bf16* vp = PROJ + (size_t)(row0 + tau) * 4096 + 1536 + h * 128 + e0;
    const u32x4 w0 = *(const u32x4*)vp, w1 = *(const u32x4*)(vp + 8); const unsigned ww[8] = {w0.x, w0.y, w0.z, w0.w, w1.x, w1.y, w1.z, w1.w};
#pragma unroll
    for (int i = 0; i < 8; ++i) { *(LAS bf16*)(lds + L_VT + swz128(e0 + 2 * i, tau * 2)) = (bf16)(ww[i] & 0xffffu); *(LAS bf16*)(lds + L_VT + swz128(e0 + 2 * i + 1, tau * 2)) = (bf16)(ww[i] >> 16); }
}
}
template <int LV> __device__ __forceinline__ void ph_hgrn_local(const Prm& p, int l, LAS unsigned char* lds) {
    constexpr int RS = 288, L_VR = hg::L_VT, L_KR = hg::L_QP;
    const int ev = l / 2; const bf16* PROJ = (const bf16*)(p.ws + WS_PROJ); bf16* DS = (bf16*)(p.ws + (LV == 0 ? WS_HDS : WS_XE)); float* G = (float*)(p.ws + (LV == 0 ? WS_HG : WS_OF));
    const int tid = otid(), lane = tid & 63, wv = tid >> 6;
    u32x4 zpre0, zpre1, vw0, vw1; float zv[16]; float lbt = 0.f;
#define HGL_LOAD(it_) do { const int c_ = (it_) % HG_NCH, chain_ = (it_) / HG_NCH, dir_ = chain_ & 1, h_ = (chain_ >> 1) & 3, b_ = chain_ >> 3; \
        const bool isc_ = c_ < 4; const int j_ = isc_ ? c_ : c_ - 4, nt_ = isc_ ? 4 : 64, tj_ = dir_ ? nt_ - 1 - j_ : j_; const int row0_ = isc_ ? ML + b_ * TC + tj_ * 64 : b_ * T + tj_ * 64; \
        { const int s_ = tid >> 3, tau_ = dir_ ? 63 - s_ : s_; const bf16* zp_ = PROJ + (size_t)(row0_ + tau_) * 4096 + 512 + dir_ * 512 + h_ * 128 + (tid & 7) * 16; zpre0 = *(const u32x4*)zp_; zpre1 = *(const u32x4*)(zp_ + 8); } \
        { const int qt_ = tid >> 7, d_ = tid & 127; const bf16* zc_ = PROJ + (size_t)(row0_ + (dir_ ? 63 - qt_ * 16 : qt_ * 16)) * 4096 + 512 + dir_ * 512 + h_ * 128 + d_; \
          _Pragma("unroll") for (int i = 0; i < 16; ++i) zv[i] = bf2f(dir_ ? *(zc_ - (size_t)i * 4096) : zc_[(size_t)i * 4096]); \
          const bf16* vp_ = PROJ + (size_t)(row0_ + (tid >> 3)) * 4096 + 1536 + h_ * 128 + (tid & 7) * 16; vw0 = *(const u32x4*)vp_; vw1 = *(const u32x4*)(vp_ + 8); } \
        lbt = hg::lbound(p.hgrn_lb, ev, dir_, h_ * 128 + (tid & 127)); } while (0)
    if (obid() < HG_ITEMS) HGL_LOAD(obid());
    for (int it = obid(); it < HG_ITEMS; it += gridDim.x) {
        const int c = it % HG_NCH, chain = it / HG_NCH, dir = chain & 1, h = (chain >> 1) & 3, b = chain >> 3;
        (void)c; (void)h; (void)b;
        __syncthreads();
        hg::pass1_pre(zv, lbt, lds, 0, tid);
        { LAS unsigned char* vr = lds + L_VR + (tid >> 3) * RS + (tid & 7) * 32; *(LAS u32x4*)vr = vw0; *(LAS u32x4*)(vr + 16) = vw1; }
        __syncthreads();
        {
            const int s = tid >> 3, dg = (tid & 7) * 16, tau = dir ? 63 - s : s;
            const unsigned zz[8] = {zpre0.x, zpre0.y, zpre0.z, zpre0.w, zpre1.x, zpre1.y, zpre1.z, zpre1.w}; float kh[16];
#pragma unroll
            for (int g4 = 0; g4 < 4; ++g4) { f32x4 bb, bm, bl, lb; hg::decay4(lds, s, dg + g4 * 4, bb, bm, bl, lb);
#pragma unroll
                for (int i = 0; i < 4; ++i) { const int k = g4 * 4 + i, d = dg + k; const float z = (k & 1) ? __uint_as_float(zz[k >> 1] & 0xffff0000u) : __uint_as_float(zz[k >> 1] << 16);
                    const float f = lb[i] + (1.f - lb[i]) * sigmoidf_(z);
                    kh[k] = (1.f - f) * __expf(bl[i] - bb[i]);
                    if (s == 0) G[(size_t)it * 128 + d] = __expf(bl[i]); } }
            LAS unsigned char* kr = lds + L_KR + tau * RS + dg * 2;
            *(LAS u32x4*)kr = (u32x4){dat::cvtpk(kh[0], kh[1]), dat::cvtpk(kh[2], kh[3]), dat::cvtpk(kh[4], kh[5]), dat::cvtpk(kh[6], kh[7])};
            *(LAS u32x4*)(kr + 16) = (u32x4){dat::cvtpk(kh[8], kh[9]), dat::cvtpk(kh[10], kh[11]), dat::cvtpk(kh[12], kh[13]), dat::cvtpk(kh[14], kh[15])};
        }
        __syncthreads();
        if (it + (int)gridDim.x < HG_ITEMS) HGL_LOAD(it + (int)gridDim.x);
        {
            f32x4 acc[8];
#pragma unroll
            for (int db = 0; db < 8; ++db) acc[db] = (f32x4){0.f, 0.f, 0.f, 0.f};
            const int r16 = lane & 15, q4 = lane >> 4;
            const int trb = (q4 * 8 + (r16 >> 2)) * RS + (r16 & 3) * 8;
#pragma unroll
            for (int ks = 0; ks < 2; ++ks) { const int kb = trb + ks * 32 * RS;
                dat::s16x4 al, ah, bl_[8], bh_[8];
                { const int ad = (int)(uintptr_t)(lds + L_VR) + kb + wv * 32; asm volatile("ds_read_b64_tr_b16 %0, %1" : "=&v"(al) : "v"(ad) : "memory"); asm volatile("ds_read_b64_tr_b16 %0, %1 offset:1152" : "=&v"(ah) : "v"(ad) : "memory"); }
#pragma unroll
                for (int db = 0; db < 8; ++db) { const int ad = (int)(uintptr_t)(lds + L_KR) + kb + db * 32; asm volatile("ds_read_b64_tr_b16 %0, %1" : "=&v"(bl_[db]) : "v"(ad) : "memory"); asm volatile("ds_read_b64_tr_b16 %0, %1 offset:1152" : "=&v"(bh_[db]) : "v"(ad) : "memory"); }
                asm volatile("s_waitcnt lgkmcnt(0)" ::: "memory"); __builtin_amdgcn_sched_barrier(0);
                const hg::bf16x8 a = (hg::bf16x8){al[0], al[1], al[2], al[3], ah[0], ah[1], ah[2], ah[3]};
#pragma unroll
                for (int db = 0; db < 8; ++db) { const hg::bf16x8 bb = (hg::bf16x8){bl_[db][0], bl_[db][1], bl_[db][2], bl_[db][3], bh_[db][0], bh_[db][1], bh_[db][2], bh_[db][3]};
                    acc[db] = __builtin_amdgcn_mfma_f32_16x16x32_bf16(a, bb, acc[db], 0, 0, 0); } }
            bf16* dst = DS + (size_t)it * 16384;
            __builtin_amdgcn_sched_barrier(0); asm volatile("s_nop 15\n\ts_nop 7" ::: "memory"); __builtin_amdgcn_sched_barrier(0);
#pragma unroll
            for (int db = 0; db < 8; ++db)
#pragma unroll
                for (int jj = 0; jj < 4; jj += 2) { const unsigned w2 = pk2(acc[db][jj], acc[db][jj + 1]); dst[(wv * 16 + q4 * 4 + jj) * 128 + db * 16 + r16] = (bf16)(w2 & 0xffffu); dst[(wv * 16 + q4 * 4 + jj + 1) * 128 + db * 16 + r16] = (bf16)(w2 >> 16); }
        }
    }
    __syncthreads();
}
__device__ __forceinline__ void ph_hgrn_scan(const Prm& p) {
    const bf16* __restrict__ DS = (const bf16*)(p.ws + WS_HDS); bf16* __restrict__ ST = (bf16*)(p.ws + WS_HST); const float* __restrict__ G = (const float*)(p.ws + WS_HG);
    static_assert(HG_NCH % 17 == 0, "scan groups");
    for (int gt = obid() * NTHREADS + otid(); gt < 32 * 128 * 32; gt += gridDim.x * NTHREADS) {
        const int chain = gt >> 12, rem = gt & 4095; const size_t eo = (size_t)(rem >> 5) * 128 + (rem & 31) * 4; const int dq = (rem & 31) * 4;
        float s0 = 0.f, s1 = 0.f, s2 = 0.f, s3 = 0.f;
#pragma unroll 1
        for (int c0 = 0; c0 < HG_NCH; c0 += 17) { u32x2 dv[17]; f32x4 g[17];
#pragma unroll
            for (int k = 0; k < 17; ++k) { const size_t it = (size_t)chain * HG_NCH + c0 + k; dv[k] = *(const u32x2*)(DS + it * 16384 + eo); g[k] = *(const f32x4*)(G + it * 128 + dq); }
#pragma unroll
            for (int k = 0; k < 17; ++k) { const size_t it = (size_t)chain * HG_NCH + c0 + k;
                u32x2 o; o.x = pk2(s0, s1); o.y = pk2(s2, s3); *(u32x2*)(ST + it * 16384 + eo) = o;
                s0 = g[k].x * s0 + __uint_as_float(dv[k].x << 16); s1 = g[k].y * s1 + __uint_as_float(dv[k].x & 0xffff0000u); s2 = g[k].z * s2 + __uint_as_float(dv[k].y << 16); s3 = g[k].w * s3 + __uint_as_float(dv[k].y & 0xffff0000u); } }
    }
}
template <int HV> __device__ __forceinline__ void ph_hgrn_out(const Prm& p, int l, LAS unsigned char* lds) {
    constexpr int L_P2 = hg::L_ST + 36864;
    constexpr int L_RED2 = L_P2;
    static_assert(L_P2 + 8192 <= LDS_BYTES - 256, "hgrn_out LDS map");
    const int ev = l / 2; const bf16* PROJ = (const bf16*)(p.ws + WS_PROJ); const bf16* ST = (const bf16*)(p.ws + WS_HST); bf16* MIX = (bf16*)(p.ws + (HV == 0 ? WS_MIX : WS_OF));
    const int tid = otid(), lane = tid & 63, wv = tid >> 6, r16 = lane & 15, q4 = lane >> 4;
    const int tt0 = (l < 2) ? 0 : 4;
    const int nitems = 16 * (HG_NCH - tt0);
    const bool bal = gridDim.x == 256 && nitems == 1088;
    for (int k = 0;; ++k) { int it = obid() + k * (int)gridDim.x;
        if (bal && k == 4) { const int m8 = obid() & 7; if (m8 != 1 && m8 != 2) break; it = 1024 + (obid() >> 3) + 32 * (m8 - 1); }
        if (it >= nitems) break;
        const int tt = tt0 + it % (HG_NCH - tt0), bh = it / (HG_NCH - tt0), h = bh & 3, b = bh >> 2;
        const bool isc = tt < 4; const int tj = isc ? tt : tt - 4, nt = isc ? 4 : 64; const int row0 = isc ? ML + b * TC + tj * 64 : b * T + tj * 64;
        const int s2 = tid >> 3, dg = (tid & 7) * 16;
        u32x4 zq[2][2], qq[2][2]; float zv[2][16]; hg::bf16x8 sfr[2][4]; float lbv[2];
        const u32x4 vw0 = *(const u32x4*)(PROJ + (size_t)(row0 + s2) * 4096 + 1536 + h * 128 + dg), vw1 = *(const u32x4*)(PROJ + (size_t)(row0 + s2) * 4096 + 1536 + h * 128 + dg + 8);
#pragma unroll
        for (int dir = 0; dir < 2; ++dir) { const int tau = dir ? 63 - s2 : s2; const bf16* rp = PROJ + (size_t)(row0 + tau) * 4096 + h * 128 + dg;
            zq[dir][0] = *(const u32x4*)(rp + 512 + dir * 512); zq[dir][1] = *(const u32x4*)(rp + 512 + dir * 512 + 8); qq[dir][0] = *(const u32x4*)rp; qq[dir][1] = *(const u32x4*)(rp + 8);
            lbv[dir] = hg::lbound(p.hgrn_lb, ev, dir, h * 128 + (tid & 127));
            const int c = (isc ? 0 : 4) + (dir ? nt - 1 - tj : tj); const bf16* sp = ST + (size_t)(((b * 4 + h) * 2 + dir) * HG_NCH + c) * 16384 + (wv * 16 + r16) * 128 + q4 * 8;
#pragma unroll
            for (int ks = 0; ks < 4; ++ks) sfr[dir][ks] = *(const hg::bf16x8*)(sp + ks * 32); }
        f32x4 o[4];
#pragma unroll
        for (int i = 0; i < 4; ++i) o[i] = (f32x4){0.f, 0.f, 0.f, 0.f};
        { const int qt = tid >> 7, d = tid & 127; const bf16* zp = PROJ + (size_t)(row0 + qt * 16) * 4096 + 512 + h * 128 + d;
#pragma unroll
          for (int i = 0; i < 16; ++i) zv[0][i] = bf2f(zp[(size_t)i * 4096]); }
        __syncthreads();
        { const unsigned ww[8] = {vw0.x, vw0.y, vw0.z, vw0.w, vw1.x, vw1.y, vw1.z, vw1.w};
#pragma unroll
          for (int i = 0; i < 8; ++i) { *(LAS bf16*)(lds + hg::L_VT + hg::swz128(dg + 2 * i, s2 * 2)) = (bf16)(ww[i] & 0xffffu); *(LAS bf16*)(lds + hg::L_VT + hg::swz128(dg + 2 * i + 1, s2 * 2)) = (bf16)(ww[i] >> 16); } }
        { const int qt = tid >> 7, d = tid & 127; const bf16* zp = PROJ + (size_t)(row0 + 63 - qt * 16) * 4096 + 512 + 512 + h * 128 + d;
#pragma unroll
          for (int i = 0; i < 16; ++i) zv[1][i] = bf2f(*(zp - (size_t)i * 4096)); }
        __builtin_amdgcn_sched_barrier(0);
        hg::pass1_pre(zv[0], lbv[0], lds, 0, tid);
        __builtin_amdgcn_sched_barrier(0);
        hg::pass1_pre(zv[1], lbv[1], lds, hg::L_ST, tid);
        __builtin_amdgcn_sched_barrier(0);
        __syncthreads();
        const u32x4 gw0 = *(const u32x4*)(PROJ + (size_t)(row0 + s2) * 4096 + 2048 + h * 128 + dg), gw1 = *(const u32x4*)(PROJ + (size_t)(row0 + s2) * 4096 + 2048 + h * 128 + dg + 8);
#pragma unroll
        for (int dir = 0; dir < 2; ++dir) { const int tb = dir ? hg::L_ST : 0;
            if (HV != 2) {
                const int tau = dir ? 63 - s2 : s2;
                const unsigned zz[8] = {zq[dir][0].x, zq[dir][0].y, zq[dir][0].z, zq[dir][0].w, zq[dir][1].x, zq[dir][1].y, zq[dir][1].z, zq[dir][1].w};
                const unsigned qv[8] = {qq[dir][0].x, qq[dir][0].y, qq[dir][0].z, qq[dir][0].w, qq[dir][1].x, qq[dir][1].y, qq[dir][1].z, qq[dir][1].w};
#pragma unroll
                for (int jj = 0; jj < 2; ++jj) { const int d0 = dg + jj * 8; float qp[8], kp[8], qt[8];
#pragma unroll
                    for (int g4 = 0; g4 < 2; ++g4) { f32x4 bb, bm, lb; hg::decay4b(lds, tb, s2, d0 + g4 * 4, bb, bm, lb);
#pragma unroll
                        for (int i = 0; i < 4; ++i) { const int k = jj * 8 + g4 * 4 + i; const float z = (k & 1) ? __uint_as_float(zz[k >> 1] & 0xffff0000u) : __uint_as_float(zz[k >> 1] << 16);
                            const float qf = (k & 1) ? __uint_as_float(qv[k >> 1] & 0xffff0000u) : __uint_as_float(qv[k >> 1] << 16);
                            const float f = lb[i] + (1.f - lb[i]) * sigmoidf_(z); const float rel = bb[i] - bm[i];
                            qp[g4 * 4 + i] = qf * __expf(fminf(rel, 80.f)); kp[g4 * 4 + i] = (1.f - f) * __expf(fminf(-rel, 80.f)); qt[g4 * 4 + i] = qf * __expf(bb[i]); } }
                    u32x4 w; w.x = dat::cvtpk(qp[0], qp[1]); w.y = dat::cvtpk(qp[2], qp[3]); w.z = dat::cvtpk(qp[4], qp[5]); w.w = dat::cvtpk(qp[6], qp[7]); *(LAS u32x4*)(lds + hg::L_QP + hg::swz256(tau, d0 * 2)) = w;
                    w.x = dat::cvtpk(kp[0], kp[1]); w.y = dat::cvtpk(kp[2], kp[3]); w.z = dat::cvtpk(kp[4], kp[5]); w.w = dat::cvtpk(kp[6], kp[7]); *(LAS u32x4*)(lds + hg::L_KP + hg::swz256(tau, d0 * 2)) = w;
                    w.x = dat::cvtpk(qt[0], qt[1]); w.y = dat::cvtpk(qt[2], qt[3]); w.z = dat::cvtpk(qt[4], qt[5]); w.w = dat::cvtpk(qt[6], qt[7]); *(LAS u32x4*)(lds + hg::L_QT + hg::swz256(tau, d0 * 2)) = w; }
            }
            __syncthreads();
            if (HV != 3) {
#pragma unroll
                for (int k2 = 0; k2 < 2; ++k2) { const int bi = wv * 2 + k2, rbk = bi >> 2, cbk = bi & 3; f32x4 acc = (f32x4){0.f, 0.f, 0.f, 0.f};
#pragma unroll
                    for (int ks = 0; ks < 4; ++ks) { const int cb = (ks * 32 + q4 * 8) * 2;
                        const hg::bf16x8 a = *(const LAS hg::bf16x8*)(lds + hg::L_QP + hg::swz256(rbk * 16 + r16, cb)); const hg::bf16x8 bb = *(const LAS hg::bf16x8*)(lds + hg::L_KP + hg::swz256(cbk * 16 + r16, cb));
                        acc = __builtin_amdgcn_mfma_f32_16x16x32_bf16(a, bb, acc, 0, 0, 0); }
                    const int tcol = cbk * 16 + r16;
#pragma unroll
                    for (int jj = 0; jj < 4; ++jj) { const int trow = rbk * 16 + q4 * 4 + jj; const bool keep = dir ? (tcol >= trow) : (tcol <= trow);
                        *(LAS bf16*)(lds + L_P2 + hg::swz128(trow, tcol * 2)) = keep ? f2bf(acc[jj]) : (bf16)0; } }
            }
            __syncthreads();
            if (HV != 3) {
#pragma unroll
                for (int ks = 0; ks < 2; ++ks) { const int cb = (ks * 32 + q4 * 8) * 2; const hg::bf16x8 bb = *(const LAS hg::bf16x8*)(lds + hg::L_VT + hg::swz128(wv * 16 + r16, cb));
#pragma unroll
                    for (int rbk = 0; rbk < 4; ++rbk) { const hg::bf16x8 a = *(const LAS hg::bf16x8*)(lds + L_P2 + hg::swz128(rbk * 16 + r16, cb)); o[rbk] = __builtin_amdgcn_mfma_f32_16x16x32_bf16(a, bb, o[rbk], 0, 0, 0); } }
#pragma unroll
                for (int ks = 0; ks < 4; ++ks) { const int cb = (ks * 32 + q4 * 8) * 2;
#pragma unroll
                    for (int rbk = 0; rbk < 4; ++rbk) { const hg::bf16x8 a = *(const LAS hg::bf16x8*)(lds + hg::L_QT + hg::swz256(rbk * 16 + r16, cb)); o[rbk] = __builtin_amdgcn_mfma_f32_16x16x32_bf16(a, dir ? sfr[1][ks] : sfr[0][ks], o[rbk], 0, 0, 0); } }
            }
            __syncthreads();
        }
        LAS float* ot = (LAS float*)(lds + hg::L_QP);
#pragma unroll
        for (int rbk = 0; rbk < 4; ++rbk)
#pragma unroll
            for (int jj = 0; jj < 4; ++jj) ot[(rbk * 16 + q4 * 4 + jj) * 132 + wv * 16 + r16] = o[rbk][jj];
        __syncthreads();
        { f32x4 ov[4]; float ss = 0.f;
#pragma unroll
          for (int k = 0; k < 4; ++k) { ov[k] = *(const LAS f32x4*)(ot + s2 * 132 + dg + 4 * k); ss += ov[k].x * ov[k].x + ov[k].y * ov[k].y + ov[k].z * ov[k].z + ov[k].w * ov[k].w; }
          ss += __shfl_xor(ss, 1); ss += __shfl_xor(ss, 2); ss += __shfl_xor(ss, 4);
          const float rstd = rsqrtf(ss * (1.f / 128.f) + EPS);
          const unsigned gwv[8] = {gw0.x, gw0.y, gw0.z, gw0.w, gw1.x, gw1.y, gw1.z, gw1.w}; const float* gp = p.hgrn_g + (ev * 4 + h) * 128 + dg; unsigned ow[8];
#pragma unroll
          for (int k = 0; k < 4; ++k) { const f32x4 g4 = *(const f32x4*)(gp + 4 * k);
              const float a0 = __uint_as_float(gwv[2 * k] << 16), a1 = __uint_as_float(gwv[2 * k] & 0xffff0000u), a2 = __uint_as_float(gwv[2 * k + 1] << 16), a3 = __uint_as_float(gwv[2 * k + 1] & 0xffff0000u);
              ow[2 * k] = pk2(ov[k].x * rstd * g4.x * siluf_(a0), ov[k].y * rstd * g4.y * siluf_(a1)); ow[2 * k + 1] = pk2(ov[k].z * rstd * g4.z * siluf_(a2), ov[k].w * rstd * g4.w * siluf_(a3)); }
          bf16* mp = MIX + (size_t)(row0 + s2) * D + h * 128 + dg;
          *(u32x4*)mp = (u32x4){ow[0], ow[1], ow[2], ow[3]}; *(u32x4*)(mp + 8) = (u32x4){ow[4], ow[5], ow[6], ow[7]}; }
    }
    __syncthreads();
}

__device__ __forceinline__ void ph_conv(const Prm& p, int l) {
    const int j = l / 2; const bf16* PROJ = (const bf16*)(p.ws + WS_PROJ); bf16* MIX = (bf16*)(p.ws + WS_MIX); const float* cw = p.conv_w + (size_t)j * 3 * D;
    const int nrows = (l < 2) ? MT : ML; const int total = (nrows / 8) * 128;
    for (int i = obid() * NTHREADS + otid(); i < total; i += gridDim.x * NTHREADS) {
        const int rb = i >> 7, c = (i & 127) * 8, r0 = rb * 8;
        const bool isc = r0 >= ML; const int t0 = isc ? ((r0 - ML) & (TC - 1)) : (r0 & (T - 1)); const int len = isc ? TC : T;
        float w0[8], w1[8], w2[8];
        { const f32x4 a0 = *(const f32x4*)(cw + c), a1 = *(const f32x4*)(cw + c + 4), b0 = *(const f32x4*)(cw + D + c), b1 = *(const f32x4*)(cw + D + c + 4), c0 = *(const f32x4*)(cw + 2 * D + c), c1 = *(const f32x4*)(cw + 2 * D + c + 4);
          w0[0] = a0.x; w0[1] = a0.y; w0[2] = a0.z; w0[3] = a0.w; w0[4] = a1.x; w0[5] = a1.y; w0[6] = a1.z; w0[7] = a1.w;
          w1[0] = b0.x; w1[1] = b0.y; w1[2] = b0.z; w1[3] = b0.w; w1[4] = b1.x; w1[5] = b1.y; w1[6] = b1.z; w1[7] = b1.w;
          w2[0] = c0.x; w2[1] = c0.y; w2[2] = c0.z; w2[3] = c0.w; w2[4] = c1.x; w2[5] = c1.y; w2[6] = c1.z; w2[7] = c1.w; }
        float up[8], uc[8], un[8];
#define CONV_U(dst, rr, ok) do { if (ok) { const u32x4 uu_ = *(const u32x4*)(PROJ + (size_t)(rr) * 2048 + 1024 + c); const unsigned uw_[4] = {uu_.x, uu_.y, uu_.z, uu_.w}; \
            _Pragma("unroll") for (int q = 0; q < 4; ++q) { dst[2 * q] = __uint_as_float(uw_[q] << 16); dst[2 * q + 1] = __uint_as_float(uw_[q] & 0xffff0000u); } } \
          else { _Pragma("unroll") for (int q = 0; q < 8; ++q) dst[q] = 0.f; } } while (0)
        CONV_U(up, r0 - 1, t0 > 0); CONV_U(uc, r0, true);
#pragma unroll
        for (int k = 0; k < 8; ++k) { const int r = r0 + k; CONV_U(un, r + 1, t0 + k + 1 < len);
            const u32x4 bg = *(const u32x4*)(PROJ + (size_t)r * 2048 + c); const unsigned bw[4] = {bg.x, bg.y, bg.z, bg.w}; u32x4 o; unsigned ow[4];
#pragma unroll
            for (int q = 0; q < 4; ++q) { const float y0 = up[2 * q] * w0[2 * q] + uc[2 * q] * w1[2 * q] + un[2 * q] * w2[2 * q], y1 = up[2 * q + 1] * w0[2 * q + 1] + uc[2 * q + 1] * w1[2 * q + 1] + un[2 * q + 1] * w2[2 * q + 1];
                ow[q] = pk2(__uint_as_float(bw[q] << 16) * y0, __uint_as_float(bw[q] & 0xffff0000u) * y1); }
            o.x = ow[0]; o.y = ow[1]; o.z = ow[2]; o.w = ow[3]; *(u32x4*)(MIX + (size_t)r * D + c) = o;
#pragma unroll
            for (int q = 0; q < 8; ++q) { up[q] = uc[q]; uc[q] = un[q]; } }
#undef CONV_U
    }
}

__device__ __forceinline__ void ph_router(const Prm& p, int l, LAS float* lds) {
    const int tid = otid(), lane = tid & 63, gw = obid() * 8 + (tid >> 6), ngw = gridDim.x * 8;
    const float* modv = (const float*)(p.ws + WS_MODV) + (size_t)l * 5 * 6144;
    bf16* X = (bf16*)(p.ws + WS_X); const bf16* Yb = (const bf16*)(p.ws + WS_H); bf16* H2 = (bf16*)(p.ws + WS_H2); float* AFF = (float*)(p.ws + WS_AFF);
    const float* rw = p.router_w + (size_t)l * D * NE;
    const bool split = (l < 2) && gridDim.x > 32, ctxw = split && obid() < 16;
    if (ctxw) { pg8::Gemm g{(const bf16*)(p.ws + WS_MIX), (const bf16*)(p.ws + WS_WOUT), MT, D, D}; pg8::OneUnit S{ML / 256 + obid() / 4, obid() % 4};
        pg8::EpiGY E{(bf16*)(p.ws + WS_H), (const float*)(p.ws + WS_MODV) + (size_t)l * 5 * 6144 + 2 * 1024, ML};
        pg8::gemm_phase<pg8::EpiGY, pg8::OneUnit, true, true>((LAS unsigned char*)lds, g, S, E);
        mini_barrier((unsigned*)(p.ws + WS_CTL) + CW_MINI + 64 * l, 16u); }
    __syncthreads();
    for (int i = tid; i < D * NE / 4; i += NTHREADS) { const f32x4 w = *(const f32x4*)(rw + (size_t)i * 4); const int c = i >> 2, e0 = (i & 3) * 4;
        const int pos = ((((c >> 9) << 1) | ((c >> 2) & 1)) * 256) + (((c & 511) >> 3) * 4) + (c & 3);
        lds[(e0 + 0) * D + pos] = w.x; lds[(e0 + 1) * D + pos] = w.y; lds[(e0 + 2) * D + pos] = w.z; lds[(e0 + 3) * D + pos] = w.w; }
    __syncthreads();
    int ebeg, eend, estep;
    if (!split) { ebeg = gw; eend = ((l < 2) ? MT : ML) / 2; estep = ngw; }
    else if (ctxw) { ebeg = ML / 2 + gw; eend = ebeg + 1; estep = 1; }
    else { ebeg = gw - 16 * 8; eend = ML / 2 + 384; estep = ngw - 16 * 8; }
    bool seen = false;
    u32x4 nyw[2][2], nxr[2][4];
#define ROUTER_ROW_OF(en_) ((split && !ctxw && (en_) >= ML / 2) ? ((en_) + 128) * 2 : (en_) * 2)
#define ROUTER_ISSUE(en_) do { \
        if (split && !ctxw && (en_) >= ML / 2 && !seen) { unsigned* ctr = (unsigned*)(p.ws + WS_CTL) + CW_MINI + 64 * l; unsigned sp = 0u; \
            while (xb_ld(ctr) < 16u) { __builtin_amdgcn_s_sleep(1); if (++sp > XB_SPIN_CAP) break; } \
            __builtin_amdgcn_fence(__ATOMIC_ACQUIRE, "agent"); seen = true; } \
        const int rr0_ = ROUTER_ROW_OF(en_); \
        _Pragma("unroll") for (int u = 0; u < 2; ++u) { const int r = rr0_ + u; const bool isc = r >= ML; \
            _Pragma("unroll") for (int j2 = 0; j2 < 2; ++j2) nyw[u][j2] = __builtin_nontemporal_load((const u32x4*)(Yb + (size_t)r * D + 8 * lane + 512 * j2)); \
            if (l == 0) { const float* xin = isc ? p.ctx + (size_t)(r - ML) * D : p.x + (size_t)r * D; \
                _Pragma("unroll") for (int j = 0; j < 4; ++j) nxr[u][j] = __builtin_nontemporal_load((const u32x4*)(xin + CJ(j))); } \
            else { \
                _Pragma("unroll") for (int j2 = 0; j2 < 2; ++j2) nxr[u][j2] = __builtin_nontemporal_load((const u32x4*)(X + (size_t)r * D + 8 * lane + 512 * j2)); \
                nxr[u][2] = nxr[u][0]; nxr[u][3] = nxr[u][1]; } } } while (0)
    if (ebeg < eend) ROUTER_ISSUE(ebeg);
    for (int en = ebeg; en < eend; en += estep) {
        const int r0 = ROUTER_ROW_OF(en);
        u32x4 cyw[2][2], cxr[2][4];
#pragma unroll
        for (int u = 0; u < 2; ++u) {
#pragma unroll
            for (int j = 0; j < 2; ++j) cyw[u][j] = nyw[u][j];
#pragma unroll
            for (int j = 0; j < 4; ++j) cxr[u][j] = nxr[u][j]; }
        if (en + estep < eend) ROUTER_ISSUE(en + estep);
        f32x4 hv[2][4];
#pragma unroll
        for (int u = 0; u < 2; ++u) { const int r = r0 + u; const bool isc = r >= ML; const int mr = isc ? 4 : (r >> 12);
            f32x4 v[4]; float s = 0.f;
            if (l == 0) {
#pragma unroll
                for (int j = 0; j < 4; ++j) v[j] = (f32x4){__uint_as_float(cxr[u][j].x), __uint_as_float(cxr[u][j].y), __uint_as_float(cxr[u][j].z), __uint_as_float(cxr[u][j].w)}; }
            else {
#pragma unroll
                for (int j2 = 0; j2 < 2; ++j2) { v[2 * j2] = (f32x4){0.f, 0.f, 0.f, 0.f}; v[2 * j2 + 1] = (f32x4){0.f, 0.f, 0.f, 0.f}; acc_bf16x8(v[2 * j2], v[2 * j2 + 1], cxr[u][j2], 1.f); } }
            const u32x4 (&yw)[2] = cyw[u];
#pragma unroll
            for (int j2 = 0; j2 < 2; ++j2) acc_bf16x8(v[2 * j2], v[2 * j2 + 1], yw[j2], 1.f);
            store_xrow(X + (size_t)r * D, lane, v);
#pragma unroll
            for (int j = 0; j < 4; ++j) s += v[j].x * v[j].x + v[j].y * v[j].y + v[j].z * v[j].z + v[j].w * v[j].w;
            const float rstd = rsqrtf(wave_sum(s) * (1.f / D) + EPS);
#pragma unroll
            for (int j = 0; j < 4; ++j) { const int c = CJ(j);
                const f32x4 g = *(const f32x4*)(p.norm2_g + l * D + c), sh = *(const f32x4*)(modv + (size_t)mr * 6144 + 3 * 1024 + c), scl = *(const f32x4*)(modv + (size_t)mr * 6144 + 4 * 1024 + c);
                hv[u][j] = (v[j] * rstd * g) * (scl + 1.f) + sh; }
#pragma unroll
            for (int j2 = 0; j2 < 2; ++j2) *(u32x4*)(H2 + (size_t)r * D + 8 * lane + 512 * j2) = pack_bf16x8(hv[u][2 * j2], hv[u][2 * j2 + 1]); }
        float pa0[16], pa1[16];
#pragma unroll
        for (int e = 0; e < 16; ++e) { float a0 = 0.f, a1 = 0.f;
#pragma unroll
            for (int j = 0; j < 4; ++j) { const f32x4 w = *(const LAS f32x4*)(lds + e * D + j * 256 + 4 * lane);
                a0 += hv[0][j].x * w.x + hv[0][j].y * w.y + hv[0][j].z * w.z + hv[0][j].w * w.w; a1 += hv[1][j].x * w.x + hv[1][j].y * w.y + hv[1][j].z * w.z + hv[1][j].w * w.w; }
            pa0[e] = a0; pa1[e] = a1; }
        float lg[2];
#pragma unroll
        for (int u = 0; u < 2; ++u) { float v8[8], v4[4], v2[2], z;
            { const bool hi = (lane & 32) != 0;
#pragma unroll
              for (int k = 0; k < 8; ++k) { const float lo_ = u ? pa1[k] : pa0[k], hi_ = u ? pa1[k + 8] : pa0[k + 8]; const float keep = hi ? hi_ : lo_, send = hi ? lo_ : hi_; v8[k] = keep + __shfl_xor(send, 32); } }
            { const bool hi = (lane & 16) != 0;
#pragma unroll
              for (int k = 0; k < 4; ++k) { const float keep = hi ? v8[k + 4] : v8[k], send = hi ? v8[k] : v8[k + 4]; v4[k] = keep + __shfl_xor(send, 16); } }
            { const bool hi = (lane & 8) != 0;
#pragma unroll
              for (int k = 0; k < 2; ++k) { const float keep = hi ? v4[k + 2] : v4[k], send = hi ? v4[k] : v4[k + 2]; v2[k] = keep + __shfl_xor(send, 8); } }
            { const bool hi = (lane & 4) != 0; const float keep = hi ? v2[1] : v2[0], send = hi ? v2[0] : v2[1]; z = keep + __shfl_xor(send, 4); }
            z += __shfl_xor(z, 2); z += __shfl_xor(z, 1); lg[u] = z; }
        const int ex_id = ((lane >> 5) & 1) * 8 + ((lane >> 4) & 1) * 4 + ((lane >> 3) & 1) * 2 + ((lane >> 2) & 1);
#pragma unroll
        for (int u = 0; u < 2; ++u) { const int r = r0 + u; const bool isc = r >= ML; const float lgt = lg[u];
            float mx = lgt; mx = fmaxf(mx, __shfl_xor(mx, 4)); mx = fmaxf(mx, __shfl_xor(mx, 8)); mx = fmaxf(mx, __shfl_xor(mx, 16)); mx = fmaxf(mx, __shfl_xor(mx, 32));
            const float ex = __expf(lgt - mx); float den = ex; den += __shfl_xor(den, 4); den += __shfl_xor(den, 8); den += __shfl_xor(den, 16); den += __shfl_xor(den, 32);
            if ((lane & 3) == 0) { const float a = ex / den;
                if (!isc) AFF[((size_t)(r >> 12) * NE + ex_id) * T + (r & (T - 1))] = a;
                else { const int rc = r - ML; AFF[(size_t)NB * NE * T + ((size_t)(rc >> 8) * NE + ex_id) * TC + (rc & (TC - 1))] = a; } } }
    }
    __syncthreads();
}

__device__ __forceinline__ void ph_topk(const Prm& p, int l, LAS float* lds) {
    const float* AFF = (const float*)(p.ws + WS_AFF); float* GATE = (float*)(p.ws + WS_GATE); int* SEL = (int*)(p.ws + WS_SEL); int* TOKSLOT = (int*)(p.ws + WS_TOKSLOT);
    const int tid = otid(), lane = tid & 63, wv = tid >> 6; const int nitems = (l < 2) ? 128 : 64;
    LAS unsigned* hist = (LAS unsigned*)lds;
    LAS unsigned* ctl = hist + 256;
    LAS unsigned* wtot = hist + 272;
    for (int it = obid(); it < nitems; it += gridDim.x) {
        const bool isc = it >= 64; const int be = it & 63, b = be >> 4, e = be & 15; const int n = isc ? TC : T, cap = isc ? CAPC : CAP;
        const float* a = AFF + (isc ? (size_t)NB * NE * T + (size_t)be * TC : (size_t)be * T);
        const bool valid = tid * 8 < n;
        unsigned bits[8];
        if (valid) { const u32x4 w0 = *(const u32x4*)(a + tid * 8), w1 = *(const u32x4*)(a + tid * 8 + 4); bits[0] = w0.x; bits[1] = w0.y; bits[2] = w0.z; bits[3] = w0.w; bits[4] = w1.x; bits[5] = w1.y; bits[6] = w1.z; bits[7] = w1.w; }
        else {
#pragma unroll
            for (int j = 0; j < 8; ++j) bits[j] = 0u; }
        unsigned prefix = 0u, remaining = (unsigned)cap;
#pragma unroll 1
        for (int pass = 0; pass < 4; ++pass) { const int shift = 24 - 8 * pass;
            __syncthreads();
            if (tid < 256) hist[tid] = 0u;
            __syncthreads();
            if (valid) {
#pragma unroll
                for (int j = 0; j < 8; ++j) { const bool m = (pass == 0) || ((bits[j] >> (shift + 8)) == prefix); if (m) __hip_atomic_fetch_add(&hist[(bits[j] >> shift) & 255u], 1u, __ATOMIC_RELAXED, __HIP_MEMORY_SCOPE_WORKGROUP); } }
            __syncthreads();
            if (wv == 0) { const unsigned c0 = hist[4 * lane], c1 = hist[4 * lane + 1], c2 = hist[4 * lane + 2], c3 = hist[4 * lane + 3]; const unsigned s = c0 + c1 + c2 + c3;
                unsigned incl = s;
#pragma unroll
                for (int o = 1; o < 64; o <<= 1) { const unsigned t = __shfl_down(incl, o); if (lane + o < 64) incl += t; }
                unsigned above = incl - s;
                if (above < remaining && remaining <= above + s) { unsigned B;
                    if (above + c3 >= remaining) B = 4 * lane + 3; else { above += c3; if (above + c2 >= remaining) B = 4 * lane + 2; else { above += c2; if (above + c1 >= remaining) B = 4 * lane + 1; else { above += c1; B = 4 * lane; } } }
                    ctl[0] = (prefix << 8) | B; ctl[1] = remaining - above; } }
            __syncthreads();
            prefix = ctl[0]; remaining = ctl[1];
        }
        const unsigned thr = prefix;
        unsigned cg = 0u, ce = 0u;
#pragma unroll
        for (int j = 0; j < 8; ++j) { cg += (valid && bits[j] > thr) ? 1u : 0u; ce += (valid && bits[j] == thr) ? 1u : 0u; }
        unsigned pk = cg | (ce << 16), incl = pk;
#pragma unroll
        for (int o = 1; o < 64; o <<= 1) { const unsigned t = __shfl_up(incl, o); if (lane >= o) incl += t; }
        __syncthreads();
        if (lane == 63) wtot[wv] = incl;
        __syncthreads();
        unsigned base = 0u, total = 0u;
#pragma unroll
        for (int w = 0; w < 8; ++w) { const unsigned t = wtot[w]; if (w < wv) base += t; total += t; }
        const unsigned excl = base + incl - pk; unsigned gpos = excl & 0xffffu, epos = excl >> 16; const unsigned ngt = total & 0xffffu;
        if (valid) {
#pragma unroll
            for (int j = 0; j < 8; ++j) { const int t0 = tid * 8 + j; const int row = isc ? ML + b * TC + t0 : b * T + t0; int slot = -1;
                if (bits[j] > thr) { slot = (int)gpos; ++gpos; } else if (bits[j] == thr) { if (epos < remaining) slot = (int)(ngt + epos); ++epos; }
                if (slot >= 0) { const int xr = isc ? 2048 + b * CAPC + slot : b * CAP + slot; SEL[e * XR + xr] = row; GATE[e * XR + xr] = __uint_as_float(bits[j]); TOKSLOT[(size_t)row * NE + e] = xr; }
                else TOKSLOT[(size_t)row * NE + e] = -1; } }
    }
    __syncthreads();
}
__device__ __forceinline__ void ph_dispatch(const Prm& p, int l) {
    const int lane = otid() & 63, gw = obid() * 8 + (otid() >> 6), ngw = gridDim.x * 8;
    const int* SEL = (const int*)(p.ws + WS_SEL); const bf16* H2 = (const bf16*)(p.ws + WS_H2); bf16* XE = (bf16*)(p.ws + WS_XE);
    const int rows_e = (l < 2) ? 2176 : 2048;
    for (int g = gw; g < NE * rows_e; g += ngw) { const int e = g / rows_e, xr = g % rows_e; const int src = SEL[e * XR + xr];
        const u32x4* s4 = (const u32x4*)(H2 + (size_t)src * D); u32x4* d4 = (u32x4*)(XE + ((size_t)e * XR + xr) * D);
        d4[lane] = s4[lane]; d4[lane + 64] = s4[lane + 64]; }
}

__global__ void __launch_bounds__(NTHREADS, 2) mega(Prm p) {
    extern __shared__ __attribute__((aligned(16))) unsigned char lds_raw[];
    LAS unsigned char* ldsb = (LAS unsigned char*)lds_raw;
    LAS float* lds = (LAS float*)ldsb;
    volatile LAS unsigned* misc = (volatile LAS unsigned*)(ldsb + LDS_BYTES - 256);
    if (threadIdx.x < 32) misc[threadIdx.x] = 0u;
    __syncthreads();
    XcdBarrier bar = xcd_barrier_post((unsigned*)(p.ws + WS_CTL) + 1024, misc + 8);
#define GRID_BAR() do { XcdBarrier b_; { unsigned long long w_ = (unsigned long long)p.ws; asm volatile("" : "+s"(w_)); b_.bar = (unsigned*)((unsigned char*)w_ + WS_CTL) + 1024; } b_.x = xb_xcc_id(); b_.st = misc + 8; xcd_barrier(b_); } while (0)
    (void)bar;
    ph_setup(p, lds);
    ph_convert(p, 0, ldsb);
    GRID_BAR();
    if (DUP_PHASE == 13) { ph_setup(p, lds); GRID_BAR(); ph_setup(p, lds); GRID_BAR(); ph_setup(p, lds); GRID_BAR(); }
    for (int l = 0; l < DEPTH; ++l) {
        if (l > 0) ph_convert(p, l, ldsb);
        ph_norm1(p, l);
        GRID_BAR();
        ph_gemm_in(p, l, ldsb);
        GRID_BAR();
        if (DUP_PHASE == 1) { ph_gemm_in(p, l, ldsb); GRID_BAR(); }
        if (DUP_PHASE == 2) { ph_convert(p, l, ldsb); GRID_BAR(); }
        if (DUP_PHASE == 14) { ph_probe_read<0>(p, l); GRID_BAR(); }
        if (DUP_PHASE == 41) { ph_probe_read<1>(p, l); GRID_BAR(); }
        if (DUP_PHASE == 42) { ph_probe_read<2>(p, l); GRID_BAR(); }
        if (DUP_PHASE == 43) { ph_probe_read<3>(p, l); GRID_BAR(); }
        if (DUP_PHASE == 44) { ph_probe_cvt<4>(p, l); GRID_BAR(); }
        if (DUP_PHASE == 45) { ph_probe_cvt<5>(p, l); GRID_BAR(); }
        if (DUP_PHASE == 18 && l >= 1) { ph_norm1(p, l, false); GRID_BAR(); }
        if ((l & 1) == 0) {
            if (DUP_PHASE == 5 || DUP_PHASE == 7) { ph_hgrn_local<9>(p, l, ldsb); GRID_BAR(); }
            if (DUP_PHASE == 7) { ph_hgrn_local<9>(p, l, ldsb); GRID_BAR(); }
            ph_qkprep(p, l);
            ph_hgrn_local<0>(p, l, ldsb);
            GRID_BAR();
            ph_hgrn_scan(p);
            GRID_BAR();
            if (DUP_PHASE == 3) { ph_hgrn_local<9>(p, l, ldsb); GRID_BAR(); }
            if (DUP_PHASE == 4) { ph_hgrn_scan(p); GRID_BAR(); }
            ph_attn<5>(p, l, ldsb);
            ph_hgrn_out<0>(p, l, ldsb);
            GRID_BAR();
            if (DUP_PHASE == 5) { ph_attn<0>(p, l, ldsb); GRID_BAR(); }
            if (DUP_PHASE == 21) { ph_attn<1>(p, l, ldsb); GRID_BAR(); }
            if (DUP_PHASE == 22) { ph_attn<2>(p, l, ldsb); GRID_BAR(); }
            if (DUP_PHASE == 23) { ph_attn<3>(p, l, ldsb); GRID_BAR(); }
            if (DUP_PHASE == 24) { ph_attn<4>(p, l, ldsb); GRID_BAR(); }
            if (DUP_PHASE == 6) { ph_hgrn_out<5>(p, l, ldsb); GRID_BAR(); }
            if (DUP_PHASE == 31) { ph_hgrn_out<1>(p, l, ldsb); GRID_BAR(); }
            if (DUP_PHASE == 32) { ph_hgrn_out<2>(p, l, ldsb); GRID_BAR(); }
            if (DUP_PHASE == 33) { ph_hgrn_out<3>(p, l, ldsb); GRID_BAR(); }
        } else {
            ph_conv(p, l);
            GRID_BAR();
            if (DUP_PHASE == 17) { ph_conv(p, l); GRID_BAR(); }
        }
        ph_gemm_out(p, l, ldsb);
        GRID_BAR();
        ph_router(p, l, lds);
        GRID_BAR();
        ph_topk(p, l, lds);
        GRID_BAR();
        if (DUP_PHASE == 70) { ph_topk(p, l, lds); GRID_BAR(); }
        ph_expert_up(p, l, ldsb);
        GRID_BAR();
        if (DUP_PHASE == 10) { ph_expert_up(p, l, ldsb); GRID_BAR(); }
        ph_expert_down(p, l, ldsb);
        GRID_BAR();
        if (DUP_PHASE == 11) { ph_expert_down(p, l, ldsb); GRID_BAR(); }
        if (DUP_PHASE == 12) { GRID_BAR(); GRID_BAR(); GRID_BAR(); GRID_BAR(); GRID_BAR(); GRID_BAR(); GRID_BAR(); GRID_BAR(); GRID_BAR(); GRID_BAR(); }
    }
    ph_final(p);
    if (DUP_PHASE == 19) { GRID_BAR(); ph_final(p); GRID_BAR(); ph_final(p); }
}

extern "C" void kernel_launch(void* const* d_in, const int* in_sizes, int n_in, void* d_out, int out_size, void* d_ws, size_t ws_size, hipStream_t stream) {
    static int grid = 0;
    if (grid == 0) {
        if (n_in != 23 || out_size != ML * D || ws_size < WS_END) { fprintf(stderr, "kernel_launch: unexpected shapes: n_in %d out %d ws %zu (need %zu)\n", n_in, out_size, ws_size, (size_t)WS_END); grid = -1; return; }
        int dev = 0, cus = 0, per_cu = 0;
        if (hipGetDevice(&dev) != hipSuccess || hipDeviceGetAttribute(&cus, hipDeviceAttributeMultiprocessorCount, dev) != hipSuccess) { grid = -1; return; }
        if (hipFuncSetAttribute((const void*)mega, hipFuncAttributeMaxDynamicSharedMemorySize, LDS_BYTES) != hipSuccess) { fprintf(stderr, "kernel_launch: hipFuncSetAttribute failed\n"); grid = -1; return; }
        if (hipOccupancyMaxActiveBlocksPerMultiprocessor(&per_cu, (const void*)mega, NTHREADS, LDS_BYTES) != hipSuccess || per_cu < 1) fprintf(stderr, "kernel_launch: occupancy query says %d\n", per_cu);
        (void)hipGetLastError();
        grid = cus;
    }
    if (grid < 0) return;
    (void)hipMemsetAsync((char*)d_ws + WS_CTL, 0, 1 * MiB, stream);
    Prm p{};
    const float** pp = (const float**)&p;
    for (int i = 0; i < 23; ++i) pp[i] = (const float*)d_in[i];
    p.out = (float*)d_out; p.ws = (unsigned char*)d_ws;
    hipLaunchKernelGGL(mega, dim3(grid), dim3(NTHREADS), LDS_BYTES, stream, p);
}
```
